# Optimizing an MI355X kernel written in HIP

```python
import math
import jax, jax.numpy as jnp
from jax import lax
import numpy as np


D_MODEL = 2048
BATCH = 16
SEQ = 2048
DEPTH = 2

N_EVEN = (DEPTH + 1) // 2
N_ODD = DEPTH // 2
EPS = 1e-6
CONV_K = 4

LRU_WIDTH = D_MODEL // 2
LRU_BLOCKS = 8
LRU_BLOCK = LRU_WIDTH // LRU_BLOCKS
LRU_C = 8.0

MLSTM_WIDTH = D_MODEL // 2
MLSTM_HEADS = 4
MLSTM_HD = MLSTM_WIDTH // MLSTM_HEADS
MLSTM_CHUNK = 64

IN_COLS = 2 * LRU_WIDTH + 4 * MLSTM_WIDTH + 2 * MLSTM_HEADS
IN_SPLITS = (LRU_WIDTH, 2 * LRU_WIDTH, 2 * LRU_WIDTH + 2 * MLSTM_WIDTH,
             2 * LRU_WIDTH + 3 * MLSTM_WIDTH, 2 * LRU_WIDTH + 4 * MLSTM_WIDTH,
             2 * LRU_WIDTH + 4 * MLSTM_WIDTH + MLSTM_HEADS)

S5_WIDTH = D_MODEL
S5_GROUP = 16
S5_GROUPS = S5_WIDTH // S5_GROUP
S5_STATE = 64
S5_CHUNK = 64

MOE_GROUPS = 4
MOE_PER_GROUP = 4
MOE_EXPERTS = MOE_GROUPS * MOE_PER_GROUP
MOE_TOP_K = 2
MOE_FF = 512

kernel_name = 'hybrid_rglru_mlstm_s5_hmoe'


def rmsnorm(x, g):
    xf = x.astype(jnp.float32)
    y = xf * lax.rsqrt(jnp.mean(xf * xf, axis=-1, keepdims=True) + EPS)
    return y.astype(x.dtype) * g


def causal_dwconv(x, w, b):
    k, s = w.shape[0], x.shape[1]
    xp = jnp.pad(x, ((0, 0), (k - 1, 0), (0, 0)))
    out = b
    for j in range(k):
        out = out + w[j] * xp[:, j:j + s]
    return out


def _lin_combine(e1, e2):
    a1, b1 = e1
    a2, b2 = e2
    return a1 * a2, a2 * b1 + b2


def cmul(ar, ai, br, bi):
    return ar * br - ai * bi, ar * bi + ai * br


def _cplx_combine(e1, e2):
    ar1, ai1, br1, bi1 = e1
    ar2, ai2, br2, bi2 = e2
    ar, ai = cmul(ar1, ai1, ar2, ai2)
    pr, pi = cmul(ar2, ai2, br1, bi1)
    return ar, ai, pr + br2, pi + bi2


def rg_lru(x, w_a, b_a, w_x, b_x, lam):
    bsz, s, width = x.shape
    xf = x.astype(jnp.float32)
    xb = xf.reshape(bsz, s, LRU_BLOCKS, LRU_BLOCK)
    r = jax.nn.sigmoid(jnp.einsum('bsni,nij->bsnj', xb, w_a).reshape(bsz, s, width) + b_a)
    i = jax.nn.sigmoid(jnp.einsum('bsni,nij->bsnj', xb, w_x).reshape(bsz, s, width) + b_x)
    log_a = -LRU_C * r * jax.nn.softplus(-lam.astype(jnp.float32))
    a = jnp.exp(log_a)
    gated = jnp.sqrt(-jnp.expm1(2.0 * log_a)) * (i * xf)
    _, h = lax.associative_scan(_lin_combine, (a, gated), axis=1)
    return h


def mlstm_chunkwise(q, k, v, i_pre, f_pre):
    bsz, s, nh, dh = q.shape
    L = MLSTM_CHUNK
    nc = s // L
    f32 = jnp.float32

    def to_chunks(t):
        t = t.astype(f32).reshape((bsz, nc, L) + t.shape[2:])
        return jnp.moveaxis(t, (1, 3), (0, 2))

    qc = to_chunks(q)
    kc = to_chunks(k) * (dh ** -0.5)
    vc = to_chunks(v)
    ic = to_chunks(i_pre)
    lfc = to_chunks(jax.nn.log_sigmoid(f_pre.astype(f32)))
    causal = jnp.tril(jnp.ones((L, L), dtype=bool))

    def step(carry, inp):
        c_st, n_st, m_st = carry
        qb, kb, vb, ib, lfb = inp
        bcum = jnp.cumsum(lfb, axis=-1)
        d = bcum[..., :, None] - bcum[..., None, :] + ib[..., None, :]
        d = jnp.where(causal, d, -jnp.inf)
        g = bcum + m_st[..., None]
        m_t = jnp.maximum(g, jnp.max(d, axis=-1))
        w_intra = jnp.exp(d - m_t[..., None])
        w_inter = jnp.exp(g - m_t)
        s_qk = jnp.einsum('bhtd,bhjd->bhtj', qb, kb) * w_intra
        num = (jnp.einsum('bhtj,bhjd->bhtd', s_qk, vb)
               + w_inter[..., None] * jnp.einsum('bhde,bhte->bhtd', c_st, qb))
        den = jnp.sum(s_qk, axis=-1) + w_inter * jnp.einsum('bhd,bhtd->bht', n_st, qb)
        h = num / jnp.maximum(jnp.abs(den), jnp.exp(-m_t))[..., None]
        b_last = bcum[..., -1]
        d_end = b_last[..., None] - bcum + ib
        m_new = jnp.maximum(b_last + m_st, jnp.max(d_end, axis=-1))
        w_end = jnp.exp(d_end - m_new[..., None])
        decay = jnp.exp(b_last + m_st - m_new)
        c_new = decay[..., None, None] * c_st + jnp.einsum('bhj,bhjd,bhje->bhde', w_end, vb, kb)
        n_new = decay[..., None] * n_st + jnp.einsum('bhj,bhjd->bhd', w_end, kb)
        return (c_new, n_new, m_new), h

    init = (jnp.zeros((bsz, nh, dh, dh), f32), jnp.zeros((bsz, nh, dh), f32),
            jnp.zeros((bsz, nh), f32))
    _, h = lax.scan(step, init, (qc, kc, vc, ic, lfc))
    return jnp.transpose(h, (1, 0, 3, 2, 4)).reshape(bsz, s, nh, dh)


def rglru_mlstm_mixer(h, w_in, lru_conv_w, lru_conv_b, lru_w_a, lru_b_a, lru_w_x, lru_b_x,
                      lru_lam, m_conv_w, m_conv_b, m_i_bias, m_f_bias, m_head_g, w_out):
    bsz, s, _ = h.shape
    f32 = jnp.float32
    p = h @ w_in
    lru_x, lru_z, m_qk, m_v, m_o, m_i, m_f = jnp.split(p, IN_SPLITS, axis=-1)
    y_a = rg_lru(causal_dwconv(lru_x, lru_conv_w, lru_conv_b), lru_w_a, lru_b_a,
                 lru_w_x, lru_b_x, lru_lam) * jax.nn.gelu(lru_z.astype(f32))
    qk = jax.nn.silu(causal_dwconv(m_qk, m_conv_w, m_conv_b))
    q, k = jnp.split(qk, 2, axis=-1)

    def heads(t):
        return t.reshape(bsz, s, MLSTM_HEADS, MLSTM_HD)

    i_pre = m_i.astype(f32) + m_i_bias
    f_pre = m_f.astype(f32) + m_f_bias
    hm = mlstm_chunkwise(heads(q), heads(k), heads(m_v), i_pre, f_pre)
    hm = jax.nn.sigmoid(heads(m_o).astype(f32)) * hm
    hm = hm * lax.rsqrt(jnp.mean(hm * hm, axis=-1, keepdims=True) + EPS)
    y_b = hm.reshape(bsz, s, MLSTM_WIDTH) * m_head_g
    y = jnp.concatenate([y_a, y_b], axis=-1).astype(h.dtype)
    return (y @ w_out).astype(h.dtype)


def s5_mixer(h, w_in, a_re, a_im, log_step, b_re, b_im, c_re, c_im, d_skip, w_glu_v, w_glu_g):
    bsz, s, _ = h.shape
    f32 = jnp.float32
    nc = s // S5_CHUNK
    u = (h @ w_in).astype(f32).reshape(bsz, nc, S5_CHUNK, S5_GROUPS, S5_GROUP)
    u = jnp.swapaxes(u, 0, 1)
    a_re = a_re.astype(f32)
    a_im = a_im.astype(f32)
    dt = jnp.exp(log_step.astype(f32))[:, None]
    mag = jnp.exp(a_re * dt)
    lr, li = mag * jnp.cos(a_im * dt), mag * jnp.sin(a_im * dt)
    den = a_re * a_re + a_im * a_im
    fr = ((lr - 1.0) * a_re + li * a_im) / den
    fi = (li * a_re - (lr - 1.0) * a_im) / den
    bbr, bbi = cmul(fr[..., None], fi[..., None], b_re.astype(f32), b_im.astype(f32))
    c_re = c_re.astype(f32)
    c_im = c_im.astype(f32)
    dsk = d_skip.astype(f32).reshape(S5_GROUPS, S5_GROUP)

    def step(carry, ub):
        xr0, xi0 = carry
        bur = jnp.einsum('blgc,gpc->blgp', ub, bbr)
        bui = jnp.einsum('blgc,gpc->blgp', ub, bbi)
        ar = jnp.broadcast_to(lr, bur.shape)
        ai = jnp.broadcast_to(li, bur.shape)
        pr, pi, sr, si = lax.associative_scan(_cplx_combine, (ar, ai, bur, bui), axis=1)
        cr, ci = cmul(pr, pi, xr0[:, None], xi0[:, None])
        xr = sr + cr
        xi = si + ci
        y = jnp.einsum('blgp,gcp->blgc', xr, c_re) - jnp.einsum('blgp,gcp->blgc', xi, c_im)
        return (xr[:, -1], xi[:, -1]), y + dsk * ub

    init = (jnp.zeros((bsz, S5_GROUPS, S5_STATE), f32), jnp.zeros((bsz, S5_GROUPS, S5_STATE), f32))
    _, y = lax.scan(step, init, u)
    y = jax.nn.gelu(jnp.swapaxes(y, 0, 1).reshape(bsz, s, S5_WIDTH)).astype(h.dtype)
    return ((y @ w_glu_v) * jax.nn.sigmoid(y @ w_glu_g)).astype(h.dtype)


def hier_moe(h, w_coarse, b_coarse, w_fine, b_fine, w_gate, w_up, w_down):
    bsz, s, d = h.shape
    f32 = jnp.float32
    t = h.reshape(-1, d)
    lc = (t @ w_coarse).astype(f32) + b_coarse
    pc = jax.nn.softmax(lc, axis=-1)
    g_idx = jnp.argmax(lc, axis=-1)
    p_g = jnp.take_along_axis(pc, g_idx[:, None], axis=-1)
    lf = ((t @ w_fine).astype(f32) + b_fine).reshape(-1, MOE_GROUPS, MOE_PER_GROUP)
    lf_sel = jnp.take_along_axis(lf, g_idx[:, None, None], axis=1)[:, 0]
    top_v, top_i = lax.top_k(lf_sel, MOE_TOP_K)
    w2 = jax.nn.softmax(top_v, axis=-1) * p_g
    expert_id = g_idx[:, None] * MOE_PER_GROUP + top_i
    gates = jnp.sum(jax.nn.one_hot(expert_id, MOE_EXPERTS, dtype=f32) * w2[..., None], axis=1)
    y = jnp.zeros(t.shape, f32)
    for e in range(MOE_EXPERTS):
        he = jax.nn.silu(t @ w_gate[e]) * (t @ w_up[e])
        y = y + gates[:, e:e + 1] * (he @ w_down[e])
    return y.reshape(bsz, s, d).astype(h.dtype)


def setup_inputs(seed: int = 0) -> dict:
    key = jax.random.key(seed)
    ks = iter(jax.random.split(key, 64))
    f32 = jnp.float32
    NE, NO = N_EVEN, N_ODD

    def nrm(shape, scale):
        return jax.random.normal(next(ks), shape, f32) * scale

    x = nrm((BATCH, SEQ, D_MODEL), 1.0)
    norm_mix = 1.0 + nrm((DEPTH, D_MODEL), 0.02)
    norm_ffn = 1.0 + nrm((DEPTH, D_MODEL), 0.02)
    norm_final = 1.0 + nrm((D_MODEL,), 0.02)
    ab_w_in = nrm((NE, D_MODEL, IN_COLS), D_MODEL ** -0.5)
    lru_conv_w = nrm((NE, CONV_K, LRU_WIDTH), CONV_K ** -0.5)
    lru_conv_b = nrm((NE, LRU_WIDTH), 0.01)
    lru_w_a = nrm((NE, LRU_BLOCKS, LRU_BLOCK, LRU_BLOCK), LRU_BLOCK ** -0.5)
    lru_b_a = nrm((NE, LRU_WIDTH), 0.01)
    lru_w_x = nrm((NE, LRU_BLOCKS, LRU_BLOCK, LRU_BLOCK), LRU_BLOCK ** -0.5)
    lru_b_x = nrm((NE, LRU_WIDTH), 0.01)
    u = jax.random.uniform(next(ks), (NE, LRU_WIDTH), f32, 0.9, 0.999)
    a0 = u ** (1.0 / LRU_C)
    lru_lam = jnp.log(a0) - jnp.log1p(-a0)
    m_conv_w = nrm((NE, CONV_K, 2 * MLSTM_WIDTH), CONV_K ** -0.5)
    m_conv_b = nrm((NE, 2 * MLSTM_WIDTH), 0.01)
    m_i_bias = nrm((NE, MLSTM_HEADS), 0.1)
    m_f_bias = jnp.linspace(3.0, 6.0, MLSTM_HEADS, dtype=f32)[None] + nrm((NE, MLSTM_HEADS), 0.1)
    m_head_g = 1.0 + nrm((NE, MLSTM_WIDTH), 0.02)
    ab_w_out = nrm((NE, D_MODEL, D_MODEL), D_MODEL ** -0.5)
    s5_w_in = nrm((NO, D_MODEL, S5_WIDTH), D_MODEL ** -0.5)
    n_idx = jnp.arange(S5_STATE, dtype=f32)
    s5_a_re = -0.5 + nrm((NO, S5_GROUPS, S5_STATE), 0.01)
    s5_a_im = math.pi * n_idx + nrm((NO, S5_GROUPS, S5_STATE), 0.01)
    s5_log_step = jax.random.uniform(next(ks), (NO, S5_GROUPS), f32, math.log(0.001), math.log(0.1))
    s5_b_re = nrm((NO, S5_GROUPS, S5_STATE, S5_GROUP), S5_GROUP ** -0.5)
    s5_b_im = nrm((NO, S5_GROUPS, S5_STATE, S5_GROUP), S5_GROUP ** -0.5)
    s5_c_re = nrm((NO, S5_GROUPS, S5_GROUP, S5_STATE), S5_STATE ** -0.5)
    s5_c_im = nrm((NO, S5_GROUPS, S5_GROUP, S5_STATE), S5_STATE ** -0.5)
    s5_d = nrm((NO, S5_WIDTH), 1.0)
    s5_w_glu_v = nrm((NO, S5_WIDTH, D_MODEL), S5_WIDTH ** -0.5)
    s5_w_glu_g = nrm((NO, S5_WIDTH, D_MODEL), S5_WIDTH ** -0.5)
    moe_w_coarse = nrm((DEPTH, D_MODEL, MOE_GROUPS), D_MODEL ** -0.5)
    moe_b_coarse = nrm((DEPTH, MOE_GROUPS), 0.01)
    moe_w_fine = nrm((DEPTH, D_MODEL, MOE_EXPERTS), D_MODEL ** -0.5)
    moe_b_fine = nrm((DEPTH, MOE_EXPERTS), 0.01)
    moe_w_gate = nrm((DEPTH, MOE_EXPERTS, D_MODEL, MOE_FF), D_MODEL ** -0.5)
    moe_w_up = nrm((DEPTH, MOE_EXPERTS, D_MODEL, MOE_FF), D_MODEL ** -0.5)
    moe_w_down = nrm((DEPTH, MOE_EXPERTS, MOE_FF, D_MODEL), MOE_FF ** -0.5)
    return {'x': x, 'norm_mix': norm_mix, 'norm_ffn': norm_ffn, 'norm_final': norm_final,
            'ab_w_in': ab_w_in, 'lru_conv_w': lru_conv_w, 'lru_conv_b': lru_conv_b,
            'lru_w_a': lru_w_a, 'lru_b_a': lru_b_a, 'lru_w_x': lru_w_x, 'lru_b_x': lru_b_x,
            'lru_lam': lru_lam, 'm_conv_w': m_conv_w, 'm_conv_b': m_conv_b,
            'm_i_bias': m_i_bias, 'm_f_bias': m_f_bias, 'm_head_g': m_head_g, 'ab_w_out': ab_w_out,
            's5_w_in': s5_w_in, 's5_a_re': s5_a_re, 's5_a_im': s5_a_im, 's5_log_step': s5_log_step,
            's5_b_re': s5_b_re, 's5_b_im': s5_b_im, 's5_c_re': s5_c_re, 's5_c_im': s5_c_im,
            's5_d': s5_d, 's5_w_glu_v': s5_w_glu_v, 's5_w_glu_g': s5_w_glu_g,
            'moe_w_coarse': moe_w_coarse, 'moe_b_coarse': moe_b_coarse,
            'moe_w_fine': moe_w_fine, 'moe_b_fine': moe_b_fine,
            'moe_w_gate': moe_w_gate, 'moe_w_up': moe_w_up, 'moe_w_down': moe_w_down}


def reference(x, norm_mix, norm_ffn, norm_final, ab_w_in, lru_conv_w, lru_conv_b, lru_w_a, lru_b_a,
              lru_w_x, lru_b_x, lru_lam, m_conv_w, m_conv_b, m_i_bias, m_f_bias, m_head_g, ab_w_out,
              s5_w_in, s5_a_re, s5_a_im, s5_log_step, s5_b_re, s5_b_im, s5_c_re, s5_c_im, s5_d,
              s5_w_glu_v, s5_w_glu_g, moe_w_coarse, moe_b_coarse, moe_w_fine, moe_b_fine,
              moe_w_gate, moe_w_up, moe_w_down):
    for layer in range(DEPTH):
        j = layer // 2
        h = rmsnorm(x, norm_mix[layer])
        if layer % 2 == 0:
            x = x + rglru_mlstm_mixer(h, ab_w_in[j], lru_conv_w[j], lru_conv_b[j], lru_w_a[j],
                                      lru_b_a[j], lru_w_x[j], lru_b_x[j], lru_lam[j], m_conv_w[j],
                                      m_conv_b[j], m_i_bias[j], m_f_bias[j], m_head_g[j], ab_w_out[j])
        else:
            x = x + s5_mixer(h, s5_w_in[j], s5_a_re[j], s5_a_im[j], s5_log_step[j], s5_b_re[j],
                             s5_b_im[j], s5_c_re[j], s5_c_im[j], s5_d[j], s5_w_glu_v[j], s5_w_glu_g[j])
        x = x + hier_moe(rmsnorm(x, norm_ffn[layer]), moe_w_coarse[layer], moe_b_coarse[layer],
                         moe_w_fine[layer], moe_b_fine[layer], moe_w_gate[layer], moe_w_up[layer],
                         moe_w_down[layer])
    return rmsnorm(x, norm_final)
```

```cpp
#include <hip/hip_runtime.h>
#include <cstdio>
#include <cstdint>

#define LAS __attribute__((address_space(3)))
#define GAS __attribute__((address_space(1)))
typedef unsigned short bf16;
typedef short bf16x8 __attribute__((ext_vector_type(8)));
typedef float f32x4 __attribute__((ext_vector_type(4)));
typedef float f32x2 __attribute__((ext_vector_type(2)));
typedef unsigned u32x4 __attribute__((ext_vector_type(4)));
typedef unsigned u32x2 __attribute__((ext_vector_type(2)));
typedef GAS unsigned gu32;
#define RLX_AGENT __ATOMIC_RELAXED, __HIP_MEMORY_SCOPE_AGENT
#define LDS_WAIT() asm volatile("s_waitcnt lgkmcnt(0)" ::: "memory")
#define VM_WAIT() asm volatile("s_waitcnt vmcnt(0)" ::: "memory")

#ifndef MK_PER_PHASE
#define MK_PER_PHASE 0
#endif

constexpr int T = 32768, D = 2048, SEQ = 2048, NBATCH = 16;
constexpr int NWAVES = 8, NT = 512;
constexpr int INCOLS = 6152, PN = 6144;
constexpr int NEXP = 16, FF = 512;
constexpr int NPAIR = 24;
constexpr int SLOT_ROWS = 32768 + NPAIR * 256;
constexpr float EPS = 1e-6f;
constexpr int NPHASE = 18;

typedef __bf16 bf16x2_t __attribute__((ext_vector_type(2)));
__device__ __forceinline__ unsigned pk2(float lo, float hi) { f32x2 v = {lo, hi}; bf16x2_t b = __builtin_convertvector(v, bf16x2_t); return __builtin_bit_cast(unsigned, b); }
__device__ __forceinline__ unsigned f2bf(float f) { return pk2(f, 0.f) & 0xffffu; }
__device__ __forceinline__ float bf_lo(unsigned w) { return __builtin_bit_cast(float, w << 16); }
__device__ __forceinline__ float bf_hi(unsigned w) { return __builtin_bit_cast(float, w & 0xffff0000u); }
__device__ __forceinline__ float bf2f(bf16 b) { return __builtin_bit_cast(float, ((unsigned)b) << 16); }
__device__ __forceinline__ float wave_sum(float v) {
#pragma unroll
    for (int o = 1; o < 64; o <<= 1) v += __shfl_xor(v, o);
    return v;
}
__device__ __forceinline__ float sigmoidf_(float x) { return __builtin_amdgcn_rcpf(1.0f + __expf(-x)); }
__device__ __forceinline__ float gelu_tanh(float x) { const float u = 0.7978845608028654f * (x + 0.044715f * x * x * x); return x * __builtin_amdgcn_rcpf(1.0f + __expf(-2.0f * u)); }
__device__ __forceinline__ float siluf_(float x) { return x * __builtin_amdgcn_rcpf(1.0f + __expf(-x)); }

namespace pg8 {
constexpr int BM = 256, BK = 64, HALF = 128, HTB = HALF * BK * 2, STAGE_BYTES = 8 * HTB, NXCD = 8, WGM = 8;
__host__ __device__ __forceinline__ int lds_byte(int r, int c) { const int st = (r >> 4) * 2 + (c >> 5), rr = r & 15, cc = c & 31, ob = rr * 64 + cc * 2; return st * 1024 + (ob ^ (((ob >> 9) & 1) << 5)); }
__host__ __device__ __forceinline__ void stage_rc(int b, int& R, int& C) { const int st = b / 1024, sb = b % 1024, swz = sb ^ (((sb >> 9) & 1) << 5); R = (st >> 1) * 16 + swz / 64; C = (st & 1) * 32 + (swz % 64) / 2; }
__host__ __device__ __forceinline__ int perm32(int rho) { const int n = rho >> 4, i = rho & 15; return 8 * (i >> 2) + 4 * n + (i & 3); }

struct Unit { const char* a; const char* b0; const char* b1; const char* b0x; const char* b1x; int r0, c0, aux, x; };
struct GemmP { const char* gA; int K; unsigned rsA, planeA, ldb; };

struct TileOrder {
    int nM, nN, nwg, G, c;
    __device__ __forceinline__ void init(int nM_, int nN_, int G_, int c_) { nM = nM_; nN = nN_; nwg = nM * nN; G = G_; c = c_; }
    __device__ __forceinline__ bool next(int i, int& pm, int& pn) const {
        const long L = (long)i * G + c; if (L >= nwg) return false;
        int wgid = (int)L; { const int q = nwg / NXCD, r = nwg % NXCD, xcd = wgid % NXCD, off = wgid / NXCD; wgid = (xcd < r ? xcd * (q + 1) : r * (q + 1) + (xcd - r) * q) + off; }
        const int nig = WGM * nN, gid = wgid / nig, fm = gid * WGM, gsz = (nM - fm) < WGM ? (nM - fm) : WGM;
        pm = fm + ((wgid % nig) % gsz); pn = (wgid % nig) / gsz; return true;
    }
};

template <class Epi, class Sched, bool GATHER, bool DUALB = false>
__device__ __forceinline__ void gemm_phase(LAS unsigned char* lds, const GemmP g, const Sched& S, const Epi& E) {
    const int tid = threadIdx.x, wid = __builtin_amdgcn_readfirstlane(tid >> 6), lane = tid & 63, wr = wid >> 2, wc = wid & 3, fr = lane & 15, fq = lane >> 4;
    const int nt = g.K / BK;
    unsigned voffA[2], voffB[2], coff[2]; int RA[2];
#pragma unroll
    for (int i = 0; i < 2; ++i) { int R, C; stage_rc(tid * 16 + i * 8192, R, C); const int Rb = Epi::PERM ? ((R & ~31) + perm32(R & 31)) : R;
        coff[i] = (unsigned)(C >> 4) * g.planeA + (unsigned)(C & 15) * 2u; RA[i] = R;
        voffA[i] = (unsigned)R * g.rsA + coff[i]; voffB[i] = (unsigned)Rb * g.ldb + (unsigned)C * 2u; }
    const size_t ksA = (size_t)4 * g.planeA, ksB = (size_t)(BK * 2);
    const size_t hstepA = (size_t)HALF * g.rsA;
    const unsigned ldsw = (unsigned)wid * 1024u;
    const int aoff = lds_byte(wr * 64 + fr, fq * 8), boff = lds_byte(wc * 32 + fr, fq * 8);
#define PG8_SA(b, h) (((b) * 2 + (h)) * HTB)
#define PG8_SB(b, h) ((4 + (b) * 2 + (h)) * HTB)
#define PG8_STG(bufoff, ptr, o0, o1) do { \
        __builtin_amdgcn_global_load_lds((const unsigned*)((const char*)(ptr) + (o0)), (LAS unsigned*)(lds + (bufoff) + ldsw), 16, 0, 0); \
        __builtin_amdgcn_global_load_lds((const unsigned*)((const char*)(ptr) + (o1)), (LAS unsigned*)(lds + (bufoff) + ldsw + 8192), 16, 0, 0); } while (0)
#define PG8_STAGE_B(bufoff, ptr) PG8_STG(bufoff, ptr, voffB[0], voffB[1])
#define PG8_STAGE_A(bufoff, h, ptr, usenext) do { if constexpr (GATHER) { const unsigned _o0 = (usenext) ? voN[h][0] : voC[h][0], _o1 = (usenext) ? voN[h][1] : voC[h][1]; PG8_STG(bufoff, ptr, _o0, _o1); } \
        else { PG8_STG(bufoff, (ptr) + (h) * hstepA, voffA[0], voffA[1]); } } while (0)
#define PG8_LDA(dst, b, h) do { _Pragma("unroll") for (int m = 0; m < 4; ++m) _Pragma("unroll") for (int k = 0; k < 2; ++k) dst[m][k] = *(const LAS bf16x8*)(lds + PG8_SA(b, h) + aoff + m * 2048 + k * 1024); } while (0)
#define PG8_LDB(dst, b, h) do { _Pragma("unroll") for (int n = 0; n < 2; ++n) _Pragma("unroll") for (int k = 0; k < 2; ++k) dst[n][k] = *(const LAS bf16x8*)(lds + PG8_SB(b, h) + boff + n * 2048 + k * 1024); } while (0)
#define PG8_MMA(ai, bj, At, Bt) do { __builtin_amdgcn_s_setprio(1); _Pragma("unroll") for (int m = 0; m < 4; ++m) _Pragma("unroll") for (int n = 0; n < 2; ++n) _Pragma("unroll") for (int k = 0; k < 2; ++k) \
        acc[ai][bj][m][n] = __builtin_amdgcn_mfma_f32_16x16x32_bf16(Bt[n][k], At[m][k], acc[ai][bj][m][n], 0, 0, 0); __builtin_amdgcn_s_setprio(0); } while (0)
#define PG8_WAIT_V(n) asm volatile("s_waitcnt vmcnt(" #n ")" ::: "memory")
#define PG8_WAIT_L(n) asm volatile("s_waitcnt lgkmcnt(" #n ")" ::: "memory")
#define PG8_BAR __builtin_amdgcn_s_barrier()
#define PG8_SCHED __builtin_amdgcn_sched_barrier(0)
    Unit cur, nxt; int ui = 0;
    if (!S.next(0, cur)) return;
    unsigned voC[2][2], voN[2][2];
    if constexpr (GATHER) {
#pragma unroll
        for (int h = 0; h < 2; ++h)
#pragma unroll
            for (int i = 0; i < 2; ++i) { voC[h][i] = S.row_off(cur, h * HALF + RA[i]) + coff[i]; voN[h][i] = voC[h][i]; }
    } else { voC[0][0] = voC[0][1] = voC[1][0] = voC[1][1] = 0u; voN[0][0] = voN[0][1] = voN[1][0] = voN[1][1] = 0u; }
    f32x4 acc[2][2][4][2];
#pragma unroll
    for (int a = 0; a < 2; ++a)
#pragma unroll
        for (int b = 0; b < 2; ++b)
#pragma unroll
            for (int m = 0; m < 4; ++m)
#pragma unroll
                for (int n = 0; n < 2; ++n) acc[a][b][m][n] = (f32x4){0.f, 0.f, 0.f, 0.f};
    bf16x8 At[4][2], B0[2][2], B1[2][2];
    const char* cA = GATHER ? g.gA : cur.a; const char* cB0 = cur.b0; const char* cB1 = cur.b1; const char* cB0x = cur.b0x; const char* cB1x = cur.b1x;
    const int nth = nt >> 1;
#define PG8_BPTR(h, kt) ((DUALB && (kt) >= nth) ? ((h) ? cB1x : cB0x) + (size_t)((kt) - nth) * ksB : ((h) ? cB1 : cB0) + (size_t)(kt) * ksB)
    PG8_STAGE_B(PG8_SB(0, 0), cB0); PG8_STAGE_B(PG8_SB(0, 1), cB1); PG8_STAGE_A(PG8_SA(0, 0), 0, cA, false); PG8_STAGE_A(PG8_SA(0, 1), 1, cA, false);
    if (wr == 1) PG8_BAR;
    PG8_WAIT_V(2); PG8_BAR;
    PG8_STAGE_B(PG8_SB(1, 0), cB0 + ksB); PG8_STAGE_A(PG8_SA(1, 0), 0, cA + ksA, false); PG8_STAGE_B(PG8_SB(1, 1), cB1 + ksB);
    PG8_WAIT_V(6); PG8_BAR;
    for (;;) {
        const bool has_next = S.next(ui + 1, nxt);
        const char* nA = GATHER ? g.gA : (has_next ? nxt.a : cA); const char* nB0 = has_next ? nxt.b0 : cB0; const char* nB1 = has_next ? nxt.b1 : cB1;
        const char* nB0x = has_next ? nxt.b0x : cB0x; const char* nB1x = has_next ? nxt.b1x : cB1x;
        if constexpr (GATHER) {
            if (has_next) {
#pragma unroll
                for (int h = 0; h < 2; ++h)
#pragma unroll
                    for (int i = 0; i < 2; ++i) voN[h][i] = S.row_off(nxt, h * HALF + RA[i]) + coff[i];
            } else {
#pragma unroll
                for (int h = 0; h < 2; ++h)
#pragma unroll
                    for (int i = 0; i < 2; ++i) voN[h][i] = voC[h][i];
            }
        }
#pragma nounroll
        for (int t = 0; t < nt; t += 2) {
            const bool last = (t == nt - 2);
            const char* a1 = cA + (size_t)(t + 1) * ksA;
            const char* a2 = last ? nA : cA + (size_t)(t + 2) * ksA;
            const char* b20 = last ? nB0 : PG8_BPTR(0, t + 2); const char* b21 = last ? nB1 : PG8_BPTR(1, t + 2);
            const char* a3 = a2 + ksA; const char* b30 = last ? nB0 + ksB : PG8_BPTR(0, t + 3); const char* b31 = last ? nB1 + ksB : PG8_BPTR(1, t + 3);
            PG8_LDB(B0, 0, 0); PG8_LDB(B1, 0, 1); PG8_SCHED; PG8_LDA(At, 0, 0); PG8_STAGE_A(PG8_SA(1, 1), 1, a1, false);
            PG8_WAIT_V(8); PG8_WAIT_L(0); PG8_BAR; PG8_MMA(0, 0, At, B0); PG8_MMA(0, 1, At, B1); PG8_BAR; PG8_SCHED;
            PG8_LDA(At, 0, 1); PG8_STAGE_B(PG8_SB(0, 0), b20); PG8_STAGE_B(PG8_SB(0, 1), b21); PG8_STAGE_A(PG8_SA(0, 0), 0, a2, last);
            PG8_WAIT_V(8); PG8_WAIT_L(0); PG8_BAR; PG8_MMA(1, 0, At, B0); PG8_MMA(1, 1, At, B1); PG8_BAR; PG8_SCHED;
            PG8_LDB(B0, 1, 0); PG8_LDB(B1, 1, 1); PG8_SCHED; PG8_LDA(At, 1, 0); PG8_STAGE_A(PG8_SA(0, 1), 1, a2, last);
            PG8_WAIT_V(8); PG8_WAIT_L(0); PG8_BAR; PG8_MMA(0, 0, At, B0); PG8_MMA(0, 1, At, B1); PG8_BAR; PG8_SCHED;
            PG8_LDA(At, 1, 1); PG8_STAGE_B(PG8_SB(1, 0), b30); PG8_STAGE_B(PG8_SB(1, 1), b31); PG8_STAGE_A(PG8_SA(1, 0), 0, a3, last);
            PG8_WAIT_V(8); PG8_WAIT_L(0); PG8_BAR; PG8_MMA(1, 0, At, B0); PG8_MMA(1, 1, At, B1); PG8_BAR; PG8_SCHED;
        }
#ifndef PG8_NOALIGN
        if (wr == 0) PG8_BAR;
#endif
        E(acc, cur, wr, wc, fr, fq);
        if (!has_next) break;
#pragma unroll
        for (int a = 0; a < 2; ++a)
#pragma unroll
            for (int b = 0; b < 2; ++b)
#pragma unroll
                for (int m = 0; m < 4; ++m)
#pragma unroll
                    for (int n = 0; n < 2; ++n) acc[a][b][m][n] = (f32x4){0.f, 0.f, 0.f, 0.f};
        cur = nxt; cA = nA; cB0 = nB0; cB1 = nB1; cB0x = nB0x; cB1x = nB1x; ++ui;
        if constexpr (GATHER) {
#pragma unroll
            for (int h = 0; h < 2; ++h)
#pragma unroll
                for (int i = 0; i < 2; ++i) voC[h][i] = voN[h][i];
        }
#ifndef PG8_NOALIGN
        if (wr == 1) PG8_BAR;
#endif
    }
    PG8_WAIT_V(0);
#ifdef PG8_NOALIGN
    if (wr == 0) PG8_BAR;
#endif
    PG8_BAR;
#undef PG8_BPTR
#undef PG8_SA
#undef PG8_SB
#undef PG8_STG
#undef PG8_STAGE_A
#undef PG8_STAGE_B
#undef PG8_LDA
#undef PG8_LDB
#undef PG8_MMA
#undef PG8_WAIT_V
#undef PG8_WAIT_L
#undef PG8_BAR
#undef PG8_SCHED
}
}

#define XB_TMO      128
#define XB_XCNT(j)  (256  + 64 * (j))
#define XB_XSUB(j)  (1280 + 64 * (j))
#define XB_XGEN(j)  (2304 + 64 * (j))
#define XB_TOP      3328
#define XB_TOPGEN   3392
#define XCD_BAR_WORDS 3456
#define XB_SPIN_CAP (1u << 18)
__device__ __forceinline__ unsigned xb_ld(unsigned* p)              { return __hip_atomic_load(p, __ATOMIC_RELAXED, __HIP_MEMORY_SCOPE_AGENT); }
__device__ __forceinline__ unsigned xb_add(unsigned* p, unsigned v) { return __hip_atomic_fetch_add(p, v, __ATOMIC_RELAXED, __HIP_MEMORY_SCOPE_AGENT); }
__device__ __forceinline__ unsigned xb_xcc_id() { return (unsigned)__builtin_amdgcn_s_getreg((3 << 11) | 20) & 0xFu; }
#define XB_SPIN(cond, bar) do { unsigned _sp = 0; while (cond) { __builtin_amdgcn_s_sleep(1); \
    if ((++_sp & 255u) == 0u) { if (xb_ld(&(bar)[XB_TMO])) break; if (_sp > XB_SPIN_CAP) { atomicAdd(&(bar)[XB_TMO], 1u); break; } } } } while (0)
struct XcdBarrier { unsigned* bar; unsigned x; volatile LAS unsigned* st; };
__device__ __forceinline__ XcdBarrier xcd_barrier_post(unsigned* bar, volatile LAS unsigned* st) {
    XcdBarrier b; b.bar = bar; b.x = xb_xcc_id(); b.st = st;
    if (threadIdx.x == 0) (void)xb_add(&bar[XB_XCNT(b.x)], 1u);
    return b;
}
__device__ __forceinline__ void xcd_barrier_complete(unsigned* bar, unsigned x, unsigned& nloc, unsigned& nx) {
    const unsigned G = gridDim.x * gridDim.y * gridDim.z;
    unsigned sum, cnt, mine, sp = 0u;
    for (;;) {
        sum = 0u; cnt = 0u; mine = 0u;
#pragma unroll
        for (unsigned j = 0; j < 16; ++j) { const unsigned c = xb_ld(&bar[XB_XCNT(j)]); sum += c; cnt += (c > 0u) ? 1u : 0u; mine = (j == x) ? c : mine; }
        if (sum == G) break;
        __builtin_amdgcn_s_sleep(1);
        if ((++sp & 255u) == 0u) { if (xb_ld(&bar[XB_TMO])) break; if (sp > XB_SPIN_CAP) { atomicAdd(&bar[XB_TMO], 1u); break; } }
    }
    nloc = mine > 0u ? mine : 1u; nx = cnt > 0u ? cnt : 1u;
}
__device__ __forceinline__ void xcd_barrier(const XcdBarrier& b) {
    asm volatile("s_waitcnt vmcnt(0)" ::: "memory");
    __syncthreads();
    if (threadIdx.x == 0) {
        unsigned* bar = b.bar;
        __builtin_amdgcn_s_waitcnt(0);
        unsigned nloc = b.st[0], nx = b.st[1];
        if (nloc == 0u) { xcd_barrier_complete(bar, b.x, nloc, nx); b.st[0] = nloc; b.st[1] = nx; }
        const unsigned old = xb_add(&bar[XB_XSUB(b.x)], 1u);
        const unsigned gen = old / nloc;
        if (old + 1u == (gen + 1u) * nloc) {
            __builtin_amdgcn_fence(__ATOMIC_RELEASE, "agent");
            asm volatile("s_waitcnt vmcnt(0)" ::: "memory");
            const unsigned og = xb_add(&bar[XB_TOP], 1u);
            const unsigned tg = og / nx;
            if (og + 1u == (tg + 1u) * nx) xb_add(&bar[XB_TOPGEN], 1u);
            else XB_SPIN(xb_ld(&bar[XB_TOPGEN]) == tg, bar);
            __builtin_amdgcn_fence(__ATOMIC_ACQUIRE, "agent");
            xb_add(&bar[XB_XGEN(b.x)], 1u);
            asm volatile("s_waitcnt vmcnt(0)" ::: "memory");
        } else {
            XB_SPIN(xb_ld(&bar[XB_XGEN(b.x)]) == gen, bar);
            __builtin_amdgcn_fence(__ATOMIC_ACQUIRE, "agent");
            asm volatile("s_waitcnt vmcnt(0)" ::: "memory");
        }
    }
    __syncthreads();
}

constexpr size_t MiB = 1u << 20;
constexpr size_t WS_CTL = 0, CTL_ZERO_BYTES = 1 * MiB;
constexpr size_t WS_RSTD = 1 * MiB;
constexpr size_t WS_GATES = 2 * MiB;
constexpr size_t WS_SUMSQ = 3 * MiB;
constexpr size_t WS_RW = 5 * MiB;
constexpr size_t WS_LAM = 6 * MiB;
constexpr size_t WS_LRUW = 7 * MiB;
constexpr size_t WS_TOKL = 8 * MiB;
constexpr size_t WS_RSTDL = 10 * MiB;
constexpr size_t WS_GATEL = 12 * MiB;
constexpr size_t WS_TOKSLOT = 14 * MiB;
constexpr size_t WS_WIN = 16 * MiB;
constexpr size_t WS_WOUT = 40 * MiB;
constexpr size_t WS_WS5IN = 48 * MiB, WS_WGLUV = 56 * MiB, WS_WGLUG = 64 * MiB;
constexpr size_t WS_WMOE0 = 72 * MiB;
constexpr size_t WS_S5WIN = 168 * MiB;
constexpr size_t WS_S5WC = 176 * MiB;
constexpr size_t WS_XB = 200 * MiB;
constexpr size_t WS_Y = 328 * MiB;
constexpr size_t WS_P = 456 * MiB;
constexpr size_t WS_H = 456 * MiB;
constexpr size_t WS_PTOK = 540 * MiB;
constexpr size_t WS_PRSTD = 544 * MiB, WS_PGA = 548 * MiB, WS_PGB = 552 * MiB;
constexpr size_t WS_A2 = 456 * MiB;
constexpr size_t WS_XIN = 648 * MiB;
constexpr size_t WS_WMOE1 = 840 * MiB;
constexpr size_t WS_END = 936 * MiB;
static_assert(WS_H + (size_t)SLOT_ROWS * 1024 * 2 <= WS_PTOK && WS_PGB + (size_t)NPAIR * T * 4 <= WS_XIN, "moe buffers");
static_assert(WS_A2 + (size_t)128 * 2048 * 384 * 2 <= WS_XIN && WS_XIN + (size_t)128 * 2048 * 128 * 4 <= WS_WMOE1, "s5 buffers");
static_assert(WS_P + (size_t)T * PN * 2 <= WS_WMOE1, "p buffer");
constexpr int CW_BAR = 4096;
constexpr int CW_TMO = 8;
constexpr int CW_PANEL = 32768;
constexpr int CW_CNT = 16384;

constexpr int RING_BYTES = 131072;
constexpr int LDS_BYTES = 163840;
constexpr int MISC_OFF = LDS_BYTES - 1024;
constexpr int MI_PRE = 136, MI_CNT = 164;

struct Frame {
    LAS unsigned char* lds;
    volatile LAS unsigned* MISC;
    gu32* ctl;
    int tid, lane, wave, vcu, G;
    float* out; unsigned char* ws;
    __device__ __forceinline__ const float* in(int i) const {
        const unsigned lo = __builtin_amdgcn_readfirstlane(MISC[64 + 2 * i]), hi = __builtin_amdgcn_readfirstlane(MISC[65 + 2 * i]);
        return (const float*)(((unsigned long long)hi << 32) | lo); }
};

__device__ __forceinline__ void transpose_item(const float* W, int ldw, const float* gain, bf16* WT, int ldt, int nblk, LAS float* scr, int item, int lane) {
    const int kb = item / nblk, nb = item % nblk, k0 = 64 * kb, n0 = 32 * nb;
    float v[32];
#pragma unroll
    for (int i = 0; i < 32; ++i) v[i] = W[(size_t)(k0 + 2 * i + (lane >> 5)) * ldw + n0 + (lane & 31)];
    const int c = lane & 7;
    f32x4 g0 = (f32x4){1.f, 1.f, 1.f, 1.f}, g1 = g0;
    if (gain) { g0 = *(const f32x4*)(gain + k0 + 8 * c); g1 = *(const f32x4*)(gain + k0 + 8 * c + 4); }
#pragma unroll
    for (int i = 0; i < 32; ++i) scr[(2 * i + (lane >> 5)) * 33 + (lane & 31)] = v[i];
    LDS_WAIT(); asm volatile("" ::: "memory");
#pragma unroll
    for (int j = 0; j < 4; ++j) { const int n = (lane >> 3) + 8 * j; const LAS float* s = scr + (8 * c) * 33 + n;
        u32x4 o; o.x = pk2(s[0 * 33] * g0[0], s[1 * 33] * g0[1]); o.y = pk2(s[2 * 33] * g0[2], s[3 * 33] * g0[3]); o.z = pk2(s[4 * 33] * g1[0], s[5 * 33] * g1[1]); o.w = pk2(s[6 * 33] * g1[2], s[7 * 33] * g1[3]);
        *(GAS u32x4*)(WT + (size_t)(n0 + n) * ldt + k0 + 8 * c) = o; }
    LDS_WAIT(); asm volatile("" ::: "memory");
}
__device__ __forceinline__ void sincos_d(double th, double& s, double& c) {
    const double TWO_PI = 6.283185307179586476925286766559;
    const double k = __builtin_rint(th / TWO_PI); const double x = th - k * TWO_PI;
    const double x2 = x * x; double ts = x, tc = 1.0; s = x; c = 1.0;
#pragma unroll
    for (int i = 1; i <= 16; ++i) { tc *= -x2 / (double)((2 * i - 1) * (2 * i)); ts *= -x2 / (double)((2 * i) * (2 * i + 1)); c += tc; s += ts; }
}
__device__ __forceinline__ void s5_build_group(Frame& F, int g, int half) {
    LAS float* pwr = (LAS float*)(F.lds);
    LAS float* pwi = pwr + 17 * 64;
    LAS float* bbr = pwi + 17 * 64;
    LAS float* bbi = bbr + 1024;
    LAS float* cre = bbi + 1024;
    LAS float* cim = cre + 1024;
    LAS float* km = cim + 1024;
    LAS float* ff = km + 4096;
    LAS float* ctr = ff + 128;
    LAS float* cti = ctr + 1024;
    const int tid = F.tid;
    const float* a_re = F.in(19) + g * 64; const float* a_im = F.in(20) + g * 64;
    if (tid < 64) {
        const double dt = (double)expf(F.in(21)[g]), ar = (double)a_re[tid], ai = (double)a_im[tid];
        const double mag = (double)expf((float)(ar * dt)); double sn, cs; sincos_d(ai * dt, sn, cs);
        const double lr = mag * cs, li = mag * sn; double pr = 1.0, pi = 0.0;
        for (int d = 0; d <= 16; ++d) { pwr[d * 64 + tid] = (float)pr; pwi[d * 64 + tid] = (float)pi; const double nr = pr * lr - pi * li, ni = pr * li + pi * lr; pr = nr; pi = ni; }
        const double den = ar * ar + ai * ai;
        ff[tid] = (float)(((lr - 1.0) * ar + li * ai) / den); ff[64 + tid] = (float)((li * ar - (lr - 1.0) * ai) / den);
        if (half == 0) {
            double q16r = 1.0, q16i = 0.0;
            for (int d = 0; d < 16; ++d) { const double nr = q16r * lr - q16i * li, ni = q16r * li + q16i * lr; q16r = nr; q16i = ni; }
            double q64r = q16r, q64i = q16i;
            for (int d = 0; d < 2; ++d) { const double nr = q64r * q64r - q64i * q64i, ni = 2.0 * q64r * q64i; q64r = nr; q64i = ni; }
            *(f32x4*)((float*)(F.ws + WS_LAM) + ((size_t)g * 64 + tid) * 4) = (f32x4){(float)q16r, (float)q16i, (float)q64r, (float)q64i};
        }
    }
    __syncthreads();
    { const float* pbr = F.in(22) + g * 1024; const float* pbi = F.in(23) + g * 1024; const float* pcr = F.in(24) + g * 1024; const float* pci = F.in(25) + g * 1024;
    for (int idx = tid; idx < 1024; idx += NT) { const int p = idx >> 4; const float br = pbr[idx], bi = pbi[idx]; const float fr = ff[p], fi = ff[64 + p];
        bbr[idx] = fr * br - fi * bi; bbi[idx] = fr * bi + fi * br; const float cr_ = pcr[idx], ci_ = pci[idx]; cre[idx] = cr_; cim[idx] = ci_;
        ctr[(idx & 63) * 16 + (idx >> 6)] = cr_; cti[(idx & 63) * 16 + (idx >> 6)] = ci_; } }
    __syncthreads();
    if (tid < 256) {
        const int d = tid >> 4, co = tid & 15; float ac[16];
#pragma unroll
        for (int ci = 0; ci < 16; ++ci) ac[ci] = 0.f;
        for (int p = 0; p < 64; ++p) { const float c_r = ctr[p * 16 + co], c_i = cti[p * 16 + co], l_r = pwr[d * 64 + p], l_i = pwi[d * 64 + p];
            const float tr = c_r * l_r - c_i * l_i, ti = c_r * l_i + c_i * l_r;
#pragma unroll
            for (int c4 = 0; c4 < 4; ++c4) { const f32x4 br = *(const LAS f32x4*)(bbr + p * 16 + 4 * c4), bi = *(const LAS f32x4*)(bbi + p * 16 + 4 * c4);
#pragma unroll
                for (int j = 0; j < 4; ++j) ac[4 * c4 + j] += tr * br[j] - ti * bi[j]; } }
#pragma unroll
        for (int c4 = 0; c4 < 4; ++c4) *(LAS f32x4*)(km + (d << 8) + (co << 4) + 4 * c4) = (f32x4){ac[4 * c4], ac[4 * c4 + 1], ac[4 * c4 + 2], ac[4 * c4 + 3]};
    }
    __syncthreads();
    bf16* Wc = (bf16*)(F.ws + WS_S5WC) + (size_t)g * 256 * 384;
    const float* dsk = F.in(26) + g * 16;
    for (int idx = half * 128 * 384 + tid; idx < (half + 1) * 128 * 384; idx += NT) { const int row = idx / 384, col = idx - row * 384, tl = row >> 4, co = row & 15; float v;
        if (col < 256) { const int j = col >> 4, ci = col & 15; v = (j <= tl) ? km[((tl - j) << 8) + (co << 4) + ci] : 0.f; if (j == tl && ci == co) v += dsk[co]; }
        else { const int q = col - 256, p = 8 * (q >> 4) + (q & 7), part = (q >> 3) & 1;
            const float c_r = cre[co * 64 + p], c_i = cim[co * 64 + p], l_r = pwr[(tl + 1) * 64 + p], l_i = pwi[(tl + 1) * 64 + p];
            v = (part == 0) ? (c_r * l_r - c_i * l_i) : -(c_r * l_i + c_i * l_r); }
        Wc[idx] = (bf16)f2bf(v); }
    bf16* Wi = (bf16*)(F.ws + WS_S5WIN) + (size_t)g * 128 * 256;
    for (int idx = half * 64 * 256 + tid; idx < (half + 1) * 64 * 256; idx += NT) { const int row = idx >> 8, col = idx & 255, p = 8 * (row >> 4) + (row & 7), part = (row >> 3) & 1, j = col >> 4, ci = col & 15, d = 15 - j;
        const float l_r = pwr[d * 64 + p], l_i = pwi[d * 64 + p], b_r = bbr[p * 16 + ci], b_i = bbi[p * 16 + ci];
        Wi[idx] = (bf16)f2bf(part == 0 ? (l_r * b_r - l_i * b_i) : (l_r * b_i + l_i * b_r)); }
    __syncthreads();
}

__device__ __forceinline__ void ph_prologue(Frame& F, int pf) {
    LAS float* scr = (LAS float*)(F.lds + F.wave * 16384);
    const int gw = F.vcu * NWAVES + F.wave, NGW = F.G * NWAVES, lane = F.lane;
    constexpr int I_IN = 32 * 192, I_SQ = 32 * 64, I_MOE = 512;
    constexpr int NITEMS = I_IN + 4 * I_SQ + 96 * I_MOE;
    if (!(pf & 16))
    for (int it = gw; it < NITEMS; it += NGW) {
        int r = it;
        if (r < I_IN) { transpose_item(F.in(4), INCOLS, F.in(1), (bf16*)(F.ws + WS_WIN), 2048, 192, scr, r, lane); continue; } r -= I_IN;
        if (r < I_SQ) { transpose_item(F.in(17), 2048, nullptr, (bf16*)(F.ws + WS_WOUT), 2048, 64, scr, r, lane); continue; } r -= I_SQ;
        if (r < I_SQ) { transpose_item(F.in(18), 2048, F.in(1) + 2048, (bf16*)(F.ws + WS_WS5IN), 2048, 64, scr, r, lane); continue; } r -= I_SQ;
        if (r < I_SQ) { transpose_item(F.in(27), 2048, nullptr, (bf16*)(F.ws + WS_WGLUV), 2048, 64, scr, r, lane); continue; } r -= I_SQ;
        if (r < I_SQ) { transpose_item(F.in(28), 2048, nullptr, (bf16*)(F.ws + WS_WGLUG), 2048, 64, scr, r, lane); continue; } r -= I_SQ;
        const int mat = r / I_MOE, itx = r % I_MOE, l = mat / 48, rem = mat % 48, kind = rem / 16, e = rem % 16;
        bf16* base = (bf16*)(F.ws + (l ? WS_WMOE1 : WS_WMOE0));
        if (kind < 2) transpose_item((kind == 0 ? F.in(33) : F.in(34)) + (size_t)(l * 16 + e) * 2048 * 512, 512, F.in(2) + l * 2048, base + (size_t)kind * 16 * 512 * 2048 + (size_t)e * 512 * 2048, 2048, 16, scr, itx, lane);
        else transpose_item(F.in(35) + (size_t)(l * 16 + e) * 512 * 2048, 2048, nullptr, base + (size_t)2 * 16 * 512 * 2048 + (size_t)e * 2048 * 512, 512, 64, scr, itx, lane);
    }
    __syncthreads();
    if (!(pf & 32)) for (int gh = F.vcu; gh < 256; gh += F.G) s5_build_group(F, gh >> 1, gh & 1);
    __syncthreads();
    const int gt = F.vcu * NT + F.tid, NGT = F.G * NT;
    {
        bf16* LW = (bf16*)(F.ws + WS_LRUW); const float* wa_ = F.in(7); const float* wx_ = F.in(9); const float* wc_ = F.in(29); const float* wf_ = F.in(31); const float* nf_ = F.in(2);
        for (int idx = gt; idx < 8 * 256 * 128; idx += NGT) { const int n = idx >> 15, o = (idx >> 7) & 255, i = idx & 127;
            const float v = (o < 128) ? wa_[(size_t)(n * 128 + i) * 128 + o] : wx_[(size_t)(n * 128 + i) * 128 + (o - 128)]; LW[idx] = (bf16)f2bf(v); }
        float* RW = (float*)(F.ws + WS_RW);
        bf16* RWB = (bf16*)RW;
        for (int idx = gt; idx < 2 * 32 * 2048; idx += NGT) { const int l = idx >> 16, n = (idx >> 11) & 31, k = idx & 2047;
            const float w = (n < 4) ? wc_[(size_t)(l * 2048 + k) * 4 + n] * nf_[l * 2048 + k] : (n < 20) ? wf_[(size_t)(l * 2048 + k) * 16 + (n - 4)] * nf_[l * 2048 + k] : 0.f;
            const unsigned hi = f2bf(w); const float lo = w - __builtin_bit_cast(float, hi << 16);
            RWB[((size_t)(l * 2 + 0) * 32 + n) * 2048 + k] = (bf16)hi; RWB[((size_t)(l * 2 + 1) * 32 + n) * 2048 + k] = (bf16)f2bf(lo); }
    }
    LAS float* wgT = (LAS float*)F.lds;
    { const float* win = F.in(4); const float* nm0 = F.in(1);
    for (int idx = F.tid; idx < 16384; idx += NT) { const int k = idx >> 3, c = idx & 7; wgT[c * 2048 + k] = win[(size_t)k * INCOLS + 6144 + c] * nm0[k]; } }
    __syncthreads();
    const float* x = F.in(0); bf16* xb = (bf16*)(F.ws + WS_XB); float* rstd_o = (float*)(F.ws + WS_RSTD); float* gates = (float*)(F.ws + WS_GATES);
    const float bias = (lane < 4) ? F.in(14)[lane & 3] : F.in(15)[lane & 3];
    if (!(pf & 64))
    for (int m0 = 2 * gw; m0 < T; m0 += 2 * NGW) {
        f32x4 v[2][8]; float ss[2] = {0.f, 0.f};
#pragma unroll
        for (int q = 0; q < 2; ++q) { const GAS f32x4* xr = (const GAS f32x4*)(x + (size_t)(m0 + q) * D) + lane;
#pragma unroll
            for (int j = 0; j < 8; ++j) v[q][j] = xr[64 * j]; }
#pragma unroll
        for (int q = 0; q < 2; ++q) { const int m = m0 + q;
#pragma unroll
            for (int j = 0; j < 8; ++j) ss[q] += (v[q][j].x * v[q][j].x + v[q][j].y * v[q][j].y) + (v[q][j].z * v[q][j].z + v[q][j].w * v[q][j].w);
            ss[q] = wave_sum(ss[q]); const float rstd = 1.0f / sqrtf(ss[q] * (1.0f / D) + EPS);
            GAS u32x2* o8 = (GAS u32x2*)(xb + (size_t)m * D) + lane;
#pragma unroll
            for (int j = 0; j < 8; ++j) { u32x2 w; w.x = pk2(v[q][j].x, v[q][j].y); w.y = pk2(v[q][j].z, v[q][j].w); o8[64 * j] = w; }
            float ga[8];
#pragma unroll
            for (int c = 0; c < 8; ++c) { float a = 0.f;
#pragma unroll
                for (int j = 0; j < 8; ++j) { const f32x4 w = *(const LAS f32x4*)(wgT + c * 2048 + 4 * (lane + 64 * j)); a += (v[q][j].x * w.x + v[q][j].y * w.y) + (v[q][j].z * w.z + v[q][j].w * w.w); }
                ga[c] = wave_sum(a); asm volatile("" ::: "memory"); }
            float val = ga[0];
#pragma unroll
            for (int c = 1; c < 8; ++c) val = (lane == c) ? ga[c] : val;
            if (lane < 8) gates[(size_t)m * 8 + lane] = val * rstd + bias;
            if (lane == 0) rstd_o[m] = rstd; }
    }
    __syncthreads();
}

__device__ __forceinline__ unsigned ld_agent_u32(const unsigned* p) { return __hip_atomic_load(p, RLX_AGENT); }
__device__ __forceinline__ float ld_agent_f32(const float* p) { return __builtin_bit_cast(float, __hip_atomic_load((const unsigned*)p, RLX_AGENT)); }
using pg8::Unit;

struct DenseSched {
    pg8::TileOrder to; const char* A; size_t tstepA; const char* B0; const char* B1; size_t tstepB; int cpt;
    __device__ __forceinline__ bool next(int i, Unit& u) const { int pm, pn; if (!to.next(i, pm, pn)) return false;
        u.a = A + (size_t)pm * tstepA; u.b0 = B0 + (size_t)pn * tstepB; u.b1 = B1 + (size_t)pn * tstepB; u.b0x = u.b0; u.b1x = u.b1; u.r0 = pm * 256; u.c0 = pn * cpt; u.aux = 0; u.x = 0; return true; }
    __device__ __forceinline__ unsigned row_off(const Unit&, int) const { return 0u; }
    __device__ __forceinline__ void a_ready(const Unit&) const {}
};
struct S5Sched {
    int G, c; const char* A; const char* B; size_t gstepB; size_t hstepB;
    __device__ __forceinline__ bool next(int i, Unit& u) const { const int L = i * G + c; if (L >= 1024) return false; const int g = L >> 3, pm = L & 7;
        u.a = A + ((size_t)g * 2048 + (size_t)pm * 256) * 768; u.b0 = B + (size_t)g * gstepB; u.b1 = u.b0 + hstepB; u.b0x = u.b0; u.b1x = u.b1; u.r0 = pm * 256; u.c0 = 0; u.aux = g; u.x = 0; return true; }
    __device__ __forceinline__ unsigned row_off(const Unit&, int) const { return 0u; }
    __device__ __forceinline__ void a_ready(const Unit&) const {}
};
__device__ __forceinline__ void pair_experts(int q, int& ea, int& eb) { const int g = q / 6, p = q - 6 * g; const int ia = (p < 3) ? 0 : (p < 5) ? 1 : 2, ib = (p < 3) ? p + 1 : (p < 5) ? p - 1 : 3; ea = 4 * g + ia; eb = 4 * g + ib; }
template <bool DOWN> struct MoeSched {
    volatile LAS unsigned* misc; int G, c; const char* W0; const char* W1; const char* Hd; const int* ptok;
    __device__ __forceinline__ bool next(int i, Unit& u) const {
        const int L = i * G + c, ntiles = __builtin_amdgcn_readfirstlane((int)misc[MI_PRE + NPAIR]); if (L >= ntiles * 8) return false;
        int q = 0;
#pragma unroll
        for (int j = 1; j < NPAIR; ++j) q += ((L >> 3) >= __builtin_amdgcn_readfirstlane((int)misc[MI_PRE + j])) ? 1 : 0;
        const int pq = __builtin_amdgcn_readfirstlane((int)misc[MI_PRE + q]), tq = __builtin_amdgcn_readfirstlane((int)misc[MI_PRE + q + 1]) - pq, loc = L - 8 * pq;
        const int ct = loc / tq, gr = pq + (loc - ct * tq);
        int ea, eb; pair_experts(q, ea, eb);
        u.aux = q; u.r0 = gr * 256; u.x = (gr - pq) * 256;
        if (!DOWN) { const int e = (ct < 4) ? ea : eb; u.c0 = ct * 128; u.a = nullptr;
            u.b0 = W0 + (size_t)e * 512 * 4096 + (size_t)(ct & 3) * 128 * 4096; u.b1 = W1 + (size_t)e * 512 * 4096 + (size_t)(ct & 3) * 128 * 4096; u.b0x = u.b0; u.b1x = u.b1; }
        else { u.c0 = ct * 256; u.a = Hd + (size_t)gr * 256 * 2048;
            u.b0 = W0 + (size_t)ea * 2048 * 1024 + (size_t)ct * 256 * 1024; u.b1 = u.b0 + (size_t)128 * 1024; u.b0x = W0 + (size_t)eb * 2048 * 1024 + (size_t)ct * 256 * 1024; u.b1x = u.b0x + (size_t)128 * 1024; }
        return true; }
    __device__ __forceinline__ unsigned row_off(const Unit& u, int row) const { const int cnt = __builtin_amdgcn_readfirstlane((int)misc[MI_CNT + u.aux]); int idx = u.x + row; idx = idx < cnt ? idx : cnt - 1;
        return (unsigned)ptok[(size_t)u.aux * T + idx] * 4096u; }
};

struct EpiScaleBf16 {
    static constexpr bool PERM = true;
    bf16* O; int ldc; const float* scale;
    __device__ __forceinline__ void operator()(const f32x4 (&acc)[2][2][4][2], const Unit& u, int wr, int wc, int fr, int fq) const {
        const int row0 = u.r0 + wr * 64 + fr, col0 = u.c0 + wc * 32 + 8 * fq;
        float sv[2][4];
#pragma unroll
        for (int ai = 0; ai < 2; ++ai)
#pragma unroll
            for (int m = 0; m < 4; ++m) sv[ai][m] = scale[row0 + ai * 128 + m * 16];
#pragma unroll
        for (int ai = 0; ai < 2; ++ai)
#pragma unroll
            for (int m = 0; m < 4; ++m) { int zz = 0; asm volatile("" : "+v"(zz)); const int row = row0 + ai * 128 + m * 16 + zz; const float s = sv[ai][m]; bf16* rowp = O + (size_t)row * ldc + col0;
#pragma unroll
                for (int bj = 0; bj < 2; ++bj) { const f32x4 v0 = acc[ai][bj][m][0] * s, v1 = acc[ai][bj][m][1] * s;
                    u32x4 w; w.x = pk2(v0[0], v0[1]); w.y = pk2(v0[2], v0[3]); w.z = pk2(v1[0], v1[1]); w.w = pk2(v1[2], v1[3]); *(u32x4*)(rowp + bj * 128) = w; } }
    }
};
struct EpiS5U {
    static constexpr bool PERM = true;
    bf16* A2; const float* scale;
    __device__ __forceinline__ void operator()(const f32x4 (&acc)[2][2][4][2], const Unit& u, int wr, int wc, int fr, int fq) const {
        const int row0 = u.r0 + wr * 64 + fr, col0 = u.c0 + wc * 32 + 8 * fq;
        float sv[2][4];
#pragma unroll
        for (int ai = 0; ai < 2; ++ai)
#pragma unroll
            for (int m = 0; m < 4; ++m) sv[ai][m] = scale[row0 + ai * 128 + m * 16];
#pragma unroll
        for (int ai = 0; ai < 2; ++ai)
#pragma unroll
            for (int m = 0; m < 4; ++m) { int zz = 0; asm volatile("" : "+v"(zz)); const int t = row0 + ai * 128 + m * 16 + zz; const float s = sv[ai][m]; const int n = t >> 4, tl = t & 15;
#pragma unroll
                for (int bj = 0; bj < 2; ++bj) { const int c = col0 + bj * 128, g = c >> 4, half = (c >> 3) & 1; const f32x4 v0 = acc[ai][bj][m][0] * s, v1 = acc[ai][bj][m][1] * s;
                    u32x4 w; w.x = pk2(v0[0], v0[1]); w.y = pk2(v0[2], v0[3]); w.z = pk2(v1[0], v1[1]); w.w = pk2(v1[2], v1[3]);
                    *(u32x4*)(A2 + ((size_t)g * 2048 + n) * 256 + tl * 16 + half * 8) = w; } }
    }
};
struct EpiOutRes {
    static constexpr bool PERM = true;
    bf16* xb;
    __device__ __forceinline__ void operator()(const f32x4 (&acc)[2][2][4][2], const Unit& u, int wr, int wc, int fr, int fq) const {
        const int row0 = u.r0 + wr * 64 + fr, col0 = u.c0 + wc * 32 + 8 * fq;
        u32x4 xr[2][4][2];
#pragma unroll
        for (int ai = 0; ai < 2; ++ai)
#pragma unroll
            for (int m = 0; m < 4; ++m)
#pragma unroll
                for (int bj = 0; bj < 2; ++bj) xr[ai][m][bj] = *(const u32x4*)(xb + (size_t)(row0 + ai * 128 + m * 16) * D + col0 + bj * 128);
#pragma unroll
        for (int ai = 0; ai < 2; ++ai)
#pragma unroll
            for (int m = 0; m < 4; ++m) { int zz = 0; asm volatile("" : "+v"(zz)); const size_t off = (size_t)(row0 + ai * 128 + m * 16 + zz) * D + col0;
#pragma unroll
                for (int bj = 0; bj < 2; ++bj) { const f32x4 a0 = acc[ai][bj][m][0], a1 = acc[ai][bj][m][1]; const u32x4 x = xr[ai][m][bj];
                    u32x4 w; w.x = pk2(bf_lo(x.x) + a0[0], bf_hi(x.x) + a0[1]); w.y = pk2(bf_lo(x.y) + a0[2], bf_hi(x.y) + a0[3]); w.z = pk2(bf_lo(x.z) + a1[0], bf_hi(x.z) + a1[1]); w.w = pk2(bf_lo(x.w) + a1[2], bf_hi(x.w) + a1[3]);
                    *(u32x4*)(xb + off + bj * 128) = w; } }
    }
};
struct EpiGlu {
    static constexpr bool PERM = true;
    bf16* xb;
    __device__ __forceinline__ void operator()(const f32x4 (&acc)[2][2][4][2], const Unit& u, int wr, int wc, int fr, int fq) const {
        const int row0 = u.r0 + wr * 64 + fr, col0 = u.c0 + wc * 32 + 8 * fq;
        u32x4 xr[2][4];
#pragma unroll
        for (int ai = 0; ai < 2; ++ai)
#pragma unroll
            for (int m = 0; m < 4; ++m) xr[ai][m] = *(const u32x4*)(xb + (size_t)(row0 + ai * 128 + m * 16) * D + col0);
#pragma unroll
        for (int ai = 0; ai < 2; ++ai)
#pragma unroll
            for (int m = 0; m < 4; ++m) { int zz = 0; asm volatile("" : "+v"(zz)); const size_t off = (size_t)(row0 + ai * 128 + m * 16 + zz) * D + col0;
                const f32x4 a0 = acc[ai][0][m][0], a1 = acc[ai][0][m][1], g0 = acc[ai][1][m][0], g1 = acc[ai][1][m][1]; const u32x4 x = xr[ai][m];
                u32x4 w;
                w.x = pk2(bf_lo(x.x) + a0[0] * sigmoidf_(g0[0]), bf_hi(x.x) + a0[1] * sigmoidf_(g0[1])); w.y = pk2(bf_lo(x.y) + a0[2] * sigmoidf_(g0[2]), bf_hi(x.y) + a0[3] * sigmoidf_(g0[3]));
                w.z = pk2(bf_lo(x.z) + a1[0] * sigmoidf_(g1[0]), bf_hi(x.z) + a1[1] * sigmoidf_(g1[1])); w.w = pk2(bf_lo(x.w) + a1[2] * sigmoidf_(g1[2]), bf_hi(x.w) + a1[3] * sigmoidf_(g1[3]));
                *(u32x4*)(xb + off) = w; }
    }
};
struct EpiGateUp {
    static constexpr bool PERM = true;
    bf16* H; const float* prstd; const float* pga; const float* pgb; volatile LAS unsigned* misc; int pf;
    __device__ __forceinline__ void operator()(const f32x4 (&acc)[2][2][4][2], const Unit& u, int wr, int wc, int fr, int fq) const {
        if (pf & 16) { asm volatile("" :: "v"(acc[0][0][0][0][0]), "v"(acc[1][1][3][1][3])); return; }
        const int rl0 = wr * 64 + fr, col0 = u.c0 + wc * 32 + 8 * fq, cnt = __builtin_amdgcn_readfirstlane((int)misc[MI_CNT + u.aux]);
        const float* pg = (u.c0 < 512) ? pga : pgb;
        float sv[2][4], gv[2][4];
#pragma unroll
        for (int ai = 0; ai < 2; ++ai)
#pragma unroll
            for (int m = 0; m < 4; ++m) { int idx = u.x + rl0 + ai * 128 + m * 16; idx = idx < cnt ? idx : cnt - 1; sv[ai][m] = prstd[(size_t)u.aux * T + idx]; gv[ai][m] = pg[(size_t)u.aux * T + idx]; }
#pragma unroll
        for (int ai = 0; ai < 2; ++ai)
#pragma unroll
            for (int m = 0; m < 4; ++m) { int zz = 0; asm volatile("" : "+v"(zz)); const int rl = rl0 + ai * 128 + m * 16 + zz; const float r = sv[ai][m], gt = gv[ai][m] * r;
                float hv[8];
#pragma unroll
                for (int n = 0; n < 2; ++n)
#pragma unroll
                    for (int j = 0; j < 4; ++j) hv[n * 4 + j] = siluf_(acc[ai][0][m][n][j] * r) * (acc[ai][1][m][n][j] * gt);
                u32x4 w; w.x = pk2(hv[0], hv[1]); w.y = pk2(hv[2], hv[3]); w.z = pk2(hv[4], hv[5]); w.w = pk2(hv[6], hv[7]);
                *(u32x4*)(H + (size_t)(u.r0 + rl) * 1024 + col0) = w; }
    }
};
struct EpiDownRes {
    static constexpr bool PERM = true;
    bf16* xb; const int* ptok; volatile LAS unsigned* misc; bf16* dst;
    __device__ __forceinline__ void operator()(const f32x4 (&acc)[2][2][4][2], const Unit& u, int wr, int wc, int fr, int fq) const {
        const int rl0 = wr * 64 + fr, col0 = u.c0 + wc * 32 + 8 * fq, cnt = __builtin_amdgcn_readfirstlane((int)misc[MI_CNT + u.aux]);
        int tk[2][4];
#pragma unroll
        for (int ai = 0; ai < 2; ++ai)
#pragma unroll
            for (int m = 0; m < 4; ++m) { const int idx = u.x + rl0 + ai * 128 + m * 16; tk[ai][m] = (idx < cnt) ? ptok[(size_t)u.aux * T + idx] : -1; }
        u32x4 xr[2][4][2];
#pragma unroll
        for (int ai = 0; ai < 2; ++ai)
#pragma unroll
            for (int m = 0; m < 4; ++m)
#pragma unroll
                for (int bj = 0; bj < 2; ++bj) xr[ai][m][bj] = (tk[ai][m] >= 0) ? *(const u32x4*)(xb + (size_t)tk[ai][m] * D + col0 + bj * 128) : (u32x4){0u, 0u, 0u, 0u};
#pragma unroll
        for (int ai = 0; ai < 2; ++ai)
#pragma unroll
            for (int m = 0; m < 4; ++m) { int zz = 0; asm volatile("" : "+v"(zz)); const int tok = tk[ai][m] + zz;
                if (tok >= 0) {
#pragma unroll
                    for (int bj = 0; bj < 2; ++bj) { const f32x4 a0 = acc[ai][bj][m][0], a1 = acc[ai][bj][m][1]; const u32x4 x = xr[ai][m][bj];
                        u32x4 w; w.x = pk2(bf_lo(x.x) + a0[0], bf_hi(x.x) + a0[1]); w.y = pk2(bf_lo(x.y) + a0[2], bf_hi(x.y) + a0[3]); w.z = pk2(bf_lo(x.z) + a1[0], bf_hi(x.z) + a1[1]); w.w = pk2(bf_lo(x.w) + a1[2], bf_hi(x.w) + a1[3]);
                        *(u32x4*)(dst + (size_t)tok * D + col0 + bj * 128) = w; } } }
    }
};
struct EpiXin {
    static constexpr bool PERM = false;
    float* X;
    __device__ __forceinline__ void operator()(const f32x4 (&acc)[2][2][4][2], const Unit& u, int wr, int wc, int fr, int fq) const {
        const int rl0 = u.r0 + wr * 64 + fr, col0 = wc * 32 + 4 * fq;
#pragma unroll
        for (int ai = 0; ai < 2; ++ai)
#pragma unroll
            for (int m = 0; m < 4; ++m) { int zz = 0; asm volatile("" : "+v"(zz)); float* rowp = X + ((size_t)u.aux * 2048 + rl0 + ai * 128 + m * 16 + zz) * 128 + col0;
#pragma unroll
                for (int n = 0; n < 2; ++n) *(f32x4*)(rowp + n * 16) = acc[ai][0][m][n]; }
    }
};
struct EpiS5Y {
    static constexpr bool PERM = true;
    bf16* Y2;
    __device__ __forceinline__ void operator()(const f32x4 (&acc)[2][2][4][2], const Unit& u, int wr, int wc, int fr, int fq) const {
        const int rl0 = u.r0 + wr * 64 + fr, col0 = wc * 32 + 8 * fq;
#pragma unroll
        for (int ai = 0; ai < 2; ++ai)
#pragma unroll
            for (int m = 0; m < 4; ++m) { int zz = 0; asm volatile("" : "+v"(zz)); const int n = rl0 + ai * 128 + m * 16 + zz;
#pragma unroll
                for (int bj = 0; bj < 2; ++bj) { const int c = col0 + bj * 128, tl = c >> 4, half = (c >> 3) & 1; const f32x4 a0 = acc[ai][bj][m][0], a1 = acc[ai][bj][m][1];
                    u32x4 w; w.x = pk2(gelu_tanh(a0[0]), gelu_tanh(a0[1])); w.y = pk2(gelu_tanh(a0[2]), gelu_tanh(a0[3])); w.z = pk2(gelu_tanh(a1[0]), gelu_tanh(a1[1])); w.w = pk2(gelu_tanh(a1[2]), gelu_tanh(a1[3]));
                    const int tok = n * 16 + tl;
                    *(u32x4*)(Y2 + ((((size_t)(tok >> 8) * 128 + u.aux) * 256) + (tok & 255)) * 16 + half * 8) = w; } }
    }
};

constexpr int ML_QP = 528, ML_KTP = 144;
constexpr int ML_Q = 0, ML_K = 33792, ML_KT = 67584, ML_C = 104448, ML_SC = 138240;
constexpr int ML_P = ML_K, ML_VT = ML_K + 9216, ML_VWT = ML_Q;
constexpr int ML_CW = 141824;
__device__ __forceinline__ unsigned bf_elem(const u32x4& v, int i) { const unsigned w = v[i >> 1]; return (i & 1) ? (w >> 16) : (w & 0xffffu); }
__device__ __forceinline__ void mlstm_unit(Frame& F, int b, int hh, int s, int pf) {
    LAS unsigned char* L = F.lds; LAS float* sc = (LAS float*)(L + ML_SC);
    const int tid = F.tid, lane = F.lane, w = F.wave, l15 = lane & 15, lq = lane >> 4;
    const bf16* P = (const bf16*)(F.ws + WS_P); bf16* Y = (bf16*)(F.ws + ((pf & 8) ? WS_XB : WS_Y)); const float* gates = (const float*)(F.ws + WS_GATES); float* sumsq = (float*)(F.ws + ((pf & 8) ? 950 * MiB : WS_SUMSQ));
    const int isk = lane >> 5, e0 = 8 * (lane & 31), cch = (isk ? 1024 : 0) + hh * 256 + e0;
    const float osc = isk ? 0.0625f : 1.0f;
    {
        const float* cwp = F.in(12) + cch; const float* cbp = F.in(13) + cch;
        if (w == 0) {
#pragma unroll
            for (int ih = 0; ih < 2; ++ih) {
#pragma unroll
                for (int j = 0; j < 4; ++j) *(LAS f32x4*)(L + ML_CW + ((ih * 5 + j) * 64 + lane) * 16) = *(const GAS f32x4*)(cwp + j * 2048 + 4 * ih);
                *(LAS f32x4*)(L + ML_CW + ((ih * 5 + 4) * 64 + lane) * 16) = *(const GAS f32x4*)(cbp + 4 * ih); }
        }
    }
    f32x4 cacc[2][4];
#pragma unroll
    for (int q = 0; q < 2; ++q)
#pragma unroll
        for (int dc = 0; dc < 4; ++dc) cacc[q][dc] = (f32x4){0.f, 0.f, 0.f, 0.f};
    for (int idx = tid; idx < 33792 / 16; idx += NT) ((LAS u32x4*)(L + ML_C))[idx] = (u32x4){0u, 0u, 0u, 0u};
    if (tid < 256) sc[512 + tid] = 0.f;
    float m_st = 0.f;
    const int tr = w >> 1, cb2 = 2 * (w & 1);
    const int vj = tid >> 3, vdg = tid & 7;
    u32x4 raw[11];
#pragma unroll
    for (int r = 0; r < 11; ++r) { const int t = 8 * w - 3 + r;
        raw[r] = (t >= 0) ? *(const GAS u32x4*)(P + ((size_t)b * SEQ + t) * PN + 2048 + cch) : (u32x4){0u, 0u, 0u, 0u}; }
    float ipn = 0.f, fpn = 0.f;
    if (w == 0) { ipn = gates[((size_t)b * SEQ + lane) * 8 + hh]; fpn = gates[((size_t)b * SEQ + lane) * 8 + 4 + hh]; }
    __syncthreads();
    for (int ch = 0; ch < 32; ++ch) {
        const int t0 = ch * 64; const size_t row0 = (size_t)b * SEQ + t0;
        const u32x4 vraw = *(const GAS u32x4*)(P + (row0 + vj) * PN + 4096 + hh * 256 + s * 64 + 8 * vdg);
        bf16 ov[4][2];
#pragma unroll
        for (int r = 0; r < 4; ++r) { const size_t prow = (row0 + 16 * tr + 4 * lq + r) * PN + 5120 + hh * 256 + s * 64 + 16 * cb2 + l15; ov[r][0] = P[prow]; ov[r][1] = P[prow + 16]; }
        if (!(pf & 16)) {
            asm volatile("" ::: "memory");
#pragma unroll
            for (int ih = 0; ih < 2; ++ih) {
                const f32x4 cb4 = *(const LAS f32x4*)(L + ML_CW + ((ih * 5 + 4) * 64 + lane) * 16);
                f32x4 cw4[4];
#pragma unroll
                for (int j = 0; j < 4; ++j) cw4[j] = *(const LAS f32x4*)(L + ML_CW + ((ih * 5 + j) * 64 + lane) * 16);
                u32x2 outp[8];
                float xw[3][4];
#pragma unroll
                for (int r = 0; r < 3; ++r) { xw[r][0] = bf_lo(raw[r][2 * ih]); xw[r][1] = bf_hi(raw[r][2 * ih]); xw[r][2] = bf_lo(raw[r][2 * ih + 1]); xw[r][3] = bf_hi(raw[r][2 * ih + 1]); }
#pragma unroll
                for (int r = 0; r < 8; ++r) { float o[4], xc[4];
                    xc[0] = bf_lo(raw[r + 3][2 * ih]); xc[1] = bf_hi(raw[r + 3][2 * ih]); xc[2] = bf_lo(raw[r + 3][2 * ih + 1]); xc[3] = bf_hi(raw[r + 3][2 * ih + 1]);
#pragma unroll
                    for (int i4 = 0; i4 < 4; ++i4) { const float cv = cb4[i4] + cw4[0][i4] * xw[0][i4] + cw4[1][i4] * xw[1][i4] + cw4[2][i4] * xw[2][i4] + cw4[3][i4] * xc[i4]; o[i4] = siluf_(cv) * osc;
                        xw[0][i4] = xw[1][i4]; xw[1][i4] = xw[2][i4]; xw[2][i4] = xc[i4]; }
                    outp[r].x = pk2(o[0], o[1]); outp[r].y = pk2(o[2], o[3]);
                    *(LAS u32x2*)(L + (isk ? ML_K : ML_Q) + (8 * w + r) * ML_QP + (e0 + 4 * ih) * 2) = outp[r]; }
                if (isk) {
#pragma unroll
                    for (int i4 = 0; i4 < 4; ++i4) { u32x4 v;
#define ML_EL(r) ((i4 & 1) ? (outp[r][i4 >> 1] >> 16) : (outp[r][i4 >> 1] & 0xffffu))
                        v.x = ML_EL(0) | (ML_EL(1) << 16); v.y = ML_EL(2) | (ML_EL(3) << 16); v.z = ML_EL(4) | (ML_EL(5) << 16); v.w = ML_EL(6) | (ML_EL(7) << 16);
#undef ML_EL
                        *(LAS u32x4*)(L + ML_KT + (e0 + 4 * ih + i4) * ML_KTP + (8 * w) * 2) = v; }
                }
            }
        }
        asm volatile("" ::: "memory");
        if (ch + 1 < 32) {
#pragma unroll
            for (int r = 0; r < 11; ++r) raw[r] = *(const GAS u32x4*)(P + (row0 + 64 + 8 * w - 3 + r) * PN + 2048 + cch);
        }
        if (w == 0) {
            const float ip = ipn, fp = fpn;
            if (ch + 1 < 32) { ipn = gates[(row0 + 64 + lane) * 8 + hh]; fpn = gates[(row0 + 64 + lane) * 8 + 4 + hh]; }
            const float lf = fminf(fp, 0.f) - __logf(1.0f + __expf(-fabsf(fp)));
            float bc = lf;
#pragma unroll
            for (int o = 1; o < 64; o <<= 1) { const float t = __shfl_up(bc, o); if (lane >= o) bc += t; }
            const float a = ip - bc; float pm = a;
#pragma unroll
            for (int o = 1; o < 64; o <<= 1) { const float t = __shfl_up(pm, o); if (lane >= o) pm = fmaxf(pm, t); }
            const float M = fmaxf(m_st, pm);
            const float M63 = __shfl(M, 63), b63 = __shfl(bc, 63);
            sc[lane] = a; sc[64 + lane] = M; sc[128 + lane] = __expf(m_st - M); sc[192 + lane] = __expf(-(bc + M)); sc[256 + lane] = __expf(a - M63);
            if (lane == 0) sc[768] = __expf(m_st - M63);
            m_st = b63 + M63;
        }
        __syncthreads();
        float pw[2][4] = {{0.f, 0.f, 0.f, 0.f}, {0.f, 0.f, 0.f, 0.f}};
        if (!(pf & 32)) {
            f32x4 s0 = (f32x4){0.f, 0.f, 0.f, 0.f}, s1 = s0;
#pragma unroll
            for (int kk = 0; kk < 8; ++kk) {
                const bf16x8 a = *(const LAS bf16x8*)(L + ML_Q + (16 * tr + l15) * ML_QP + (32 * kk + 8 * lq) * 2);
                const bf16x8 k0 = *(const LAS bf16x8*)(L + ML_K + (16 * cb2 + l15) * ML_QP + (32 * kk + 8 * lq) * 2);
                const bf16x8 k1 = *(const LAS bf16x8*)(L + ML_K + (16 * (cb2 + 1) + l15) * ML_QP + (32 * kk + 8 * lq) * 2);
                s0 = __builtin_amdgcn_mfma_f32_16x16x32_bf16(a, k0, s0, 0, 0, 0); s1 = __builtin_amdgcn_mfma_f32_16x16x32_bf16(a, k1, s1, 0, 0, 0); }
            const int j0 = 16 * cb2 + l15, j1 = j0 + 16; const float a0 = sc[j0], a1 = sc[j1];
#pragma unroll
            for (int r = 0; r < 4; ++r) { const int t = 16 * tr + 4 * lq + r; const float Mt = sc[64 + t];
                pw[0][r] = (j0 <= t) ? s0[r] * __expf(a0 - Mt) : 0.f; pw[1][r] = (j1 <= t) ? s1[r] * __expf(a1 - Mt) : 0.f; }
        }
        __syncthreads();
#pragma unroll
        for (int r = 0; r < 4; ++r) { const int t = 16 * tr + 4 * lq + r;
            *(LAS bf16*)(L + ML_P + t * ML_KTP + (16 * cb2 + l15) * 2) = (bf16)f2bf(pw[0][r]); *(LAS bf16*)(L + ML_P + t * ML_KTP + (16 * cb2 + 16 + l15) * 2) = (bf16)f2bf(pw[1][r]); }
#pragma unroll
        for (int i = 0; i < 8; ++i) *(LAS bf16*)(L + ML_VT + (8 * vdg + i) * ML_KTP + vj * 2) = (bf16)bf_elem(vraw, i);
        __syncthreads();
        {
            const int t = tid >> 3, part = tid & 7;
            const u32x4 pv = *(const LAS u32x4*)(L + ML_P + t * ML_KTP + part * 16);
            float ds = (bf_lo(pv.x) + bf_hi(pv.x)) + (bf_lo(pv.y) + bf_hi(pv.y)) + (bf_lo(pv.z) + bf_hi(pv.z)) + (bf_lo(pv.w) + bf_hi(pv.w));
            float qn = 0.f;
#pragma unroll
            for (int q4 = 0; q4 < 4; ++q4) { const u32x4 qv = *(const LAS u32x4*)(L + ML_Q + t * ML_QP + part * 64 + q4 * 16);
                const f32x4 n0 = *(const LAS f32x4*)(sc + 512 + part * 32 + q4 * 8), n1 = *(const LAS f32x4*)(sc + 512 + part * 32 + q4 * 8 + 4);
                qn += bf_lo(qv.x) * n0[0] + bf_hi(qv.x) * n0[1] + bf_lo(qv.y) * n0[2] + bf_hi(qv.y) * n0[3] + bf_lo(qv.z) * n1[0] + bf_hi(qv.z) * n1[1] + bf_lo(qv.w) * n1[2] + bf_hi(qv.w) * n1[3]; }
#pragma unroll
            for (int o = 1; o < 8; o <<= 1) { ds += __shfl_xor(ds, o); qn += __shfl_xor(qn, o); }
            if (part == 0) sc[320 + t] = ds + sc[128 + t] * qn;
        }
        f32x4 pv0 = (f32x4){0.f, 0.f, 0.f, 0.f}, pv1 = pv0, qc0 = pv0, qc1 = pv0;
        if (!(pf & 64)) {
#pragma unroll
        for (int kk = 0; kk < 2; ++kk) {
            const bf16x8 a = *(const LAS bf16x8*)(L + ML_P + (16 * tr + l15) * ML_KTP + (32 * kk + 8 * lq) * 2);
            const bf16x8 v0 = *(const LAS bf16x8*)(L + ML_VT + (16 * cb2 + l15) * ML_KTP + (32 * kk + 8 * lq) * 2);
            const bf16x8 v1 = *(const LAS bf16x8*)(L + ML_VT + (16 * (cb2 + 1) + l15) * ML_KTP + (32 * kk + 8 * lq) * 2);
            pv0 = __builtin_amdgcn_mfma_f32_16x16x32_bf16(a, v0, pv0, 0, 0, 0); pv1 = __builtin_amdgcn_mfma_f32_16x16x32_bf16(a, v1, pv1, 0, 0, 0); }
#pragma unroll
        for (int kk = 0; kk < 8; ++kk) {
            const bf16x8 a = *(const LAS bf16x8*)(L + ML_Q + (16 * tr + l15) * ML_QP + (32 * kk + 8 * lq) * 2);
            const bf16x8 c0 = *(const LAS bf16x8*)(L + ML_C + (16 * cb2 + l15) * ML_QP + (32 * kk + 8 * lq) * 2);
            const bf16x8 c1 = *(const LAS bf16x8*)(L + ML_C + (16 * (cb2 + 1) + l15) * ML_QP + (32 * kk + 8 * lq) * 2);
            qc0 = __builtin_amdgcn_mfma_f32_16x16x32_bf16(a, c0, qc0, 0, 0, 0); qc1 = __builtin_amdgcn_mfma_f32_16x16x32_bf16(a, c1, qc1, 0, 0, 0); }
        }
        __syncthreads();
        if (!(pf & 64)) {
#pragma unroll
            for (int r = 0; r < 4; ++r) { const int t = 16 * tr + 4 * lq + r; const float wi = sc[128 + t], dn = fmaxf(fabsf(sc[320 + t]), sc[192 + t]); const float inv = __builtin_amdgcn_rcpf(dn);
                const size_t yrow = (row0 + t) * D + 1024 + hh * 256 + s * 64;
                const int d0 = 16 * cb2 + l15, d1 = d0 + 16;
                const float h0 = (pv0[r] + wi * qc0[r]) * inv * sigmoidf_(bf2f(ov[r][0])), h1 = (pv1[r] + wi * qc1[r]) * inv * sigmoidf_(bf2f(ov[r][1]));
                Y[yrow + d0] = (bf16)f2bf(h0); Y[yrow + d1] = (bf16)f2bf(h1);
                float q = h0 * h0 + h1 * h1;
#pragma unroll
                for (int o = 1; o < 16; o <<= 1) q += __shfl_xor(q, o);
                if (l15 == 0) sc[384 + (w & 1) * 64 + t] = q; }
        }
        const float decay = sc[768];
        {
            const float we = sc[256 + vj];
#pragma unroll
            for (int i = 0; i < 8; ++i) *(LAS bf16*)(L + ML_VWT + (8 * vdg + i) * ML_KTP + vj * 2) = (bf16)f2bf(__builtin_bit_cast(float, bf_elem(vraw, i) << 16) * we);
            if (tid < 256) { float a = 0.f;
#pragma unroll
                for (int j8 = 0; j8 < 8; ++j8) { const u32x4 kv = *(const LAS u32x4*)(L + ML_KT + tid * ML_KTP + j8 * 16); const f32x4 w0 = *(const LAS f32x4*)(sc + 256 + j8 * 8), w1 = *(const LAS f32x4*)(sc + 256 + j8 * 8 + 4);
                    a += bf_lo(kv.x) * w0[0] + bf_hi(kv.x) * w0[1] + bf_lo(kv.y) * w0[2] + bf_hi(kv.y) * w0[3] + bf_lo(kv.z) * w1[0] + bf_hi(kv.z) * w1[1] + bf_lo(kv.w) * w1[2] + bf_hi(kv.w) * w1[3]; }
                sc[512 + tid] = decay * sc[512 + tid] + a; }
#pragma unroll
            for (int q = 0; q < 2; ++q)
#pragma unroll
                for (int dc = 0; dc < 4; ++dc) cacc[q][dc] *= decay;
        }
        __syncthreads();
        if (tid < 64) sumsq[(row0 + tid) * 16 + hh * 4 + s] = sc[384 + tid] + sc[448 + tid];
        if (!(pf & 128)) {
#pragma unroll
        for (int kk = 0; kk < 2; ++kk) {
            bf16x8 aE[2], bD[4];
#pragma unroll
            for (int q = 0; q < 2; ++q) aE[q] = *(const LAS bf16x8*)(L + ML_KT + (16 * (2 * w + q) + l15) * ML_KTP + (32 * kk + 8 * lq) * 2);
#pragma unroll
            for (int dc = 0; dc < 4; ++dc) bD[dc] = *(const LAS bf16x8*)(L + ML_VWT + (16 * dc + l15) * ML_KTP + (32 * kk + 8 * lq) * 2);
#pragma unroll
            for (int q = 0; q < 2; ++q)
#pragma unroll
                for (int dc = 0; dc < 4; ++dc) cacc[q][dc] = __builtin_amdgcn_mfma_f32_16x16x32_bf16(aE[q], bD[dc], cacc[q][dc], 0, 0, 0); }
#pragma unroll
        for (int q = 0; q < 2; ++q)
#pragma unroll
            for (int dc = 0; dc < 4; ++dc) { u32x2 wv; wv.x = pk2(cacc[q][dc][0], cacc[q][dc][1]); wv.y = pk2(cacc[q][dc][2], cacc[q][dc][3]);
                *(LAS u32x2*)(L + ML_C + (16 * dc + l15) * ML_QP + (16 * (2 * w + q) + 4 * lq) * 2) = wv; }
        }
        __syncthreads();
    }
}

constexpr int LR_XP = 272, LR_TT = 128;
constexpr int LR_XC = 0, LR_W = 34816, LR_A = 69632, LR_G = 102912, LR_SEG = 136192, LR_CARRY = 140288, LR_CWT = 140544;
__device__ __forceinline__ void lru_unit(Frame& F, int b, int n, int jh) {
    LAS unsigned char* L = F.lds;
    LAS float* Aa = (LAS float*)(L + LR_A); LAS float* Ga = (LAS float*)(L + LR_G); LAS float* seg = (LAS float*)(L + LR_SEG); LAS float* carry = (LAS float*)(L + LR_CARRY);
    const int tid = F.tid, lane = F.lane, w = F.wave, l15 = lane & 15, lq = lane >> 4;
    const bf16* P = (const bf16*)(F.ws + WS_P); bf16* Y = (bf16*)(F.ws + WS_Y); const bf16* LW = (const bf16*)(F.ws + WS_LRUW) + (size_t)n * 256 * 128;
    for (int pc = tid; pc < 2048; pc += NT) { const int orow = pc >> 4, c16 = pc & 15; const int src = (orow < 64) ? (jh * 64 + orow) : (128 + jh * 64 + (orow - 64));
        *(LAS u32x4*)(L + LR_W + orow * LR_XP + c16 * 16) = *(const GAS u32x4*)(LW + (size_t)src * 128 + c16 * 8); }
    const int cgx = tid & 15, rgx = tid >> 4, cch = n * 128 + 8 * cgx;
    if (tid < 16) {
        const float* cwp_ = F.in(5) + cch; const float* cbp_ = F.in(6) + cch;
#pragma unroll
        for (int j = 0; j < 4; ++j) { *(LAS f32x4*)(L + LR_CWT + (cgx * 5 + j) * 32) = *(const GAS f32x4*)(cwp_ + j * 1024); *(LAS f32x4*)(L + LR_CWT + (cgx * 5 + j) * 32 + 16) = *(const GAS f32x4*)(cwp_ + j * 1024 + 4); }
        *(LAS f32x4*)(L + LR_CWT + (cgx * 5 + 4) * 32) = *(const GAS f32x4*)cbp_; *(LAS f32x4*)(L + LR_CWT + (cgx * 5 + 4) * 32 + 16) = *(const GAS f32x4*)(cbp_ + 4);
    }
    const int trb = 2 * (w >> 1), ocb = 2 * (w & 1);
    float ba[2], bx[2], sp[2];
    const float* pba_ = F.in(8); const float* pbx_ = F.in(10); const float* plam_ = F.in(11);
#pragma unroll
    for (int q = 0; q < 2; ++q) { const int chq = n * 128 + jh * 64 + 16 * (ocb + q) + l15; ba[q] = pba_[chq]; bx[q] = pbx_[chq]; const float nl = -plam_[chq]; sp[q] = fmaxf(nl, 0.f) + log1pf(expf(-fabsf(nl))); }
    const int ch_s = n * 128 + jh * 64 + lane;
    if (tid < 64) carry[tid] = 0.f;
    u32x4 raw[7];
#pragma unroll
    for (int r = 0; r < 7; ++r) { const int t = 4 * rgx - 3 + r; raw[r] = (t >= 0) ? *(const GAS u32x4*)(P + ((size_t)b * SEQ + t) * PN + cch) : (u32x4){0u, 0u, 0u, 0u}; }
    __syncthreads();
    for (int tile = 0; tile < SEQ / LR_TT; ++tile) {
        const int t0 = tile * LR_TT; const size_t row0 = (size_t)b * SEQ + t0;
        bf16 zv[16];
#pragma unroll
        for (int i = 0; i < 16; ++i) zv[i] = P[(row0 + 16 * w + i) * PN + 1024 + ch_s];
        {
            float cw[4][8], cb[8];
#pragma unroll
            for (int j = 0; j < 5; ++j) { const f32x4 c0 = *(const LAS f32x4*)(L + LR_CWT + (cgx * 5 + j) * 32), c1 = *(const LAS f32x4*)(L + LR_CWT + (cgx * 5 + j) * 32 + 16);
#pragma unroll
                for (int i = 0; i < 4; ++i) { if (j < 4) { cw[j < 4 ? j : 0][i] = c0[i]; cw[j < 4 ? j : 0][4 + i] = c1[i]; } else { cb[i] = c0[i]; cb[4 + i] = c1[i]; } } }
#pragma unroll
            for (int r = 0; r < 4; ++r) { float o[8];
#pragma unroll
                for (int i = 0; i < 8; ++i) { const int wd = i >> 1; float x0, x1, x2, x3;
                    if (i & 1) { x0 = bf_hi(raw[r][wd]); x1 = bf_hi(raw[r + 1][wd]); x2 = bf_hi(raw[r + 2][wd]); x3 = bf_hi(raw[r + 3][wd]); }
                    else { x0 = bf_lo(raw[r][wd]); x1 = bf_lo(raw[r + 1][wd]); x2 = bf_lo(raw[r + 2][wd]); x3 = bf_lo(raw[r + 3][wd]); }
                    o[i] = cb[i] + cw[0][i] * x0 + cw[1][i] * x1 + cw[2][i] * x2 + cw[3][i] * x3; }
                u32x4 ov; ov.x = pk2(o[0], o[1]); ov.y = pk2(o[2], o[3]); ov.z = pk2(o[4], o[5]); ov.w = pk2(o[6], o[7]);
                *(LAS u32x4*)(L + LR_XC + (4 * rgx + r) * LR_XP + cgx * 16) = ov; }
            asm volatile("" ::: "memory");
            if (tile + 1 < SEQ / LR_TT) {
#pragma unroll
                for (int r = 0; r < 7; ++r) raw[r] = *(const GAS u32x4*)(P + (row0 + LR_TT + 4 * rgx - 3 + r) * PN + cch);
            }
        }
        __syncthreads();
        {
            f32x4 ga[2][2], gx[2][2];
#pragma unroll
            for (int rt = 0; rt < 2; ++rt)
#pragma unroll
                for (int q = 0; q < 2; ++q) { ga[rt][q] = (f32x4){0.f, 0.f, 0.f, 0.f}; gx[rt][q] = ga[rt][q]; }
#pragma unroll
            for (int kk = 0; kk < 4; ++kk) { bf16x8 a[2], wa[2], wx[2];
#pragma unroll
                for (int rt = 0; rt < 2; ++rt) a[rt] = *(const LAS bf16x8*)(L + LR_XC + (16 * (trb + rt) + l15) * LR_XP + (32 * kk + 8 * lq) * 2);
#pragma unroll
                for (int q = 0; q < 2; ++q) { wa[q] = *(const LAS bf16x8*)(L + LR_W + (16 * (ocb + q) + l15) * LR_XP + (32 * kk + 8 * lq) * 2);
                    wx[q] = *(const LAS bf16x8*)(L + LR_W + (64 + 16 * (ocb + q) + l15) * LR_XP + (32 * kk + 8 * lq) * 2); }
#pragma unroll
                for (int rt = 0; rt < 2; ++rt)
#pragma unroll
                    for (int q = 0; q < 2; ++q) { ga[rt][q] = __builtin_amdgcn_mfma_f32_16x16x32_bf16(a[rt], wa[q], ga[rt][q], 0, 0, 0); gx[rt][q] = __builtin_amdgcn_mfma_f32_16x16x32_bf16(a[rt], wx[q], gx[rt][q], 0, 0, 0); } }
#pragma unroll
            for (int rt = 0; rt < 2; ++rt)
#pragma unroll
                for (int q = 0; q < 2; ++q)
#pragma unroll
                    for (int r = 0; r < 4; ++r) { const int t = 16 * (trb + rt) + 4 * lq + r, jo = 16 * (ocb + q) + l15;
                        const float rg = sigmoidf_(ga[rt][q][r] + ba[q]), ig = sigmoidf_(gx[rt][q][r] + bx[q]); const float la = -8.0f * rg * sp[q];
                        const float xf = bf2f(*(const LAS bf16*)(L + LR_XC + t * LR_XP + (jh * 64 + jo) * 2));
                        const float av = __expf(la); Aa[t * 65 + jo] = av; Ga[t * 65 + jo] = __builtin_amdgcn_sqrtf(fmaxf(1.0f - av * av, 0.f)) * (ig * xf); }
        }
        __syncthreads();
        {
            float Ap = 1.f, H = 0.f;
#pragma unroll
            for (int i = 0; i < 16; ++i) { const float a = Aa[(16 * w + i) * 65 + lane], g = Ga[(16 * w + i) * 65 + lane]; H = a * H + g; Ap *= a; }
            seg[(w * 64 + lane) * 2] = Ap; seg[(w * 64 + lane) * 2 + 1] = H;
        }
        __syncthreads();
        float h = carry[lane];
        for (int s2 = 0; s2 < w; ++s2) h = seg[(s2 * 64 + lane) * 2] * h + seg[(s2 * 64 + lane) * 2 + 1];
#pragma unroll
        for (int i = 0; i < 16; ++i) { const int t = 16 * w + i; h = Aa[t * 65 + lane] * h + Ga[t * 65 + lane]; Y[(row0 + t) * D + ch_s] = (bf16)f2bf(h * gelu_tanh(bf2f(zv[i]))); }
        __syncthreads();
        if (w == 7) carry[lane] = h;
    }
    __syncthreads();
}

__device__ __forceinline__ void ph_headnorm(Frame& F) {
    bf16* Y = (bf16*)(F.ws + WS_Y); const float* sumsq = (const float*)(F.ws + WS_SUMSQ); const float* hg = F.in(16);
    const int gt = F.vcu * NT + F.tid, NGT = F.G * NT;
    for (int idx = gt; idx < T * 128; idx += NGT) { const int t = idx >> 7, c8 = idx & 127, hh = c8 >> 5;
        const f32x4 ss = *(const f32x4*)(sumsq + (size_t)t * 16 + hh * 4); const float rstd = 1.0f / sqrtf(((ss[0] + ss[1]) + (ss[2] + ss[3])) * (1.0f / 256.0f) + EPS);
        bf16* p = Y + (size_t)t * D + 1024 + c8 * 8; const u32x4 v = *(const u32x4*)p; const f32x4 g0 = *(const f32x4*)(hg + c8 * 8), g1 = *(const f32x4*)(hg + c8 * 8 + 4);
        u32x4 o; o.x = pk2(bf_lo(v.x) * rstd * g0[0], bf_hi(v.x) * rstd * g0[1]); o.y = pk2(bf_lo(v.y) * rstd * g0[2], bf_hi(v.y) * rstd * g0[3]);
        o.z = pk2(bf_lo(v.z) * rstd * g1[0], bf_hi(v.z) * rstd * g1[1]); o.w = pk2(bf_lo(v.w) * rstd * g1[2], bf_hi(v.w) * rstd * g1[3]);
        *(u32x4*)p = o; }
}

constexpr int RT_ROWS = 128;
__device__ __forceinline__ void ph_router(Frame& F, int l, bool dummy) {
    LAS float* lg = (LAS float*)(F.lds);
    LAS float* info = (LAS float*)(F.lds + 20480);
    LAS unsigned* lcnt = (LAS unsigned*)(F.lds + 28672);
    const int tid = F.tid, lane = F.lane, w = F.wave, l15 = lane & 15, lq = lane >> 4;
    const bf16* x1 = (const bf16*)(F.ws + WS_XB); const bf16* WH = (const bf16*)(F.ws + WS_RW) + (size_t)(l * 2) * 32 * 2048; const bf16* WL = WH + (size_t)32 * 2048;
    const float* bcs = F.in(30) + l * 4; const float* bfn = F.in(32) + l * 16;
    const size_t doff = dummy ? (size_t)200 * MiB : 0; const int cw = dummy ? 20480 : CW_CNT + l * 32 * 64;
    int* ptok = (int*)(F.ws + WS_PTOK + doff); float* prstd = (float*)(F.ws + WS_PRSTD + doff); float* pga = (float*)(F.ws + WS_PGA + doff); float* pgb = (float*)(F.ws + WS_PGB + doff);
    for (int base = F.vcu * RT_ROWS; base < T; base += F.G * RT_ROWS) {
        if (tid < 32) lcnt[tid] = 0u;
        {
            const bf16* xr = x1 + (size_t)(base + 16 * w + l15) * D + 8 * lq;
            const bf16* wh0 = WH + (size_t)l15 * 2048 + 8 * lq; const bf16* wh1 = WH + (size_t)(16 + l15) * 2048 + 8 * lq;
            const bf16* wl0 = WL + (size_t)l15 * 2048 + 8 * lq; const bf16* wl1 = WL + (size_t)(16 + l15) * 2048 + 8 * lq;
            f32x4 acc0 = (f32x4){0.f, 0.f, 0.f, 0.f}, acc1 = acc0; float ss = 0.f;
#pragma unroll 4
            for (int ks = 0; ks < 64; ++ks) {
                const bf16x8 a = *(const GAS bf16x8*)(xr + 32 * ks);
                const bf16x8 h0 = *(const GAS bf16x8*)(wh0 + 32 * ks), h1 = *(const GAS bf16x8*)(wh1 + 32 * ks), o0 = *(const GAS bf16x8*)(wl0 + 32 * ks), o1 = *(const GAS bf16x8*)(wl1 + 32 * ks);
                acc0 = __builtin_amdgcn_mfma_f32_16x16x32_bf16(a, h0, acc0, 0, 0, 0); acc1 = __builtin_amdgcn_mfma_f32_16x16x32_bf16(a, h1, acc1, 0, 0, 0);
                acc0 = __builtin_amdgcn_mfma_f32_16x16x32_bf16(a, o0, acc0, 0, 0, 0); acc1 = __builtin_amdgcn_mfma_f32_16x16x32_bf16(a, o1, acc1, 0, 0, 0);
                const u32x4 au = __builtin_bit_cast(u32x4, a);
                ss += (bf_lo(au.x) * bf_lo(au.x) + bf_hi(au.x) * bf_hi(au.x)) + (bf_lo(au.y) * bf_lo(au.y) + bf_hi(au.y) * bf_hi(au.y)) + (bf_lo(au.z) * bf_lo(au.z) + bf_hi(au.z) * bf_hi(au.z)) + (bf_lo(au.w) * bf_lo(au.w) + bf_hi(au.w) * bf_hi(au.w)); }
            ss += __shfl_xor(ss, 16); ss += __shfl_xor(ss, 32);
#pragma unroll
            for (int r = 0; r < 4; ++r) { lg[(16 * w + 4 * lq + r) * 33 + l15] = acc0[r]; lg[(16 * w + 4 * lq + r) * 33 + 16 + l15] = acc1[r]; }
            if (lq == 0) lg[(16 * w + l15) * 33 + 32] = ss;
        }
        __syncthreads();
        if (tid < RT_ROWS) {
            const LAS float* lr = lg + tid * 33;
            const float rstd = 1.0f / sqrtf(lr[32] * (1.0f / D) + EPS);
            float lc[4], lf[16];
#pragma unroll
            for (int c = 0; c < 4; ++c) lc[c] = lr[c] * rstd + bcs[c];
#pragma unroll
            for (int c = 0; c < 16; ++c) lf[c] = lr[4 + c] * rstd + bfn[c];
            int gi = 0; float gm = lc[0];
#pragma unroll
            for (int c = 1; c < 4; ++c) if (lc[c] > gm) { gm = lc[c]; gi = c; }
            float se = 0.f;
#pragma unroll
            for (int c = 0; c < 4; ++c) se += expf(lc[c] - gm);
            const float pg = 1.0f / se;
            float fs[4];
#pragma unroll
            for (int c = 0; c < 4; ++c) fs[c] = (gi == 0) ? lf[c] : (gi == 1) ? lf[4 + c] : (gi == 2) ? lf[8 + c] : lf[12 + c];
            int i0 = 0; float v0 = fs[0];
#pragma unroll
            for (int c = 1; c < 4; ++c) if (fs[c] > v0) { v0 = fs[c]; i0 = c; }
            int i1 = -1; float v1 = 0.f;
#pragma unroll
            for (int c = 0; c < 4; ++c) if (c != i0 && (i1 < 0 || fs[c] > v1)) { v1 = fs[c]; i1 = c; }
            const float e1 = expf(v1 - v0), s0 = 1.0f / (1.0f + e1), w0g = s0 * pg, w1g = (e1 * s0) * pg;
            const int ia = i0 < i1 ? i0 : i1, ib = i0 < i1 ? i1 : i0, pidx = (ia == 0) ? ib - 1 : (ia == 1) ? ib + 1 : 5, q = gi * 6 + pidx;
            LAS float* ip = info + tid * 8; ip[0] = __builtin_bit_cast(float, q); ip[1] = (i0 < i1) ? w0g : w1g; ip[2] = (i0 < i1) ? w1g : w0g; ip[3] = rstd;
            ip[4] = __builtin_bit_cast(float, __hip_atomic_fetch_add(&lcnt[q], 1u, __ATOMIC_RELAXED, __HIP_MEMORY_SCOPE_WORKGROUP));
        }
        __syncthreads();
        if (tid < NPAIR) lcnt[32 + tid] = __hip_atomic_fetch_add((unsigned*)(F.ctl + cw + tid * 64), lcnt[tid], RLX_AGENT);
        __syncthreads();
        if (tid < RT_ROWS) { LAS float* ip = info + tid * 8; const int row = base + tid; const int q = __builtin_bit_cast(int, ip[0]);
            const size_t p = (size_t)q * T + lcnt[32 + q] + __builtin_bit_cast(unsigned, ip[4]);
            ptok[p] = row; pga[p] = ip[1]; pgb[p] = ip[2]; prstd[p] = ip[3]; }
        __syncthreads();
    }
}
__device__ __forceinline__ void moe_table(Frame& F, int l) {
    if (F.tid == 0) { unsigned pre = 0u;
        for (int q = 0; q < NPAIR; ++q) { const unsigned c = ld_agent_u32((const unsigned*)(F.ctl + CW_CNT + (l * 32 + q) * 64)); F.MISC[MI_CNT + q] = c; F.MISC[MI_PRE + q] = pre; pre += (c + 255u) >> 8; }
        F.MISC[MI_PRE + NPAIR] = pre; }
    __syncthreads();
}
__device__ __forceinline__ void ph_rowpass(Frame& F, int l, bool dummy) {
    const int gw = F.vcu * NWAVES + F.wave, NGW = F.G * NWAVES, lane = F.lane;
    const bf16* xb = (const bf16*)(F.ws + WS_XB); float* rstd_o = (float*)(F.ws + WS_RSTD);
    const float* gfin = F.in(3);
    for (int m = gw; m < T; m += NGW) {
        const GAS u32x2* xr = (const GAS u32x2*)(xb + (size_t)m * D) + lane;
        f32x4 v[8]; float ss = 0.f;
#pragma unroll
        for (int j = 0; j < 8; ++j) { const u32x2 x = xr[64 * j]; v[j].x = bf_lo(x.x); v[j].y = bf_hi(x.x); v[j].z = bf_lo(x.y); v[j].w = bf_hi(x.y);
            ss += (v[j].x * v[j].x + v[j].y * v[j].y) + (v[j].z * v[j].z + v[j].w * v[j].w); }
        ss = wave_sum(ss); const float rstd = 1.0f / sqrtf(ss * (1.0f / D) + EPS);
        if (l == 0) { if (lane == 0) (dummy ? (float*)(F.ws + 950 * MiB) : rstd_o)[m] = rstd; }
        else {
            GAS f32x4* xw = dummy ? (GAS f32x4*)((float*)(F.ws + WS_Y) + (size_t)(m & 16383) * D) + lane : (GAS f32x4*)(F.out + (size_t)m * D) + lane;
#pragma unroll
            for (int j = 0; j < 8; ++j) { const f32x4 g = *((const f32x4*)gfin + lane + 64 * j); xw[64 * j] = v[j] * rstd * g; }
        }
    }
}
constexpr int S5_UP = 528, S5_XP = 272, S5_U = 0, S5_X = 67584, S5_T = 106496;
__device__ __forceinline__ void cmul_add(float ar, float ai, float br, float bi, float cr, float ci, float& orr, float& oi) { orr = ar * br - ai * bi + cr; oi = ar * bi + ai * br + ci; }
__device__ __forceinline__ void ph_s5core(Frame& F, int pf) {
    LAS unsigned char* L = F.lds;
    const int tid = F.tid, lane = F.lane, w = F.wave, l15 = lane & 15, lq = lane >> 4;
    const bf16* A2 = (const bf16*)(F.ws + WS_A2); bf16* Y2 = (bf16*)(F.ws + ((pf & 8) ? WS_XIN : WS_Y));
    const int urow = tid >> 2, uq = tid & 3;
    u32x4 ust[8];
    const int upc = (2048 + F.G - 1) / F.G;
    const int L0 = F.vcu * upc, Lend = (L0 + upc < 2048) ? L0 + upc : 2048;
    if (L0 < 2048) { const bf16* src = A2 + ((size_t)(L0 >> 4) * 2048 + (size_t)(L0 & 15) * 128 + urow) * 256 + uq * 64;
#pragma unroll
        for (int i = 0; i < 8; ++i) ust[i] = *(const GAS u32x4*)(src + i * 8); }
    for (int Lu = L0; Lu < Lend; ++Lu) {
        const int g = Lu >> 4, b = Lu & 15;
        const bf16* Wi = (const bf16*)(F.ws + WS_S5WIN) + (size_t)g * 128 * 256; const bf16* Wc = (const bf16*)(F.ws + WS_S5WC) + (size_t)g * 256 * 384;
#pragma unroll
        for (int i = 0; i < 8; ++i) *(LAS u32x4*)(L + S5_U + urow * S5_UP + (uq * 64 + i * 8) * 2) = ust[i];
        bf16x8 wb[8];
#pragma unroll
        for (int ks = 0; ks < 8; ++ks) wb[ks] = *(const GAS bf16x8*)(Wi + (size_t)(16 * w + l15) * 256 + 32 * ks + 8 * lq);
        const f32x4 lam = *(const GAS f32x4*)((const float*)(F.ws + WS_LAM) + ((size_t)g * 64 + 8 * w + (l15 & 7)) * 4);
        __syncthreads();
        f32x4 X[8];
#pragma unroll
        for (int rt = 0; rt < 8; ++rt) X[rt] = (f32x4){0.f, 0.f, 0.f, 0.f};
        if (!(pf & 64)) {
#pragma unroll
        for (int ks = 0; ks < 8; ++ks) {
#pragma unroll
            for (int rt = 0; rt < 8; ++rt) { const bf16x8 a = *(const LAS bf16x8*)(L + S5_U + (16 * rt + l15) * S5_UP + (32 * ks + 8 * lq) * 2);
                X[rt] = __builtin_amdgcn_mfma_f32_16x16x32_bf16(a, wb[ks], X[rt], 0, 0, 0); } }
        }
        bf16x8 wa[2][4];
#pragma unroll
        for (int mt = 0; mt < 2; ++mt)
#pragma unroll
            for (int k4 = 0; k4 < 4; ++k4) wa[mt][k4] = *(const GAS bf16x8*)(Wc + (size_t)(16 * (2 * w + mt) + l15) * 384 + 32 * k4 + 8 * lq);
        if (!(pf & 16)) {
            const bool isim = (l15 & 8) != 0;
#define S5_XRI(rt_, r_) const float mine_ = X[rt_][r_], oth_ = __builtin_bit_cast(float, __builtin_amdgcn_update_dpp(0, __builtin_bit_cast(int, mine_), 0x128  , 0xf, 0xf, false)); \
            const float xr_ = isim ? oth_ : mine_, xi_ = isim ? mine_ : oth_
            LAS unsigned char* tb = L + S5_T + w * 4096;
#pragma unroll
            for (int rt = 0; rt < 8; ++rt) { float ar = 0.f, ai = 0.f;
#pragma unroll
                for (int r = 0; r < 4; ++r) { S5_XRI(rt, r); float nr, ni; cmul_add(lam[0], lam[1], ar, ai, xr_, xi_, nr, ni); ar = nr; ai = ni; }
                *(LAS f32x2*)(tb + ((rt * 16 + l15) * 4 + lq) * 8) = (f32x2){ar, ai}; }
            asm volatile("s_waitcnt lgkmcnt(0)" ::: "memory");
            float cr = 0.f, ci = 0.f;
#pragma unroll
            for (int rt = 0; rt < 8; ++rt) {
                const f32x4 t0 = *(const LAS f32x4*)(tb + (rt * 16 + l15) * 32), t1 = *(const LAS f32x4*)(tb + (rt * 16 + l15) * 32 + 16);
                float ar = 0.f, ai = 0.f;
#pragma unroll
                for (int o = 0; o < 4; ++o) { if (lq == o) { ar = cr; ai = ci; }
                    const float tr_ = (o == 0) ? t0[0] : (o == 1) ? t0[2] : (o == 2) ? t1[0] : t1[2], ti_ = (o == 0) ? t0[1] : (o == 1) ? t0[3] : (o == 2) ? t1[1] : t1[3];
                    float nr, ni; cmul_add(lam[2], lam[3], cr, ci, tr_, ti_, nr, ni); cr = nr; ci = ni; }
#pragma unroll
                for (int r = 0; r < 4; ++r) { *(LAS bf16*)(L + S5_X + (16 * rt + 4 * lq + r) * S5_XP + (16 * w + l15) * 2) = (bf16)f2bf(isim ? ai : ar);
                    S5_XRI(rt, r); float nr, ni; cmul_add(lam[0], lam[1], ar, ai, xr_, xi_, nr, ni); ar = nr; ai = ni; } }
#undef S5_XRI
        }
        { const int Ln = Lu + 1; if (Ln < Lend) { const bf16* src = A2 + ((size_t)(Ln >> 4) * 2048 + (size_t)(Ln & 15) * 128 + urow) * 256 + uq * 64;
#pragma unroll
            for (int i = 0; i < 8; ++i) ust[i] = *(const GAS u32x4*)(src + i * 8); } }
        __syncthreads();
        f32x4 acc[2][8];
#pragma unroll
        for (int mt = 0; mt < 2; ++mt)
#pragma unroll
            for (int nt = 0; nt < 8; ++nt) acc[mt][nt] = (f32x4){0.f, 0.f, 0.f, 0.f};
        if (!(pf & 32)) {
#pragma unroll
        for (int kb = 0; kb < 3; ++kb) {
            bf16x8 wnx[2][4];
            if (kb < 2) {
#pragma unroll
                for (int mt = 0; mt < 2; ++mt)
#pragma unroll
                    for (int k4 = 0; k4 < 4; ++k4) wnx[mt][k4] = *(const GAS bf16x8*)(Wc + (size_t)(16 * (2 * w + mt) + l15) * 384 + 32 * (4 * (kb + 1) + k4) + 8 * lq);
            }
#pragma unroll
            for (int k4 = 0; k4 < 4; ++k4) { const int ks = 4 * kb + k4;
#pragma unroll
                for (int nt = 0; nt < 8; ++nt) {
                    const bf16x8 bv = (ks < 8) ? *(const LAS bf16x8*)(L + S5_U + (16 * nt + l15) * S5_UP + (32 * ks + 8 * lq) * 2)
                                               : *(const LAS bf16x8*)(L + S5_X + (16 * nt + l15) * S5_XP + (32 * (ks - 8) + 8 * lq) * 2);
                    acc[0][nt] = __builtin_amdgcn_mfma_f32_16x16x32_bf16(wa[0][k4], bv, acc[0][nt], 0, 0, 0);
                    acc[1][nt] = __builtin_amdgcn_mfma_f32_16x16x32_bf16(wa[1][k4], bv, acc[1][nt], 0, 0, 0); } }
            if (kb < 2) {
#pragma unroll
                for (int mt = 0; mt < 2; ++mt)
#pragma unroll
                    for (int k4 = 0; k4 < 4; ++k4) wa[mt][k4] = wnx[mt][k4];
            }
        }
        }
#pragma unroll
        for (int mt = 0; mt < 2; ++mt)
#pragma unroll
            for (int nt = 0; nt < 8; ++nt) { const int tok = (b * 128 + 16 * nt + l15) * 16 + 2 * w + mt; const f32x4 a = acc[mt][nt];
                u32x2 wv; wv.x = pk2(gelu_tanh(a[0]), gelu_tanh(a[1])); wv.y = pk2(gelu_tanh(a[2]), gelu_tanh(a[3]));
                if (!(pf & 256)) *(GAS u32x2*)(Y2 + ((((size_t)(tok >> 8) * 128 + g) * 256) + (tok & 255)) * 16 + 4 * lq) = wv; else asm volatile("" :: "v"(wv.x), "v"(wv.y)); }
        __syncthreads();
    }
}

struct Args { const float* in[36]; float* out; unsigned char* ws; int ph_lo, ph_hi; };
__global__ void __launch_bounds__(NT, 2) fwd(Args args) {
    extern __shared__ __attribute__((aligned(16))) unsigned char lds[];
    Frame F;
    F.lds = (LAS unsigned char*)lds;
    F.MISC = (volatile LAS unsigned*)(F.lds + MISC_OFF);
    F.tid = threadIdx.x; F.lane = F.tid & 63; F.wave = __builtin_amdgcn_readfirstlane(F.tid >> 6);
    F.G = gridDim.x; { const int bx = blockIdx.x; F.vcu = (F.G % 8 == 0) ? (bx % 8) * (F.G / 8) + bx / 8 : bx; }
    F.out = args.out; F.ws = args.ws; F.ctl = (gu32*)(args.ws + WS_CTL);
    if (F.tid < 64) F.MISC[F.tid] = 0u;
    if (F.tid >= 64 && F.tid < 100) { const unsigned long long pv = (unsigned long long)args.in[F.tid - 64]; F.MISC[64 + 2 * (F.tid - 64)] = (unsigned)pv; F.MISC[65 + 2 * (F.tid - 64)] = (unsigned)(pv >> 32); }
    __syncthreads();
    XcdBarrier bar; bar.bar = (unsigned*)(F.ctl + CW_BAR); bar.x = 0; bar.st = nullptr;
    if (!MK_PER_PHASE) bar = xcd_barrier_post((unsigned*)(F.ctl + CW_BAR), F.MISC + 8);
    const int lo = args.ph_lo & 255, hi = args.ph_hi, pflags = args.ph_lo >> 8;
#ifndef PHMASK
#define PHMASK 0x3ffff
#endif
#define IN(k) ((((PHMASK) >> (k)) & 1) && lo <= (k) && (k) < hi)
#define SEAM(k) do { if (!MK_PER_PHASE && IN(k) && IN((k) + 1)) xcd_barrier(bar); } while (0)
    unsigned char* ws = args.ws;
    bf16* XB = (bf16*)(ws + WS_XB); bf16* Pb = (bf16*)(ws + WS_P); bf16* Yb = (bf16*)(ws + WS_Y); float* RSTD = (float*)(ws + WS_RSTD);
    const int bx = (int)blockIdx.x;

    if (IN(0)) { ph_prologue(F, pflags); }
    SEAM(0);
    if (IN(1)) {
        pg8::GemmP g{nullptr, 2048, 4096u, 32u, 4096u};
        DenseSched S; S.to.init(T / 256, PN / 256, F.G, bx); S.A = (const char*)XB; S.tstepA = (size_t)256 * 4096; S.B0 = (const char*)(ws + WS_WIN); S.B1 = S.B0 + (size_t)128 * 4096; S.tstepB = (size_t)256 * 4096; S.cpt = 256;
        EpiScaleBf16 E{Pb, PN, RSTD};
        pg8::gemm_phase<EpiScaleBf16, DenseSched, false>(F.lds, g, S, E);
    }
    SEAM(1);
    if (IN(2)) {
#ifndef NO_MLSTM
        if (!(pflags & 1)) for (int u = F.vcu; u < 256; u += F.G) mlstm_unit(F, u >> 4, (u >> 2) & 3, u & 3, pflags);
#endif
#ifndef NO_LRU
        if (!(pflags & 2)) for (int u = F.vcu; u < 256; u += F.G) lru_unit(F, u >> 4, (u >> 1) & 7, u & 1);
#endif
    }
    SEAM(2);
    if (IN(3)) { ph_headnorm(F); }
    SEAM(3);
    if (IN(4)) {
        pg8::GemmP g{nullptr, 2048, 4096u, 32u, 4096u};
        DenseSched S; S.to.init(T / 256, D / 256, F.G, bx); S.A = (const char*)Yb; S.tstepA = (size_t)256 * 4096; S.B0 = (const char*)(ws + WS_WOUT); S.B1 = S.B0 + (size_t)128 * 4096; S.tstepB = (size_t)256 * 4096; S.cpt = 256;
        EpiOutRes E{XB};
        pg8::gemm_phase<EpiOutRes, DenseSched, false>(F.lds, g, S, E);
    }
    SEAM(4);
#define MOE_LAYER(PH, l, WSW) \
    if (IN(PH)) { ph_router(F, l, (pflags & 4) != 0); } \
    SEAM(PH); \
    if (IN(PH + 1)) { moe_table(F, l); \
        pg8::GemmP g{(const char*)XB, 2048, 4096u, 32u, 4096u}; \
        MoeSched<false> S{F.MISC, F.G, F.vcu, (const char*)(ws + WSW), (const char*)(ws + WSW + 32 * MiB), nullptr, (const int*)(ws + WS_PTOK)}; \
        EpiGateUp E{(bf16*)(ws + WS_H), (const float*)(ws + WS_PRSTD), (const float*)(ws + WS_PGA), (const float*)(ws + WS_PGB), F.MISC, pflags}; \
        pg8::gemm_phase<EpiGateUp, MoeSched<false>, true>(F.lds, g, S, E); } \
    SEAM(PH + 1); \
    if (IN(PH + 2)) { moe_table(F, l); \
        pg8::GemmP g{nullptr, 1024, 2048u, 32u, 1024u}; \
        MoeSched<true> S{F.MISC, F.G, F.vcu, (const char*)(ws + WSW + 64 * MiB), nullptr, (const char*)(ws + WS_H), nullptr}; \
        EpiDownRes E{XB, (const int*)(ws + WS_PTOK), F.MISC, (pflags & 4) ? (bf16*)(ws + WS_XIN) : XB}; \
        pg8::gemm_phase<EpiDownRes, MoeSched<true>, false, true>(F.lds, g, S, E); } \
    SEAM(PH + 2); \
    if (IN(PH + 3)) { ph_rowpass(F, l, (pflags & 4) != 0); }
    MOE_LAYER(5, 0, WS_WMOE0)
    SEAM(8);
    if (IN(9)) {
        pg8::GemmP g{nullptr, 2048, 4096u, 32u, 4096u};
        DenseSched S; S.to.init(T / 256, D / 256, F.G, bx); S.A = (const char*)XB; S.tstepA = (size_t)256 * 4096; S.B0 = (const char*)(ws + WS_WS5IN); S.B1 = S.B0 + (size_t)128 * 4096; S.tstepB = (size_t)256 * 4096; S.cpt = 256;
        EpiS5U E{(bf16*)(ws + WS_A2), RSTD};
        pg8::gemm_phase<EpiS5U, DenseSched, false>(F.lds, g, S, E);
    }
    SEAM(9);
    if (IN(10)) { ph_s5core(F, pflags); }
    SEAM(12);
    if (IN(13)) {
        pg8::GemmP g{nullptr, 2048, 32u, 8192u, 4096u};
        DenseSched S; S.to.init(T / 256, D / 128, F.G, bx); S.A = (const char*)Yb; S.tstepA = (size_t)128 * 8192; S.B0 = (const char*)(ws + WS_WGLUV); S.B1 = (const char*)(ws + WS_WGLUG); S.tstepB = (size_t)128 * 4096; S.cpt = 128;
        EpiGlu E{(pflags & 4) ? (bf16*)(ws + 712 * MiB) : XB};
        pg8::gemm_phase<EpiGlu, DenseSched, false>(F.lds, g, S, E);
    }
    SEAM(13);
    MOE_LAYER(14, 1, WS_WMOE1)
#undef IN
#undef SEAM
}

extern "C" void kernel_launch(void* const* d_in, const int* in_sizes, int n_in, void* d_out, int out_size, void* d_ws, size_t ws_size, hipStream_t stream) {
    static int grid = 0;
    if (grid == 0) {
        if (n_in != 36 || in_sizes[0] != T * D || out_size != T * D || ws_size < WS_END) { fprintf(stderr, "kernel_launch: unexpected shapes (n_in %d, in0 %d, out %d, ws %zu < %zu); nothing launched\n", n_in, n_in > 0 ? in_sizes[0] : -1, out_size, ws_size, (size_t)WS_END); grid = -1; return; }
        int dev = 0, cus = 0, per_cu = 0;
        if (hipGetDevice(&dev) != hipSuccess || hipDeviceGetAttribute(&cus, hipDeviceAttributeMultiprocessorCount, dev) != hipSuccess) { grid = -1; return; }
        if (hipFuncSetAttribute((const void*)fwd, hipFuncAttributeMaxDynamicSharedMemorySize, LDS_BYTES) != hipSuccess) { fprintf(stderr, "kernel_launch: hipFuncSetAttribute failed\n"); grid = -1; return; }
        if (hipOccupancyMaxActiveBlocksPerMultiprocessor(&per_cu, (const void*)fwd, NT, LDS_BYTES) != hipSuccess || per_cu < 1) fprintf(stderr, "kernel_launch: occupancy query says %d\n", per_cu);
        (void)hipGetLastError();
        grid = cus;
    }
    if (grid < 0) return;
    (void)hipMemsetAsync((char*)d_ws + WS_CTL, 0, CTL_ZERO_BYTES, stream);
    Args a{};
    for (int i = 0; i < 36; ++i) a.in[i] = (const float*)d_in[i];
    a.out = (float*)d_out; a.ws = (unsigned char*)d_ws;
#if MK_PER_PHASE
    for (int ph = 0; ph < NPHASE; ++ph) { a.ph_lo = ph; a.ph_hi = ph + 1; hipLaunchKernelGGL(fwd, dim3(grid), dim3(NT), LDS_BYTES, stream, a);
#ifdef REPEAT_PHASE
        if (ph == REPEAT_PHASE) {
#ifdef REPEAT_FLAGS
            a.ph_lo = ph | (REPEAT_FLAGS << 8);
#endif
            hipLaunchKernelGGL(fwd, dim3(grid), dim3(NT), LDS_BYTES, stream, a); }
#endif
    }
#else
    a.ph_lo = 0; a.ph_hi = NPHASE;
    hipLaunchKernelGGL(fwd, dim3(grid), dim3(NT), LDS_BYTES, stream, a);
#endif
    const hipError_t le = hipPeekAtLastError();
    if (le != hipSuccess) fprintf(stderr, "kernel_launch: launch failed: %s\n", hipGetErrorName(le));
}
```

```cpp
#include <hip/hip_runtime.h>
#include <cstdio>
#include <cstdint>

#define LAS __attribute__((address_space(3)))
#define GAS __attribute__((address_space(1)))
typedef unsigned short bf16;
typedef short bf16x8 __attribute__((ext_vector_type(8)));
typedef float f32x4 __attribute__((ext_vector_type(4)));
typedef float f32x2 __attribute__((ext_vector_type(2)));
typedef unsigned u32x4 __attribute__((ext_vector_type(4)));
typedef unsigned u32x2 __attribute__((ext_vector_type(2)));
typedef GAS unsigned gu32;
#define RLX_AGENT __ATOMIC_RELAXED, __HIP_MEMORY_SCOPE_AGENT
#define LDS_WAIT() asm volatile("s_waitcnt lgkmcnt(0)" ::: "memory")
#define VM_WAIT() asm volatile("s_waitcnt vmcnt(0)" ::: "memory")

#ifndef MK_PER_PHASE
#define MK_PER_PHASE 0
#endif

constexpr int T = 32768, D = 2048, SEQ = 2048, NBATCH = 16;
constexpr int NWAVES = 8, NT = 512;
constexpr int INCOLS = 6152, PN = 6144;
constexpr int NEXP = 16, FF = 512;
constexpr int NPAIR = 24;
constexpr int SLOT_ROWS = 32768 + NPAIR * 256;
constexpr float EPS = 1e-6f;
constexpr int NPHASE = 18;

typedef __bf16 bf16x2_t __attribute__((ext_vector_type(2)));
__device__ __forceinline__ unsigned pk2(float lo, float hi) { f32x2 v = {lo, hi}; bf16x2_t b = __builtin_convertvector(v, bf16x2_t); return __builtin_bit_cast(unsigned, b); }
__device__ __forceinline__ unsigned f2bf(float f) { return pk2(f, 0.f) & 0xffffu; }
__device__ __forceinline__ float bf_lo(unsigned w) { return __builtin_bit_cast(float, w << 16); }
__device__ __forceinline__ float bf_hi(unsigned w) { return __builtin_bit_cast(float, w & 0xffff0000u); }
__device__ __forceinline__ float bf2f(bf16 b) { return __builtin_bit_cast(float, ((unsigned)b) << 16); }
typedef int i32x8 __attribute__((ext_vector_type(8)));
typedef int i32x4 __attribute__((ext_vector_type(4)));
__device__ __forceinline__ unsigned pk4_f8(float a, float b, float c, float d) {
    a = __builtin_amdgcn_fmed3f(a, -448.f, 448.f); b = __builtin_amdgcn_fmed3f(b, -448.f, 448.f); c = __builtin_amdgcn_fmed3f(c, -448.f, 448.f); d = __builtin_amdgcn_fmed3f(d, -448.f, 448.f);
    int p = __builtin_amdgcn_cvt_pk_fp8_f32(a, b, 0, false); p = __builtin_amdgcn_cvt_pk_fp8_f32(c, d, p, true); return (unsigned)p; }
constexpr float F8_SX = 8.f, F8_SH = 64.f, F8_SY = 16.f, F8_SW = 512.f, F8_SWD = 256.f;
__device__ __forceinline__ float wave_sum(float v) {
#pragma unroll
    for (int o = 1; o < 64; o <<= 1) v += __shfl_xor(v, o);
    return v;
}
__device__ __forceinline__ float sigmoidf_(float x) { return __builtin_amdgcn_rcpf(1.0f + __expf(-x)); }
__device__ __forceinline__ float gelu_tanh(float x) { const float u = 0.7978845608028654f * (x + 0.044715f * x * x * x); return x * __builtin_amdgcn_rcpf(1.0f + __expf(-2.0f * u)); }
__device__ __forceinline__ float siluf_(float x) { return x * __builtin_amdgcn_rcpf(1.0f + __expf(-x)); }

namespace pg8 {
constexpr int BM = 256, BK = 64, HALF = 128, HTB = HALF * BK * 2, STAGE_BYTES = 8 * HTB, NXCD = 8, WGM = 8;
__host__ __device__ __forceinline__ int lds_byte(int r, int c) { const int st = (r >> 4) * 2 + (c >> 5), rr = r & 15, cc = c & 31, ob = rr * 64 + cc * 2; return st * 1024 + (ob ^ (((ob >> 9) & 1) << 5)); }
__host__ __device__ __forceinline__ void stage_rc(int b, int& R, int& C) { const int st = b / 1024, sb = b % 1024, swz = sb ^ (((sb >> 9) & 1) << 5); R = (st >> 1) * 16 + swz / 64; C = (st & 1) * 32 + (swz % 64) / 2; }
__host__ __device__ __forceinline__ int perm32(int rho) { const int n = rho >> 4, i = rho & 15; return 8 * (i >> 2) + 4 * n + (i & 3); }

struct Unit { const char* a; const char* b0; const char* b1; const char* b0x; const char* b1x; int r0, c0, aux, x; };
struct GemmP { const char* gA; int K; unsigned rsA, planeA, ldb; };

struct TileOrder {
    int nM, nN, nwg, G, c, wgm;
    __device__ __forceinline__ void init(int nM_, int nN_, int G_, int c_, int wgm_ = WGM) { nM = nM_; nN = nN_; nwg = nM * nN; G = G_; c = c_; wgm = wgm_; }
    __device__ __forceinline__ bool next(int i, int& pm, int& pn) const {
        const long L = (long)i * G + c; if (L >= nwg) return false;
        int wgid = (int)L; { const int q = nwg / NXCD, r = nwg % NXCD, xcd = wgid % NXCD, off = wgid / NXCD; wgid = (xcd < r ? xcd * (q + 1) : r * (q + 1) + (xcd - r) * q) + off; }
        const int nig = wgm * nN, gid = wgid / nig, fm = gid * wgm, gsz = (nM - fm) < wgm ? (nM - fm) : wgm;
        pm = fm + ((wgid % nig) % gsz); pn = (wgid % nig) / gsz; return true;
    }
};

template <class Epi, class Sched, bool GATHER, bool DUALB = false, bool FP8 = false>
__device__ __forceinline__ void gemm_phase(LAS unsigned char* lds, const GemmP g, const Sched& S, const Epi& E) {
    const int tid = threadIdx.x, wid = __builtin_amdgcn_readfirstlane(tid >> 6), lane = tid & 63, wr = wid >> 2, wc = wid & 3, fr = lane & 15, fq = lane >> 4;
    const int nt = g.K / BK;
    unsigned voffA[2], voffB[2], coff[2]; int RA[2];
#pragma unroll
    for (int i = 0; i < 2; ++i) { int R, C; stage_rc(tid * 16 + i * 8192, R, C); const int Rb = Epi::PERM ? ((R & ~31) + perm32(R & 31)) : R;
        coff[i] = (unsigned)(C >> 4) * g.planeA + (unsigned)(C & 15) * 2u; RA[i] = R;
        voffA[i] = (unsigned)R * g.rsA + coff[i]; voffB[i] = (unsigned)Rb * g.ldb + (unsigned)C * 2u; }
    const size_t ksA = (size_t)4 * g.planeA, ksB = (size_t)(BK * 2);
    const size_t hstepA = (size_t)HALF * g.rsA;
    const unsigned ldsw = (unsigned)wid * 1024u;
    const int aoff = lds_byte(wr * 64 + fr, fq * 8), boff = lds_byte(wc * 32 + fr, fq * 8);
#define PG8_SA(b, h) (((b) * 2 + (h)) * HTB)
#define PG8_SB(b, h) ((4 + (b) * 2 + (h)) * HTB)
#define PG8_STG(bufoff, ptr, o0, o1) do { \
        __builtin_amdgcn_global_load_lds((const unsigned*)((const char*)(ptr) + (o0)), (LAS unsigned*)(lds + (bufoff) + ldsw), 16, 0, 0); \
        __builtin_amdgcn_global_load_lds((const unsigned*)((const char*)(ptr) + (o1)), (LAS unsigned*)(lds + (bufoff) + ldsw + 8192), 16, 0, 0); } while (0)
#define PG8_STAGE_B(bufoff, ptr) PG8_STG(bufoff, ptr, voffB[0], voffB[1])
#define PG8_STAGE_A(bufoff, h, ptr, usenext) do { if constexpr (GATHER) { const unsigned _o0 = (usenext) ? voN[h][0] : voC[h][0], _o1 = (usenext) ? voN[h][1] : voC[h][1]; PG8_STG(bufoff, ptr, _o0, _o1); } \
        else { PG8_STG(bufoff, (ptr) + (h) * hstepA, voffA[0], voffA[1]); } } while (0)
#define PG8_LD16(off) (*(const LAS bf16x8*)(lds + (off)))
#define PG8_CAT8(x, y) __builtin_shufflevector(__builtin_bit_cast(i32x4, x), __builtin_bit_cast(i32x4, y), 0, 1, 2, 3, 4, 5, 6, 7)
#define PG8_LDA(dst, b, h) do { if constexpr (FP8) { _Pragma("unroll") for (int m = 0; m < 4; ++m) dst##8[m] = PG8_CAT8(PG8_LD16(PG8_SA(b, h) + aoff + m * 2048), PG8_LD16(PG8_SA(b, h) + aoff + m * 2048 + 1024)); } \
        else { _Pragma("unroll") for (int m = 0; m < 4; ++m) _Pragma("unroll") for (int k = 0; k < 2; ++k) dst[m][k] = PG8_LD16(PG8_SA(b, h) + aoff + m * 2048 + k * 1024); } } while (0)
#define PG8_LDB(dst, b, h) do { if constexpr (FP8) { _Pragma("unroll") for (int n = 0; n < 2; ++n) dst##8[n] = PG8_CAT8(PG8_LD16(PG8_SB(b, h) + boff + n * 2048), PG8_LD16(PG8_SB(b, h) + boff + n * 2048 + 1024)); } \
        else { _Pragma("unroll") for (int n = 0; n < 2; ++n) _Pragma("unroll") for (int k = 0; k < 2; ++k) dst[n][k] = PG8_LD16(PG8_SB(b, h) + boff + n * 2048 + k * 1024); } } while (0)
#define PG8_MMA(ai, bj, At, Bt) do { __builtin_amdgcn_s_setprio(1); \
        if constexpr (FP8) { _Pragma("unroll") for (int m = 0; m < 4; ++m) _Pragma("unroll") for (int n = 0; n < 2; ++n) \
            asm volatile("v_mfma_f32_16x16x128_f8f6f4 %0, %1, %2, %0" : "+v"(acc[ai][bj][m][n]) : "v"(Bt##8[n]), "v"(At##8[m])); } \
        else { _Pragma("unroll") for (int m = 0; m < 4; ++m) _Pragma("unroll") for (int n = 0; n < 2; ++n) _Pragma("unroll") for (int k = 0; k < 2; ++k) \
            acc[ai][bj][m][n] = __builtin_amdgcn_mfma_f32_16x16x32_bf16(Bt[n][k], At[m][k], acc[ai][bj][m][n], 0, 0, 0); } \
        __builtin_amdgcn_s_setprio(0); } while (0)
#define PG8_WAIT_V(n) asm volatile("s_waitcnt vmcnt(" #n ")" ::: "memory")
#define PG8_WAIT_L(n) asm volatile("s_waitcnt lgkmcnt(" #n ")" ::: "memory")
#define PG8_BAR __builtin_amdgcn_s_barrier()
#define PG8_SCHED __builtin_amdgcn_sched_barrier(0)
    Unit cur, nxt; int ui = 0;
    if (!S.next(0, cur)) return;
    unsigned voC[2][2], voN[2][2];
    if constexpr (GATHER) {
#pragma unroll
        for (int h = 0; h < 2; ++h)
#pragma unroll
            for (int i = 0; i < 2; ++i) { voC[h][i] = S.row_off(cur, h * HALF + RA[i]) + coff[i]; voN[h][i] = voC[h][i]; }
    } else { voC[0][0] = voC[0][1] = voC[1][0] = voC[1][1] = 0u; voN[0][0] = voN[0][1] = voN[1][0] = voN[1][1] = 0u; }
    f32x4 acc[2][2][4][2];
#pragma unroll
    for (int a = 0; a < 2; ++a)
#pragma unroll
        for (int b = 0; b < 2; ++b)
#pragma unroll
            for (int m = 0; m < 4; ++m)
#pragma unroll
                for (int n = 0; n < 2; ++n) acc[a][b][m][n] = (f32x4){0.f, 0.f, 0.f, 0.f};
    bf16x8 At[4][2], B0[2][2], B1[2][2];
    i32x8 At8[4], B08[2], B18[2];
    const char* cA = GATHER ? g.gA : cur.a; const char* cB0 = cur.b0; const char* cB1 = cur.b1; const char* cB0x = cur.b0x; const char* cB1x = cur.b1x;
    const int nth = nt >> 1;
#define PG8_BPTR(h, kt) ((DUALB && (kt) >= nth) ? ((h) ? cB1x : cB0x) + (size_t)((kt) - nth) * ksB : ((h) ? cB1 : cB0) + (size_t)(kt) * ksB)
    PG8_STAGE_B(PG8_SB(0, 0), cB0); PG8_STAGE_B(PG8_SB(0, 1), cB1); PG8_STAGE_A(PG8_SA(0, 0), 0, cA, false); PG8_STAGE_A(PG8_SA(0, 1), 1, cA, false);
    if (wr == 1) PG8_BAR;
    PG8_WAIT_V(2); PG8_BAR;
    PG8_STAGE_B(PG8_SB(1, 0), cB0 + ksB); PG8_STAGE_A(PG8_SA(1, 0), 0, cA + ksA, false); PG8_STAGE_B(PG8_SB(1, 1), cB1 + ksB);
    PG8_WAIT_V(6); PG8_BAR;
    for (;;) {
        const bool has_next = S.next(ui + 1, nxt);
        const char* nA = GATHER ? g.gA : (has_next ? nxt.a : cA); const char* nB0 = has_next ? nxt.b0 : cB0; const char* nB1 = has_next ? nxt.b1 : cB1;
        const char* nB0x = has_next ? nxt.b0x : cB0x; const char* nB1x = has_next ? nxt.b1x : cB1x;
        if constexpr (GATHER) {
            if (has_next) {
#pragma unroll
                for (int h = 0; h < 2; ++h)
#pragma unroll
                    for (int i = 0; i < 2; ++i) voN[h][i] = S.row_off(nxt, h * HALF + RA[i]) + coff[i];
            } else {
#pragma unroll
                for (int h = 0; h < 2; ++h)
#pragma unroll
                    for (int i = 0; i < 2; ++i) voN[h][i] = voC[h][i];
            }
        }
#pragma nounroll
        for (int t = 0; t < nt; t += 2) {
            const bool last = (t == nt - 2);
            const char* a1 = cA + (size_t)(t + 1) * ksA;
            const char* a2 = last ? nA : cA + (size_t)(t + 2) * ksA;
            const char* b20 = last ? nB0 : PG8_BPTR(0, t + 2); const char* b21 = last ? nB1 : PG8_BPTR(1, t + 2);
            const char* a3 = a2 + ksA; const char* b30 = last ? nB0 + ksB : PG8_BPTR(0, t + 3); const char* b31 = last ? nB1 + ksB : PG8_BPTR(1, t + 3);
            PG8_LDB(B0, 0, 0); PG8_LDB(B1, 0, 1); PG8_SCHED; PG8_LDA(At, 0, 0); PG8_STAGE_A(PG8_SA(1, 1), 1, a1, false);
            PG8_WAIT_V(8); PG8_WAIT_L(0); PG8_BAR; PG8_MMA(0, 0, At, B0); PG8_MMA(0, 1, At, B1); PG8_BAR; PG8_SCHED;
            PG8_LDA(At, 0, 1); PG8_STAGE_B(PG8_SB(0, 0), b20); PG8_STAGE_B(PG8_SB(0, 1), b21); PG8_STAGE_A(PG8_SA(0, 0), 0, a2, last);
            PG8_WAIT_V(8); PG8_WAIT_L(0); PG8_BAR; PG8_MMA(1, 0, At, B0); PG8_MMA(1, 1, At, B1); PG8_BAR; PG8_SCHED;
            PG8_LDB(B0, 1, 0); PG8_LDB(B1, 1, 1); PG8_SCHED; PG8_LDA(At, 1, 0); PG8_STAGE_A(PG8_SA(0, 1), 1, a2, last);
            PG8_WAIT_V(8); PG8_WAIT_L(0); PG8_BAR; PG8_MMA(0, 0, At, B0); PG8_MMA(0, 1, At, B1); PG8_BAR; PG8_SCHED;
            PG8_LDA(At, 1, 1); PG8_STAGE_B(PG8_SB(1, 0), b30); PG8_STAGE_B(PG8_SB(1, 1), b31); PG8_STAGE_A(PG8_SA(1, 0), 0, a3, last);
            PG8_WAIT_V(8); PG8_WAIT_L(0); PG8_BAR; PG8_MMA(1, 0, At, B0); PG8_MMA(1, 1, At, B1); PG8_BAR; PG8_SCHED;
        }
#ifndef PG8_NOALIGN
        if (wr == 0) PG8_BAR;
#endif
        if constexpr (FP8) asm volatile("s_nop 15\n\ts_nop 15" ::: "memory");
        E(acc, cur, wr, wc, fr, fq);
        if (!has_next) break;
#pragma unroll
        for (int a = 0; a < 2; ++a)
#pragma unroll
            for (int b = 0; b < 2; ++b)
#pragma unroll
                for (int m = 0; m < 4; ++m)
#pragma unroll
                    for (int n = 0; n < 2; ++n) acc[a][b][m][n] = (f32x4){0.f, 0.f, 0.f, 0.f};
        cur = nxt; cA = nA; cB0 = nB0; cB1 = nB1; cB0x = nB0x; cB1x = nB1x; ++ui;
        if constexpr (GATHER) {
#pragma unroll
            for (int h = 0; h < 2; ++h)
#pragma unroll
                for (int i = 0; i < 2; ++i) voC[h][i] = voN[h][i];
        }
#ifndef PG8_NOALIGN
        if (wr == 1) PG8_BAR;
#endif
    }
    PG8_WAIT_V(0);
#ifdef PG8_NOALIGN
    if (wr == 0) PG8_BAR;
#endif
    PG8_BAR;
#undef PG8_BPTR
#undef PG8_SA
#undef PG8_SB
#undef PG8_STG
#undef PG8_STAGE_A
#undef PG8_STAGE_B
#undef PG8_LDA
#undef PG8_LDB
#undef PG8_MMA
#undef PG8_CAT8
#undef PG8_LD16
#undef PG8_WAIT_V
#undef PG8_WAIT_L
#undef PG8_BAR
#undef PG8_SCHED
}
}

#define XB_TMO      128
#define XB_XCNT(j)  (256  + 64 * (j))
#define XB_XSUB(j)  (1280 + 64 * (j))
#define XB_XGEN(j)  (2304 + 64 * (j))
#define XB_TOP      3328
#define XB_TOPGEN   3392
#define XCD_BAR_WORDS 3456
#define XB_SPIN_CAP (1u << 18)
__device__ __forceinline__ unsigned xb_ld(unsigned* p)              { return __hip_atomic_load(p, __ATOMIC_RELAXED, __HIP_MEMORY_SCOPE_AGENT); }
__device__ __forceinline__ unsigned xb_add(unsigned* p, unsigned v) { return __hip_atomic_fetch_add(p, v, __ATOMIC_RELAXED, __HIP_MEMORY_SCOPE_AGENT); }
__device__ __forceinline__ unsigned xb_xcc_id() { return (unsigned)__builtin_amdgcn_s_getreg((3 << 11) | 20) & 0xFu; }
#define XB_SPIN(cond, bar) do { unsigned _sp = 0; while (cond) { __builtin_amdgcn_s_sleep(1); \
    if ((++_sp & 255u) == 0u) { if (xb_ld(&(bar)[XB_TMO])) break; if (_sp > XB_SPIN_CAP) { atomicAdd(&(bar)[XB_TMO], 1u); break; } } } } while (0)
struct XcdBarrier { unsigned* bar; unsigned x; volatile LAS unsigned* st; };
__device__ __forceinline__ XcdBarrier xcd_barrier_post(unsigned* bar, volatile LAS unsigned* st) {
    XcdBarrier b; b.bar = bar; b.x = xb_xcc_id(); b.st = st;
    if (threadIdx.x == 0) (void)xb_add(&bar[XB_XCNT(b.x)], 1u);
    return b;
}
__device__ __forceinline__ void xcd_barrier_complete(unsigned* bar, unsigned x, unsigned& nloc, unsigned& nx) {
    const unsigned G = gridDim.x * gridDim.y * gridDim.z;
    unsigned sum, cnt, mine, sp = 0u;
    for (;;) {
        sum = 0u; cnt = 0u; mine = 0u;
#pragma unroll
        for (unsigned j = 0; j < 16; ++j) { const unsigned c = xb_ld(&bar[XB_XCNT(j)]); sum += c; cnt += (c > 0u) ? 1u : 0u; mine = (j == x) ? c : mine; }
        if (sum == G) break;
        __builtin_amdgcn_s_sleep(1);
        if ((++sp & 255u) == 0u) { if (xb_ld(&bar[XB_TMO])) break; if (sp > XB_SPIN_CAP) { atomicAdd(&bar[XB_TMO], 1u); break; } }
    }
    nloc = mine > 0u ? mine : 1u; nx = cnt > 0u ? cnt : 1u;
}
__device__ __forceinline__ void xcd_barrier(const XcdBarrier& b) {
    asm volatile("s_waitcnt vmcnt(0)" ::: "memory");
    __syncthreads();
    if (threadIdx.x == 0) {
        unsigned* bar = b.bar;
        __builtin_amdgcn_s_waitcnt(0);
        unsigned nloc = b.st[0], nx = b.st[1];
        if (nloc == 0u) { xcd_barrier_complete(bar, b.x, nloc, nx); b.st[0] = nloc; b.st[1] = nx; }
        const unsigned old = xb_add(&bar[XB_XSUB(b.x)], 1u);
        const unsigned gen = old / nloc;
        if (old + 1u == (gen + 1u) * nloc) {
            __builtin_amdgcn_fence(__ATOMIC_RELEASE, "agent");
            asm volatile("s_waitcnt vmcnt(0)" ::: "memory");
            const unsigned og = xb_add(&bar[XB_TOP], 1u);
            const unsigned tg = og / nx;
            if (og + 1u == (tg + 1u) * nx) xb_add(&bar[XB_TOPGEN], 1u);
            else XB_SPIN(xb_ld(&bar[XB_TOPGEN]) == tg, bar);
            __builtin_amdgcn_fence(__ATOMIC_ACQUIRE, "agent");
            xb_add(&bar[XB_XGEN(b.x)], 1u);
            asm volatile("s_waitcnt vmcnt(0)" ::: "memory");
        } else {
            XB_SPIN(xb_ld(&bar[XB_XGEN(b.x)]) == gen, bar);
            __builtin_amdgcn_fence(__ATOMIC_ACQUIRE, "agent");
            asm volatile("s_waitcnt vmcnt(0)" ::: "memory");
        }
    }
    __syncthreads();
}

constexpr size_t MiB = 1u << 20;
constexpr size_t WS_CTL = 0, CTL_ZERO_BYTES = 1 * MiB;
constexpr size_t WS_RSTD = 1 * MiB;
constexpr size_t WS_GATES = 2 * MiB;
constexpr size_t WS_SUMSQ = 3 * MiB;
constexpr size_t WS_RW = 5 * MiB;
constexpr size_t WS_LAM = 6 * MiB;
constexpr size_t WS_LRUW = 7 * MiB;
constexpr size_t WS_TOKL = 8 * MiB;
constexpr size_t WS_RSTDL = 10 * MiB;
constexpr size_t WS_GATEL = 12 * MiB;
constexpr size_t WS_TOKSLOT = 14 * MiB;
constexpr size_t WS_WIN = 16 * MiB;
constexpr size_t WS_WOUT = 40 * MiB;
constexpr size_t WS_WS5IN = 48 * MiB, WS_WGLUV = 56 * MiB, WS_WGLUG = 64 * MiB;
constexpr size_t WS_WMOE0 = 72 * MiB;
constexpr size_t WS_S5WIN = 168 * MiB;
constexpr size_t WS_S5WO = 176 * MiB;
constexpr size_t WS_S5K = 192 * MiB;
constexpr size_t WS_XB = 200 * MiB;
constexpr size_t WS_Y = 328 * MiB;
constexpr size_t WS_P = 456 * MiB;
constexpr size_t WS_H = 456 * MiB;
constexpr size_t WS_PTOK = 540 * MiB;
constexpr size_t WS_PRSTD = 544 * MiB, WS_PGA = 548 * MiB, WS_PGB = 552 * MiB;
constexpr size_t WS_A2 = 456 * MiB;
constexpr size_t WS_XIN = 648 * MiB;
constexpr size_t WS_X8IN = 328 * MiB;
constexpr size_t WS_X8 = 648 * MiB;
constexpr size_t WS_WMOE1 = 840 * MiB;
constexpr size_t WS_END = 936 * MiB;
static_assert(WS_H + (size_t)SLOT_ROWS * 1024 * 2 <= WS_PTOK && WS_PGB + (size_t)NPAIR * T * 4 <= WS_XIN, "moe buffers");
static_assert(WS_A2 + (size_t)128 * 2048 * 384 * 2 <= WS_XIN && WS_XIN + (size_t)128 * 2048 * 128 * 4 <= WS_WMOE1, "s5 buffers");
static_assert(WS_P + (size_t)T * PN * 2 <= WS_WMOE1, "p buffer");
constexpr int CW_BAR = 4096;
constexpr int CW_TMO = 8;
constexpr int CW_PANEL = 32768;
constexpr int CW_CNT = 16384;

constexpr int RING_BYTES = 131072;
constexpr int LDS_BYTES = 163840;
constexpr int MISC_OFF = LDS_BYTES - 1024;
constexpr int MI_PRE = 136, MI_CNT = 164;

struct Frame {
    LAS unsigned char* lds;
    volatile LAS unsigned* MISC;
    gu32* ctl;
    int tid, lane, wave, vcu, G;
    float* out; unsigned char* ws;
    __device__ __forceinline__ const float* in(int i) const {
        const unsigned lo = __builtin_amdgcn_readfirstlane(MISC[64 + 2 * i]), hi = __builtin_amdgcn_readfirstlane(MISC[65 + 2 * i]);
        return (const float*)(((unsigned long long)hi << 32) | lo); }
};

__device__ __forceinline__ void transpose_item(const float* W, int ldw, const float* gain, bf16* WT, int ldt, int nblk, LAS float* scr, int item, int lane) {
    const int kb = item / nblk, nb = item % nblk, k0 = 64 * kb, n0 = 32 * nb;
    float v[32];
#pragma unroll
    for (int i = 0; i < 32; ++i) v[i] = W[(size_t)(k0 + 2 * i + (lane >> 5)) * ldw + n0 + (lane & 31)];
    const int c = lane & 7;
    f32x4 g0 = (f32x4){1.f, 1.f, 1.f, 1.f}, g1 = g0;
    if (gain) { g0 = *(const f32x4*)(gain + k0 + 8 * c); g1 = *(const f32x4*)(gain + k0 + 8 * c + 4); }
#pragma unroll
    for (int i = 0; i < 32; ++i) scr[(2 * i + (lane >> 5)) * 33 + (lane & 31)] = v[i];
    LDS_WAIT(); asm volatile("" ::: "memory");
#pragma unroll
    for (int j = 0; j < 4; ++j) { const int n = (lane >> 3) + 8 * j; const LAS float* s = scr + (8 * c) * 33 + n;
        u32x4 o; o.x = pk2(s[0 * 33] * g0[0], s[1 * 33] * g0[1]); o.y = pk2(s[2 * 33] * g0[2], s[3 * 33] * g0[3]); o.z = pk2(s[4 * 33] * g1[0], s[5 * 33] * g1[1]); o.w = pk2(s[6 * 33] * g1[2], s[7 * 33] * g1[3]);
        *(GAS u32x4*)(WT + (size_t)(n0 + n) * ldt + k0 + 8 * c) = o; }
    LDS_WAIT(); asm volatile("" ::: "memory");
}
__device__ __forceinline__ void transpose_item8(const float* W, int ldw, const float* gain, unsigned char* WT, int ldt, int nblk, LAS float* scr, int item, int lane, float sc) {
    const int kb = item / nblk, nb = item % nblk, k0 = 64 * kb, n0 = 32 * nb;
    float v[32];
#pragma unroll
    for (int i = 0; i < 32; ++i) v[i] = W[(size_t)(k0 + 2 * i + (lane >> 5)) * ldw + n0 + (lane & 31)];
    const int c = lane & 7;
    f32x4 g0 = (f32x4){sc, sc, sc, sc}, g1 = g0;
    if (gain) { g0 = *(const f32x4*)(gain + k0 + 8 * c) * sc; g1 = *(const f32x4*)(gain + k0 + 8 * c + 4) * sc; }
#pragma unroll
    for (int i = 0; i < 32; ++i) scr[(2 * i + (lane >> 5)) * 33 + (lane & 31)] = v[i];
    LDS_WAIT(); asm volatile("" ::: "memory");
#pragma unroll
    for (int j = 0; j < 4; ++j) { const int n = (lane >> 3) + 8 * j; const LAS float* s = scr + (8 * c) * 33 + n;
        u32x2 o; o.x = pk4_f8(s[0 * 33] * g0[0], s[1 * 33] * g0[1], s[2 * 33] * g0[2], s[3 * 33] * g0[3]); o.y = pk4_f8(s[4 * 33] * g1[0], s[5 * 33] * g1[1], s[6 * 33] * g1[2], s[7 * 33] * g1[3]);
        *(GAS u32x2*)(WT + (size_t)(n0 + n) * ldt + k0 + 8 * c) = o; }
    LDS_WAIT(); asm volatile("" ::: "memory");
}
__device__ __forceinline__ void sincos_d(double th, double& s, double& c) {
    const double TWO_PI = 6.283185307179586476925286766559;
    const double k = __builtin_rint(th / TWO_PI); const double x = th - k * TWO_PI;
    const double x2 = x * x; double ts = x, tc = 1.0; s = x; c = 1.0;
#pragma unroll
    for (int i = 1; i <= 16; ++i) { tc *= -x2 / (double)((2 * i - 1) * (2 * i)); ts *= -x2 / (double)((2 * i) * (2 * i + 1)); c += tc; s += ts; }
}
__device__ __forceinline__ void s5_build_group(Frame& F, int g, int half) {
    LAS float* pwr = (LAS float*)(F.lds);
    LAS float* pwi = pwr + 17 * 64;
    LAS float* bbr = pwi + 17 * 64;
    LAS float* bbi = bbr + 1024;
    LAS float* cre = bbi + 1024;
    LAS float* cim = cre + 1024;
    LAS float* km = cim + 1024;
    LAS float* ff = km + 4096;
    LAS float* ctr = ff + 128;
    LAS float* cti = ctr + 1024;
    const int tid = F.tid;
    const float* a_re = F.in(19) + g * 64; const float* a_im = F.in(20) + g * 64;
    if (tid < 64) {
        const double dt = (double)expf(F.in(21)[g]), ar = (double)a_re[tid], ai = (double)a_im[tid];
        const double mag = (double)expf((float)(ar * dt)); double sn, cs; sincos_d(ai * dt, sn, cs);
        const double lr = mag * cs, li = mag * sn; double pr = 1.0, pi = 0.0;
        for (int d = 0; d <= 16; ++d) { pwr[d * 64 + tid] = (float)pr; pwi[d * 64 + tid] = (float)pi; const double nr = pr * lr - pi * li, ni = pr * li + pi * lr; pr = nr; pi = ni; }
        const double den = ar * ar + ai * ai;
        ff[tid] = (float)(((lr - 1.0) * ar + li * ai) / den); ff[64 + tid] = (float)((li * ar - (lr - 1.0) * ai) / den);
        if (half == 0) {
            double q16r = 1.0, q16i = 0.0;
            for (int d = 0; d < 16; ++d) { const double nr = q16r * lr - q16i * li, ni = q16r * li + q16i * lr; q16r = nr; q16i = ni; }
            double q64r = q16r, q64i = q16i;
            for (int d = 0; d < 2; ++d) { const double nr = q64r * q64r - q64i * q64i, ni = 2.0 * q64r * q64i; q64r = nr; q64i = ni; }
            *(f32x4*)((float*)(F.ws + WS_LAM) + ((size_t)g * 64 + tid) * 4) = (f32x4){(float)q16r, (float)q16i, (float)q64r, (float)q64i};
        }
    }
    __syncthreads();
    { const float* pbr = F.in(22) + g * 1024; const float* pbi = F.in(23) + g * 1024; const float* pcr = F.in(24) + g * 1024; const float* pci = F.in(25) + g * 1024;
    for (int idx = tid; idx < 1024; idx += NT) { const int p = idx >> 4; const float br = pbr[idx], bi = pbi[idx]; const float fr = ff[p], fi = ff[64 + p];
        bbr[idx] = fr * br - fi * bi; bbi[idx] = fr * bi + fi * br; const float cr_ = pcr[idx], ci_ = pci[idx]; cre[idx] = cr_; cim[idx] = ci_;
        ctr[(idx & 63) * 16 + (idx >> 6)] = cr_; cti[(idx & 63) * 16 + (idx >> 6)] = ci_; } }
    __syncthreads();
    if (tid < 256) {
        const int d = tid >> 4, co = tid & 15; float ac[16];
#pragma unroll
        for (int ci = 0; ci < 16; ++ci) ac[ci] = 0.f;
        for (int p = 0; p < 64; ++p) { const float c_r = ctr[p * 16 + co], c_i = cti[p * 16 + co], l_r = pwr[d * 64 + p], l_i = pwi[d * 64 + p];
            const float tr = c_r * l_r - c_i * l_i, ti = c_r * l_i + c_i * l_r;
#pragma unroll
            for (int c4 = 0; c4 < 4; ++c4) { const f32x4 br = *(const LAS f32x4*)(bbr + p * 16 + 4 * c4), bi = *(const LAS f32x4*)(bbi + p * 16 + 4 * c4);
#pragma unroll
                for (int j = 0; j < 4; ++j) ac[4 * c4 + j] += tr * br[j] - ti * bi[j]; } }
#pragma unroll
        for (int c4 = 0; c4 < 4; ++c4) *(LAS f32x4*)(km + (d << 8) + (co << 4) + 4 * c4) = (f32x4){ac[4 * c4], ac[4 * c4 + 1], ac[4 * c4 + 2], ac[4 * c4 + 3]};
    }
    __syncthreads();
    const float* dsk = F.in(26) + g * 16;
    if (half == 0) { bf16* KB = (bf16*)(F.ws + WS_S5K) + (size_t)g * 4096;
        for (int idx = tid; idx < 4096; idx += NT) { const int co = (idx >> 4) & 15, ci = idx & 15; float v = km[idx]; if (idx < 256 && ci == co) v += dsk[co]; KB[idx] = (bf16)f2bf(v); } }
    bf16* Wo = (bf16*)(F.ws + WS_S5WO) + (size_t)g * 256 * 128;
    for (int idx = half * 128 * 128 + tid; idx < (half + 1) * 128 * 128; idx += NT) { const int row = idx >> 7, q = idx & 127, tl = row >> 4, co = row & 15, p = 8 * (q >> 4) + (q & 7), part = (q >> 3) & 1;
        const float c_r = cre[co * 64 + p], c_i = cim[co * 64 + p], l_r = pwr[(tl + 1) * 64 + p], l_i = pwi[(tl + 1) * 64 + p];
        Wo[idx] = (bf16)f2bf((part == 0) ? (c_r * l_r - c_i * l_i) : -(c_r * l_i + c_i * l_r)); }
    bf16* Wi = (bf16*)(F.ws + WS_S5WIN) + (size_t)g * 128 * 256;
    for (int idx = half * 64 * 256 + tid; idx < (half + 1) * 64 * 256; idx += NT) { const int row = idx >> 8, col = idx & 255, p = 8 * (row >> 4) + (row & 7), part = (row >> 3) & 1, j = col >> 4, ci = col & 15, d = 15 - j;
        const float l_r = pwr[d * 64 + p], l_i = pwi[d * 64 + p], b_r = bbr[p * 16 + ci], b_i = bbi[p * 16 + ci];
        Wi[idx] = (bf16)f2bf(part == 0 ? (l_r * b_r - l_i * b_i) : (l_r * b_i + l_i * b_r)); }
    __syncthreads();
}

__device__ __forceinline__ void ph_prologue(Frame& F, int pf) {
    LAS float* scr = (LAS float*)(F.lds + F.wave * 16384);
    const int gw = F.vcu * NWAVES + F.wave, NGW = F.G * NWAVES, lane = F.lane;
    constexpr int I_IN = 32 * 192, I_SQ = 32 * 64, I_MOE = 512;
    constexpr int NITEMS = I_IN + 4 * I_SQ + 96 * I_MOE;
    const bool s5first = (F.vcu & 1) != 0;
#pragma nounroll
    for (int pass = 0; pass < 2; ++pass) {
    if ((pass == 0) == s5first) { if (!(pf & 32)) for (int gh = F.vcu; gh < 256; gh += F.G) s5_build_group(F, gh >> 1, gh & 1); }
    else if (!(pf & 16))
    for (int it = gw; it < NITEMS; it += NGW) {
        int r = it;
        if (r < I_IN) { if ((r % 192) < 64) transpose_item8(F.in(4), INCOLS, F.in(1), F.ws + WS_WIN, 2048, 192, scr, r, lane, F8_SW);
            else transpose_item(F.in(4), INCOLS, F.in(1), (bf16*)(F.ws + WS_WIN), 2048, 192, scr, r, lane); continue; } r -= I_IN;
        if (r < I_SQ) { transpose_item(F.in(17), 2048, nullptr, (bf16*)(F.ws + WS_WOUT), 2048, 64, scr, r, lane); continue; } r -= I_SQ;
        if (r < I_SQ) { transpose_item8(F.in(18), 2048, F.in(1) + 2048, F.ws + WS_WS5IN, 2048, 64, scr, r, lane, F8_SW); continue; } r -= I_SQ;
        if (r < I_SQ) { transpose_item8(F.in(27), 2048, nullptr, F.ws + WS_WGLUV, 2048, 64, scr, r, lane, F8_SW); continue; } r -= I_SQ;
        if (r < I_SQ) { transpose_item8(F.in(28), 2048, nullptr, F.ws + WS_WGLUG, 2048, 64, scr, r, lane, F8_SW); continue; } r -= I_SQ;
        const int mat = r / I_MOE, itx = r % I_MOE, l = mat / 48, rem = mat % 48, kind = rem / 16, e = rem % 16;
        unsigned char* base = F.ws + (l ? WS_WMOE1 : WS_WMOE0);
        if (kind < 2) transpose_item8((kind == 0 ? F.in(33) : F.in(34)) + (size_t)(l * 16 + e) * 2048 * 512, 512, F.in(2) + l * 2048, base + (size_t)kind * 32 * MiB + (size_t)e * 512 * 2048, 2048, 16, scr, itx, lane, F8_SW);
        else transpose_item8(F.in(35) + (size_t)(l * 16 + e) * 512 * 2048, 2048, nullptr, base + (size_t)64 * MiB + (size_t)e * 2048 * 512, 512, 64, scr, itx, lane, F8_SWD);
    }
    __syncthreads();
    }
    const int gt = F.vcu * NT + F.tid, NGT = F.G * NT;
    {
        bf16* LW = (bf16*)(F.ws + WS_LRUW); const float* wa_ = F.in(7); const float* wx_ = F.in(9); const float* wc_ = F.in(29); const float* wf_ = F.in(31); const float* nf_ = F.in(2);
        for (int idx = gt; idx < 8 * 256 * 128; idx += NGT) { const int n = idx >> 15, o = (idx >> 7) & 255, i = idx & 127;
            const float v = (o < 128) ? wa_[(size_t)(n * 128 + i) * 128 + o] : wx_[(size_t)(n * 128 + i) * 128 + (o - 128)]; LW[idx] = (bf16)f2bf(v); }
        float* RW = (float*)(F.ws + WS_RW);
        bf16* RWB = (bf16*)RW;
        for (int idx = gt; idx < 2 * 32 * 2048; idx += NGT) { const int l = idx >> 16, n = (idx >> 11) & 31, k = idx & 2047;
            const float w = (n < 4) ? wc_[(size_t)(l * 2048 + k) * 4 + n] * nf_[l * 2048 + k] : (n < 20) ? wf_[(size_t)(l * 2048 + k) * 16 + (n - 4)] * nf_[l * 2048 + k] : 0.f;
            const unsigned hi = f2bf(w); const float lo = w - __builtin_bit_cast(float, hi << 16);
            RWB[((size_t)(l * 2 + 0) * 32 + n) * 2048 + k] = (bf16)hi; RWB[((size_t)(l * 2 + 1) * 32 + n) * 2048 + k] = (bf16)f2bf(lo); }
    }
    LAS float* wgT = (LAS float*)F.lds;
    { const float* win = F.in(4); const float* nm0 = F.in(1);
    for (int idx = F.tid; idx < 16384; idx += NT) { const int k = idx >> 3, c = idx & 7; wgT[c * 2048 + k] = win[(size_t)k * INCOLS + 6144 + c] * nm0[k]; } }
    __syncthreads();
    const float* x = F.in(0); bf16* xb = (bf16*)(F.ws + WS_XB); unsigned char* x8 = F.ws + WS_X8IN; float* rstd_o = (float*)(F.ws + WS_RSTD); float* gates = (float*)(F.ws + WS_GATES);
    const float bias = (lane < 4) ? F.in(14)[lane & 3] : F.in(15)[lane & 3];
    if (!(pf & 64))
    for (int m0 = 2 * gw; m0 < T; m0 += 2 * NGW) {
        f32x4 v[2][8]; float ss[2] = {0.f, 0.f};
#pragma unroll
        for (int q = 0; q < 2; ++q) { const GAS f32x4* xr = (const GAS f32x4*)(x + (size_t)(m0 + q) * D) + lane;
#pragma unroll
            for (int j = 0; j < 8; ++j) v[q][j] = xr[64 * j]; }
#pragma unroll
        for (int q = 0; q < 2; ++q) { const int m = m0 + q;
#pragma unroll
            for (int j = 0; j < 8; ++j) ss[q] += (v[q][j].x * v[q][j].x + v[q][j].y * v[q][j].y) + (v[q][j].z * v[q][j].z + v[q][j].w * v[q][j].w);
            ss[q] = wave_sum(ss[q]); const float rstd = 1.0f / sqrtf(ss[q] * (1.0f / D) + EPS);
            GAS u32x2* o8 = (GAS u32x2*)(xb + (size_t)m * D) + lane; GAS unsigned* o4 = (GAS unsigned*)(x8 + (size_t)m * D) + lane;
#pragma unroll
            for (int j = 0; j < 8; ++j) { u32x2 w; w.x = pk2(v[q][j].x, v[q][j].y); w.y = pk2(v[q][j].z, v[q][j].w); o8[64 * j] = w;
                o4[64 * j] = pk4_f8(v[q][j].x * F8_SX, v[q][j].y * F8_SX, v[q][j].z * F8_SX, v[q][j].w * F8_SX); }
            float ga[8];
#pragma unroll
            for (int c = 0; c < 8; ++c) { float a = 0.f;
#pragma unroll
                for (int j = 0; j < 8; ++j) { const f32x4 w = *(const LAS f32x4*)(wgT + c * 2048 + 4 * (lane + 64 * j)); a += (v[q][j].x * w.x + v[q][j].y * w.y) + (v[q][j].z * w.z + v[q][j].w * w.w); }
                ga[c] = wave_sum(a); asm volatile("" ::: "memory"); }
            float val = ga[0];
#pragma unroll
            for (int c = 1; c < 8; ++c) val = (lane == c) ? ga[c] : val;
            if (lane < 8) gates[(size_t)m * 8 + lane] = val * rstd + bias;
            if (lane == 0) rstd_o[m] = rstd; }
    }
    __syncthreads();
}

__device__ __forceinline__ unsigned ld_agent_u32(const unsigned* p) { return __hip_atomic_load(p, RLX_AGENT); }
__device__ __forceinline__ float ld_agent_f32(const float* p) { return __builtin_bit_cast(float, __hip_atomic_load((const unsigned*)p, RLX_AGENT)); }
using pg8::Unit;

struct DenseSched {
    pg8::TileOrder to; const char* A; size_t tstepA; const char* B0; const char* B1; size_t tstepB; int cpt;
    __device__ __forceinline__ bool next(int i, Unit& u) const { int pm, pn; if (!to.next(i, pm, pn)) return false;
        u.a = A + (size_t)pm * tstepA; u.b0 = B0 + (size_t)pn * tstepB; u.b1 = B1 + (size_t)pn * tstepB; u.b0x = u.b0; u.b1x = u.b1; u.r0 = pm * 256; u.c0 = pn * cpt; u.aux = 0; u.x = 0; return true; }
    __device__ __forceinline__ unsigned row_off(const Unit&, int) const { return 0u; }
    __device__ __forceinline__ void a_ready(const Unit&) const {}
};
struct S5Sched {
    int G, c; const char* A; const char* B; size_t gstepB; size_t hstepB;
    __device__ __forceinline__ bool next(int i, Unit& u) const { const int L = i * G + c; if (L >= 1024) return false; const int g = L >> 3, pm = L & 7;
        u.a = A + ((size_t)g * 2048 + (size_t)pm * 256) * 768; u.b0 = B + (size_t)g * gstepB; u.b1 = u.b0 + hstepB; u.b0x = u.b0; u.b1x = u.b1; u.r0 = pm * 256; u.c0 = 0; u.aux = g; u.x = 0; return true; }
    __device__ __forceinline__ unsigned row_off(const Unit&, int) const { return 0u; }
    __device__ __forceinline__ void a_ready(const Unit&) const {}
};
__device__ __forceinline__ void pair_experts(int q, int& ea, int& eb) { const int g = q / 6, p = q - 6 * g; const int ia = (p < 3) ? 0 : (p < 5) ? 1 : 2, ib = (p < 3) ? p + 1 : (p < 5) ? p - 1 : 3; ea = 4 * g + ia; eb = 4 * g + ib; }
template <bool DOWN> struct MoeSched {
    volatile LAS unsigned* misc; int G, c; const char* W0; const char* W1; const char* Hd; const int* ptok;
    __device__ __forceinline__ bool next(int i, Unit& u) const {
        const int L = i * G + c, ntiles = __builtin_amdgcn_readfirstlane((int)misc[MI_PRE + NPAIR]); if (L >= ntiles * 8) return false;
        int q = 0;
#pragma unroll
        for (int j = 1; j < NPAIR; ++j) q += ((L >> 3) >= __builtin_amdgcn_readfirstlane((int)misc[MI_PRE + j])) ? 1 : 0;
        const int pq = __builtin_amdgcn_readfirstlane((int)misc[MI_PRE + q]), tq = __builtin_amdgcn_readfirstlane((int)misc[MI_PRE + q + 1]) - pq, loc = L - 8 * pq;
        const int ct = loc / tq, gr = pq + (loc - ct * tq);
        int ea, eb; pair_experts(q, ea, eb);
        u.aux = q; u.r0 = gr * 256; u.x = (gr - pq) * 256;
        if (!DOWN) { const int e = (ct < 4) ? ea : eb; u.c0 = ct * 128; u.a = nullptr;
            u.b0 = W0 + (size_t)e * 512 * 2048 + (size_t)(ct & 3) * 128 * 2048; u.b1 = W1 + (size_t)e * 512 * 2048 + (size_t)(ct & 3) * 128 * 2048; u.b0x = u.b0; u.b1x = u.b1; }
        else { u.c0 = ct * 256; u.a = Hd + (size_t)gr * 256 * 1024;
            u.b0 = W0 + (size_t)ea * 2048 * 512 + (size_t)ct * 256 * 512; u.b1 = u.b0 + (size_t)128 * 512; u.b0x = W0 + (size_t)eb * 2048 * 512 + (size_t)ct * 256 * 512; u.b1x = u.b0x + (size_t)128 * 512; }
        return true; }
    __device__ __forceinline__ unsigned row_off(const Unit& u, int row) const { const int cnt = __builtin_amdgcn_readfirstlane((int)misc[MI_CNT + u.aux]); int idx = u.x + row; idx = idx < cnt ? idx : cnt - 1;
        return (unsigned)ptok[(size_t)u.aux * T + idx] * 2048u; }
};

struct EpiScaleBf16 {
    static constexpr bool PERM = true;
    bf16* O; int ldc; const float* scale; int pf; float k;
    __device__ __forceinline__ void operator()(const f32x4 (&acc)[2][2][4][2], const Unit& u, int wr, int wc, int fr, int fq) const {
        const int row0 = u.r0 + wr * 64 + fr, col0 = u.c0 + wc * 32 + 8 * fq;
        float sv[2][4];
#pragma unroll
        for (int ai = 0; ai < 2; ++ai)
#pragma unroll
            for (int m = 0; m < 4; ++m) sv[ai][m] = scale[row0 + ai * 128 + m * 16];
#pragma unroll
        for (int ai = 0; ai < 2; ++ai)
#pragma unroll
            for (int m = 0; m < 4; ++m) { int zz = 0; asm volatile("" : "+v"(zz)); const int row = row0 + ai * 128 + m * 16 + zz; const float s = sv[ai][m] * k; bf16* rowp = O + (size_t)row * ldc + col0;
#pragma unroll
                for (int bj = 0; bj < 2; ++bj) { const f32x4 v0 = acc[ai][bj][m][0] * s, v1 = acc[ai][bj][m][1] * s;
                    u32x4 w; w.x = pk2(v0[0], v0[1]); w.y = pk2(v0[2], v0[3]); w.z = pk2(v1[0], v1[1]); w.w = pk2(v1[2], v1[3]);
                    if (!(pf & 16)) *(u32x4*)(rowp + bj * 128) = w; else asm volatile("" :: "v"(w.x), "v"(w.y), "v"(w.z), "v"(w.w)); } }
    }
};
struct EpiS5U {
    static constexpr bool PERM = true;
    bf16* A2; const float* scale; float k;
    __device__ __forceinline__ void operator()(const f32x4 (&acc)[2][2][4][2], const Unit& u, int wr, int wc, int fr, int fq) const {
        const int row0 = u.r0 + wr * 64 + fr, col0 = u.c0 + wc * 32 + 8 * fq;
        float sv[2][4];
#pragma unroll
        for (int ai = 0; ai < 2; ++ai)
#pragma unroll
            for (int m = 0; m < 4; ++m) sv[ai][m] = scale[row0 + ai * 128 + m * 16];
#pragma unroll
        for (int ai = 0; ai < 2; ++ai)
#pragma unroll
            for (int m = 0; m < 4; ++m) { int zz = 0; asm volatile("" : "+v"(zz)); const int t = row0 + ai * 128 + m * 16 + zz; const float s = sv[ai][m] * k; const int n = t >> 4, tl = t & 15;
#pragma unroll
                for (int bj = 0; bj < 2; ++bj) { const int c = col0 + bj * 128, g = c >> 4, half = (c >> 3) & 1; const f32x4 v0 = acc[ai][bj][m][0] * s, v1 = acc[ai][bj][m][1] * s;
                    u32x4 w; w.x = pk2(v0[0], v0[1]); w.y = pk2(v0[2], v0[3]); w.z = pk2(v1[0], v1[1]); w.w = pk2(v1[2], v1[3]);
                    *(u32x4*)(A2 + ((size_t)g * 2048 + n) * 256 + tl * 16 + half * 8) = w; } }
    }
};
struct EpiOutRes {
    static constexpr bool PERM = true;
    bf16* xb; unsigned char* x8;
    __device__ __forceinline__ void operator()(const f32x4 (&acc)[2][2][4][2], const Unit& u, int wr, int wc, int fr, int fq) const {
        const int row0 = u.r0 + wr * 64 + fr, col0 = u.c0 + wc * 32 + 8 * fq;
        u32x4 xr[2][4][2];
#pragma unroll
        for (int ai = 0; ai < 2; ++ai)
#pragma unroll
            for (int m = 0; m < 4; ++m)
#pragma unroll
                for (int bj = 0; bj < 2; ++bj) xr[ai][m][bj] = *(const u32x4*)(xb + (size_t)(row0 + ai * 128 + m * 16) * D + col0 + bj * 128);
#pragma unroll
        for (int ai = 0; ai < 2; ++ai)
#pragma unroll
            for (int m = 0; m < 4; ++m) { int zz = 0; asm volatile("" : "+v"(zz)); const size_t off = (size_t)(row0 + ai * 128 + m * 16 + zz) * D + col0;
#pragma unroll
                for (int bj = 0; bj < 2; ++bj) { const f32x4 a0 = acc[ai][bj][m][0], a1 = acc[ai][bj][m][1]; const u32x4 x = xr[ai][m][bj];
                    const float v0 = bf_lo(x.x) + a0[0], v1 = bf_hi(x.x) + a0[1], v2 = bf_lo(x.y) + a0[2], v3 = bf_hi(x.y) + a0[3], v4 = bf_lo(x.z) + a1[0], v5 = bf_hi(x.z) + a1[1], v6 = bf_lo(x.w) + a1[2], v7 = bf_hi(x.w) + a1[3];
                    u32x4 w; w.x = pk2(v0, v1); w.y = pk2(v2, v3); w.z = pk2(v4, v5); w.w = pk2(v6, v7);
                    *(u32x4*)(xb + off + bj * 128) = w;
                    u32x2 o; o.x = pk4_f8(v0 * F8_SX, v1 * F8_SX, v2 * F8_SX, v3 * F8_SX); o.y = pk4_f8(v4 * F8_SX, v5 * F8_SX, v6 * F8_SX, v7 * F8_SX);
                    *(u32x2*)(x8 + off + bj * 128) = o; } }
    }
};
struct EpiGlu {
    static constexpr bool PERM = true;
    bf16* xb; unsigned char* x8;
    __device__ __forceinline__ void operator()(const f32x4 (&acc)[2][2][4][2], const Unit& u, int wr, int wc, int fr, int fq) const {
        const int row0 = u.r0 + wr * 64 + fr, col0 = u.c0 + wc * 32 + 8 * fq;
        u32x4 xr[2][4];
#pragma unroll
        for (int ai = 0; ai < 2; ++ai)
#pragma unroll
            for (int m = 0; m < 4; ++m) xr[ai][m] = *(const u32x4*)(xb + (size_t)(row0 + ai * 128 + m * 16) * D + col0);
#pragma unroll
        for (int ai = 0; ai < 2; ++ai)
#pragma unroll
            for (int m = 0; m < 4; ++m) { int zz = 0; asm volatile("" : "+v"(zz)); const size_t off = (size_t)(row0 + ai * 128 + m * 16 + zz) * D + col0;
                constexpr float kk = 1.0f / (F8_SY * F8_SW);
                const f32x4 a0 = acc[ai][0][m][0] * kk, a1 = acc[ai][0][m][1] * kk, g0 = acc[ai][1][m][0] * kk, g1 = acc[ai][1][m][1] * kk; const u32x4 x = xr[ai][m];
                const float v0 = bf_lo(x.x) + a0[0] * sigmoidf_(g0[0]), v1 = bf_hi(x.x) + a0[1] * sigmoidf_(g0[1]), v2 = bf_lo(x.y) + a0[2] * sigmoidf_(g0[2]), v3 = bf_hi(x.y) + a0[3] * sigmoidf_(g0[3]);
                const float v4 = bf_lo(x.z) + a1[0] * sigmoidf_(g1[0]), v5 = bf_hi(x.z) + a1[1] * sigmoidf_(g1[1]), v6 = bf_lo(x.w) + a1[2] * sigmoidf_(g1[2]), v7 = bf_hi(x.w) + a1[3] * sigmoidf_(g1[3]);
                u32x4 w; w.x = pk2(v0, v1); w.y = pk2(v2, v3); w.z = pk2(v4, v5); w.w = pk2(v6, v7);
                *(u32x4*)(xb + off) = w;
                u32x2 o; o.x = pk4_f8(v0 * F8_SX, v1 * F8_SX, v2 * F8_SX, v3 * F8_SX); o.y = pk4_f8(v4 * F8_SX, v5 * F8_SX, v6 * F8_SX, v7 * F8_SX);
                *(u32x2*)(x8 + off) = o; }
    }
};
struct EpiGateUp {
    static constexpr bool PERM = true;
    unsigned char* H; const float* prstd; const float* pga; const float* pgb; volatile LAS unsigned* misc; int pf;
    __device__ __forceinline__ void operator()(const f32x4 (&acc)[2][2][4][2], const Unit& u, int wr, int wc, int fr, int fq) const {
        if (pf & 16) { asm volatile("" :: "v"(acc[0][0][0][0][0]), "v"(acc[1][1][3][1][3])); return; }
        const int rl0 = wr * 64 + fr, col0 = u.c0 + wc * 32 + 8 * fq, cnt = __builtin_amdgcn_readfirstlane((int)misc[MI_CNT + u.aux]);
        const float* pg = (u.c0 < 512) ? pga : pgb;
        float sv[2][4], gv[2][4];
#pragma unroll
        for (int ai = 0; ai < 2; ++ai)
#pragma unroll
            for (int m = 0; m < 4; ++m) { int idx = u.x + rl0 + ai * 128 + m * 16; idx = idx < cnt ? idx : cnt - 1; sv[ai][m] = prstd[(size_t)u.aux * T + idx]; gv[ai][m] = pg[(size_t)u.aux * T + idx]; }
#pragma unroll
        for (int ai = 0; ai < 2; ++ai)
#pragma unroll
            for (int m = 0; m < 4; ++m) { int zz = 0; asm volatile("" : "+v"(zz)); const int rl = rl0 + ai * 128 + m * 16 + zz; const float r = sv[ai][m] * (1.0f / (F8_SX * F8_SW)), gt = gv[ai][m] * r * F8_SH;
                float hv[8];
#pragma unroll
                for (int n = 0; n < 2; ++n)
#pragma unroll
                    for (int j = 0; j < 4; ++j) hv[n * 4 + j] = siluf_(acc[ai][0][m][n][j] * r) * (acc[ai][1][m][n][j] * gt);
                u32x2 w; w.x = pk4_f8(hv[0], hv[1], hv[2], hv[3]); w.y = pk4_f8(hv[4], hv[5], hv[6], hv[7]);
                *(u32x2*)(H + (size_t)(u.r0 + rl) * 1024 + col0) = w; }
    }
};
struct EpiDownRes {
    static constexpr bool PERM = true;
    bf16* xb; const int* ptok; volatile LAS unsigned* misc; bf16* dst; unsigned char* x8;
    __device__ __forceinline__ void operator()(const f32x4 (&acc)[2][2][4][2], const Unit& u, int wr, int wc, int fr, int fq) const {
        const int rl0 = wr * 64 + fr, col0 = u.c0 + wc * 32 + 8 * fq, cnt = __builtin_amdgcn_readfirstlane((int)misc[MI_CNT + u.aux]);
        int tk[2][4];
#pragma unroll
        for (int ai = 0; ai < 2; ++ai)
#pragma unroll
            for (int m = 0; m < 4; ++m) { const int idx = u.x + rl0 + ai * 128 + m * 16; tk[ai][m] = (idx < cnt) ? ptok[(size_t)u.aux * T + idx] : -1; }
        u32x4 xr[2][4][2];
#pragma unroll
        for (int ai = 0; ai < 2; ++ai)
#pragma unroll
            for (int m = 0; m < 4; ++m)
#pragma unroll
                for (int bj = 0; bj < 2; ++bj) xr[ai][m][bj] = (tk[ai][m] >= 0) ? *(const u32x4*)(xb + (size_t)tk[ai][m] * D + col0 + bj * 128) : (u32x4){0u, 0u, 0u, 0u};
#pragma unroll
        for (int ai = 0; ai < 2; ++ai)
#pragma unroll
            for (int m = 0; m < 4; ++m) { int zz = 0; asm volatile("" : "+v"(zz)); const int tok = tk[ai][m] + zz;
                if (tok >= 0) {
#pragma unroll
                    for (int bj = 0; bj < 2; ++bj) { constexpr float kk = 1.0f / (F8_SH * F8_SWD); const f32x4 a0 = acc[ai][bj][m][0] * kk, a1 = acc[ai][bj][m][1] * kk; const u32x4 x = xr[ai][m][bj];
                        const float v0 = bf_lo(x.x) + a0[0], v1 = bf_hi(x.x) + a0[1], v2 = bf_lo(x.y) + a0[2], v3 = bf_hi(x.y) + a0[3], v4 = bf_lo(x.z) + a1[0], v5 = bf_hi(x.z) + a1[1], v6 = bf_lo(x.w) + a1[2], v7 = bf_hi(x.w) + a1[3];
                        u32x4 w; w.x = pk2(v0, v1); w.y = pk2(v2, v3); w.z = pk2(v4, v5); w.w = pk2(v6, v7);
                        *(u32x4*)(dst + (size_t)tok * D + col0 + bj * 128) = w;
                        if (x8) { u32x2 o; o.x = pk4_f8(v0 * F8_SX, v1 * F8_SX, v2 * F8_SX, v3 * F8_SX); o.y = pk4_f8(v4 * F8_SX, v5 * F8_SX, v6 * F8_SX, v7 * F8_SX);
                            *(u32x2*)(x8 + (size_t)tok * D + col0 + bj * 128) = o; } } } }
    }
};
struct EpiXin {
    static constexpr bool PERM = false;
    float* X;
    __device__ __forceinline__ void operator()(const f32x4 (&acc)[2][2][4][2], const Unit& u, int wr, int wc, int fr, int fq) const {
        const int rl0 = u.r0 + wr * 64 + fr, col0 = wc * 32 + 4 * fq;
#pragma unroll
        for (int ai = 0; ai < 2; ++ai)
#pragma unroll
            for (int m = 0; m < 4; ++m) { int zz = 0; asm volatile("" : "+v"(zz)); float* rowp = X + ((size_t)u.aux * 2048 + rl0 + ai * 128 + m * 16 + zz) * 128 + col0;
#pragma unroll
                for (int n = 0; n < 2; ++n) *(f32x4*)(rowp + n * 16) = acc[ai][0][m][n]; }
    }
};
struct EpiS5Y {
    static constexpr bool PERM = true;
    bf16* Y2;
    __device__ __forceinline__ void operator()(const f32x4 (&acc)[2][2][4][2], const Unit& u, int wr, int wc, int fr, int fq) const {
        const int rl0 = u.r0 + wr * 64 + fr, col0 = wc * 32 + 8 * fq;
#pragma unroll
        for (int ai = 0; ai < 2; ++ai)
#pragma unroll
            for (int m = 0; m < 4; ++m) { int zz = 0; asm volatile("" : "+v"(zz)); const int n = rl0 + ai * 128 + m * 16 + zz;
#pragma unroll
                for (int bj = 0; bj < 2; ++bj) { const int c = col0 + bj * 128, tl = c >> 4, half = (c >> 3) & 1; const f32x4 a0 = acc[ai][bj][m][0], a1 = acc[ai][bj][m][1];
                    u32x4 w; w.x = pk2(gelu_tanh(a0[0]), gelu_tanh(a0[1])); w.y = pk2(gelu_tanh(a0[2]), gelu_tanh(a0[3])); w.z = pk2(gelu_tanh(a1[0]), gelu_tanh(a1[1])); w.w = pk2(gelu_tanh(a1[2]), gelu_tanh(a1[3]));
                    const int tok = n * 16 + tl;
                    *(u32x4*)(Y2 + ((((size_t)(tok >> 8) * 128 + u.aux) * 256) + (tok & 255)) * 16 + half * 8) = w; } }
    }
};

constexpr int ML_QP = 528, ML_KTP = 144;
constexpr int ML_Q = 0, ML_K = 33792, ML_KT = 67584, ML_C = 104448, ML_SC = 138240;
constexpr int ML_P = ML_K, ML_VT = ML_K + 9216, ML_VWT = ML_Q;
constexpr int ML_CW = 141824;
__device__ __forceinline__ unsigned bf_elem(const u32x4& v, int i) { const unsigned w = v[i >> 1]; return (i & 1) ? (w >> 16) : (w & 0xffffu); }
__device__ __forceinline__ void mlstm_unit(Frame& F, int b, int hh, int s, int pf) {
    LAS unsigned char* L = F.lds; LAS float* sc = (LAS float*)(L + ML_SC);
    const int tid = F.tid, lane = F.lane, w = F.wave, l15 = lane & 15, lq = lane >> 4;
    const bf16* P = (const bf16*)(F.ws + WS_P); bf16* Y = (bf16*)(F.ws + ((pf & 8) ? WS_XB : WS_Y)); const float* gates = (const float*)(F.ws + WS_GATES); float* sumsq = (float*)(F.ws + ((pf & 8) ? 950 * MiB : WS_SUMSQ));
    const int isk = lane >> 5, e0 = 8 * (lane & 31), cch = (isk ? 1024 : 0) + hh * 256 + e0;
    const float osc = isk ? 0.0625f : 1.0f;
    {
        const float* cwp = F.in(12) + cch; const float* cbp = F.in(13) + cch;
        if (w == 0) {
#pragma unroll
            for (int ih = 0; ih < 2; ++ih) {
#pragma unroll
                for (int j = 0; j < 4; ++j) *(LAS f32x4*)(L + ML_CW + ((ih * 5 + j) * 64 + lane) * 16) = *(const GAS f32x4*)(cwp + j * 2048 + 4 * ih);
                *(LAS f32x4*)(L + ML_CW + ((ih * 5 + 4) * 64 + lane) * 16) = *(const GAS f32x4*)(cbp + 4 * ih); }
        }
    }
    f32x4 cacc[2][4];
#pragma unroll
    for (int q = 0; q < 2; ++q)
#pragma unroll
        for (int dc = 0; dc < 4; ++dc) cacc[q][dc] = (f32x4){0.f, 0.f, 0.f, 0.f};
    for (int idx = tid; idx < 33792 / 16; idx += NT) ((LAS u32x4*)(L + ML_C))[idx] = (u32x4){0u, 0u, 0u, 0u};
    if (tid < 256) sc[512 + tid] = 0.f;
    float m_st = 0.f;
    const int tr = w >> 1, cb2 = 2 * (w & 1);
    const int vj = tid >> 3, vdg = tid & 7;
    u32x4 raw[11];
#pragma unroll
    for (int r = 0; r < 11; ++r) { const int t = 8 * w - 3 + r;
        raw[r] = (t >= 0) ? *(const GAS u32x4*)(P + ((size_t)b * SEQ + t) * PN + 2048 + cch) : (u32x4){0u, 0u, 0u, 0u}; }
    float ipn = 0.f, fpn = 0.f;
    if (w == 0) { ipn = gates[((size_t)b * SEQ + lane) * 8 + hh]; fpn = gates[((size_t)b * SEQ + lane) * 8 + 4 + hh]; }
    __syncthreads();
    for (int ch = 0; ch < 32; ++ch) {
        const int t0 = ch * 64; const size_t row0 = (size_t)b * SEQ + t0;
        const u32x4 vraw = *(const GAS u32x4*)(P + (row0 + vj) * PN + 4096 + hh * 256 + s * 64 + 8 * vdg);
        bf16 ov[4][2];
#pragma unroll
        for (int r = 0; r < 4; ++r) { const size_t prow = (row0 + 16 * tr + 4 * lq + r) * PN + 5120 + hh * 256 + s * 64 + 16 * cb2 + l15; ov[r][0] = P[prow]; ov[r][1] = P[prow + 16]; }
        if (!(pf & 16)) {
            asm volatile("" ::: "memory");
#pragma unroll
            for (int ih = 0; ih < 2; ++ih) {
                const f32x4 cb4 = *(const LAS f32x4*)(L + ML_CW + ((ih * 5 + 4) * 64 + lane) * 16);
                f32x4 cw4[4];
#pragma unroll
                for (int j = 0; j < 4; ++j) cw4[j] = *(const LAS f32x4*)(L + ML_CW + ((ih * 5 + j) * 64 + lane) * 16);
                u32x2 outp[8];
                float xw[3][4];
#pragma unroll
                for (int r = 0; r < 3; ++r) { xw[r][0] = bf_lo(raw[r][2 * ih]); xw[r][1] = bf_hi(raw[r][2 * ih]); xw[r][2] = bf_lo(raw[r][2 * ih + 1]); xw[r][3] = bf_hi(raw[r][2 * ih + 1]); }
#pragma unroll
                for (int r = 0; r < 8; ++r) { float o[4], xc[4];
                    xc[0] = bf_lo(raw[r + 3][2 * ih]); xc[1] = bf_hi(raw[r + 3][2 * ih]); xc[2] = bf_lo(raw[r + 3][2 * ih + 1]); xc[3] = bf_hi(raw[r + 3][2 * ih + 1]);
#pragma unroll
                    for (int i4 = 0; i4 < 4; ++i4) { const float cv = cb4[i4] + cw4[0][i4] * xw[0][i4] + cw4[1][i4] * xw[1][i4] + cw4[2][i4] * xw[2][i4] + cw4[3][i4] * xc[i4]; o[i4] = siluf_(cv) * osc;
                        xw[0][i4] = xw[1][i4]; xw[1][i4] = xw[2][i4]; xw[2][i4] = xc[i4]; }
                    outp[r].x = pk2(o[0], o[1]); outp[r].y = pk2(o[2], o[3]);
                    *(LAS u32x2*)(L + (isk ? ML_K : ML_Q) + (8 * w + r) * ML_QP + (e0 + 4 * ih) * 2) = outp[r]; }
                if (isk) {
#pragma unroll
                    for (int i4 = 0; i4 < 4; ++i4) { u32x4 v;
#define ML_EL(r) ((i4 & 1) ? (outp[r][i4 >> 1] >> 16) : (outp[r][i4 >> 1] & 0xffffu))
                        v.x = ML_EL(0) | (ML_EL(1) << 16); v.y = ML_EL(2) | (ML_EL(3) << 16); v.z = ML_EL(4) | (ML_EL(5) << 16); v.w = ML_EL(6) | (ML_EL(7) << 16);
#undef ML_EL
                        *(LAS u32x4*)(L + ML_KT + (e0 + 4 * ih + i4) * ML_KTP + (8 * w) * 2) = v; }
                }
            }
        }
        asm volatile("" ::: "memory");
        if (ch + 1 < 32) {
#pragma unroll
            for (int r = 0; r < 11; ++r) raw[r] = *(const GAS u32x4*)(P + (row0 + 64 + 8 * w - 3 + r) * PN + 2048 + cch);
        }
        if (w == 0) {
            const float ip = ipn, fp = fpn;
            if (ch + 1 < 32) { ipn = gates[(row0 + 64 + lane) * 8 + hh]; fpn = gates[(row0 + 64 + lane) * 8 + 4 + hh]; }
            const float lf = fminf(fp, 0.f) - __logf(1.0f + __expf(-fabsf(fp)));
            float bc = lf;
#pragma unroll
            for (int o = 1; o < 64; o <<= 1) { const float t = __shfl_up(bc, o); if (lane >= o) bc += t; }
            const float a = ip - bc; float pm = a;
#pragma unroll
            for (int o = 1; o < 64; o <<= 1) { const float t = __shfl_up(pm, o); if (lane >= o) pm = fmaxf(pm, t); }
            const float M = fmaxf(m_st, pm);
            const float M63 = __shfl(M, 63), b63 = __shfl(bc, 63);
            sc[lane] = a; sc[64 + lane] = M; sc[128 + lane] = __expf(m_st - M); sc[192 + lane] = __expf(-(bc + M)); sc[256 + lane] = __expf(a - M63);
            if (lane == 0) sc[768] = __expf(m_st - M63);
            m_st = b63 + M63;
        }
        __syncthreads();
        float pw[2][4] = {{0.f, 0.f, 0.f, 0.f}, {0.f, 0.f, 0.f, 0.f}};
        if (!(pf & 32)) {
            f32x4 s0 = (f32x4){0.f, 0.f, 0.f, 0.f}, s1 = s0;
#pragma unroll
            for (int kk = 0; kk < 8; ++kk) {
                const bf16x8 a = *(const LAS bf16x8*)(L + ML_Q + (16 * tr + l15) * ML_QP + (32 * kk + 8 * lq) * 2);
                const bf16x8 k0 = *(const LAS bf16x8*)(L + ML_K + (16 * cb2 + l15) * ML_QP + (32 * kk + 8 * lq) * 2);
                const bf16x8 k1 = *(const LAS bf16x8*)(L + ML_K + (16 * (cb2 + 1) + l15) * ML_QP + (32 * kk + 8 * lq) * 2);
                s0 = __builtin_amdgcn_mfma_f32_16x16x32_bf16(a, k0, s0, 0, 0, 0); s1 = __builtin_amdgcn_mfma_f32_16x16x32_bf16(a, k1, s1, 0, 0, 0); }
            const int j0 = 16 * cb2 + l15, j1 = j0 + 16; const float a0 = sc[j0], a1 = sc[j1];
#pragma unroll
            for (int r = 0; r < 4; ++r) { const int t = 16 * tr + 4 * lq + r; const float Mt = sc[64 + t];
                pw[0][r] = (j0 <= t) ? s0[r] * __expf(a0 - Mt) : 0.f; pw[1][r] = (j1 <= t) ? s1[r] * __expf(a1 - Mt) : 0.f; }
        }
        __syncthreads();
#pragma unroll
        for (int r = 0; r < 4; ++r) { const int t = 16 * tr + 4 * lq + r;
            *(LAS bf16*)(L + ML_P + t * ML_KTP + (16 * cb2 + l15) * 2) = (bf16)f2bf(pw[0][r]); *(LAS bf16*)(L + ML_P + t * ML_KTP + (16 * cb2 + 16 + l15) * 2) = (bf16)f2bf(pw[1][r]); }
#pragma unroll
        for (int i = 0; i < 8; ++i) *(LAS bf16*)(L + ML_VT + (8 * vdg + i) * ML_KTP + vj * 2) = (bf16)bf_elem(vraw, i);
        __syncthreads();
        {
            const int t = tid >> 3, part = tid & 7;
            const u32x4 pv = *(const LAS u32x4*)(L + ML_P + t * ML_KTP + part * 16);
            float ds = (bf_lo(pv.x) + bf_hi(pv.x)) + (bf_lo(pv.y) + bf_hi(pv.y)) + (bf_lo(pv.z) + bf_hi(pv.z)) + (bf_lo(pv.w) + bf_hi(pv.w));
            float qn = 0.f;
#pragma unroll
            for (int q4 = 0; q4 < 4; ++q4) { const u32x4 qv = *(const LAS u32x4*)(L + ML_Q + t * ML_QP + part * 64 + q4 * 16);
                const f32x4 n0 = *(const LAS f32x4*)(sc + 512 + part * 32 + q4 * 8), n1 = *(const LAS f32x4*)(sc + 512 + part * 32 + q4 * 8 + 4);
                qn += bf_lo(qv.x) * n0[0] + bf_hi(qv.x) * n0[1] + bf_lo(qv.y) * n0[2] + bf_hi(qv.y) * n0[3] + bf_lo(qv.z) * n1[0] + bf_hi(qv.z) * n1[1] + bf_lo(qv.w) * n1[2] + bf_hi(qv.w) * n1[3]; }
#pragma unroll
            for (int o = 1; o < 8; o <<= 1) { ds += __shfl_xor(ds, o); qn += __shfl_xor(qn, o); }
            if (part == 0) sc[320 + t] = ds + sc[128 + t] * qn;
        }
        f32x4 pv0 = (f32x4){0.f, 0.f, 0.f, 0.f}, pv1 = pv0, qc0 = pv0, qc1 = pv0;
        if (!(pf & 64)) {
#pragma unroll
        for (int kk = 0; kk < 2; ++kk) {
            const bf16x8 a = *(const LAS bf16x8*)(L + ML_P + (16 * tr + l15) * ML_KTP + (32 * kk + 8 * lq) * 2);
            const bf16x8 v0 = *(const LAS bf16x8*)(L + ML_VT + (16 * cb2 + l15) * ML_KTP + (32 * kk + 8 * lq) * 2);
            const bf16x8 v1 = *(const LAS bf16x8*)(L + ML_VT + (16 * (cb2 + 1) + l15) * ML_KTP + (32 * kk + 8 * lq) * 2);
            pv0 = __builtin_amdgcn_mfma_f32_16x16x32_bf16(a, v0, pv0, 0, 0, 0); pv1 = __builtin_amdgcn_mfma_f32_16x16x32_bf16(a, v1, pv1, 0, 0, 0); }
#pragma unroll
        for (int kk = 0; kk < 8; ++kk) {
            const bf16x8 a = *(const LAS bf16x8*)(L + ML_Q + (16 * tr + l15) * ML_QP + (32 * kk + 8 * lq) * 2);
            const bf16x8 c0 = *(const LAS bf16x8*)(L + ML_C + (16 * cb2 + l15) * ML_QP + (32 * kk + 8 * lq) * 2);
            const bf16x8 c1 = *(const LAS bf16x8*)(L + ML_C + (16 * (cb2 + 1) + l15) * ML_QP + (32 * kk + 8 * lq) * 2);
            qc0 = __builtin_amdgcn_mfma_f32_16x16x32_bf16(a, c0, qc0, 0, 0, 0); qc1 = __builtin_amdgcn_mfma_f32_16x16x32_bf16(a, c1, qc1, 0, 0, 0); }
        }
        __syncthreads();
        if (!(pf & 64)) {
#pragma unroll
            for (int r = 0; r < 4; ++r) { const int t = 16 * tr + 4 * lq + r; const float wi = sc[128 + t], dn = fmaxf(fabsf(sc[320 + t]), sc[192 + t]); const float inv = __builtin_amdgcn_rcpf(dn);
                const size_t yrow = (row0 + t) * D + 1024 + hh * 256 + s * 64;
                const int d0 = 16 * cb2 + l15, d1 = d0 + 16;
                const float h0 = (pv0[r] + wi * qc0[r]) * inv * sigmoidf_(bf2f(ov[r][0])), h1 = (pv1[r] + wi * qc1[r]) * inv * sigmoidf_(bf2f(ov[r][1]));
                Y[yrow + d0] = (bf16)f2bf(h0); Y[yrow + d1] = (bf16)f2bf(h1);
                float q = h0 * h0 + h1 * h1;
#pragma unroll
                for (int o = 1; o < 16; o <<= 1) q += __shfl_xor(q, o);
                if (l15 == 0) sc[384 + (w & 1) * 64 + t] = q; }
        }
        const float decay = sc[768];
        {
            const float we = sc[256 + vj];
#pragma unroll
            for (int i = 0; i < 8; ++i) *(LAS bf16*)(L + ML_VWT + (8 * vdg + i) * ML_KTP + vj * 2) = (bf16)f2bf(__builtin_bit_cast(float, bf_elem(vraw, i) << 16) * we);
            if (tid < 256) { float a = 0.f;
#pragma unroll
                for (int j8 = 0; j8 < 8; ++j8) { const u32x4 kv = *(const LAS u32x4*)(L + ML_KT + tid * ML_KTP + j8 * 16); const f32x4 w0 = *(const LAS f32x4*)(sc + 256 + j8 * 8), w1 = *(const LAS f32x4*)(sc + 256 + j8 * 8 + 4);
                    a += bf_lo(kv.x) * w0[0] + bf_hi(kv.x) * w0[1] + bf_lo(kv.y) * w0[2] + bf_hi(kv.y) * w0[3] + bf_lo(kv.z) * w1[0] + bf_hi(kv.z) * w1[1] + bf_lo(kv.w) * w1[2] + bf_hi(kv.w) * w1[3]; }
                sc[512 + tid] = decay * sc[512 + tid] + a; }
#pragma unroll
            for (int q = 0; q < 2; ++q)
#pragma unroll
                for (int dc = 0; dc < 4; ++dc) cacc[q][dc] *= decay;
        }
        __syncthreads();
        if (tid < 64) sumsq[(row0 + tid) * 16 + hh * 4 + s] = sc[384 + tid] + sc[448 + tid];
        if (!(pf & 128)) {
#pragma unroll
        for (int kk = 0; kk < 2; ++kk) {
            bf16x8 aE[2], bD[4];
#pragma unroll
            for (int q = 0; q < 2; ++q) aE[q] = *(const LAS bf16x8*)(L + ML_KT + (16 * (2 * w + q) + l15) * ML_KTP + (32 * kk + 8 * lq) * 2);
#pragma unroll
            for (int dc = 0; dc < 4; ++dc) bD[dc] = *(const LAS bf16x8*)(L + ML_VWT + (16 * dc + l15) * ML_KTP + (32 * kk + 8 * lq) * 2);
#pragma unroll
            for (int q = 0; q < 2; ++q)
#pragma unroll
                for (int dc = 0; dc < 4; ++dc) cacc[q][dc] = __builtin_amdgcn_mfma_f32_16x16x32_bf16(aE[q], bD[dc], cacc[q][dc], 0, 0, 0); }
#pragma unroll
        for (int q = 0; q < 2; ++q)
#pragma unroll
            for (int dc = 0; dc < 4; ++dc) { u32x2 wv; wv.x = pk2(cacc[q][dc][0], cacc[q][dc][1]); wv.y = pk2(cacc[q][dc][2], cacc[q][dc][3]);
                *(LAS u32x2*)(L + ML_C + (16 * dc + l15) * ML_QP + (16 * (2 * w + q) + 4 * lq) * 2) = wv; }
        }
        __syncthreads();
    }
}

constexpr int LR_XP = 272, LR_TT = 128;
constexpr int LR_XC = 0, LR_W = 34816, LR_A = 69632, LR_G = 102912, LR_SEG = 136192, LR_CARRY = 140288, LR_CWT = 140544;
__device__ __forceinline__ void lru_unit(Frame& F, int b, int n, int jh) {
    LAS unsigned char* L = F.lds;
    LAS float* Aa = (LAS float*)(L + LR_A); LAS float* Ga = (LAS float*)(L + LR_G); LAS float* seg = (LAS float*)(L + LR_SEG); LAS float* carry = (LAS float*)(L + LR_CARRY);
    const int tid = F.tid, lane = F.lane, w = F.wave, l15 = lane & 15, lq = lane >> 4;
    const bf16* P = (const bf16*)(F.ws + WS_P); bf16* Y = (bf16*)(F.ws + WS_Y); const bf16* LW = (const bf16*)(F.ws + WS_LRUW) + (size_t)n * 256 * 128;
    for (int pc = tid; pc < 2048; pc += NT) { const int orow = pc >> 4, c16 = pc & 15; const int src = (orow < 64) ? (jh * 64 + orow) : (128 + jh * 64 + (orow - 64));
        *(LAS u32x4*)(L + LR_W + orow * LR_XP + c16 * 16) = *(const GAS u32x4*)(LW + (size_t)src * 128 + c16 * 8); }
    const int cgx = tid & 15, rgx = tid >> 4, cch = n * 128 + 8 * cgx;
    if (tid < 16) {
        const float* cwp_ = F.in(5) + cch; const float* cbp_ = F.in(6) + cch;
#pragma unroll
        for (int j = 0; j < 4; ++j) { *(LAS f32x4*)(L + LR_CWT + (cgx * 5 + j) * 32) = *(const GAS f32x4*)(cwp_ + j * 1024); *(LAS f32x4*)(L + LR_CWT + (cgx * 5 + j) * 32 + 16) = *(const GAS f32x4*)(cwp_ + j * 1024 + 4); }
        *(LAS f32x4*)(L + LR_CWT + (cgx * 5 + 4) * 32) = *(const GAS f32x4*)cbp_; *(LAS f32x4*)(L + LR_CWT + (cgx * 5 + 4) * 32 + 16) = *(const GAS f32x4*)(cbp_ + 4);
    }
    const int trb = 2 * (w >> 1), ocb = 2 * (w & 1);
    float ba[2], bx[2], sp[2];
    const float* pba_ = F.in(8); const float* pbx_ = F.in(10); const float* plam_ = F.in(11);
#pragma unroll
    for (int q = 0; q < 2; ++q) { const int chq = n * 128 + jh * 64 + 16 * (ocb + q) + l15; ba[q] = pba_[chq]; bx[q] = pbx_[chq]; const float nl = -plam_[chq]; sp[q] = fmaxf(nl, 0.f) + log1pf(expf(-fabsf(nl))); }
    const int ch_s = n * 128 + jh * 64 + lane;
    if (tid < 64) carry[tid] = 0.f;
    u32x4 raw[7];
#pragma unroll
    for (int r = 0; r < 7; ++r) { const int t = 4 * rgx - 3 + r; raw[r] = (t >= 0) ? *(const GAS u32x4*)(P + ((size_t)b * SEQ + t) * PN + cch) : (u32x4){0u, 0u, 0u, 0u}; }
    __syncthreads();
    for (int tile = 0; tile < SEQ / LR_TT; ++tile) {
        const int t0 = tile * LR_TT; const size_t row0 = (size_t)b * SEQ + t0;
        bf16 zv[16];
#pragma unroll
        for (int i = 0; i < 16; ++i) zv[i] = P[(row0 + 16 * w + i) * PN + 1024 + ch_s];
        {
            float cw[4][8], cb[8];
#pragma unroll
            for (int j = 0; j < 5; ++j) { const f32x4 c0 = *(const LAS f32x4*)(L + LR_CWT + (cgx * 5 + j) * 32), c1 = *(const LAS f32x4*)(L + LR_CWT + (cgx * 5 + j) * 32 + 16);
#pragma unroll
                for (int i = 0; i < 4; ++i) { if (j < 4) { cw[j < 4 ? j : 0][i] = c0[i]; cw[j < 4 ? j : 0][4 + i] = c1[i]; } else { cb[i] = c0[i]; cb[4 + i] = c1[i]; } } }
#pragma unroll
            for (int r = 0; r < 4; ++r) { float o[8];
#pragma unroll
                for (int i = 0; i < 8; ++i) { const int wd = i >> 1; float x0, x1, x2, x3;
                    if (i & 1) { x0 = bf_hi(raw[r][wd]); x1 = bf_hi(raw[r + 1][wd]); x2 = bf_hi(raw[r + 2][wd]); x3 = bf_hi(raw[r + 3][wd]); }
                    else { x0 = bf_lo(raw[r][wd]); x1 = bf_lo(raw[r + 1][wd]); x2 = bf_lo(raw[r + 2][wd]); x3 = bf_lo(raw[r + 3][wd]); }
                    o[i] = cb[i] + cw[0][i] * x0 + cw[1][i] * x1 + cw[2][i] * x2 + cw[3][i] * x3; }
                u32x4 ov; ov.x = pk2(o[0], o[1]); ov.y = pk2(o[2], o[3]); ov.z = pk2(o[4], o[5]); ov.w = pk2(o[6], o[7]);
                *(LAS u32x4*)(L + LR_XC + (4 * rgx + r) * LR_XP + cgx * 16) = ov; }
            asm volatile("" ::: "memory");
            if (tile + 1 < SEQ / LR_TT) {
#pragma unroll
                for (int r = 0; r < 7; ++r) raw[r] = *(const GAS u32x4*)(P + (row0 + LR_TT + 4 * rgx - 3 + r) * PN + cch);
            }
        }
        __syncthreads();
        {
            f32x4 ga[2][2], gx[2][2];
#pragma unroll
            for (int rt = 0; rt < 2; ++rt)
#pragma unroll
                for (int q = 0; q < 2; ++q) { ga[rt][q] = (f32x4){0.f, 0.f, 0.f, 0.f}; gx[rt][q] = ga[rt][q]; }
#pragma unroll
            for (int kk = 0; kk < 4; ++kk) { bf16x8 a[2], wa[2], wx[2];
#pragma unroll
                for (int rt = 0; rt < 2; ++rt) a[rt] = *(const LAS bf16x8*)(L + LR_XC + (16 * (trb + rt) + l15) * LR_XP + (32 * kk + 8 * lq) * 2);
#pragma unroll
                for (int q = 0; q < 2; ++q) { wa[q] = *(const LAS bf16x8*)(L + LR_W + (16 * (ocb + q) + l15) * LR_XP + (32 * kk + 8 * lq) * 2);
                    wx[q] = *(const LAS bf16x8*)(L + LR_W + (64 + 16 * (ocb + q) + l15) * LR_XP + (32 * kk + 8 * lq) * 2); }
#pragma unroll
                for (int rt = 0; rt < 2; ++rt)
#pragma unroll
                    for (int q = 0; q < 2; ++q) { ga[rt][q] = __builtin_amdgcn_mfma_f32_16x16x32_bf16(a[rt], wa[q], ga[rt][q], 0, 0, 0); gx[rt][q] = __builtin_amdgcn_mfma_f32_16x16x32_bf16(a[rt], wx[q], gx[rt][q], 0, 0, 0); } }
#pragma unroll
            for (int rt = 0; rt < 2; ++rt)
#pragma unroll
                for (int q = 0; q < 2; ++q)
#pragma unroll
                    for (int r = 0; r < 4; ++r) { const int t = 16 * (trb + rt) + 4 * lq + r, jo = 16 * (ocb + q) + l15;
                        const float rg = sigmoidf_(ga[rt][q][r] + ba[q]), ig = sigmoidf_(gx[rt][q][r] + bx[q]); const float la = -8.0f * rg * sp[q];
                        const float xf = bf2f(*(const LAS bf16*)(L + LR_XC + t * LR_XP + (jh * 64 + jo) * 2));
                        const float av = __expf(la); Aa[t * 65 + jo] = av; Ga[t * 65 + jo] = __builtin_amdgcn_sqrtf(fmaxf(1.0f - av * av, 0.f)) * (ig * xf); }
        }
        __syncthreads();
        {
            float Ap = 1.f, H = 0.f;
#pragma unroll
            for (int i = 0; i < 16; ++i) { const float a = Aa[(16 * w + i) * 65 + lane], g = Ga[(16 * w + i) * 65 + lane]; H = a * H + g; Ap *= a; }
            seg[(w * 64 + lane) * 2] = Ap; seg[(w * 64 + lane) * 2 + 1] = H;
        }
        __syncthreads();
        float h = carry[lane];
        for (int s2 = 0; s2 < w; ++s2) h = seg[(s2 * 64 + lane) * 2] * h + seg[(s2 * 64 + lane) * 2 + 1];
#pragma unroll
        for (int i = 0; i < 16; ++i) { const int t = 16 * w + i; h = Aa[t * 65 + lane] * h + Ga[t * 65 + lane]; Y[(row0 + t) * D + ch_s] = (bf16)f2bf(h * gelu_tanh(bf2f(zv[i]))); }
        __syncthreads();
        if (w == 7) carry[lane] = h;
    }
    __syncthreads();
}

__device__ __forceinline__ void ph_headnorm(Frame& F) {
    bf16* Y = (bf16*)(F.ws + WS_Y); const float* sumsq = (const float*)(F.ws + WS_SUMSQ); const float* hg = F.in(16);
    const int gt = F.vcu * NT + F.tid, NGT = F.G * NT;
    for (int idx = gt; idx < T * 128; idx += NGT) { const int t = idx >> 7, c8 = idx & 127, hh = c8 >> 5;
        const f32x4 ss = *(const f32x4*)(sumsq + (size_t)t * 16 + hh * 4); const float rstd = 1.0f / sqrtf(((ss[0] + ss[1]) + (ss[2] + ss[3])) * (1.0f / 256.0f) + EPS);
        bf16* p = Y + (size_t)t * D + 1024 + c8 * 8; const u32x4 v = *(const u32x4*)p; const f32x4 g0 = *(const f32x4*)(hg + c8 * 8), g1 = *(const f32x4*)(hg + c8 * 8 + 4);
        u32x4 o; o.x = pk2(bf_lo(v.x) * rstd * g0[0], bf_hi(v.x) * rstd * g0[1]); o.y = pk2(bf_lo(v.y) * rstd * g0[2], bf_hi(v.y) * rstd * g0[3]);
        o.z = pk2(bf_lo(v.z) * rstd * g1[0], bf_hi(v.z) * rstd * g1[1]); o.w = pk2(bf_lo(v.w) * rstd * g1[2], bf_hi(v.w) * rstd * g1[3]);
        *(u32x4*)p = o; }
}

constexpr int RT_ROWS = 128;
__device__ __forceinline__ void ph_router(Frame& F, int l, bool dummy) {
    LAS float* lg = (LAS float*)(F.lds);
    LAS float* info = (LAS float*)(F.lds + 20480);
    LAS unsigned* lcnt = (LAS unsigned*)(F.lds + 28672);
    const int tid = F.tid, lane = F.lane, w = F.wave, l15 = lane & 15, lq = lane >> 4;
    const bf16* x1 = (const bf16*)(F.ws + WS_XB); const bf16* WH = (const bf16*)(F.ws + WS_RW) + (size_t)(l * 2) * 32 * 2048; const bf16* WL = WH + (size_t)32 * 2048;
    const float* bcs = F.in(30) + l * 4; const float* bfn = F.in(32) + l * 16;
    const size_t doff = dummy ? (size_t)200 * MiB : 0; const int cw = dummy ? 20480 : CW_CNT + l * 32 * 64;
    int* ptok = (int*)(F.ws + WS_PTOK + doff); float* prstd = (float*)(F.ws + WS_PRSTD + doff); float* pga = (float*)(F.ws + WS_PGA + doff); float* pgb = (float*)(F.ws + WS_PGB + doff);
    for (int base = F.vcu * RT_ROWS; base < T; base += F.G * RT_ROWS) {
        if (tid < 32) lcnt[tid] = 0u;
        {
            const bf16* xr = x1 + (size_t)(base + 16 * w + l15) * D + 8 * lq;
            const bf16* wh0 = WH + (size_t)l15 * 2048 + 8 * lq; const bf16* wh1 = WH + (size_t)(16 + l15) * 2048 + 8 * lq;
            const bf16* wl0 = WL + (size_t)l15 * 2048 + 8 * lq; const bf16* wl1 = WL + (size_t)(16 + l15) * 2048 + 8 * lq;
            f32x4 acc0 = (f32x4){0.f, 0.f, 0.f, 0.f}, acc1 = acc0; float ss = 0.f;
#pragma unroll 4
            for (int ks = 0; ks < 64; ++ks) {
                const bf16x8 a = *(const GAS bf16x8*)(xr + 32 * ks);
                const bf16x8 h0 = *(const GAS bf16x8*)(wh0 + 32 * ks), h1 = *(const GAS bf16x8*)(wh1 + 32 * ks), o0 = *(const GAS bf16x8*)(wl0 + 32 * ks), o1 = *(const GAS bf16x8*)(wl1 + 32 * ks);
                acc0 = __builtin_amdgcn_mfma_f32_16x16x32_bf16(a, h0, acc0, 0, 0, 0); acc1 = __builtin_amdgcn_mfma_f32_16x16x32_bf16(a, h1, acc1, 0, 0, 0);
                acc0 = __builtin_amdgcn_mfma_f32_16x16x32_bf16(a, o0, acc0, 0, 0, 0); acc1 = __builtin_amdgcn_mfma_f32_16x16x32_bf16(a, o1, acc1, 0, 0, 0);
                const u32x4 au = __builtin_bit_cast(u32x4, a);
                ss += (bf_lo(au.x) * bf_lo(au.x) + bf_hi(au.x) * bf_hi(au.x)) + (bf_lo(au.y) * bf_lo(au.y) + bf_hi(au.y) * bf_hi(au.y)) + (bf_lo(au.z) * bf_lo(au.z) + bf_hi(au.z) * bf_hi(au.z)) + (bf_lo(au.w) * bf_lo(au.w) + bf_hi(au.w) * bf_hi(au.w)); }
            ss += __shfl_xor(ss, 16); ss += __shfl_xor(ss, 32);
#pragma unroll
            for (int r = 0; r < 4; ++r) { lg[(16 * w + 4 * lq + r) * 33 + l15] = acc0[r]; lg[(16 * w + 4 * lq + r) * 33 + 16 + l15] = acc1[r]; }
            if (lq == 0) lg[(16 * w + l15) * 33 + 32] = ss;
        }
        __syncthreads();
        if (tid < RT_ROWS) {
            const LAS float* lr = lg + tid * 33;
            const float rstd = 1.0f / sqrtf(lr[32] * (1.0f / D) + EPS);
            float lc[4], lf[16];
#pragma unroll
            for (int c = 0; c < 4; ++c) lc[c] = lr[c] * rstd + bcs[c];
#pragma unroll
            for (int c = 0; c < 16; ++c) lf[c] = lr[4 + c] * rstd + bfn[c];
            int gi = 0; float gm = lc[0];
#pragma unroll
            for (int c = 1; c < 4; ++c) if (lc[c] > gm) { gm = lc[c]; gi = c; }
            float se = 0.f;
#pragma unroll
            for (int c = 0; c < 4; ++c) se += expf(lc[c] - gm);
            const float pg = 1.0f / se;
            float fs[4];
#pragma unroll
            for (int c = 0; c < 4; ++c) fs[c] = (gi == 0) ? lf[c] : (gi == 1) ? lf[4 + c] : (gi == 2) ? lf[8 + c] : lf[12 + c];
            int i0 = 0; float v0 = fs[0];
#pragma unroll
            for (int c = 1; c < 4; ++c) if (fs[c] > v0) { v0 = fs[c]; i0 = c; }
            int i1 = -1; float v1 = 0.f;
#pragma unroll
            for (int c = 0; c < 4; ++c) if (c != i0 && (i1 < 0 || fs[c] > v1)) { v1 = fs[c]; i1 = c; }
            const float e1 = expf(v1 - v0), s0 = 1.0f / (1.0f + e1), w0g = s0 * pg, w1g = (e1 * s0) * pg;
            const int ia = i0 < i1 ? i0 : i1, ib = i0 < i1 ? i1 : i0, pidx = (ia == 0) ? ib - 1 : (ia == 1) ? ib + 1 : 5, q = gi * 6 + pidx;
            LAS float* ip = info + tid * 8; ip[0] = __builtin_bit_cast(float, q); ip[1] = (i0 < i1) ? w0g : w1g; ip[2] = (i0 < i1) ? w1g : w0g; ip[3] = rstd;
            ip[4] = __builtin_bit_cast(float, __hip_atomic_fetch_add(&lcnt[q], 1u, __ATOMIC_RELAXED, __HIP_MEMORY_SCOPE_WORKGROUP));
        }
        __syncthreads();
        if (tid < NPAIR) lcnt[32 + tid] = __hip_atomic_fetch_add((unsigned*)(F.ctl + cw + tid * 64), lcnt[tid], RLX_AGENT);
        __syncthreads();
        if (tid < RT_ROWS) { LAS float* ip = info + tid * 8; const int row = base + tid; const int q = __builtin_bit_cast(int, ip[0]);
            const size_t p = (size_t)q * T + lcnt[32 + q] + __builtin_bit_cast(unsigned, ip[4]);
            ptok[p] = row; pga[p] = ip[1]; pgb[p] = ip[2]; prstd[p] = ip[3]; }
        __syncthreads();
    }
}
__device__ __forceinline__ void moe_table(Frame& F, int l) {
    if (F.tid == 0) { unsigned pre = 0u;
        for (int q = 0; q < NPAIR; ++q) { const unsigned c = ld_agent_u32((const unsigned*)(F.ctl + CW_CNT + (l * 32 + q) * 64)); F.MISC[MI_CNT + q] = c; F.MISC[MI_PRE + q] = pre; pre += (c + 255u) >> 8; }
        F.MISC[MI_PRE + NPAIR] = pre; }
    __syncthreads();
}
__device__ __forceinline__ void ph_rowpass(Frame& F, int l, bool dummy) {
    const int gw = F.vcu * NWAVES + F.wave, NGW = F.G * NWAVES, lane = F.lane;
    const bf16* xb = (const bf16*)(F.ws + WS_XB); float* rstd_o = (float*)(F.ws + WS_RSTD);
    const float* gfin = F.in(3);
    for (int m = gw; m < T; m += NGW) {
        const GAS u32x2* xr = (const GAS u32x2*)(xb + (size_t)m * D) + lane;
        f32x4 v[8]; float ss = 0.f;
#pragma unroll
        for (int j = 0; j < 8; ++j) { const u32x2 x = xr[64 * j]; v[j].x = bf_lo(x.x); v[j].y = bf_hi(x.x); v[j].z = bf_lo(x.y); v[j].w = bf_hi(x.y);
            ss += (v[j].x * v[j].x + v[j].y * v[j].y) + (v[j].z * v[j].z + v[j].w * v[j].w); }
        ss = wave_sum(ss); const float rstd = 1.0f / sqrtf(ss * (1.0f / D) + EPS);
        if (l == 0) { if (lane == 0) (dummy ? (float*)(F.ws + 950 * MiB) : rstd_o)[m] = rstd; }
        else {
            GAS f32x4* xw = dummy ? (GAS f32x4*)((float*)(F.ws + WS_Y) + (size_t)(m & 16383) * D) + lane : (GAS f32x4*)(F.out + (size_t)m * D) + lane;
#pragma unroll
            for (int j = 0; j < 8; ++j) { const f32x4 g = *((const f32x4*)gfin + lane + 64 * j); xw[64 * j] = v[j] * rstd * g; }
        }
    }
}
constexpr int S5_UP = 528, S5_XP = 272, S5_U = 0, S5_X = 67584, S5_T = 106496;
__device__ __forceinline__ void cmul_add(float ar, float ai, float br, float bi, float cr, float ci, float& orr, float& oi) { orr = ar * br - ai * bi + cr; oi = ar * bi + ai * br + ci; }
__device__ __forceinline__ void ph_s5core(Frame& F, int pf) {
    LAS unsigned char* L = F.lds;
    const int tid = F.tid, lane = F.lane, w = F.wave, l15 = lane & 15, lq = lane >> 4;
    const bf16* A2 = (const bf16*)(F.ws + WS_A2); unsigned char* Y8 = F.ws + ((pf & 8) ? 776 * MiB : WS_Y);
    const int urow = tid >> 2, uq = tid & 3;
    u32x4 ust[8];
    const int upc = (2048 + F.G - 1) / F.G;
    const int L0 = F.vcu * upc, Lend = (L0 + upc < 2048) ? L0 + upc : 2048;
    if (L0 < 2048) { const bf16* src = A2 + ((size_t)(L0 >> 4) * 2048 + (size_t)(L0 & 15) * 128 + urow) * 256 + uq * 64;
#pragma unroll
        for (int i = 0; i < 8; ++i) ust[i] = *(const GAS u32x4*)(src + i * 8); }
    for (int Lu = L0; Lu < Lend; ++Lu) {
        const int g = Lu >> 4, b = Lu & 15;
        const bf16* Wi = (const bf16*)(F.ws + WS_S5WIN) + (size_t)g * 128 * 256; const bf16* KB = (const bf16*)(F.ws + WS_S5K) + (size_t)g * 4096; const bf16* Wo = (const bf16*)(F.ws + WS_S5WO) + (size_t)g * 256 * 128;
#define S5_WFRAG(mt_, ks_) (((ks_) < 8) ? (((2 * w + (mt_)) - (2 * (ks_) + (lq >> 1)) >= 0) ? *(const GAS bf16x8*)(KB + (((2 * w + (mt_)) - (2 * (ks_) + (lq >> 1))) * 16 + l15) * 16 + 8 * (lq & 1)) : (bf16x8){0, 0, 0, 0, 0, 0, 0, 0}) \
                                        : *(const GAS bf16x8*)(Wo + (size_t)(16 * (2 * w + (mt_)) + l15) * 128 + 32 * ((ks_) - 8) + 8 * lq))
#pragma unroll
        for (int i = 0; i < 8; ++i) *(LAS u32x4*)(L + S5_U + urow * S5_UP + (uq * 64 + i * 8) * 2) = ust[i];
        bf16x8 wb[8];
#pragma unroll
        for (int ks = 0; ks < 8; ++ks) wb[ks] = *(const GAS bf16x8*)(Wi + (size_t)(16 * w + l15) * 256 + 32 * ks + 8 * lq);
        const f32x4 lam = *(const GAS f32x4*)((const float*)(F.ws + WS_LAM) + ((size_t)g * 64 + 8 * w + (l15 & 7)) * 4);
        __syncthreads();
        f32x4 X[8];
#pragma unroll
        for (int rt = 0; rt < 8; ++rt) X[rt] = (f32x4){0.f, 0.f, 0.f, 0.f};
        if (!(pf & 64)) {
#pragma unroll
        for (int ks = 0; ks < 8; ++ks) {
#pragma unroll
            for (int rt = 0; rt < 8; ++rt) { const bf16x8 a = *(const LAS bf16x8*)(L + S5_U + (16 * rt + l15) * S5_UP + (32 * ks + 8 * lq) * 2);
                X[rt] = __builtin_amdgcn_mfma_f32_16x16x32_bf16(a, wb[ks], X[rt], 0, 0, 0); } }
        }
        bf16x8 wa[2][4];
#pragma unroll
        for (int mt = 0; mt < 2; ++mt)
#pragma unroll
            for (int k4 = 0; k4 < 4; ++k4) wa[mt][k4] = S5_WFRAG(mt, k4);
        if (!(pf & 16)) {
            const bool isim = (l15 & 8) != 0;
#define S5_XRI(rt_, r_) const float mine_ = X[rt_][r_], oth_ = __builtin_bit_cast(float, __builtin_amdgcn_update_dpp(0, __builtin_bit_cast(int, mine_), 0x128  , 0xf, 0xf, false)); \
            const float xr_ = isim ? oth_ : mine_, xi_ = isim ? mine_ : oth_
            LAS unsigned char* tb = L + S5_T + w * 4096;
#pragma unroll
            for (int rt = 0; rt < 8; ++rt) { float ar = 0.f, ai = 0.f;
#pragma unroll
                for (int r = 0; r < 4; ++r) { S5_XRI(rt, r); float nr, ni; cmul_add(lam[0], lam[1], ar, ai, xr_, xi_, nr, ni); ar = nr; ai = ni; }
                *(LAS f32x2*)(tb + ((rt * 16 + l15) * 4 + lq) * 8) = (f32x2){ar, ai}; }
            asm volatile("s_waitcnt lgkmcnt(0)" ::: "memory");
            float cr = 0.f, ci = 0.f;
#pragma unroll
            for (int rt = 0; rt < 8; ++rt) {
                const f32x4 t0 = *(const LAS f32x4*)(tb + (rt * 16 + l15) * 32), t1 = *(const LAS f32x4*)(tb + (rt * 16 + l15) * 32 + 16);
                float ar = 0.f, ai = 0.f;
#pragma unroll
                for (int o = 0; o < 4; ++o) { if (lq == o) { ar = cr; ai = ci; }
                    const float tr_ = (o == 0) ? t0[0] : (o == 1) ? t0[2] : (o == 2) ? t1[0] : t1[2], ti_ = (o == 0) ? t0[1] : (o == 1) ? t0[3] : (o == 2) ? t1[1] : t1[3];
                    float nr, ni; cmul_add(lam[2], lam[3], cr, ci, tr_, ti_, nr, ni); cr = nr; ci = ni; }
#pragma unroll
                for (int r = 0; r < 4; ++r) { *(LAS bf16*)(L + S5_X + (16 * rt + 4 * lq + r) * S5_XP + (16 * w + l15) * 2) = (bf16)f2bf(isim ? ai : ar);
                    S5_XRI(rt, r); float nr, ni; cmul_add(lam[0], lam[1], ar, ai, xr_, xi_, nr, ni); ar = nr; ai = ni; } }
#undef S5_XRI
        }
        { const int Ln = Lu + 1; if (Ln < Lend) { const bf16* src = A2 + ((size_t)(Ln >> 4) * 2048 + (size_t)(Ln & 15) * 128 + urow) * 256 + uq * 64;
#pragma unroll
            for (int i = 0; i < 8; ++i) ust[i] = *(const GAS u32x4*)(src + i * 8); } }
        __syncthreads();
        f32x4 acc[2][8];
#pragma unroll
        for (int mt = 0; mt < 2; ++mt)
#pragma unroll
            for (int nt = 0; nt < 8; ++nt) acc[mt][nt] = (f32x4){0.f, 0.f, 0.f, 0.f};
        if (!(pf & 32)) {
#pragma unroll
        for (int kb = 0; kb < 3; ++kb) {
            bf16x8 wnx[2][4];
            if (kb < 2) {
#pragma unroll
                for (int mt = 0; mt < 2; ++mt)
#pragma unroll
                    for (int k4 = 0; k4 < 4; ++k4) wnx[mt][k4] = S5_WFRAG(mt, 4 * (kb + 1) + k4);
            }
#pragma unroll
            for (int k4 = 0; k4 < 4; ++k4) { const int ks = 4 * kb + k4;
                if (ks >= 8 || ks <= w) {
#pragma unroll
                for (int nt = 0; nt < 8; ++nt) {
                    const bf16x8 bv = (ks < 8) ? *(const LAS bf16x8*)(L + S5_U + (16 * nt + l15) * S5_UP + (32 * ks + 8 * lq) * 2)
                                               : *(const LAS bf16x8*)(L + S5_X + (16 * nt + l15) * S5_XP + (32 * (ks - 8) + 8 * lq) * 2);
                    acc[0][nt] = __builtin_amdgcn_mfma_f32_16x16x32_bf16(wa[0][k4], bv, acc[0][nt], 0, 0, 0);
                    acc[1][nt] = __builtin_amdgcn_mfma_f32_16x16x32_bf16(wa[1][k4], bv, acc[1][nt], 0, 0, 0); } } }
            if (kb < 2) {
#pragma unroll
                for (int mt = 0; mt < 2; ++mt)
#pragma unroll
                    for (int k4 = 0; k4 < 4; ++k4) wa[mt][k4] = wnx[mt][k4];
            }
        }
        }
#pragma unroll
        for (int mt = 0; mt < 2; ++mt)
#pragma unroll
            for (int nt = 0; nt < 8; ++nt) { const int tok = (b * 128 + 16 * nt + l15) * 16 + 2 * w + mt; const f32x4 a = acc[mt][nt];
                const unsigned wv = pk4_f8(gelu_tanh(a[0]) * F8_SY, gelu_tanh(a[1]) * F8_SY, gelu_tanh(a[2]) * F8_SY, gelu_tanh(a[3]) * F8_SY);
                if (!(pf & 256)) *(GAS unsigned*)(Y8 + ((((size_t)(tok >> 8) * 64 + (g >> 1)) * 256) + (tok & 255)) * 32 + (g & 1) * 16 + 4 * lq) = wv; else asm volatile("" :: "v"(wv)); }
        __syncthreads();
    }
}

struct Args { const float* in[36]; float* out; unsigned char* ws; int ph_lo, ph_hi; };
__global__ void __launch_bounds__(NT, 2) fwd(Args args) {
    extern __shared__ __attribute__((aligned(16))) unsigned char lds[];
    Frame F;
    F.lds = (LAS unsigned char*)lds;
    F.MISC = (volatile LAS unsigned*)(F.lds + MISC_OFF);
    F.tid = threadIdx.x; F.lane = F.tid & 63; F.wave = __builtin_amdgcn_readfirstlane(F.tid >> 6);
    F.G = gridDim.x; { const int bx = blockIdx.x; F.vcu = (F.G % 8 == 0) ? (bx % 8) * (F.G / 8) + bx / 8 : bx; }
    F.out = args.out; F.ws = args.ws; F.ctl = (gu32*)(args.ws + WS_CTL);
    if (F.tid < 64) F.MISC[F.tid] = 0u;
    if (F.tid >= 64 && F.tid < 100) { const unsigned long long pv = (unsigned long long)args.in[F.tid - 64]; F.MISC[64 + 2 * (F.tid - 64)] = (unsigned)pv; F.MISC[65 + 2 * (F.tid - 64)] = (unsigned)(pv >> 32); }
    __syncthreads();
    XcdBarrier bar; bar.bar = (unsigned*)(F.ctl + CW_BAR); bar.x = 0; bar.st = nullptr;
    if (!MK_PER_PHASE) bar = xcd_barrier_post((unsigned*)(F.ctl + CW_BAR), F.MISC + 8);
    const int lo = args.ph_lo & 255, hi = args.ph_hi, pflags = args.ph_lo >> 8;
#ifndef PHMASK
#define PHMASK 0x3ffff
#endif
#define IN(k) ((((PHMASK) >> (k)) & 1) && lo <= (k) && (k) < hi)
#ifdef DOUBLE_BAR
#define SEAM(k) do { if (!MK_PER_PHASE && IN(k) && IN((k) + 1)) { xcd_barrier(bar); xcd_barrier(bar); } } while (0)
#else
#define SEAM(k) do { if (!MK_PER_PHASE && IN(k) && IN((k) + 1)) xcd_barrier(bar); } while (0)
#endif
    unsigned char* ws = args.ws;
    bf16* XB = (bf16*)(ws + WS_XB); bf16* Pb = (bf16*)(ws + WS_P); bf16* Yb = (bf16*)(ws + WS_Y); float* RSTD = (float*)(ws + WS_RSTD);
    const int bx = (int)blockIdx.x;

    if (IN(0)) { ph_prologue(F, pflags); }
    SEAM(0);
#ifndef P1_WGM
#define P1_WGM 8
#endif
    if (IN(1)) {
        pg8::GemmP g{nullptr, 2048, 4096u, 32u, 4096u};
#ifdef P1_STAGGER
        {
            const unsigned long long t0 = __builtin_amdgcn_s_memrealtime(), dl = (unsigned long long)((bx >> 3) & 3) * (P1_STAGGER * 100ull);
            while (__builtin_amdgcn_s_memrealtime() - t0 < dl) __builtin_amdgcn_s_sleep(8);
        }
#endif
#ifdef P1_SPLIT3
#pragma unroll
        for (int j3 = 0; j3 < 3; ++j3) {
            DenseSched S; S.to.init(T / 256, 8, F.G, bx, P1_WGM); S.A = (const char*)XB; S.tstepA = (size_t)256 * 4096; S.B0 = (const char*)(ws + WS_WIN) + (size_t)j3 * 2048 * 4096; S.B1 = S.B0 + (size_t)128 * 4096; S.tstepB = (size_t)256 * 4096; S.cpt = 256;
            EpiScaleBf16 E{Pb + j3 * 2048, PN, RSTD, pflags, 1.0f};
            pg8::gemm_phase<EpiScaleBf16, DenseSched, false>(F.lds, g, S, E); }
#else
        {
            pg8::GemmP g8{nullptr, 1024, 2048u, 32u, 2048u};
            DenseSched S; S.to.init(T / 256, 8, F.G, bx, P1_WGM); S.A = (const char*)(ws + WS_X8IN); S.tstepA = (size_t)256 * 2048; S.B0 = (const char*)(ws + WS_WIN); S.B1 = S.B0 + (size_t)128 * 2048; S.tstepB = (size_t)256 * 2048; S.cpt = 256;
            EpiScaleBf16 E{Pb, PN, RSTD, pflags, 1.0f / (F8_SX * F8_SW)};
            pg8::gemm_phase<EpiScaleBf16, DenseSched, false, false, true>(F.lds, g8, S, E); }
        {
            DenseSched S; S.to.init(T / 256, 16, F.G, bx, P1_WGM); S.A = (const char*)XB; S.tstepA = (size_t)256 * 4096; S.B0 = (const char*)(ws + WS_WIN) + (size_t)2048 * 4096; S.B1 = S.B0 + (size_t)128 * 4096; S.tstepB = (size_t)256 * 4096; S.cpt = 256;
            EpiScaleBf16 E{Pb + 2048, PN, RSTD, pflags, 1.0f};
            pg8::gemm_phase<EpiScaleBf16, DenseSched, false>(F.lds, g, S, E); }
#endif
    }
    SEAM(1);
    if (IN(2)) {
#ifndef NO_MLSTM
        if (!(pflags & 1)) for (int u = F.vcu; u < 256; u += F.G) mlstm_unit(F, u >> 4, (u >> 2) & 3, u & 3, pflags);
#endif
#ifndef NO_LRU
        if (!(pflags & 2)) for (int u = F.vcu; u < 256; u += F.G) lru_unit(F, u >> 4, (u >> 1) & 7, u & 1);
#endif
    }
    SEAM(2);
    if (IN(3)) { ph_headnorm(F); }
    SEAM(3);
    if (IN(4)) {
        pg8::GemmP g{nullptr, 2048, 4096u, 32u, 4096u};
        DenseSched S; S.to.init(T / 256, D / 256, F.G, bx); S.A = (const char*)Yb; S.tstepA = (size_t)256 * 4096; S.B0 = (const char*)(ws + WS_WOUT); S.B1 = S.B0 + (size_t)128 * 4096; S.tstepB = (size_t)256 * 4096; S.cpt = 256;
        EpiOutRes E{XB, ws + WS_X8};
        pg8::gemm_phase<EpiOutRes, DenseSched, false>(F.lds, g, S, E);
    }
    SEAM(4);
#define MOE_LAYER(PH, l, WSW) \
    if (IN(PH)) { ph_router(F, l, (pflags & 4) != 0); } \
    SEAM(PH); \
    if (IN(PH + 1)) { moe_table(F, l); \
        pg8::GemmP g{(const char*)(ws + WS_X8), 1024, 2048u, 32u, 2048u}; \
        MoeSched<false> S{F.MISC, F.G, F.vcu, (const char*)(ws + WSW), (const char*)(ws + WSW + 32 * MiB), nullptr, (const int*)(ws + WS_PTOK)}; \
        EpiGateUp E{ws + WS_H, (const float*)(ws + WS_PRSTD), (const float*)(ws + WS_PGA), (const float*)(ws + WS_PGB), F.MISC, pflags}; \
        pg8::gemm_phase<EpiGateUp, MoeSched<false>, true, false, true>(F.lds, g, S, E); } \
    SEAM(PH + 1); \
    if (IN(PH + 2)) { moe_table(F, l); \
        pg8::GemmP g{nullptr, 512, 1024u, 32u, 512u}; \
        MoeSched<true> S{F.MISC, F.G, F.vcu, (const char*)(ws + WSW + 64 * MiB), nullptr, (const char*)(ws + WS_H), nullptr}; \
        EpiDownRes E{XB, (const int*)(ws + WS_PTOK), F.MISC, (pflags & 4) ? (bf16*)(ws + 712 * MiB) : XB, (l == 0) ? ws + ((pflags & 4) ? 776 * MiB : WS_X8) : nullptr}; \
        pg8::gemm_phase<EpiDownRes, MoeSched<true>, false, true, true>(F.lds, g, S, E); } \
    SEAM(PH + 2); \
    if (IN(PH + 3)) { ph_rowpass(F, l, (pflags & 4) != 0); }
    MOE_LAYER(5, 0, WS_WMOE0)
    SEAM(8);
    if (IN(9)) {
        pg8::GemmP g{nullptr, 1024, 2048u, 32u, 2048u};
        DenseSched S; S.to.init(T / 256, D / 256, F.G, bx); S.A = (const char*)(ws + WS_X8); S.tstepA = (size_t)256 * 2048; S.B0 = (const char*)(ws + WS_WS5IN); S.B1 = S.B0 + (size_t)128 * 2048; S.tstepB = (size_t)256 * 2048; S.cpt = 256;
        EpiS5U E{(bf16*)(ws + WS_A2), RSTD, 1.0f / (F8_SX * F8_SW)};
        pg8::gemm_phase<EpiS5U, DenseSched, false, false, true>(F.lds, g, S, E);
    }
    SEAM(9);
    if (IN(10)) { ph_s5core(F, pflags); }
    SEAM(12);
    if (IN(13)) {
        pg8::GemmP g{nullptr, 1024, 32u, 8192u, 2048u};
        DenseSched S; S.to.init(T / 256, D / 128, F.G, bx); S.A = (const char*)Yb; S.tstepA = (size_t)64 * 8192; S.B0 = (const char*)(ws + WS_WGLUV); S.B1 = (const char*)(ws + WS_WGLUG); S.tstepB = (size_t)128 * 2048; S.cpt = 128;
        EpiGlu E{(pflags & 4) ? (bf16*)(ws + 712 * MiB) : XB, ws + ((pflags & 4) ? 776 * MiB : WS_X8)};
        pg8::gemm_phase<EpiGlu, DenseSched, false, false, true>(F.lds, g, S, E);
    }
    SEAM(13);
    MOE_LAYER(14, 1, WS_WMOE1)
#undef IN
#undef SEAM
}

extern "C" void kernel_launch(void* const* d_in, const int* in_sizes, int n_in, void* d_out, int out_size, void* d_ws, size_t ws_size, hipStream_t stream) {
    static int grid = 0;
    if (grid == 0) {
        if (n_in != 36 || in_sizes[0] != T * D || out_size != T * D || ws_size < WS_END) { fprintf(stderr, "kernel_launch: unexpected shapes (n_in %d, in0 %d, out %d, ws %zu < %zu); nothing launched\n", n_in, n_in > 0 ? in_sizes[0] : -1, out_size, ws_size, (size_t)WS_END); grid = -1; return; }
        int dev = 0, cus = 0, per_cu = 0;
        if (hipGetDevice(&dev) != hipSuccess || hipDeviceGetAttribute(&cus, hipDeviceAttributeMultiprocessorCount, dev) != hipSuccess) { grid = -1; return; }
        if (hipFuncSetAttribute((const void*)fwd, hipFuncAttributeMaxDynamicSharedMemorySize, LDS_BYTES) != hipSuccess) { fprintf(stderr, "kernel_launch: hipFuncSetAttribute failed\n"); grid = -1; return; }
        if (hipOccupancyMaxActiveBlocksPerMultiprocessor(&per_cu, (const void*)fwd, NT, LDS_BYTES) != hipSuccess || per_cu < 1) fprintf(stderr, "kernel_launch: occupancy query says %d\n", per_cu);
        (void)hipGetLastError();
        grid = cus;
    }
    if (grid < 0) return;
    (void)hipMemsetAsync((char*)d_ws + WS_CTL, 0, CTL_ZERO_BYTES, stream);
    Args a{};
    for (int i = 0; i < 36; ++i) a.in[i] = (const float*)d_in[i];
    a.out = (float*)d_out; a.ws = (unsigned char*)d_ws;
#if MK_PER_PHASE
    for (int ph = 0; ph < NPHASE; ++ph) { a.ph_lo = ph; a.ph_hi = ph + 1; hipLaunchKernelGGL(fwd, dim3(grid), dim3(NT), LDS_BYTES, stream, a);
#ifdef REPEAT_PHASE
        if (ph == REPEAT_PHASE) {
#ifdef REPEAT_FLAGS
            a.ph_lo = ph | (REPEAT_FLAGS << 8);
#endif
            hipLaunchKernelGGL(fwd, dim3(grid), dim3(NT), LDS_BYTES, stream, a); }
#endif
    }
#else
    a.ph_lo = 0; a.ph_hi = NPHASE;
    hipLaunchKernelGGL(fwd, dim3(grid), dim3(NT), LDS_BYTES, stream, a);
#endif
    const hipError_t le = hipPeekAtLastError();
    if (le != hipSuccess) fprintf(stderr, "kernel_launch: launch failed: %s\n", hipGetErrorName(le));
}
```

```cpp
#include <hip/hip_runtime.h>
#include <cstdio>
#include <cstdint>

#define LAS __attribute__((address_space(3)))
#define GAS __attribute__((address_space(1)))
typedef unsigned short bf16;
typedef short bf16x8 __attribute__((ext_vector_type(8)));
typedef float f32x4 __attribute__((ext_vector_type(4)));
typedef float f32x2 __attribute__((ext_vector_type(2)));
typedef unsigned u32x4 __attribute__((ext_vector_type(4)));
typedef unsigned u32x2 __attribute__((ext_vector_type(2)));
typedef GAS unsigned gu32;
#define RLX_AGENT __ATOMIC_RELAXED, __HIP_MEMORY_SCOPE_AGENT
#define LDS_WAIT() asm volatile("s_waitcnt lgkmcnt(0)" ::: "memory")
#define VM_WAIT() asm volatile("s_waitcnt vmcnt(0)" ::: "memory")

#ifndef MK_PER_PHASE
#define MK_PER_PHASE 0
#endif

constexpr int T = 32768, D = 2048, SEQ = 2048, NBATCH = 16;
constexpr int NWAVES = 8, NT = 512;
constexpr int INCOLS = 6152, PN = 6144;
constexpr int NEXP = 16, FF = 512;
constexpr int NPAIR = 24;
constexpr int SLOT_ROWS = 32768 + NPAIR * 256;
constexpr float EPS = 1e-6f;
constexpr int NPHASE = 18;

typedef __bf16 bf16x2_t __attribute__((ext_vector_type(2)));
__device__ __forceinline__ unsigned pk2(float lo, float hi) { f32x2 v = {lo, hi}; bf16x2_t b = __builtin_convertvector(v, bf16x2_t); return __builtin_bit_cast(unsigned, b); }
__device__ __forceinline__ unsigned f2bf(float f) { return pk2(f, 0.f) & 0xffffu; }
__device__ __forceinline__ float bf_lo(unsigned w) { return __builtin_bit_cast(float, w << 16); }
__device__ __forceinline__ float bf_hi(unsigned w) { return __builtin_bit_cast(float, w & 0xffff0000u); }
__device__ __forceinline__ float bf2f(bf16 b) { return __builtin_bit_cast(float, ((unsigned)b) << 16); }
typedef int i32x8 __attribute__((ext_vector_type(8)));
typedef int i32x4 __attribute__((ext_vector_type(4)));
__device__ __forceinline__ unsigned pk4_f8(float a, float b, float c, float d) {
    a = __builtin_amdgcn_fmed3f(a, -448.f, 448.f); b = __builtin_amdgcn_fmed3f(b, -448.f, 448.f); c = __builtin_amdgcn_fmed3f(c, -448.f, 448.f); d = __builtin_amdgcn_fmed3f(d, -448.f, 448.f);
    int p = __builtin_amdgcn_cvt_pk_fp8_f32(a, b, 0, false); p = __builtin_amdgcn_cvt_pk_fp8_f32(c, d, p, true); return (unsigned)p; }
constexpr float F8_SX = 8.f, F8_SH = 64.f, F8_SY = 16.f, F8_SW = 512.f, F8_SWD = 256.f;
__device__ __forceinline__ float wave_sum(float v) {
#pragma unroll
    for (int o = 1; o < 64; o <<= 1) v += __shfl_xor(v, o);
    return v;
}
__device__ __forceinline__ float sigmoidf_(float x) { return __builtin_amdgcn_rcpf(1.0f + __expf(-x)); }
__device__ __forceinline__ float gelu_tanh(float x) { const float u = 0.7978845608028654f * (x + 0.044715f * x * x * x); return x * __builtin_amdgcn_rcpf(1.0f + __expf(-2.0f * u)); }
__device__ __forceinline__ float siluf_(float x) { return x * __builtin_amdgcn_rcpf(1.0f + __expf(-x)); }

namespace pg8 {
constexpr int BM = 256, BK = 64, HALF = 128, HTB = HALF * BK * 2, STAGE_BYTES = 8 * HTB, NXCD = 8, WGM = 8;
__host__ __device__ __forceinline__ int lds_byte(int r, int c) { const int st = (r >> 4) * 2 + (c >> 5), rr = r & 15, cc = c & 31, ob = rr * 64 + cc * 2; return st * 1024 + (ob ^ (((ob >> 9) & 1) << 5)); }
__host__ __device__ __forceinline__ void stage_rc(int b, int& R, int& C) { const int st = b / 1024, sb = b % 1024, swz = sb ^ (((sb >> 9) & 1) << 5); R = (st >> 1) * 16 + swz / 64; C = (st & 1) * 32 + (swz % 64) / 2; }
__host__ __device__ __forceinline__ int perm32(int rho) { const int n = rho >> 4, i = rho & 15; return 8 * (i >> 2) + 4 * n + (i & 3); }

struct Unit { const char* a; const char* b0; const char* b1; const char* b0x; const char* b1x; int r0, c0, aux, x; };
struct GemmP { const char* gA; int K; unsigned rsA, planeA, ldb; };

struct TileOrder {
    int nM, nN, nwg, G, c, wgm;
    __device__ __forceinline__ void init(int nM_, int nN_, int G_, int c_, int wgm_ = WGM) { nM = nM_; nN = nN_; nwg = nM * nN; G = G_; c = c_; wgm = wgm_; }
    __device__ __forceinline__ bool next(int i, int& pm, int& pn) const {
        const long L = (long)i * G + c; if (L >= nwg) return false;
        int wgid = (int)L; { const int q = nwg / NXCD, r = nwg % NXCD, xcd = wgid % NXCD, off = wgid / NXCD; wgid = (xcd < r ? xcd * (q + 1) : r * (q + 1) + (xcd - r) * q) + off; }
        const int nig = wgm * nN, gid = wgid / nig, fm = gid * wgm, gsz = (nM - fm) < wgm ? (nM - fm) : wgm;
        pm = fm + ((wgid % nig) % gsz); pn = (wgid % nig) / gsz; return true;
    }
};

template <class Epi, class Sched, bool GATHER, bool DUALB = false, bool FP8 = false>
__device__ __forceinline__ void gemm_phase(LAS unsigned char* lds, const GemmP g, const Sched& S, const Epi& E) {
    const int tid = threadIdx.x, wid = __builtin_amdgcn_readfirstlane(tid >> 6), lane = tid & 63, wr = wid >> 2, wc = wid & 3, fr = lane & 15, fq = lane >> 4;
    const int nt = g.K / BK;
    unsigned voffA[2], voffB[2], coff[2]; int RA[2];
#pragma unroll
    for (int i = 0; i < 2; ++i) { int R, C; stage_rc(tid * 16 + i * 8192, R, C); const int Rb = Epi::PERM ? ((R & ~31) + perm32(R & 31)) : R;
        coff[i] = (unsigned)(C >> 4) * g.planeA + (unsigned)(C & 15) * 2u; RA[i] = R;
        voffA[i] = (unsigned)R * g.rsA + coff[i]; voffB[i] = (unsigned)Rb * g.ldb + (unsigned)C * 2u; }
    const size_t ksA = (size_t)4 * g.planeA, ksB = (size_t)(BK * 2);
    const size_t hstepA = (size_t)HALF * g.rsA;
    const unsigned ldsw = (unsigned)wid * 1024u;
    const int aoff = lds_byte(wr * 64 + fr, fq * 8), boff = lds_byte(wc * 32 + fr, fq * 8);
#define PG8_SA(b, h) (((b) * 2 + (h)) * HTB)
#define PG8_SB(b, h) ((4 + (b) * 2 + (h)) * HTB)
#define PG8_STG(bufoff, ptr, o0, o1) do { \
        __builtin_amdgcn_global_load_lds((const unsigned*)((const char*)(ptr) + (o0)), (LAS unsigned*)(lds + (bufoff) + ldsw), 16, 0, 0); \
        __builtin_amdgcn_global_load_lds((const unsigned*)((const char*)(ptr) + (o1)), (LAS unsigned*)(lds + (bufoff) + ldsw + 8192), 16, 0, 0); } while (0)
#define PG8_STAGE_B(bufoff, ptr) PG8_STG(bufoff, ptr, voffB[0], voffB[1])
#define PG8_STAGE_A(bufoff, h, ptr, usenext) do { if constexpr (GATHER) { const unsigned _o0 = (usenext) ? voN[h][0] : voC[h][0], _o1 = (usenext) ? voN[h][1] : voC[h][1]; PG8_STG(bufoff, ptr, _o0, _o1); } \
        else { PG8_STG(bufoff, (ptr) + (h) * hstepA, voffA[0], voffA[1]); } } while (0)
#define PG8_LD16(off) (*(const LAS bf16x8*)(lds + (off)))
#define PG8_CAT8(x, y) __builtin_shufflevector(__builtin_bit_cast(i32x4, x), __builtin_bit_cast(i32x4, y), 0, 1, 2, 3, 4, 5, 6, 7)
#define PG8_LDA(dst, b, h) do { if constexpr (FP8) { _Pragma("unroll") for (int m = 0; m < 4; ++m) dst##8[m] = PG8_CAT8(PG8_LD16(PG8_SA(b, h) + aoff + m * 2048), PG8_LD16(PG8_SA(b, h) + aoff + m * 2048 + 1024)); } \
        else { _Pragma("unroll") for (int m = 0; m < 4; ++m) _Pragma("unroll") for (int k = 0; k < 2; ++k) dst[m][k] = PG8_LD16(PG8_SA(b, h) + aoff + m * 2048 + k * 1024); } } while (0)
#define PG8_LDB(dst, b, h) do { if constexpr (FP8) { _Pragma("unroll") for (int n = 0; n < 2; ++n) dst##8[n] = PG8_CAT8(PG8_LD16(PG8_SB(b, h) + boff + n * 2048), PG8_LD16(PG8_SB(b, h) + boff + n * 2048 + 1024)); } \
        else { _Pragma("unroll") for (int n = 0; n < 2; ++n) _Pragma("unroll") for (int k = 0; k < 2; ++k) dst[n][k] = PG8_LD16(PG8_SB(b, h) + boff + n * 2048 + k * 1024); } } while (0)
#define PG8_MMA(ai, bj, At, Bt) do { __builtin_amdgcn_s_setprio(1); \
        if constexpr (FP8) { _Pragma("unroll") for (int m = 0; m < 4; ++m) _Pragma("unroll") for (int n = 0; n < 2; ++n) \
            asm volatile("v_mfma_f32_16x16x128_f8f6f4 %0, %1, %2, %0" : "+v"(acc[ai][bj][m][n]) : "v"(Bt##8[n]), "v"(At##8[m])); } \
        else { _Pragma("unroll") for (int m = 0; m < 4; ++m) _Pragma("unroll") for (int n = 0; n < 2; ++n) _Pragma("unroll") for (int k = 0; k < 2; ++k) \
            acc[ai][bj][m][n] = __builtin_amdgcn_mfma_f32_16x16x32_bf16(Bt[n][k], At[m][k], acc[ai][bj][m][n], 0, 0, 0); } \
        __builtin_amdgcn_s_setprio(0); } while (0)
#define PG8_WAIT_V(n) asm volatile("s_waitcnt vmcnt(" #n ")" ::: "memory")
#define PG8_WAIT_L(n) asm volatile("s_waitcnt lgkmcnt(" #n ")" ::: "memory")
#define PG8_BAR __builtin_amdgcn_s_barrier()
#define PG8_SCHED __builtin_amdgcn_sched_barrier(0)
    Unit cur, nxt; int ui = 0;
    if (!S.next(0, cur)) return;
    unsigned voC[2][2], voN[2][2];
    if constexpr (GATHER) {
#pragma unroll
        for (int h = 0; h < 2; ++h)
#pragma unroll
            for (int i = 0; i < 2; ++i) { voC[h][i] = S.row_off(cur, h * HALF + RA[i]) + coff[i]; voN[h][i] = voC[h][i]; }
    } else { voC[0][0] = voC[0][1] = voC[1][0] = voC[1][1] = 0u; voN[0][0] = voN[0][1] = voN[1][0] = voN[1][1] = 0u; }
    f32x4 acc[2][2][4][2];
#pragma unroll
    for (int a = 0; a < 2; ++a)
#pragma unroll
        for (int b = 0; b < 2; ++b)
#pragma unroll
            for (int m = 0; m < 4; ++m)
#pragma unroll
                for (int n = 0; n < 2; ++n) acc[a][b][m][n] = (f32x4){0.f, 0.f, 0.f, 0.f};
    bf16x8 At[4][2], B0[2][2], B1[2][2];
    i32x8 At8[4], B08[2], B18[2];
    const char* cA = GATHER ? g.gA : cur.a; const char* cB0 = cur.b0; const char* cB1 = cur.b1; const char* cB0x = cur.b0x; const char* cB1x = cur.b1x;
    const int nth = nt >> 1;
#define PG8_BPTR(h, kt) ((DUALB && (kt) >= nth) ? ((h) ? cB1x : cB0x) + (size_t)((kt) - nth) * ksB : ((h) ? cB1 : cB0) + (size_t)(kt) * ksB)
    PG8_STAGE_B(PG8_SB(0, 0), cB0); PG8_STAGE_B(PG8_SB(0, 1), cB1); PG8_STAGE_A(PG8_SA(0, 0), 0, cA, false); PG8_STAGE_A(PG8_SA(0, 1), 1, cA, false);
    if (wr == 1) PG8_BAR;
    PG8_WAIT_V(2); PG8_BAR;
    PG8_STAGE_B(PG8_SB(1, 0), cB0 + ksB); PG8_STAGE_A(PG8_SA(1, 0), 0, cA + ksA, false); PG8_STAGE_B(PG8_SB(1, 1), cB1 + ksB);
    PG8_WAIT_V(6); PG8_BAR;
    for (;;) {
        const bool has_next = S.next(ui + 1, nxt);
        const char* nA = GATHER ? g.gA : (has_next ? nxt.a : cA); const char* nB0 = has_next ? nxt.b0 : cB0; const char* nB1 = has_next ? nxt.b1 : cB1;
        const char* nB0x = has_next ? nxt.b0x : cB0x; const char* nB1x = has_next ? nxt.b1x : cB1x;
        if constexpr (GATHER) {
            if (has_next) {
#pragma unroll
                for (int h = 0; h < 2; ++h)
#pragma unroll
                    for (int i = 0; i < 2; ++i) voN[h][i] = S.row_off(nxt, h * HALF + RA[i]) + coff[i];
            } else {
#pragma unroll
                for (int h = 0; h < 2; ++h)
#pragma unroll
                    for (int i = 0; i < 2; ++i) voN[h][i] = voC[h][i];
            }
        }
#pragma nounroll
        for (int t = 0; t < nt; t += 2) {
            const bool last = (t == nt - 2);
            const char* a1 = cA + (size_t)(t + 1) * ksA;
            const char* a2 = last ? nA : cA + (size_t)(t + 2) * ksA;
            const char* b20 = last ? nB0 : PG8_BPTR(0, t + 2); const char* b21 = last ? nB1 : PG8_BPTR(1, t + 2);
            const char* a3 = a2 + ksA; const char* b30 = last ? nB0 + ksB : PG8_BPTR(0, t + 3); const char* b31 = last ? nB1 + ksB : PG8_BPTR(1, t + 3);
            PG8_LDB(B0, 0, 0); PG8_LDB(B1, 0, 1); PG8_SCHED; PG8_LDA(At, 0, 0); PG8_STAGE_A(PG8_SA(1, 1), 1, a1, false);
            PG8_WAIT_V(8); PG8_WAIT_L(0); PG8_BAR; PG8_MMA(0, 0, At, B0); PG8_MMA(0, 1, At, B1); PG8_BAR; PG8_SCHED;
            PG8_LDA(At, 0, 1); PG8_STAGE_B(PG8_SB(0, 0), b20); PG8_STAGE_B(PG8_SB(0, 1), b21); PG8_STAGE_A(PG8_SA(0, 0), 0, a2, last);
            PG8_WAIT_V(8); PG8_WAIT_L(0); PG8_BAR; PG8_MMA(1, 0, At, B0); PG8_MMA(1, 1, At, B1); PG8_BAR; PG8_SCHED;
            PG8_LDB(B0, 1, 0); PG8_LDB(B1, 1, 1); PG8_SCHED; PG8_LDA(At, 1, 0); PG8_STAGE_A(PG8_SA(0, 1), 1, a2, last);
            PG8_WAIT_V(8); PG8_WAIT_L(0); PG8_BAR; PG8_MMA(0, 0, At, B0); PG8_MMA(0, 1, At, B1); PG8_BAR; PG8_SCHED;
            PG8_LDA(At, 1, 1); PG8_STAGE_B(PG8_SB(1, 0), b30); PG8_STAGE_B(PG8_SB(1, 1), b31); PG8_STAGE_A(PG8_SA(1, 0), 0, a3, last);
            PG8_WAIT_V(8); PG8_WAIT_L(0); PG8_BAR; PG8_MMA(1, 0, At, B0); PG8_MMA(1, 1, At, B1); PG8_BAR; PG8_SCHED;
        }
#ifndef PG8_NOALIGN
        if (wr == 0) PG8_BAR;
#endif
        if constexpr (FP8) asm volatile("s_nop 15\n\ts_nop 15" ::: "memory");
        E(acc, cur, wr, wc, fr, fq);
        if (!has_next) break;
#pragma unroll
        for (int a = 0; a < 2; ++a)
#pragma unroll
            for (int b = 0; b < 2; ++b)
#pragma unroll
                for (int m = 0; m < 4; ++m)
#pragma unroll
                    for (int n = 0; n < 2; ++n) acc[a][b][m][n] = (f32x4){0.f, 0.f, 0.f, 0.f};
        cur = nxt; cA = nA; cB0 = nB0; cB1 = nB1; cB0x = nB0x; cB1x = nB1x; ++ui;
        if constexpr (GATHER) {
#pragma unroll
            for (int h = 0; h < 2; ++h)
#pragma unroll
                for (int i = 0; i < 2; ++i) voC[h][i] = voN[h][i];
        }
#ifndef PG8_NOALIGN
        if (wr == 1) PG8_BAR;
#endif
    }
    PG8_WAIT_V(0);
#ifdef PG8_NOALIGN
    if (wr == 0) PG8_BAR;
#endif
    PG8_BAR;
#undef PG8_BPTR
#undef PG8_SA
#undef PG8_SB
#undef PG8_STG
#undef PG8_STAGE_A
#undef PG8_STAGE_B
#undef PG8_LDA
#undef PG8_LDB
#undef PG8_MMA
#undef PG8_CAT8
#undef PG8_LD16
#undef PG8_WAIT_V
#undef PG8_WAIT_L
#undef PG8_BAR
#undef PG8_SCHED
}
}

#define XB_TMO      128
#define XB_XCNT(j)  (256  + 64 * (j))
#define XB_XSUB(j)  (1280 + 64 * (j))
#define XB_XGEN(j)  (2304 + 64 * (j))
#define XB_TOP      3328
#define XB_TOPGEN   3392
#define XCD_BAR_WORDS 3456
#define XB_SPIN_CAP (1u << 18)
__device__ __forceinline__ unsigned xb_ld(unsigned* p)              { return __hip_atomic_load(p, __ATOMIC_RELAXED, __HIP_MEMORY_SCOPE_AGENT); }
__device__ __forceinline__ unsigned xb_add(unsigned* p, unsigned v) { return __hip_atomic_fetch_add(p, v, __ATOMIC_RELAXED, __HIP_MEMORY_SCOPE_AGENT); }
__device__ __forceinline__ unsigned xb_xcc_id() { return (unsigned)__builtin_amdgcn_s_getreg((3 << 11) | 20) & 0xFu; }
#define XB_SPIN(cond, bar) do { unsigned _sp = 0; while (cond) { __builtin_amdgcn_s_sleep(1); \
    if ((++_sp & 255u) == 0u) { if (xb_ld(&(bar)[XB_TMO])) break; if (_sp > XB_SPIN_CAP) { atomicAdd(&(bar)[XB_TMO], 1u); break; } } } } while (0)
struct XcdBarrier { unsigned* bar; unsigned x; volatile LAS unsigned* st; };
__device__ __forceinline__ XcdBarrier xcd_barrier_post(unsigned* bar, volatile LAS unsigned* st) {
    XcdBarrier b; b.bar = bar; b.x = xb_xcc_id(); b.st = st;
    if (threadIdx.x == 0) (void)xb_add(&bar[XB_XCNT(b.x)], 1u);
    return b;
}
__device__ __forceinline__ void xcd_barrier_complete(unsigned* bar, unsigned x, unsigned& nloc, unsigned& nx) {
    const unsigned G = gridDim.x * gridDim.y * gridDim.z;
    unsigned sum, cnt, mine, sp = 0u;
    for (;;) {
        sum = 0u; cnt = 0u; mine = 0u;
#pragma unroll
        for (unsigned j = 0; j < 16; ++j) { const unsigned c = xb_ld(&bar[XB_XCNT(j)]); sum += c; cnt += (c > 0u) ? 1u : 0u; mine = (j == x) ? c : mine; }
        if (sum == G) break;
        __builtin_amdgcn_s_sleep(1);
        if ((++sp & 255u) == 0u) { if (xb_ld(&bar[XB_TMO])) break; if (sp > XB_SPIN_CAP) { atomicAdd(&bar[XB_TMO], 1u); break; } }
    }
    nloc = mine > 0u ? mine : 1u; nx = cnt > 0u ? cnt : 1u;
}
__device__ __forceinline__ void xcd_barrier(const XcdBarrier& b) {
    asm volatile("s_waitcnt vmcnt(0)" ::: "memory");
    __syncthreads();
    if (threadIdx.x == 0) {
        unsigned* bar = b.bar;
        __builtin_amdgcn_s_waitcnt(0);
        unsigned nloc = b.st[0], nx = b.st[1];
        if (nloc == 0u) { xcd_barrier_complete(bar, b.x, nloc, nx); b.st[0] = nloc; b.st[1] = nx; }
        const unsigned old = xb_add(&bar[XB_XSUB(b.x)], 1u);
        const unsigned gen = old / nloc;
        if (old + 1u == (gen + 1u) * nloc) {
            __builtin_amdgcn_fence(__ATOMIC_RELEASE, "agent");
            asm volatile("s_waitcnt vmcnt(0)" ::: "memory");
            const unsigned og = xb_add(&bar[XB_TOP], 1u);
            const unsigned tg = og / nx;
            if (og + 1u == (tg + 1u) * nx) xb_add(&bar[XB_TOPGEN], 1u);
            else XB_SPIN(xb_ld(&bar[XB_TOPGEN]) == tg, bar);
            __builtin_amdgcn_fence(__ATOMIC_ACQUIRE, "agent");
            xb_add(&bar[XB_XGEN(b.x)], 1u);
            asm volatile("s_waitcnt vmcnt(0)" ::: "memory");
        } else {
            XB_SPIN(xb_ld(&bar[XB_XGEN(b.x)]) == gen, bar);
            __builtin_amdgcn_fence(__ATOMIC_ACQUIRE, "agent");
            asm volatile("s_waitcnt vmcnt(0)" ::: "memory");
        }
    }
    __syncthreads();
}

constexpr size_t MiB = 1u << 20;
constexpr size_t WS_CTL = 0, CTL_ZERO_BYTES = 1 * MiB;
constexpr size_t WS_RSTD = 1 * MiB;
constexpr size_t WS_GATES = 2 * MiB;
constexpr size_t WS_SUMSQ = 3 * MiB;
constexpr size_t WS_RW = 5 * MiB;
constexpr size_t WS_LAM = 6 * MiB;
constexpr size_t WS_LRUW = 7 * MiB;
constexpr size_t WS_TOKL = 8 * MiB;
constexpr size_t WS_RSTDL = 10 * MiB;
constexpr size_t WS_GATEL = 12 * MiB;
constexpr size_t WS_TOKSLOT = 14 * MiB;
constexpr size_t WS_WIN = 16 * MiB;
constexpr size_t WS_WOUT = 40 * MiB;
constexpr size_t WS_WS5IN = 48 * MiB, WS_WGLUV = 56 * MiB, WS_WGLUG = 64 * MiB;
constexpr size_t WS_WMOE0 = 72 * MiB;
constexpr size_t WS_S5WIN = 168 * MiB;
constexpr size_t WS_S5WO = 176 * MiB;
constexpr size_t WS_S5K = 192 * MiB;
constexpr size_t WS_XB = 200 * MiB;
constexpr size_t WS_Y = 328 * MiB;
constexpr size_t WS_P = 456 * MiB;
constexpr size_t WS_H = 456 * MiB;
constexpr size_t WS_PTOK = 540 * MiB;
constexpr size_t WS_PRSTD = 544 * MiB, WS_PGA = 548 * MiB, WS_PGB = 552 * MiB;
constexpr size_t WS_A2 = 456 * MiB;
constexpr size_t WS_XIN = 648 * MiB;
constexpr size_t WS_X8IN = 328 * MiB;
constexpr size_t WS_X8 = 648 * MiB;
constexpr size_t WS_WMOE1 = 840 * MiB;
constexpr size_t WS_END = 936 * MiB;
static_assert(WS_H + (size_t)SLOT_ROWS * 1024 * 2 <= WS_PTOK && WS_PGB + (size_t)NPAIR * T * 4 <= WS_XIN, "moe buffers");
static_assert(WS_A2 + (size_t)128 * 2048 * 384 * 2 <= WS_XIN && WS_XIN + (size_t)128 * 2048 * 128 * 4 <= WS_WMOE1, "s5 buffers");
static_assert(WS_P + (size_t)T * PN * 2 <= WS_WMOE1, "p buffer");
constexpr int CW_BAR = 4096;
constexpr int CW_TMO = 8;
constexpr int CW_PANEL = 32768;
constexpr int CW_HN = 131072;
constexpr int CW_CNT = 16384;

constexpr int RING_BYTES = 131072;
constexpr int LDS_BYTES = 163840;
constexpr int MISC_OFF = LDS_BYTES - 1024;
constexpr int MI_PRE = 136, MI_CNT = 164;

struct Frame {
    LAS unsigned char* lds;
    volatile LAS unsigned* MISC;
    gu32* ctl;
    int tid, lane, wave, vcu, G;
    float* out; unsigned char* ws;
    __device__ __forceinline__ const float* in(int i) const {
        const unsigned lo = __builtin_amdgcn_readfirstlane(MISC[64 + 2 * i]), hi = __builtin_amdgcn_readfirstlane(MISC[65 + 2 * i]);
        return (const float*)(((unsigned long long)hi << 32) | lo); }
};

__device__ __forceinline__ void transpose_item(const float* W, int ldw, const float* gain, bf16* WT, int ldt, int nblk, LAS float* scr, int item, int lane) {
    const int kb = item / nblk, nb = item % nblk, k0 = 64 * kb, n0 = 32 * nb;
    float v[32];
#pragma unroll
    for (int i = 0; i < 32; ++i) v[i] = W[(size_t)(k0 + 2 * i + (lane >> 5)) * ldw + n0 + (lane & 31)];
    const int c = lane & 7;
    f32x4 g0 = (f32x4){1.f, 1.f, 1.f, 1.f}, g1 = g0;
    if (gain) { g0 = *(const f32x4*)(gain + k0 + 8 * c); g1 = *(const f32x4*)(gain + k0 + 8 * c + 4); }
#pragma unroll
    for (int i = 0; i < 32; ++i) scr[(2 * i + (lane >> 5)) * 33 + (lane & 31)] = v[i];
    LDS_WAIT(); asm volatile("" ::: "memory");
#pragma unroll
    for (int j = 0; j < 4; ++j) { const int n = (lane >> 3) + 8 * j; const LAS float* s = scr + (8 * c) * 33 + n;
        u32x4 o; o.x = pk2(s[0 * 33] * g0[0], s[1 * 33] * g0[1]); o.y = pk2(s[2 * 33] * g0[2], s[3 * 33] * g0[3]); o.z = pk2(s[4 * 33] * g1[0], s[5 * 33] * g1[1]); o.w = pk2(s[6 * 33] * g1[2], s[7 * 33] * g1[3]);
        *(GAS u32x4*)(WT + (size_t)(n0 + n) * ldt + k0 + 8 * c) = o; }
    LDS_WAIT(); asm volatile("" ::: "memory");
}
__device__ __forceinline__ void transpose_item8(const float* W, int ldw, const float* gain, unsigned char* WT, int ldt, int nblk, LAS float* scr, int item, int lane, float sc) {
    const int kb = item / nblk, nb = item % nblk, k0 = 64 * kb, n0 = 32 * nb;
    float v[32];
#pragma unroll
    for (int i = 0; i < 32; ++i) v[i] = W[(size_t)(k0 + 2 * i + (lane >> 5)) * ldw + n0 + (lane & 31)];
    const int c = lane & 7;
    f32x4 g0 = (f32x4){sc, sc, sc, sc}, g1 = g0;
    if (gain) { g0 = *(const f32x4*)(gain + k0 + 8 * c) * sc; g1 = *(const f32x4*)(gain + k0 + 8 * c + 4) * sc; }
#pragma unroll
    for (int i = 0; i < 32; ++i) scr[(2 * i + (lane >> 5)) * 33 + (lane & 31)] = v[i];
    LDS_WAIT(); asm volatile("" ::: "memory");
#pragma unroll
    for (int j = 0; j < 4; ++j) { const int n = (lane >> 3) + 8 * j; const LAS float* s = scr + (8 * c) * 33 + n;
        u32x2 o; o.x = pk4_f8(s[0 * 33] * g0[0], s[1 * 33] * g0[1], s[2 * 33] * g0[2], s[3 * 33] * g0[3]); o.y = pk4_f8(s[4 * 33] * g1[0], s[5 * 33] * g1[1], s[6 * 33] * g1[2], s[7 * 33] * g1[3]);
        *(GAS u32x2*)(WT + (size_t)(n0 + n) * ldt + k0 + 8 * c) = o; }
    LDS_WAIT(); asm volatile("" ::: "memory");
}
__device__ __forceinline__ void sincos_d(double th, double& s, double& c) {
    const double TWO_PI = 6.283185307179586476925286766559;
    const double k = __builtin_rint(th / TWO_PI); const double x = th - k * TWO_PI;
    const double x2 = x * x; double ts = x, tc = 1.0; s = x; c = 1.0;
#pragma unroll
    for (int i = 1; i <= 16; ++i) { tc *= -x2 / (double)((2 * i - 1) * (2 * i)); ts *= -x2 / (double)((2 * i) * (2 * i + 1)); c += tc; s += ts; }
}
__device__ __forceinline__ void s5_build_group(Frame& F, int g, int half) {
    LAS float* pwr = (LAS float*)(F.lds);
    LAS float* pwi = pwr + 17 * 64;
    LAS float* bbr = pwi + 17 * 64;
    LAS float* bbi = bbr + 1024;
    LAS float* cre = bbi + 1024;
    LAS float* cim = cre + 1024;
    LAS float* km = cim + 1024;
    LAS float* ff = km + 4096;
    LAS float* ctr = ff + 128;
    LAS float* cti = ctr + 1024;
    const int tid = F.tid;
    const float* a_re = F.in(19) + g * 64; const float* a_im = F.in(20) + g * 64;
    if (tid < 64) {
        const double dt = (double)expf(F.in(21)[g]), ar = (double)a_re[tid], ai = (double)a_im[tid];
        const double mag = (double)expf((float)(ar * dt)); double sn, cs; sincos_d(ai * dt, sn, cs);
        const double lr = mag * cs, li = mag * sn; double pr = 1.0, pi = 0.0;
        for (int d = 0; d <= 16; ++d) { pwr[d * 64 + tid] = (float)pr; pwi[d * 64 + tid] = (float)pi; const double nr = pr * lr - pi * li, ni = pr * li + pi * lr; pr = nr; pi = ni; }
        const double den = ar * ar + ai * ai;
        ff[tid] = (float)(((lr - 1.0) * ar + li * ai) / den); ff[64 + tid] = (float)((li * ar - (lr - 1.0) * ai) / den);
        if (half == 0) {
            double q16r = 1.0, q16i = 0.0;
            for (int d = 0; d < 16; ++d) { const double nr = q16r * lr - q16i * li, ni = q16r * li + q16i * lr; q16r = nr; q16i = ni; }
            double q64r = q16r, q64i = q16i;
            for (int d = 0; d < 2; ++d) { const double nr = q64r * q64r - q64i * q64i, ni = 2.0 * q64r * q64i; q64r = nr; q64i = ni; }
            *(f32x4*)((float*)(F.ws + WS_LAM) + ((size_t)g * 64 + tid) * 4) = (f32x4){(float)q16r, (float)q16i, (float)q64r, (float)q64i};
        }
    }
    __syncthreads();
    { const float* pbr = F.in(22) + g * 1024; const float* pbi = F.in(23) + g * 1024; const float* pcr = F.in(24) + g * 1024; const float* pci = F.in(25) + g * 1024;
    for (int idx = tid; idx < 1024; idx += NT) { const int p = idx >> 4; const float br = pbr[idx], bi = pbi[idx]; const float fr = ff[p], fi = ff[64 + p];
        bbr[idx] = fr * br - fi * bi; bbi[idx] = fr * bi + fi * br; const float cr_ = pcr[idx], ci_ = pci[idx]; cre[idx] = cr_; cim[idx] = ci_;
        ctr[(idx & 63) * 16 + (idx >> 6)] = cr_; cti[(idx & 63) * 16 + (idx >> 6)] = ci_; } }
    __syncthreads();
    if (tid < 256) {
        const int d = tid >> 4, co = tid & 15; float ac[16];
#pragma unroll
        for (int ci = 0; ci < 16; ++ci) ac[ci] = 0.f;
        for (int p = 0; p < 64; ++p) { const float c_r = ctr[p * 16 + co], c_i = cti[p * 16 + co], l_r = pwr[d * 64 + p], l_i = pwi[d * 64 + p];
            const float tr = c_r * l_r - c_i * l_i, ti = c_r * l_i + c_i * l_r;
#pragma unroll
            for (int c4 = 0; c4 < 4; ++c4) { const f32x4 br = *(const LAS f32x4*)(bbr + p * 16 + 4 * c4), bi = *(const LAS f32x4*)(bbi + p * 16 + 4 * c4);
#pragma unroll
                for (int j = 0; j < 4; ++j) ac[4 * c4 + j] += tr * br[j] - ti * bi[j]; } }
#pragma unroll
        for (int c4 = 0; c4 < 4; ++c4) *(LAS f32x4*)(km + (d << 8) + (co << 4) + 4 * c4) = (f32x4){ac[4 * c4], ac[4 * c4 + 1], ac[4 * c4 + 2], ac[4 * c4 + 3]};
    }
    __syncthreads();
    const float* dsk = F.in(26) + g * 16;
    if (half == 0) { bf16* KB = (bf16*)(F.ws + WS_S5K) + (size_t)g * 4096;
        for (int idx = tid; idx < 4096; idx += NT) { const int co = (idx >> 4) & 15, ci = idx & 15; float v = km[idx]; if (idx < 256 && ci == co) v += dsk[co]; KB[idx] = (bf16)f2bf(v); } }
    bf16* Wo = (bf16*)(F.ws + WS_S5WO) + (size_t)g * 256 * 128;
    for (int idx = half * 128 * 128 + tid; idx < (half + 1) * 128 * 128; idx += NT) { const int row = idx >> 7, q = idx & 127, tl = row >> 4, co = row & 15, p = 8 * (q >> 4) + (q & 7), part = (q >> 3) & 1;
        const float c_r = cre[co * 64 + p], c_i = cim[co * 64 + p], l_r = pwr[(tl + 1) * 64 + p], l_i = pwi[(tl + 1) * 64 + p];
        Wo[idx] = (bf16)f2bf((part == 0) ? (c_r * l_r - c_i * l_i) : -(c_r * l_i + c_i * l_r)); }
    bf16* Wi = (bf16*)(F.ws + WS_S5WIN) + (size_t)g * 128 * 256;
    for (int idx = half * 64 * 256 + tid; idx < (half + 1) * 64 * 256; idx += NT) { const int row = idx >> 8, col = idx & 255, p = 8 * (row >> 4) + (row & 7), part = (row >> 3) & 1, j = col >> 4, ci = col & 15, d = 15 - j;
        const float l_r = pwr[d * 64 + p], l_i = pwi[d * 64 + p], b_r = bbr[p * 16 + ci], b_i = bbi[p * 16 + ci];
        Wi[idx] = (bf16)f2bf(part == 0 ? (l_r * b_r - l_i * b_i) : (l_r * b_i + l_i * b_r)); }
    __syncthreads();
}

__device__ __forceinline__ void ph_prologue(Frame& F, int pf) {
    LAS float* scr = (LAS float*)(F.lds + F.wave * 16384);
    const int gw = F.vcu * NWAVES + F.wave, NGW = F.G * NWAVES, lane = F.lane;
    constexpr int I_IN = 32 * 192, I_SQ = 32 * 64, I_MOE = 512;
    constexpr int NITEMS = I_IN + 4 * I_SQ + 96 * I_MOE;
    if (!(pf & 16))
    for (int it = gw; it < NITEMS; it += NGW) {
        int r = it;
        if (r < I_IN) { if ((r % 192) < 64) transpose_item8(F.in(4), INCOLS, F.in(1), F.ws + WS_WIN, 2048, 192, scr, r, lane, F8_SW);
            else transpose_item(F.in(4), INCOLS, F.in(1), (bf16*)(F.ws + WS_WIN), 2048, 192, scr, r, lane); continue; } r -= I_IN;
        if (r < I_SQ) { transpose_item(F.in(17), 2048, nullptr, (bf16*)(F.ws + WS_WOUT), 2048, 64, scr, r, lane); continue; } r -= I_SQ;
        if (r < I_SQ) { transpose_item8(F.in(18), 2048, F.in(1) + 2048, F.ws + WS_WS5IN, 2048, 64, scr, r, lane, F8_SW); continue; } r -= I_SQ;
        if (r < I_SQ) { transpose_item8(F.in(27), 2048, nullptr, F.ws + WS_WGLUV, 2048, 64, scr, r, lane, F8_SW); continue; } r -= I_SQ;
        if (r < I_SQ) { transpose_item8(F.in(28), 2048, nullptr, F.ws + WS_WGLUG, 2048, 64, scr, r, lane, F8_SW); continue; } r -= I_SQ;
        const int mat = r / I_MOE, itx = r % I_MOE, l = mat / 48, rem = mat % 48, kind = rem / 16, e = rem % 16;
        unsigned char* base = F.ws + (l ? WS_WMOE1 : WS_WMOE0);
        if (kind < 2) transpose_item8((kind == 0 ? F.in(33) : F.in(34)) + (size_t)(l * 16 + e) * 2048 * 512, 512, F.in(2) + l * 2048, base + (size_t)kind * 32 * MiB + (size_t)e * 512 * 2048, 2048, 16, scr, itx, lane, F8_SW);
        else transpose_item8(F.in(35) + (size_t)(l * 16 + e) * 512 * 2048, 2048, nullptr, base + (size_t)64 * MiB + (size_t)e * 2048 * 512, 512, 64, scr, itx, lane, F8_SWD);
    }
    __syncthreads();
    if (!(pf & 32)) for (int gh = F.vcu; gh < 256; gh += F.G) s5_build_group(F, gh >> 1, gh & 1);
    __syncthreads();
    const int gt = F.vcu * NT + F.tid, NGT = F.G * NT;
    {
        bf16* LW = (bf16*)(F.ws + WS_LRUW); const float* wa_ = F.in(7); const float* wx_ = F.in(9); const float* wc_ = F.in(29); const float* wf_ = F.in(31); const float* nf_ = F.in(2);
        for (int idx = gt; idx < 8 * 256 * 128; idx += NGT) { const int n = idx >> 15, o = (idx >> 7) & 255, i = idx & 127;
            const float v = (o < 128) ? wa_[(size_t)(n * 128 + i) * 128 + o] : wx_[(size_t)(n * 128 + i) * 128 + (o - 128)]; LW[idx] = (bf16)f2bf(v); }
        float* RW = (float*)(F.ws + WS_RW);
        bf16* RWB = (bf16*)RW;
        for (int idx = gt; idx < 2 * 32 * 2048; idx += NGT) { const int l = idx >> 16, n = (idx >> 11) & 31, k = idx & 2047;
            const float w = (n < 4) ? wc_[(size_t)(l * 2048 + k) * 4 + n] * nf_[l * 2048 + k] : (n < 20) ? wf_[(size_t)(l * 2048 + k) * 16 + (n - 4)] * nf_[l * 2048 + k] : 0.f;
            const unsigned hi = f2bf(w); const float lo = w - __builtin_bit_cast(float, hi << 16);
            RWB[((size_t)(l * 2 + 0) * 32 + n) * 2048 + k] = (bf16)hi; RWB[((size_t)(l * 2 + 1) * 32 + n) * 2048 + k] = (bf16)f2bf(lo); }
    }
    LAS float* wgT = (LAS float*)F.lds;
    { const float* win = F.in(4); const float* nm0 = F.in(1);
    for (int idx = F.tid; idx < 16384; idx += NT) { const int k = idx >> 3, c = idx & 7; wgT[c * 2048 + k] = win[(size_t)k * INCOLS + 6144 + c] * nm0[k]; } }
    __syncthreads();
    const float* x = F.in(0); bf16* xb = (bf16*)(F.ws + WS_XB); unsigned char* x8 = F.ws + WS_X8IN; float* rstd_o = (float*)(F.ws + WS_RSTD); float* gates = (float*)(F.ws + WS_GATES);
    const float bias = (lane < 4) ? F.in(14)[lane & 3] : F.in(15)[lane & 3];
    if (!(pf & 64))
    for (int m0 = 2 * gw; m0 < T; m0 += 2 * NGW) {
        f32x4 v[2][8]; float ss[2] = {0.f, 0.f};
#pragma unroll
        for (int q = 0; q < 2; ++q) { const GAS f32x4* xr = (const GAS f32x4*)(x + (size_t)(m0 + q) * D) + lane;
#pragma unroll
            for (int j = 0; j < 8; ++j) v[q][j] = xr[64 * j]; }
#pragma unroll
        for (int q = 0; q < 2; ++q) { const int m = m0 + q;
#pragma unroll
            for (int j = 0; j < 8; ++j) ss[q] += (v[q][j].x * v[q][j].x + v[q][j].y * v[q][j].y) + (v[q][j].z * v[q][j].z + v[q][j].w * v[q][j].w);
            ss[q] = wave_sum(ss[q]); const float rstd = 1.0f / sqrtf(ss[q] * (1.0f / D) + EPS);
            GAS u32x2* o8 = (GAS u32x2*)(xb + (size_t)m * D) + lane; GAS unsigned* o4 = (GAS unsigned*)(x8 + (size_t)m * D) + lane;
#pragma unroll
            for (int j = 0; j < 8; ++j) { u32x2 w; w.x = pk2(v[q][j].x, v[q][j].y); w.y = pk2(v[q][j].z, v[q][j].w); o8[64 * j] = w;
                o4[64 * j] = pk4_f8(v[q][j].x * F8_SX, v[q][j].y * F8_SX, v[q][j].z * F8_SX, v[q][j].w * F8_SX); }
            float ga[8];
#pragma unroll
            for (int c = 0; c < 8; ++c) { float a = 0.f;
#pragma unroll
                for (int j = 0; j < 8; ++j) { const f32x4 w = *(const LAS f32x4*)(wgT + c * 2048 + 4 * (lane + 64 * j)); a += (v[q][j].x * w.x + v[q][j].y * w.y) + (v[q][j].z * w.z + v[q][j].w * w.w); }
                ga[c] = wave_sum(a); asm volatile("" ::: "memory"); }
            float val = ga[0];
#pragma unroll
            for (int c = 1; c < 8; ++c) val = (lane == c) ? ga[c] : val;
            if (lane < 8) gates[(size_t)m * 8 + lane] = val * rstd + bias;
            if (lane == 0) rstd_o[m] = rstd; }
    }
    __syncthreads();
}

__device__ __forceinline__ unsigned ld_agent_u32(const unsigned* p) { return __hip_atomic_load(p, RLX_AGENT); }
__device__ __forceinline__ float ld_agent_f32(const float* p) { return __builtin_bit_cast(float, __hip_atomic_load((const unsigned*)p, RLX_AGENT)); }
using pg8::Unit;

struct DenseSched {
    pg8::TileOrder to; const char* A; size_t tstepA; const char* B0; const char* B1; size_t tstepB; int cpt;
    __device__ __forceinline__ bool next(int i, Unit& u) const { int pm, pn; if (!to.next(i, pm, pn)) return false;
        u.a = A + (size_t)pm * tstepA; u.b0 = B0 + (size_t)pn * tstepB; u.b1 = B1 + (size_t)pn * tstepB; u.b0x = u.b0; u.b1x = u.b1; u.r0 = pm * 256; u.c0 = pn * cpt; u.aux = 0; u.x = 0; return true; }
    __device__ __forceinline__ unsigned row_off(const Unit&, int) const { return 0u; }
    __device__ __forceinline__ void a_ready(const Unit&) const {}
};
struct S5Sched {
    int G, c; const char* A; const char* B; size_t gstepB; size_t hstepB;
    __device__ __forceinline__ bool next(int i, Unit& u) const { const int L = i * G + c; if (L >= 1024) return false; const int g = L >> 3, pm = L & 7;
        u.a = A + ((size_t)g * 2048 + (size_t)pm * 256) * 768; u.b0 = B + (size_t)g * gstepB; u.b1 = u.b0 + hstepB; u.b0x = u.b0; u.b1x = u.b1; u.r0 = pm * 256; u.c0 = 0; u.aux = g; u.x = 0; return true; }
    __device__ __forceinline__ unsigned row_off(const Unit&, int) const { return 0u; }
    __device__ __forceinline__ void a_ready(const Unit&) const {}
};
__device__ __forceinline__ void pair_experts(int q, int& ea, int& eb) { const int g = q / 6, p = q - 6 * g; const int ia = (p < 3) ? 0 : (p < 5) ? 1 : 2, ib = (p < 3) ? p + 1 : (p < 5) ? p - 1 : 3; ea = 4 * g + ia; eb = 4 * g + ib; }
template <bool DOWN> struct MoeSched {
    volatile LAS unsigned* misc; int G, c; const char* W0; const char* W1; const char* Hd; const int* ptok;
    __device__ __forceinline__ bool next(int i, Unit& u) const {
        const int L = i * G + c, ntiles = __builtin_amdgcn_readfirstlane((int)misc[MI_PRE + NPAIR]); if (L >= ntiles * 8) return false;
        int q = 0;
#pragma unroll
        for (int j = 1; j < NPAIR; ++j) q += ((L >> 3) >= __builtin_amdgcn_readfirstlane((int)misc[MI_PRE + j])) ? 1 : 0;
        const int pq = __builtin_amdgcn_readfirstlane((int)misc[MI_PRE + q]), tq = __builtin_amdgcn_readfirstlane((int)misc[MI_PRE + q + 1]) - pq, loc = L - 8 * pq;
        const int ct = loc / tq, gr = pq + (loc - ct * tq);
        int ea, eb; pair_experts(q, ea, eb);
        u.aux = q; u.r0 = gr * 256; u.x = (gr - pq) * 256;
        if (!DOWN) { const int e = (ct < 4) ? ea : eb; u.c0 = ct * 128; u.a = nullptr;
            u.b0 = W0 + (size_t)e * 512 * 2048 + (size_t)(ct & 3) * 128 * 2048; u.b1 = W1 + (size_t)e * 512 * 2048 + (size_t)(ct & 3) * 128 * 2048; u.b0x = u.b0; u.b1x = u.b1; }
        else { u.c0 = ct * 256; u.a = Hd + (size_t)gr * 256 * 1024;
            u.b0 = W0 + (size_t)ea * 2048 * 512 + (size_t)ct * 256 * 512; u.b1 = u.b0 + (size_t)128 * 512; u.b0x = W0 + (size_t)eb * 2048 * 512 + (size_t)ct * 256 * 512; u.b1x = u.b0x + (size_t)128 * 512; }
        return true; }
    __device__ __forceinline__ unsigned row_off(const Unit& u, int row) const { const int cnt = __builtin_amdgcn_readfirstlane((int)misc[MI_CNT + u.aux]); int idx = u.x + row; idx = idx < cnt ? idx : cnt - 1;
        return (unsigned)ptok[(size_t)u.aux * T + idx] * 2048u; }
};

struct EpiScaleBf16 {
    static constexpr bool PERM = true;
    bf16* O; int ldc; const float* scale; int pf; float k;
    __device__ __forceinline__ void operator()(const f32x4 (&acc)[2][2][4][2], const Unit& u, int wr, int wc, int fr, int fq) const {
        const int row0 = u.r0 + wr * 64 + fr, col0 = u.c0 + wc * 32 + 8 * fq;
        float sv[2][4];
#pragma unroll
        for (int ai = 0; ai < 2; ++ai)
#pragma unroll
            for (int m = 0; m < 4; ++m) sv[ai][m] = scale[row0 + ai * 128 + m * 16];
#pragma unroll
        for (int ai = 0; ai < 2; ++ai)
#pragma unroll
            for (int m = 0; m < 4; ++m) { int zz = 0; asm volatile("" : "+v"(zz)); const int row = row0 + ai * 128 + m * 16 + zz; const float s = sv[ai][m] * k; bf16* rowp = O + (size_t)row * ldc + col0;
#pragma unroll
                for (int bj = 0; bj < 2; ++bj) { const f32x4 v0 = acc[ai][bj][m][0] * s, v1 = acc[ai][bj][m][1] * s;
                    u32x4 w; w.x = pk2(v0[0], v0[1]); w.y = pk2(v0[2], v0[3]); w.z = pk2(v1[0], v1[1]); w.w = pk2(v1[2], v1[3]);
                    if (!(pf & 16)) *(u32x4*)(rowp + bj * 128) = w; else asm volatile("" :: "v"(w.x), "v"(w.y), "v"(w.z), "v"(w.w)); } }
    }
};
struct EpiS5U {
    static constexpr bool PERM = true;
    bf16* A2; const float* scale; float k;
    __device__ __forceinline__ void operator()(const f32x4 (&acc)[2][2][4][2], const Unit& u, int wr, int wc, int fr, int fq) const {
        const int row0 = u.r0 + wr * 64 + fr, col0 = u.c0 + wc * 32 + 8 * fq;
        float sv[2][4];
#pragma unroll
        for (int ai = 0; ai < 2; ++ai)
#pragma unroll
            for (int m = 0; m < 4; ++m) sv[ai][m] = scale[row0 + ai * 128 + m * 16];
#pragma unroll
        for (int ai = 0; ai < 2; ++ai)
#pragma unroll
            for (int m = 0; m < 4; ++m) { int zz = 0; asm volatile("" : "+v"(zz)); const int t = row0 + ai * 128 + m * 16 + zz; const float s = sv[ai][m] * k; const int n = t >> 4, tl = t & 15;
#pragma unroll
                for (int bj = 0; bj < 2; ++bj) { const int c = col0 + bj * 128, g = c >> 4, half = (c >> 3) & 1; const f32x4 v0 = acc[ai][bj][m][0] * s, v1 = acc[ai][bj][m][1] * s;
                    u32x4 w; w.x = pk2(v0[0], v0[1]); w.y = pk2(v0[2], v0[3]); w.z = pk2(v1[0], v1[1]); w.w = pk2(v1[2], v1[3]);
                    *(u32x4*)(A2 + ((size_t)g * 2048 + n) * 256 + tl * 16 + half * 8) = w; } }
    }
};
struct EpiOutRes {
    static constexpr bool PERM = true;
    bf16* xb; unsigned char* x8;
    __device__ __forceinline__ void operator()(const f32x4 (&acc)[2][2][4][2], const Unit& u, int wr, int wc, int fr, int fq) const {
        const int row0 = u.r0 + wr * 64 + fr, col0 = u.c0 + wc * 32 + 8 * fq;
        u32x4 xr[2][4][2];
#pragma unroll
        for (int ai = 0; ai < 2; ++ai)
#pragma unroll
            for (int m = 0; m < 4; ++m)
#pragma unroll
                for (int bj = 0; bj < 2; ++bj) xr[ai][m][bj] = *(const u32x4*)(xb + (size_t)(row0 + ai * 128 + m * 16) * D + col0 + bj * 128);
#pragma unroll
        for (int ai = 0; ai < 2; ++ai)
#pragma unroll
            for (int m = 0; m < 4; ++m) { int zz = 0; asm volatile("" : "+v"(zz)); const size_t off = (size_t)(row0 + ai * 128 + m * 16 + zz) * D + col0;
#pragma unroll
                for (int bj = 0; bj < 2; ++bj) { const f32x4 a0 = acc[ai][bj][m][0], a1 = acc[ai][bj][m][1]; const u32x4 x = xr[ai][m][bj];
                    const float v0 = bf_lo(x.x) + a0[0], v1 = bf_hi(x.x) + a0[1], v2 = bf_lo(x.y) + a0[2], v3 = bf_hi(x.y) + a0[3], v4 = bf_lo(x.z) + a1[0], v5 = bf_hi(x.z) + a1[1], v6 = bf_lo(x.w) + a1[2], v7 = bf_hi(x.w) + a1[3];
                    u32x4 w; w.x = pk2(v0, v1); w.y = pk2(v2, v3); w.z = pk2(v4, v5); w.w = pk2(v6, v7);
                    *(u32x4*)(xb + off + bj * 128) = w;
                    u32x2 o; o.x = pk4_f8(v0 * F8_SX, v1 * F8_SX, v2 * F8_SX, v3 * F8_SX); o.y = pk4_f8(v4 * F8_SX, v5 * F8_SX, v6 * F8_SX, v7 * F8_SX);
                    *(u32x2*)(x8 + off + bj * 128) = o; } }
    }
};
struct EpiGlu {
    static constexpr bool PERM = true;
    bf16* xb; unsigned char* x8;
    __device__ __forceinline__ void operator()(const f32x4 (&acc)[2][2][4][2], const Unit& u, int wr, int wc, int fr, int fq) const {
        const int row0 = u.r0 + wr * 64 + fr, col0 = u.c0 + wc * 32 + 8 * fq;
        u32x4 xr[2][4];
#pragma unroll
        for (int ai = 0; ai < 2; ++ai)
#pragma unroll
            for (int m = 0; m < 4; ++m) xr[ai][m] = *(const u32x4*)(xb + (size_t)(row0 + ai * 128 + m * 16) * D + col0);
#pragma unroll
        for (int ai = 0; ai < 2; ++ai)
#pragma unroll
            for (int m = 0; m < 4; ++m) { int zz = 0; asm volatile("" : "+v"(zz)); const size_t off = (size_t)(row0 + ai * 128 + m * 16 + zz) * D + col0;
                constexpr float kk = 1.0f / (F8_SY * F8_SW);
                const f32x4 a0 = acc[ai][0][m][0] * kk, a1 = acc[ai][0][m][1] * kk, g0 = acc[ai][1][m][0] * kk, g1 = acc[ai][1][m][1] * kk; const u32x4 x = xr[ai][m];
                const float v0 = bf_lo(x.x) + a0[0] * sigmoidf_(g0[0]), v1 = bf_hi(x.x) + a0[1] * sigmoidf_(g0[1]), v2 = bf_lo(x.y) + a0[2] * sigmoidf_(g0[2]), v3 = bf_hi(x.y) + a0[3] * sigmoidf_(g0[3]);
                const float v4 = bf_lo(x.z) + a1[0] * sigmoidf_(g1[0]), v5 = bf_hi(x.z) + a1[1] * sigmoidf_(g1[1]), v6 = bf_lo(x.w) + a1[2] * sigmoidf_(g1[2]), v7 = bf_hi(x.w) + a1[3] * sigmoidf_(g1[3]);
                u32x4 w; w.x = pk2(v0, v1); w.y = pk2(v2, v3); w.z = pk2(v4, v5); w.w = pk2(v6, v7);
                *(u32x4*)(xb + off) = w;
                u32x2 o; o.x = pk4_f8(v0 * F8_SX, v1 * F8_SX, v2 * F8_SX, v3 * F8_SX); o.y = pk4_f8(v4 * F8_SX, v5 * F8_SX, v6 * F8_SX, v7 * F8_SX);
                *(u32x2*)(x8 + off) = o; }
    }
};
struct EpiGateUp {
    static constexpr bool PERM = true;
    unsigned char* H; const float* prstd; const float* pga; const float* pgb; volatile LAS unsigned* misc; int pf;
    __device__ __forceinline__ void operator()(const f32x4 (&acc)[2][2][4][2], const Unit& u, int wr, int wc, int fr, int fq) const {
        if (pf & 16) { asm volatile("" :: "v"(acc[0][0][0][0][0]), "v"(acc[1][1][3][1][3])); return; }
        const int rl0 = wr * 64 + fr, col0 = u.c0 + wc * 32 + 8 * fq, cnt = __builtin_amdgcn_readfirstlane((int)misc[MI_CNT + u.aux]);
        const float* pg = (u.c0 < 512) ? pga : pgb;
        float sv[2][4], gv[2][4];
#pragma unroll
        for (int ai = 0; ai < 2; ++ai)
#pragma unroll
            for (int m = 0; m < 4; ++m) { int idx = u.x + rl0 + ai * 128 + m * 16; idx = idx < cnt ? idx : cnt - 1; sv[ai][m] = prstd[(size_t)u.aux * T + idx]; gv[ai][m] = pg[(size_t)u.aux * T + idx]; }
#pragma unroll
        for (int ai = 0; ai < 2; ++ai)
#pragma unroll
            for (int m = 0; m < 4; ++m) { int zz = 0; asm volatile("" : "+v"(zz)); const int rl = rl0 + ai * 128 + m * 16 + zz; const float r = sv[ai][m] * (1.0f / (F8_SX * F8_SW)), gt = gv[ai][m] * r * F8_SH;
                float hv[8];
#pragma unroll
                for (int n = 0; n < 2; ++n)
#pragma unroll
                    for (int j = 0; j < 4; ++j) hv[n * 4 + j] = siluf_(acc[ai][0][m][n][j] * r) * (acc[ai][1][m][n][j] * gt);
                u32x2 w; w.x = pk4_f8(hv[0], hv[1], hv[2], hv[3]); w.y = pk4_f8(hv[4], hv[5], hv[6], hv[7]);
                *(u32x2*)(H + (size_t)(u.r0 + rl) * 1024 + col0) = w; }
    }
};
struct EpiDownRes {
    static constexpr bool PERM = true;
    bf16* xb; const int* ptok; volatile LAS unsigned* misc; bf16* dst; unsigned char* x8;
    __device__ __forceinline__ void operator()(const f32x4 (&acc)[2][2][4][2], const Unit& u, int wr, int wc, int fr, int fq) const {
        const int rl0 = wr * 64 + fr, col0 = u.c0 + wc * 32 + 8 * fq, cnt = __builtin_amdgcn_readfirstlane((int)misc[MI_CNT + u.aux]);
        int tk[2][4];
#pragma unroll
        for (int ai = 0; ai < 2; ++ai)
#pragma unroll
            for (int m = 0; m < 4; ++m) { const int idx = u.x + rl0 + ai * 128 + m * 16; tk[ai][m] = (idx < cnt) ? ptok[(size_t)u.aux * T + idx] : -1; }
        u32x4 xr[2][4][2];
#pragma unroll
        for (int ai = 0; ai < 2; ++ai)
#pragma unroll
            for (int m = 0; m < 4; ++m)
#pragma unroll
                for (int bj = 0; bj < 2; ++bj) xr[ai][m][bj] = (tk[ai][m] >= 0) ? *(const u32x4*)(xb + (size_t)tk[ai][m] * D + col0 + bj * 128) : (u32x4){0u, 0u, 0u, 0u};
#pragma unroll
        for (int ai = 0; ai < 2; ++ai)
#pragma unroll
            for (int m = 0; m < 4; ++m) { int zz = 0; asm volatile("" : "+v"(zz)); const int tok = tk[ai][m] + zz;
                if (tok >= 0) {
#pragma unroll
                    for (int bj = 0; bj < 2; ++bj) { constexpr float kk = 1.0f / (F8_SH * F8_SWD); const f32x4 a0 = acc[ai][bj][m][0] * kk, a1 = acc[ai][bj][m][1] * kk; const u32x4 x = xr[ai][m][bj];
                        const float v0 = bf_lo(x.x) + a0[0], v1 = bf_hi(x.x) + a0[1], v2 = bf_lo(x.y) + a0[2], v3 = bf_hi(x.y) + a0[3], v4 = bf_lo(x.z) + a1[0], v5 = bf_hi(x.z) + a1[1], v6 = bf_lo(x.w) + a1[2], v7 = bf_hi(x.w) + a1[3];
                        u32x4 w; w.x = pk2(v0, v1); w.y = pk2(v2, v3); w.z = pk2(v4, v5); w.w = pk2(v6, v7);
                        *(u32x4*)(dst + (size_t)tok * D + col0 + bj * 128) = w;
                        if (x8) { u32x2 o; o.x = pk4_f8(v0 * F8_SX, v1 * F8_SX, v2 * F8_SX, v3 * F8_SX); o.y = pk4_f8(v4 * F8_SX, v5 * F8_SX, v6 * F8_SX, v7 * F8_SX);
                            *(u32x2*)(x8 + (size_t)tok * D + col0 + bj * 128) = o; } } } }
    }
};
struct EpiXin {
    static constexpr bool PERM = false;
    float* X;
    __device__ __forceinline__ void operator()(const f32x4 (&acc)[2][2][4][2], const Unit& u, int wr, int wc, int fr, int fq) const {
        const int rl0 = u.r0 + wr * 64 + fr, col0 = wc * 32 + 4 * fq;
#pragma unroll
        for (int ai = 0; ai < 2; ++ai)
#pragma unroll
            for (int m = 0; m < 4; ++m) { int zz = 0; asm volatile("" : "+v"(zz)); float* rowp = X + ((size_t)u.aux * 2048 + rl0 + ai * 128 + m * 16 + zz) * 128 + col0;
#pragma unroll
                for (int n = 0; n < 2; ++n) *(f32x4*)(rowp + n * 16) = acc[ai][0][m][n]; }
    }
};
struct EpiS5Y {
    static constexpr bool PERM = true;
    bf16* Y2;
    __device__ __forceinline__ void operator()(const f32x4 (&acc)[2][2][4][2], const Unit& u, int wr, int wc, int fr, int fq) const {
        const int rl0 = u.r0 + wr * 64 + fr, col0 = wc * 32 + 8 * fq;
#pragma unroll
        for (int ai = 0; ai < 2; ++ai)
#pragma unroll
            for (int m = 0; m < 4; ++m) { int zz = 0; asm volatile("" : "+v"(zz)); const int n = rl0 + ai * 128 + m * 16 + zz;
#pragma unroll
                for (int bj = 0; bj < 2; ++bj) { const int c = col0 + bj * 128, tl = c >> 4, half = (c >> 3) & 1; const f32x4 a0 = acc[ai][bj][m][0], a1 = acc[ai][bj][m][1];
                    u32x4 w; w.x = pk2(gelu_tanh(a0[0]), gelu_tanh(a0[1])); w.y = pk2(gelu_tanh(a0[2]), gelu_tanh(a0[3])); w.z = pk2(gelu_tanh(a1[0]), gelu_tanh(a1[1])); w.w = pk2(gelu_tanh(a1[2]), gelu_tanh(a1[3]));
                    const int tok = n * 16 + tl;
                    *(u32x4*)(Y2 + ((((size_t)(tok >> 8) * 128 + u.aux) * 256) + (tok & 255)) * 16 + half * 8) = w; } }
    }
};

constexpr int ML_QP = 528, ML_KTP = 144;
constexpr int ML_Q = 0, ML_K = 33792, ML_KT = 67584, ML_C = 104448, ML_SC = 138240;
constexpr int ML_P = ML_K, ML_VT = ML_K + 9216, ML_VWT = ML_Q;
constexpr int ML_CW = 141824;
__device__ __forceinline__ unsigned bf_elem(const u32x4& v, int i) { const unsigned w = v[i >> 1]; return (i & 1) ? (w >> 16) : (w & 0xffffu); }
__device__ __forceinline__ void mlstm_unit(Frame& F, int b, int hh, int s, int pf) {
    LAS unsigned char* L = F.lds; LAS float* sc = (LAS float*)(L + ML_SC);
    const int tid = F.tid, lane = F.lane, w = F.wave, l15 = lane & 15, lq = lane >> 4;
    const bf16* P = (const bf16*)(F.ws + WS_P); bf16* Y = (bf16*)(F.ws + ((pf & 8) ? WS_XB : WS_Y)); const float* gates = (const float*)(F.ws + WS_GATES); float* sumsq = (float*)(F.ws + ((pf & 8) ? 950 * MiB : WS_SUMSQ));
    const int isk = lane >> 5, e0 = 8 * (lane & 31), cch = (isk ? 1024 : 0) + hh * 256 + e0;
    const float osc = isk ? 0.0625f : 1.0f;
    {
        const float* cwp = F.in(12) + cch; const float* cbp = F.in(13) + cch;
        if (w == 0) {
#pragma unroll
            for (int ih = 0; ih < 2; ++ih) {
#pragma unroll
                for (int j = 0; j < 4; ++j) *(LAS f32x4*)(L + ML_CW + ((ih * 5 + j) * 64 + lane) * 16) = *(const GAS f32x4*)(cwp + j * 2048 + 4 * ih);
                *(LAS f32x4*)(L + ML_CW + ((ih * 5 + 4) * 64 + lane) * 16) = *(const GAS f32x4*)(cbp + 4 * ih); }
        }
    }
    f32x4 cacc[2][4];
#pragma unroll
    for (int q = 0; q < 2; ++q)
#pragma unroll
        for (int dc = 0; dc < 4; ++dc) cacc[q][dc] = (f32x4){0.f, 0.f, 0.f, 0.f};
    for (int idx = tid; idx < 33792 / 16; idx += NT) ((LAS u32x4*)(L + ML_C))[idx] = (u32x4){0u, 0u, 0u, 0u};
    if (tid < 256) sc[512 + tid] = 0.f;
    float m_st = 0.f;
    const int tr = w >> 1, cb2 = 2 * (w & 1);
    const int vj = tid >> 3, vdg = tid & 7;
    u32x4 raw[11];
#pragma unroll
    for (int r = 0; r < 11; ++r) { const int t = 8 * w - 3 + r;
        raw[r] = (t >= 0) ? *(const GAS u32x4*)(P + ((size_t)b * SEQ + t) * PN + 2048 + cch) : (u32x4){0u, 0u, 0u, 0u}; }
    float ipn = 0.f, fpn = 0.f;
    if (w == 0) { ipn = gates[((size_t)b * SEQ + lane) * 8 + hh]; fpn = gates[((size_t)b * SEQ + lane) * 8 + 4 + hh]; }
    __syncthreads();
    for (int ch = 0; ch < 32; ++ch) {
        const int t0 = ch * 64; const size_t row0 = (size_t)b * SEQ + t0;
        const u32x4 vraw = *(const GAS u32x4*)(P + (row0 + vj) * PN + 4096 + hh * 256 + s * 64 + 8 * vdg);
        bf16 ov[4][2];
#pragma unroll
        for (int r = 0; r < 4; ++r) { const size_t prow = (row0 + 16 * tr + 4 * lq + r) * PN + 5120 + hh * 256 + s * 64 + 16 * cb2 + l15; ov[r][0] = P[prow]; ov[r][1] = P[prow + 16]; }
        if (!(pf & 16)) {
            asm volatile("" ::: "memory");
#pragma unroll
            for (int ih = 0; ih < 2; ++ih) {
                const f32x4 cb4 = *(const LAS f32x4*)(L + ML_CW + ((ih * 5 + 4) * 64 + lane) * 16);
                f32x4 cw4[4];
#pragma unroll
                for (int j = 0; j < 4; ++j) cw4[j] = *(const LAS f32x4*)(L + ML_CW + ((ih * 5 + j) * 64 + lane) * 16);
                u32x2 outp[8];
                float xw[3][4];
#pragma unroll
                for (int r = 0; r < 3; ++r) { xw[r][0] = bf_lo(raw[r][2 * ih]); xw[r][1] = bf_hi(raw[r][2 * ih]); xw[r][2] = bf_lo(raw[r][2 * ih + 1]); xw[r][3] = bf_hi(raw[r][2 * ih + 1]); }
#pragma unroll
                for (int r = 0; r < 8; ++r) { float o[4], xc[4];
                    xc[0] = bf_lo(raw[r + 3][2 * ih]); xc[1] = bf_hi(raw[r + 3][2 * ih]); xc[2] = bf_lo(raw[r + 3][2 * ih + 1]); xc[3] = bf_hi(raw[r + 3][2 * ih + 1]);
#pragma unroll
                    for (int i4 = 0; i4 < 4; ++i4) { const float cv = cb4[i4] + cw4[0][i4] * xw[0][i4] + cw4[1][i4] * xw[1][i4] + cw4[2][i4] * xw[2][i4] + cw4[3][i4] * xc[i4]; o[i4] = siluf_(cv) * osc;
                        xw[0][i4] = xw[1][i4]; xw[1][i4] = xw[2][i4]; xw[2][i4] = xc[i4]; }
                    outp[r].x = pk2(o[0], o[1]); outp[r].y = pk2(o[2], o[3]);
                    *(LAS u32x2*)(L + (isk ? ML_K : ML_Q) + (8 * w + r) * ML_QP + (e0 + 4 * ih) * 2) = outp[r]; }
                if (isk) {
#pragma unroll
                    for (int i4 = 0; i4 < 4; ++i4) { u32x4 v;
#define ML_EL(r) ((i4 & 1) ? (outp[r][i4 >> 1] >> 16) : (outp[r][i4 >> 1] & 0xffffu))
                        v.x = ML_EL(0) | (ML_EL(1) << 16); v.y = ML_EL(2) | (ML_EL(3) << 16); v.z = ML_EL(4) | (ML_EL(5) << 16); v.w = ML_EL(6) | (ML_EL(7) << 16);
#undef ML_EL
                        *(LAS u32x4*)(L + ML_KT + (e0 + 4 * ih + i4) * ML_KTP + (8 * w) * 2) = v; }
                }
            }
        }
        asm volatile("" ::: "memory");
        if (ch + 1 < 32) {
#pragma unroll
            for (int r = 0; r < 11; ++r) raw[r] = *(const GAS u32x4*)(P + (row0 + 64 + 8 * w - 3 + r) * PN + 2048 + cch);
        }
        if (w == 0) {
            const float ip = ipn, fp = fpn;
            if (ch + 1 < 32) { ipn = gates[(row0 + 64 + lane) * 8 + hh]; fpn = gates[(row0 + 64 + lane) * 8 + 4 + hh]; }
            const float lf = fminf(fp, 0.f) - __logf(1.0f + __expf(-fabsf(fp)));
            float bc = lf;
#pragma unroll
            for (int o = 1; o < 64; o <<= 1) { const float t = __shfl_up(bc, o); if (lane >= o) bc += t; }
            const float a = ip - bc; float pm = a;
#pragma unroll
            for (int o = 1; o < 64; o <<= 1) { const float t = __shfl_up(pm, o); if (lane >= o) pm = fmaxf(pm, t); }
            const float M = fmaxf(m_st, pm);
            const float M63 = __shfl(M, 63), b63 = __shfl(bc, 63);
            sc[lane] = a; sc[64 + lane] = M; sc[128 + lane] = __expf(m_st - M); sc[192 + lane] = __expf(-(bc + M)); sc[256 + lane] = __expf(a - M63);
            if (lane == 0) sc[768] = __expf(m_st - M63);
            m_st = b63 + M63;
        }
        __syncthreads();
        float pw[2][4] = {{0.f, 0.f, 0.f, 0.f}, {0.f, 0.f, 0.f, 0.f}};
        if (!(pf & 32)) {
            f32x4 s0 = (f32x4){0.f, 0.f, 0.f, 0.f}, s1 = s0;
#pragma unroll
            for (int kk = 0; kk < 8; ++kk) {
                const bf16x8 a = *(const LAS bf16x8*)(L + ML_Q + (16 * tr + l15) * ML_QP + (32 * kk + 8 * lq) * 2);
                const bf16x8 k0 = *(const LAS bf16x8*)(L + ML_K + (16 * cb2 + l15) * ML_QP + (32 * kk + 8 * lq) * 2);
                const bf16x8 k1 = *(const LAS bf16x8*)(L + ML_K + (16 * (cb2 + 1) + l15) * ML_QP + (32 * kk + 8 * lq) * 2);
                s0 = __builtin_amdgcn_mfma_f32_16x16x32_bf16(a, k0, s0, 0, 0, 0); s1 = __builtin_amdgcn_mfma_f32_16x16x32_bf16(a, k1, s1, 0, 0, 0); }
            const int j0 = 16 * cb2 + l15, j1 = j0 + 16; const float a0 = sc[j0], a1 = sc[j1];
#pragma unroll
            for (int r = 0; r < 4; ++r) { const int t = 16 * tr + 4 * lq + r; const float Mt = sc[64 + t];
                pw[0][r] = (j0 <= t) ? s0[r] * __expf(a0 - Mt) : 0.f; pw[1][r] = (j1 <= t) ? s1[r] * __expf(a1 - Mt) : 0.f; }
        }
        __syncthreads();
#pragma unroll
        for (int r = 0; r < 4; ++r) { const int t = 16 * tr + 4 * lq + r;
            *(LAS bf16*)(L + ML_P + t * ML_KTP + (16 * cb2 + l15) * 2) = (bf16)f2bf(pw[0][r]); *(LAS bf16*)(L + ML_P + t * ML_KTP + (16 * cb2 + 16 + l15) * 2) = (bf16)f2bf(pw[1][r]); }
#pragma unroll
        for (int i = 0; i < 8; ++i) *(LAS bf16*)(L + ML_VT + (8 * vdg + i) * ML_KTP + vj * 2) = (bf16)bf_elem(vraw, i);
        __syncthreads();
        {
            const int t = tid >> 3, part = tid & 7;
            const u32x4 pv = *(const LAS u32x4*)(L + ML_P + t * ML_KTP + part * 16);
            float ds = (bf_lo(pv.x) + bf_hi(pv.x)) + (bf_lo(pv.y) + bf_hi(pv.y)) + (bf_lo(pv.z) + bf_hi(pv.z)) + (bf_lo(pv.w) + bf_hi(pv.w));
            float qn = 0.f;
#pragma unroll
            for (int q4 = 0; q4 < 4; ++q4) { const u32x4 qv = *(const LAS u32x4*)(L + ML_Q + t * ML_QP + part * 64 + q4 * 16);
                const f32x4 n0 = *(const LAS f32x4*)(sc + 512 + part * 32 + q4 * 8), n1 = *(const LAS f32x4*)(sc + 512 + part * 32 + q4 * 8 + 4);
                qn += bf_lo(qv.x) * n0[0] + bf_hi(qv.x) * n0[1] + bf_lo(qv.y) * n0[2] + bf_hi(qv.y) * n0[3] + bf_lo(qv.z) * n1[0] + bf_hi(qv.z) * n1[1] + bf_lo(qv.w) * n1[2] + bf_hi(qv.w) * n1[3]; }
#pragma unroll
            for (int o = 1; o < 8; o <<= 1) { ds += __shfl_xor(ds, o); qn += __shfl_xor(qn, o); }
            if (part == 0) sc[320 + t] = ds + sc[128 + t] * qn;
        }
        f32x4 pv0 = (f32x4){0.f, 0.f, 0.f, 0.f}, pv1 = pv0, qc0 = pv0, qc1 = pv0;
        if (!(pf & 64)) {
#pragma unroll
        for (int kk = 0; kk < 2; ++kk) {
            const bf16x8 a = *(const LAS bf16x8*)(L + ML_P + (16 * tr + l15) * ML_KTP + (32 * kk + 8 * lq) * 2);
            const bf16x8 v0 = *(const LAS bf16x8*)(L + ML_VT + (16 * cb2 + l15) * ML_KTP + (32 * kk + 8 * lq) * 2);
            const bf16x8 v1 = *(const LAS bf16x8*)(L + ML_VT + (16 * (cb2 + 1) + l15) * ML_KTP + (32 * kk + 8 * lq) * 2);
            pv0 = __builtin_amdgcn_mfma_f32_16x16x32_bf16(a, v0, pv0, 0, 0, 0); pv1 = __builtin_amdgcn_mfma_f32_16x16x32_bf16(a, v1, pv1, 0, 0, 0); }
#pragma unroll
        for (int kk = 0; kk < 8; ++kk) {
            const bf16x8 a = *(const LAS bf16x8*)(L + ML_Q + (16 * tr + l15) * ML_QP + (32 * kk + 8 * lq) * 2);
            const bf16x8 c0 = *(const LAS bf16x8*)(L + ML_C + (16 * cb2 + l15) * ML_QP + (32 * kk + 8 * lq) * 2);
            const bf16x8 c1 = *(const LAS bf16x8*)(L + ML_C + (16 * (cb2 + 1) + l15) * ML_QP + (32 * kk + 8 * lq) * 2);
            qc0 = __builtin_amdgcn_mfma_f32_16x16x32_bf16(a, c0, qc0, 0, 0, 0); qc1 = __builtin_amdgcn_mfma_f32_16x16x32_bf16(a, c1, qc1, 0, 0, 0); }
        }
        __syncthreads();
        if (!(pf & 64)) {
#pragma unroll
            for (int r = 0; r < 4; ++r) { const int t = 16 * tr + 4 * lq + r; const float wi = sc[128 + t], dn = fmaxf(fabsf(sc[320 + t]), sc[192 + t]); const float inv = __builtin_amdgcn_rcpf(dn);
                const size_t yrow = (row0 + t) * D + 1024 + hh * 256 + s * 64;
                const int d0 = 16 * cb2 + l15, d1 = d0 + 16;
                const float h0 = (pv0[r] + wi * qc0[r]) * inv * sigmoidf_(bf2f(ov[r][0])), h1 = (pv1[r] + wi * qc1[r]) * inv * sigmoidf_(bf2f(ov[r][1]));
                Y[yrow + d0] = (bf16)f2bf(h0); Y[yrow + d1] = (bf16)f2bf(h1);
                float q = h0 * h0 + h1 * h1;
#pragma unroll
                for (int o = 1; o < 16; o <<= 1) q += __shfl_xor(q, o);
                if (l15 == 0) sc[384 + (w & 1) * 64 + t] = q; }
        }
        const float decay = sc[768];
        {
            const float we = sc[256 + vj];
#pragma unroll
            for (int i = 0; i < 8; ++i) *(LAS bf16*)(L + ML_VWT + (8 * vdg + i) * ML_KTP + vj * 2) = (bf16)f2bf(__builtin_bit_cast(float, bf_elem(vraw, i) << 16) * we);
            if (tid < 256) { float a = 0.f;
#pragma unroll
                for (int j8 = 0; j8 < 8; ++j8) { const u32x4 kv = *(const LAS u32x4*)(L + ML_KT + tid * ML_KTP + j8 * 16); const f32x4 w0 = *(const LAS f32x4*)(sc + 256 + j8 * 8), w1 = *(const LAS f32x4*)(sc + 256 + j8 * 8 + 4);
                    a += bf_lo(kv.x) * w0[0] + bf_hi(kv.x) * w0[1] + bf_lo(kv.y) * w0[2] + bf_hi(kv.y) * w0[3] + bf_lo(kv.z) * w1[0] + bf_hi(kv.z) * w1[1] + bf_lo(kv.w) * w1[2] + bf_hi(kv.w) * w1[3]; }
                sc[512 + tid] = decay * sc[512 + tid] + a; }
#pragma unroll
            for (int q = 0; q < 2; ++q)
#pragma unroll
                for (int dc = 0; dc < 4; ++dc) cacc[q][dc] *= decay;
        }
        __syncthreads();
        if (tid < 64) sumsq[(row0 + tid) * 16 + hh * 4 + s] = sc[384 + tid] + sc[448 + tid];
        if (!(pf & 128)) {
#pragma unroll
        for (int kk = 0; kk < 2; ++kk) {
            bf16x8 aE[2], bD[4];
#pragma unroll
            for (int q = 0; q < 2; ++q) aE[q] = *(const LAS bf16x8*)(L + ML_KT + (16 * (2 * w + q) + l15) * ML_KTP + (32 * kk + 8 * lq) * 2);
#pragma unroll
            for (int dc = 0; dc < 4; ++dc) bD[dc] = *(const LAS bf16x8*)(L + ML_VWT + (16 * dc + l15) * ML_KTP + (32 * kk + 8 * lq) * 2);
#pragma unroll
            for (int q = 0; q < 2; ++q)
#pragma unroll
                for (int dc = 0; dc < 4; ++dc) cacc[q][dc] = __builtin_amdgcn_mfma_f32_16x16x32_bf16(aE[q], bD[dc], cacc[q][dc], 0, 0, 0); }
#pragma unroll
        for (int q = 0; q < 2; ++q)
#pragma unroll
            for (int dc = 0; dc < 4; ++dc) { u32x2 wv; wv.x = pk2(cacc[q][dc][0], cacc[q][dc][1]); wv.y = pk2(cacc[q][dc][2], cacc[q][dc][3]);
                *(LAS u32x2*)(L + ML_C + (16 * dc + l15) * ML_QP + (16 * (2 * w + q) + 4 * lq) * 2) = wv; }
        }
        __syncthreads();
    }
}

constexpr int LR_XP = 272, LR_TT = 128;
constexpr int LR_XC = 0, LR_W = 34816, LR_A = 69632, LR_G = 102912, LR_SEG = 136192, LR_CARRY = 140288, LR_CWT = 140544;
__device__ __forceinline__ void lru_unit(Frame& F, int b, int n, int jh) {
    LAS unsigned char* L = F.lds;
    LAS float* Aa = (LAS float*)(L + LR_A); LAS float* Ga = (LAS float*)(L + LR_G); LAS float* seg = (LAS float*)(L + LR_SEG); LAS float* carry = (LAS float*)(L + LR_CARRY);
    const int tid = F.tid, lane = F.lane, w = F.wave, l15 = lane & 15, lq = lane >> 4;
    const bf16* P = (const bf16*)(F.ws + WS_P); bf16* Y = (bf16*)(F.ws + WS_Y); const bf16* LW = (const bf16*)(F.ws + WS_LRUW) + (size_t)n * 256 * 128;
    for (int pc = tid; pc < 2048; pc += NT) { const int orow = pc >> 4, c16 = pc & 15; const int src = (orow < 64) ? (jh * 64 + orow) : (128 + jh * 64 + (orow - 64));
        *(LAS u32x4*)(L + LR_W + orow * LR_XP + c16 * 16) = *(const GAS u32x4*)(LW + (size_t)src * 128 + c16 * 8); }
    const int cgx = tid & 15, rgx = tid >> 4, cch = n * 128 + 8 * cgx;
    if (tid < 16) {
        const float* cwp_ = F.in(5) + cch; const float* cbp_ = F.in(6) + cch;
#pragma unroll
        for (int j = 0; j < 4; ++j) { *(LAS f32x4*)(L + LR_CWT + (cgx * 5 + j) * 32) = *(const GAS f32x4*)(cwp_ + j * 1024); *(LAS f32x4*)(L + LR_CWT + (cgx * 5 + j) * 32 + 16) = *(const GAS f32x4*)(cwp_ + j * 1024 + 4); }
        *(LAS f32x4*)(L + LR_CWT + (cgx * 5 + 4) * 32) = *(const GAS f32x4*)cbp_; *(LAS f32x4*)(L + LR_CWT + (cgx * 5 + 4) * 32 + 16) = *(const GAS f32x4*)(cbp_ + 4);
    }
    const int trb = 2 * (w >> 1), ocb = 2 * (w & 1);
    float ba[2], bx[2], sp[2];
    const float* pba_ = F.in(8); const float* pbx_ = F.in(10); const float* plam_ = F.in(11);
#pragma unroll
    for (int q = 0; q < 2; ++q) { const int chq = n * 128 + jh * 64 + 16 * (ocb + q) + l15; ba[q] = pba_[chq]; bx[q] = pbx_[chq]; const float nl = -plam_[chq]; sp[q] = fmaxf(nl, 0.f) + log1pf(expf(-fabsf(nl))); }
    const int ch_s = n * 128 + jh * 64 + lane;
    if (tid < 64) carry[tid] = 0.f;
    u32x4 raw[7];
#pragma unroll
    for (int r = 0; r < 7; ++r) { const int t = 4 * rgx - 3 + r; raw[r] = (t >= 0) ? *(const GAS u32x4*)(P + ((size_t)b * SEQ + t) * PN + cch) : (u32x4){0u, 0u, 0u, 0u}; }
    __syncthreads();
    for (int tile = 0; tile < SEQ / LR_TT; ++tile) {
        const int t0 = tile * LR_TT; const size_t row0 = (size_t)b * SEQ + t0;
        bf16 zv[16];
#pragma unroll
        for (int i = 0; i < 16; ++i) zv[i] = P[(row0 + 16 * w + i) * PN + 1024 + ch_s];
        {
            float cw[4][8], cb[8];
#pragma unroll
            for (int j = 0; j < 5; ++j) { const f32x4 c0 = *(const LAS f32x4*)(L + LR_CWT + (cgx * 5 + j) * 32), c1 = *(const LAS f32x4*)(L + LR_CWT + (cgx * 5 + j) * 32 + 16);
#pragma unroll
                for (int i = 0; i < 4; ++i) { if (j < 4) { cw[j < 4 ? j : 0][i] = c0[i]; cw[j < 4 ? j : 0][4 + i] = c1[i]; } else { cb[i] = c0[i]; cb[4 + i] = c1[i]; } } }
#pragma unroll
            for (int r = 0; r < 4; ++r) { float o[8];
#pragma unroll
                for (int i = 0; i < 8; ++i) { const int wd = i >> 1; float x0, x1, x2, x3;
                    if (i & 1) { x0 = bf_hi(raw[r][wd]); x1 = bf_hi(raw[r + 1][wd]); x2 = bf_hi(raw[r + 2][wd]); x3 = bf_hi(raw[r + 3][wd]); }
                    else { x0 = bf_lo(raw[r][wd]); x1 = bf_lo(raw[r + 1][wd]); x2 = bf_lo(raw[r + 2][wd]); x3 = bf_lo(raw[r + 3][wd]); }
                    o[i] = cb[i] + cw[0][i] * x0 + cw[1][i] * x1 + cw[2][i] * x2 + cw[3][i] * x3; }
                u32x4 ov; ov.x = pk2(o[0], o[1]); ov.y = pk2(o[2], o[3]); ov.z = pk2(o[4], o[5]); ov.w = pk2(o[6], o[7]);
                *(LAS u32x4*)(L + LR_XC + (4 * rgx + r) * LR_XP + cgx * 16) = ov; }
            asm volatile("" ::: "memory");
            if (tile + 1 < SEQ / LR_TT) {
#pragma unroll
                for (int r = 0; r < 7; ++r) raw[r] = *(const GAS u32x4*)(P + (row0 + LR_TT + 4 * rgx - 3 + r) * PN + cch);
            }
        }
        __syncthreads();
        {
            f32x4 ga[2][2], gx[2][2];
#pragma unroll
            for (int rt = 0; rt < 2; ++rt)
#pragma unroll
                for (int q = 0; q < 2; ++q) { ga[rt][q] = (f32x4){0.f, 0.f, 0.f, 0.f}; gx[rt][q] = ga[rt][q]; }
#pragma unroll
            for (int kk = 0; kk < 4; ++kk) { bf16x8 a[2], wa[2], wx[2];
#pragma unroll
                for (int rt = 0; rt < 2; ++rt) a[rt] = *(const LAS bf16x8*)(L + LR_XC + (16 * (trb + rt) + l15) * LR_XP + (32 * kk + 8 * lq) * 2);
#pragma unroll
                for (int q = 0; q < 2; ++q) { wa[q] = *(const LAS bf16x8*)(L + LR_W + (16 * (ocb + q) + l15) * LR_XP + (32 * kk + 8 * lq) * 2);
                    wx[q] = *(const LAS bf16x8*)(L + LR_W + (64 + 16 * (ocb + q) + l15) * LR_XP + (32 * kk + 8 * lq) * 2); }
#pragma unroll
                for (int rt = 0; rt < 2; ++rt)
#pragma unroll
                    for (int q = 0; q < 2; ++q) { ga[rt][q] = __builtin_amdgcn_mfma_f32_16x16x32_bf16(a[rt], wa[q], ga[rt][q], 0, 0, 0); gx[rt][q] = __builtin_amdgcn_mfma_f32_16x16x32_bf16(a[rt], wx[q], gx[rt][q], 0, 0, 0); } }
#pragma unroll
            for (int rt = 0; rt < 2; ++rt)
#pragma unroll
                for (int q = 0; q < 2; ++q)
#pragma unroll
                    for (int r = 0; r < 4; ++r) { const int t = 16 * (trb + rt) + 4 * lq + r, jo = 16 * (ocb + q) + l15;
                        const float rg = sigmoidf_(ga[rt][q][r] + ba[q]), ig = sigmoidf_(gx[rt][q][r] + bx[q]); const float la = -8.0f * rg * sp[q];
                        const float xf = bf2f(*(const LAS bf16*)(L + LR_XC + t * LR_XP + (jh * 64 + jo) * 2));
                        const float av = __expf(la); Aa[t * 65 + jo] = av; Ga[t * 65 + jo] = __builtin_amdgcn_sqrtf(fmaxf(1.0f - av * av, 0.f)) * (ig * xf); }
        }
        __syncthreads();
        {
            float Ap = 1.f, H = 0.f;
#pragma unroll
            for (int i = 0; i < 16; ++i) { const float a = Aa[(16 * w + i) * 65 + lane], g = Ga[(16 * w + i) * 65 + lane]; H = a * H + g; Ap *= a; }
            seg[(w * 64 + lane) * 2] = Ap; seg[(w * 64 + lane) * 2 + 1] = H;
        }
        __syncthreads();
        float h = carry[lane];
        for (int s2 = 0; s2 < w; ++s2) h = seg[(s2 * 64 + lane) * 2] * h + seg[(s2 * 64 + lane) * 2 + 1];
#pragma unroll
        for (int i = 0; i < 16; ++i) { const int t = 16 * w + i; h = Aa[t * 65 + lane] * h + Ga[t * 65 + lane]; Y[(row0 + t) * D + ch_s] = (bf16)f2bf(h * gelu_tanh(bf2f(zv[i]))); }
        __syncthreads();
        if (w == 7) carry[lane] = h;
    }
    __syncthreads();
}

__device__ __forceinline__ void hn_post(Frame& F, int grp) {
    asm volatile("s_waitcnt vmcnt(0)" ::: "memory");
    __syncthreads();
    if (F.tid == 0) { __builtin_amdgcn_fence(__ATOMIC_RELEASE, "agent"); (void)__hip_atomic_fetch_add((unsigned*)F.ctl + CW_HN + grp * 64, 1u, RLX_AGENT); }
}
__device__ __forceinline__ void hn_wait(Frame& F, int grp) {
    if (F.tid == 0) { unsigned* bar = (unsigned*)F.ctl + CW_BAR; unsigned* w = (unsigned*)F.ctl + CW_HN + grp * 64;
        XB_SPIN(xb_ld(w) < 4u, bar);
        __builtin_amdgcn_fence(__ATOMIC_ACQUIRE, "agent"); }
    __syncthreads();
}
__device__ __forceinline__ void headnorm_slice(Frame& F, int b, int hh, int s) {
    bf16* Y = (bf16*)(F.ws + WS_Y); const float* sumsq = (const float*)(F.ws + WS_SUMSQ); const float* hg = F.in(16) + hh * 256 + s * 64;
    const int c8 = F.tid & 7;
    const f32x4 g0 = *(const f32x4*)(hg + c8 * 8), g1 = *(const f32x4*)(hg + c8 * 8 + 4);
#pragma unroll 4
    for (int t = F.tid >> 3; t < SEQ; t += NT / 8) { const size_t row = (size_t)b * SEQ + t;
        const f32x4 ss = *(const f32x4*)(sumsq + row * 16 + hh * 4); const float rstd = 1.0f / sqrtf(((ss[0] + ss[1]) + (ss[2] + ss[3])) * (1.0f / 256.0f) + EPS);
        bf16* p = Y + row * D + 1024 + hh * 256 + s * 64 + c8 * 8; const u32x4 v = *(const u32x4*)p;
        u32x4 o; o.x = pk2(bf_lo(v.x) * rstd * g0[0], bf_hi(v.x) * rstd * g0[1]); o.y = pk2(bf_lo(v.y) * rstd * g0[2], bf_hi(v.y) * rstd * g0[3]);
        o.z = pk2(bf_lo(v.z) * rstd * g1[0], bf_hi(v.z) * rstd * g1[1]); o.w = pk2(bf_lo(v.w) * rstd * g1[2], bf_hi(v.w) * rstd * g1[3]);
        *(u32x4*)p = o; }
}
__device__ __forceinline__ void ph_headnorm(Frame& F) {
    bf16* Y = (bf16*)(F.ws + WS_Y); const float* sumsq = (const float*)(F.ws + WS_SUMSQ); const float* hg = F.in(16);
    const int gt = F.vcu * NT + F.tid, NGT = F.G * NT;
    for (int idx = gt; idx < T * 128; idx += NGT) { const int t = idx >> 7, c8 = idx & 127, hh = c8 >> 5;
        const f32x4 ss = *(const f32x4*)(sumsq + (size_t)t * 16 + hh * 4); const float rstd = 1.0f / sqrtf(((ss[0] + ss[1]) + (ss[2] + ss[3])) * (1.0f / 256.0f) + EPS);
        bf16* p = Y + (size_t)t * D + 1024 + c8 * 8; const u32x4 v = *(const u32x4*)p; const f32x4 g0 = *(const f32x4*)(hg + c8 * 8), g1 = *(const f32x4*)(hg + c8 * 8 + 4);
        u32x4 o; o.x = pk2(bf_lo(v.x) * rstd * g0[0], bf_hi(v.x) * rstd * g0[1]); o.y = pk2(bf_lo(v.y) * rstd * g0[2], bf_hi(v.y) * rstd * g0[3]);
        o.z = pk2(bf_lo(v.z) * rstd * g1[0], bf_hi(v.z) * rstd * g1[1]); o.w = pk2(bf_lo(v.w) * rstd * g1[2], bf_hi(v.w) * rstd * g1[3]);
        *(u32x4*)p = o; }
}

constexpr int RT_ROWS = 128;
__device__ __forceinline__ void ph_router(Frame& F, int l, bool dummy) {
    LAS float* lg = (LAS float*)(F.lds);
    LAS float* info = (LAS float*)(F.lds + 20480);
    LAS unsigned* lcnt = (LAS unsigned*)(F.lds + 28672);
    const int tid = F.tid, lane = F.lane, w = F.wave, l15 = lane & 15, lq = lane >> 4;
    const bf16* x1 = (const bf16*)(F.ws + WS_XB); const bf16* WH = (const bf16*)(F.ws + WS_RW) + (size_t)(l * 2) * 32 * 2048; const bf16* WL = WH + (size_t)32 * 2048;
    const float* bcs = F.in(30) + l * 4; const float* bfn = F.in(32) + l * 16;
    const size_t doff = dummy ? (size_t)200 * MiB : 0; const int cw = dummy ? 20480 : CW_CNT + l * 32 * 64;
    int* ptok = (int*)(F.ws + WS_PTOK + doff); float* prstd = (float*)(F.ws + WS_PRSTD + doff); float* pga = (float*)(F.ws + WS_PGA + doff); float* pgb = (float*)(F.ws + WS_PGB + doff);
    for (int base = F.vcu * RT_ROWS; base < T; base += F.G * RT_ROWS) {
        if (tid < 32) lcnt[tid] = 0u;
        {
            const bf16* xr = x1 + (size_t)(base + 16 * w + l15) * D + 8 * lq;
            const bf16* wh0 = WH + (size_t)l15 * 2048 + 8 * lq; const bf16* wh1 = WH + (size_t)(16 + l15) * 2048 + 8 * lq;
            const bf16* wl0 = WL + (size_t)l15 * 2048 + 8 * lq; const bf16* wl1 = WL + (size_t)(16 + l15) * 2048 + 8 * lq;
            f32x4 acc0 = (f32x4){0.f, 0.f, 0.f, 0.f}, acc1 = acc0; float ss = 0.f;
#pragma unroll 4
            for (int ks = 0; ks < 64; ++ks) {
                const bf16x8 a = *(const GAS bf16x8*)(xr + 32 * ks);
                const bf16x8 h0 = *(const GAS bf16x8*)(wh0 + 32 * ks), h1 = *(const GAS bf16x8*)(wh1 + 32 * ks), o0 = *(const GAS bf16x8*)(wl0 + 32 * ks), o1 = *(const GAS bf16x8*)(wl1 + 32 * ks);
                acc0 = __builtin_amdgcn_mfma_f32_16x16x32_bf16(a, h0, acc0, 0, 0, 0); acc1 = __builtin_amdgcn_mfma_f32_16x16x32_bf16(a, h1, acc1, 0, 0, 0);
                acc0 = __builtin_amdgcn_mfma_f32_16x16x32_bf16(a, o0, acc0, 0, 0, 0); acc1 = __builtin_amdgcn_mfma_f32_16x16x32_bf16(a, o1, acc1, 0, 0, 0);
                const u32x4 au = __builtin_bit_cast(u32x4, a);
                ss += (bf_lo(au.x) * bf_lo(au.x) + bf_hi(au.x) * bf_hi(au.x)) + (bf_lo(au.y) * bf_lo(au.y) + bf_hi(au.y) * bf_hi(au.y)) + (bf_lo(au.z) * bf_lo(au.z) + bf_hi(au.z) * bf_hi(au.z)) + (bf_lo(au.w) * bf_lo(au.w) + bf_hi(au.w) * bf_hi(au.w)); }
            ss += __shfl_xor(ss, 16); ss += __shfl_xor(ss, 32);
#pragma unroll
            for (int r = 0; r < 4; ++r) { lg[(16 * w + 4 * lq + r) * 33 + l15] = acc0[r]; lg[(16 * w + 4 * lq + r) * 33 + 16 + l15] = acc1[r]; }
            if (lq == 0) lg[(16 * w + l15) * 33 + 32] = ss;
        }
        __syncthreads();
        if (tid < RT_ROWS) {
            const LAS float* lr = lg + tid * 33;
            const float rstd = 1.0f / sqrtf(lr[32] * (1.0f / D) + EPS);
            float lc[4], lf[16];
#pragma unroll
            for (int c = 0; c < 4; ++c) lc[c] = lr[c] * rstd + bcs[c];
#pragma unroll
            for (int c = 0; c < 16; ++c) lf[c] = lr[4 + c] * rstd + bfn[c];
            int gi = 0; float gm = lc[0];
#pragma unroll
            for (int c = 1; c < 4; ++c) if (lc[c] > gm) { gm = lc[c]; gi = c; }
            float se = 0.f;
#pragma unroll
            for (int c = 0; c < 4; ++c) se += expf(lc[c] - gm);
            const float pg = 1.0f / se;
            float fs[4];
#pragma unroll
            for (int c = 0; c < 4; ++c) fs[c] = (gi == 0) ? lf[c] : (gi == 1) ? lf[4 + c] : (gi == 2) ? lf[8 + c] : lf[12 + c];
            int i0 = 0; float v0 = fs[0];
#pragma unroll
            for (int c = 1; c < 4; ++c) if (fs[c] > v0) { v0 = fs[c]; i0 = c; }
            int i1 = -1; float v1 = 0.f;
#pragma unroll
            for (int c = 0; c < 4; ++c) if (c != i0 && (i1 < 0 || fs[c] > v1)) { v1 = fs[c]; i1 = c; }
            const float e1 = expf(v1 - v0), s0 = 1.0f / (1.0f + e1), w0g = s0 * pg, w1g = (e1 * s0) * pg;
            const int ia = i0 < i1 ? i0 : i1, ib = i0 < i1 ? i1 : i0, pidx = (ia == 0) ? ib - 1 : (ia == 1) ? ib + 1 : 5, q = gi * 6 + pidx;
            LAS float* ip = info + tid * 8; ip[0] = __builtin_bit_cast(float, q); ip[1] = (i0 < i1) ? w0g : w1g; ip[2] = (i0 < i1) ? w1g : w0g; ip[3] = rstd;
            ip[4] = __builtin_bit_cast(float, __hip_atomic_fetch_add(&lcnt[q], 1u, __ATOMIC_RELAXED, __HIP_MEMORY_SCOPE_WORKGROUP));
        }
        __syncthreads();
        if (tid < NPAIR) lcnt[32 + tid] = __hip_atomic_fetch_add((unsigned*)(F.ctl + cw + tid * 64), lcnt[tid], RLX_AGENT);
        __syncthreads();
        if (tid < RT_ROWS) { LAS float* ip = info + tid * 8; const int row = base + tid; const int q = __builtin_bit_cast(int, ip[0]);
            const size_t p = (size_t)q * T + lcnt[32 + q] + __builtin_bit_cast(unsigned, ip[4]);
            ptok[p] = row; pga[p] = ip[1]; pgb[p] = ip[2]; prstd[p] = ip[3]; }
        __syncthreads();
    }
}
__device__ __forceinline__ void moe_table(Frame& F, int l) {
    if (F.tid == 0) { unsigned pre = 0u;
        for (int q = 0; q < NPAIR; ++q) { const unsigned c = ld_agent_u32((const unsigned*)(F.ctl + CW_CNT + (l * 32 + q) * 64)); F.MISC[MI_CNT + q] = c; F.MISC[MI_PRE + q] = pre; pre += (c + 255u) >> 8; }
        F.MISC[MI_PRE + NPAIR] = pre; }
    __syncthreads();
}
__device__ __forceinline__ void ph_rowpass(Frame& F, int l, bool dummy) {
    const int gw = F.vcu * NWAVES + F.wave, NGW = F.G * NWAVES, lane = F.lane;
    const bf16* xb = (const bf16*)(F.ws + WS_XB); float* rstd_o = (float*)(F.ws + WS_RSTD);
    const float* gfin = F.in(3);
    for (int m = gw; m < T; m += NGW) {
        const GAS u32x2* xr = (const GAS u32x2*)(xb + (size_t)m * D) + lane;
        f32x4 v[8]; float ss = 0.f;
#pragma unroll
        for (int j = 0; j < 8; ++j) { const u32x2 x = xr[64 * j]; v[j].x = bf_lo(x.x); v[j].y = bf_hi(x.x); v[j].z = bf_lo(x.y); v[j].w = bf_hi(x.y);
            ss += (v[j].x * v[j].x + v[j].y * v[j].y) + (v[j].z * v[j].z + v[j].w * v[j].w); }
        ss = wave_sum(ss); const float rstd = 1.0f / sqrtf(ss * (1.0f / D) + EPS);
        if (l == 0) { if (lane == 0) (dummy ? (float*)(F.ws + 950 * MiB) : rstd_o)[m] = rstd; }
        else {
            GAS f32x4* xw = dummy ? (GAS f32x4*)((float*)(F.ws + WS_Y) + (size_t)(m & 16383) * D) + lane : (GAS f32x4*)(F.out + (size_t)m * D) + lane;
#pragma unroll
            for (int j = 0; j < 8; ++j) { const f32x4 g = *((const f32x4*)gfin + lane + 64 * j); xw[64 * j] = v[j] * rstd * g; }
        }
    }
}
constexpr int S5_UP = 528, S5_XP = 272, S5_U = 0, S5_X = 67584, S5_T = 106496;
__device__ __forceinline__ void cmul_add(float ar, float ai, float br, float bi, float cr, float ci, float& orr, float& oi) { orr = ar * br - ai * bi + cr; oi = ar * bi + ai * br + ci; }
__device__ __forceinline__ void ph_s5core(Frame& F, int pf) {
    LAS unsigned char* L = F.lds;
    const int tid = F.tid, lane = F.lane, w = F.wave, l15 = lane & 15, lq = lane >> 4;
    const bf16* A2 = (const bf16*)(F.ws + WS_A2); unsigned char* Y8 = F.ws + ((pf & 8) ? 776 * MiB : WS_Y);
    const int urow = tid >> 2, uq = tid & 3;
    u32x4 ust[8];
    const int upc = (2048 + F.G - 1) / F.G;
    const int L0 = F.vcu * upc, Lend = (L0 + upc < 2048) ? L0 + upc : 2048;
    if (L0 < 2048) { const bf16* src = A2 + ((size_t)(L0 >> 4) * 2048 + (size_t)(L0 & 15) * 128 + urow) * 256 + uq * 64;
#pragma unroll
        for (int i = 0; i < 8; ++i) ust[i] = *(const GAS u32x4*)(src + i * 8); }
    for (int Lu = L0; Lu < Lend; ++Lu) {
        const int g = Lu >> 4, b = Lu & 15;
        const bf16* Wi = (const bf16*)(F.ws + WS_S5WIN) + (size_t)g * 128 * 256; const bf16* KB = (const bf16*)(F.ws + WS_S5K) + (size_t)g * 4096; const bf16* Wo = (const bf16*)(F.ws + WS_S5WO) + (size_t)g * 256 * 128;
#define S5_WFRAG(mt_, ks_) (((ks_) < 8) ? (((2 * w + (mt_)) - (2 * (ks_) + (lq >> 1)) >= 0) ? *(const GAS bf16x8*)(KB + (((2 * w + (mt_)) - (2 * (ks_) + (lq >> 1))) * 16 + l15) * 16 + 8 * (lq & 1)) : (bf16x8){0, 0, 0, 0, 0, 0, 0, 0}) \
                                        : *(const GAS bf16x8*)(Wo + (size_t)(16 * (2 * w + (mt_)) + l15) * 128 + 32 * ((ks_) - 8) + 8 * lq))
#pragma unroll
        for (int i = 0; i < 8; ++i) *(LAS u32x4*)(L + S5_U + urow * S5_UP + (uq * 64 + i * 8) * 2) = ust[i];
        bf16x8 wb[8];
#pragma unroll
        for (int ks = 0; ks < 8; ++ks) wb[ks] = *(const GAS bf16x8*)(Wi + (size_t)(16 * w + l15) * 256 + 32 * ks + 8 * lq);
        const f32x4 lam = *(const GAS f32x4*)((const float*)(F.ws + WS_LAM) + ((size_t)g * 64 + 8 * w + (l15 & 7)) * 4);
        __syncthreads();
        f32x4 X[8];
#pragma unroll
        for (int rt = 0; rt < 8; ++rt) X[rt] = (f32x4){0.f, 0.f, 0.f, 0.f};
        if (!(pf & 64)) {
#pragma unroll
        for (int ks = 0; ks < 8; ++ks) {
#pragma unroll
            for (int rt = 0; rt < 8; ++rt) { const bf16x8 a = *(const LAS bf16x8*)(L + S5_U + (16 * rt + l15) * S5_UP + (32 * ks + 8 * lq) * 2);
                X[rt] = __builtin_amdgcn_mfma_f32_16x16x32_bf16(a, wb[ks], X[rt], 0, 0, 0); } }
        }
        bf16x8 wa[2][4];
#pragma unroll
        for (int mt = 0; mt < 2; ++mt)
#pragma unroll
            for (int k4 = 0; k4 < 4; ++k4) wa[mt][k4] = S5_WFRAG(mt, k4);
        if (!(pf & 16)) {
            const bool isim = (l15 & 8) != 0;
#define S5_XRI(rt_, r_) const float mine_ = X[rt_][r_], oth_ = __builtin_bit_cast(float, __builtin_amdgcn_update_dpp(0, __builtin_bit_cast(int, mine_), 0x128  , 0xf, 0xf, false)); \
            const float xr_ = isim ? oth_ : mine_, xi_ = isim ? mine_ : oth_
            LAS unsigned char* tb = L + S5_T + w * 4096;
#pragma unroll
            for (int rt = 0; rt < 8; ++rt) { float ar = 0.f, ai = 0.f;
#pragma unroll
                for (int r = 0; r < 4; ++r) { S5_XRI(rt, r); float nr, ni; cmul_add(lam[0], lam[1], ar, ai, xr_, xi_, nr, ni); ar = nr; ai = ni; }
                *(LAS f32x2*)(tb + ((rt * 16 + l15) * 4 + lq) * 8) = (f32x2){ar, ai}; }
            asm volatile("s_waitcnt lgkmcnt(0)" ::: "memory");
            float cr = 0.f, ci = 0.f;
#pragma unroll
            for (int rt = 0; rt < 8; ++rt) {
                const f32x4 t0 = *(const LAS f32x4*)(tb + (rt * 16 + l15) * 32), t1 = *(const LAS f32x4*)(tb + (rt * 16 + l15) * 32 + 16);
                float ar = 0.f, ai = 0.f;
#pragma unroll
                for (int o = 0; o < 4; ++o) { if (lq == o) { ar = cr; ai = ci; }
                    const float tr_ = (o == 0) ? t0[0] : (o == 1) ? t0[2] : (o == 2) ? t1[0] : t1[2], ti_ = (o == 0) ? t0[1] : (o == 1) ? t0[3] : (o == 2) ? t1[1] : t1[3];
                    float nr, ni; cmul_add(lam[2], lam[3], cr, ci, tr_, ti_, nr, ni); cr = nr; ci = ni; }
#pragma unroll
                for (int r = 0; r < 4; ++r) { *(LAS bf16*)(L + S5_X + (16 * rt + 4 * lq + r) * S5_XP + (16 * w + l15) * 2) = (bf16)f2bf(isim ? ai : ar);
                    S5_XRI(rt, r); float nr, ni; cmul_add(lam[0], lam[1], ar, ai, xr_, xi_, nr, ni); ar = nr; ai = ni; } }
#undef S5_XRI
        }
        { const int Ln = Lu + 1; if (Ln < Lend) { const bf16* src = A2 + ((size_t)(Ln >> 4) * 2048 + (size_t)(Ln & 15) * 128 + urow) * 256 + uq * 64;
#pragma unroll
            for (int i = 0; i < 8; ++i) ust[i] = *(const GAS u32x4*)(src + i * 8); } }
        __syncthreads();
        f32x4 acc[2][8];
#pragma unroll
        for (int mt = 0; mt < 2; ++mt)
#pragma unroll
            for (int nt = 0; nt < 8; ++nt) acc[mt][nt] = (f32x4){0.f, 0.f, 0.f, 0.f};
        if (!(pf & 32)) {
#pragma unroll
        for (int kb = 0; kb < 3; ++kb) {
            bf16x8 wnx[2][4];
            if (kb < 2) {
#pragma unroll
                for (int mt = 0; mt < 2; ++mt)
#pragma unroll
                    for (int k4 = 0; k4 < 4; ++k4) wnx[mt][k4] = S5_WFRAG(mt, 4 * (kb + 1) + k4);
            }
#pragma unroll
            for (int k4 = 0; k4 < 4; ++k4) { const int ks = 4 * kb + k4;
                if (ks >= 8 || ks <= w) {
#pragma unroll
                for (int nt = 0; nt < 8; ++nt) {
                    const bf16x8 bv = (ks < 8) ? *(const LAS bf16x8*)(L + S5_U + (16 * nt + l15) * S5_UP + (32 * ks + 8 * lq) * 2)
                                               : *(const LAS bf16x8*)(L + S5_X + (16 * nt + l15) * S5_XP + (32 * (ks - 8) + 8 * lq) * 2);
                    acc[0][nt] = __builtin_amdgcn_mfma_f32_16x16x32_bf16(wa[0][k4], bv, acc[0][nt], 0, 0, 0);
                    acc[1][nt] = __builtin_amdgcn_mfma_f32_16x16x32_bf16(wa[1][k4], bv, acc[1][nt], 0, 0, 0); } } }
            if (kb < 2) {
#pragma unroll
                for (int mt = 0; mt < 2; ++mt)
#pragma unroll
                    for (int k4 = 0; k4 < 4; ++k4) wa[mt][k4] = wnx[mt][k4];
            }
        }
        }
#pragma unroll
        for (int mt = 0; mt < 2; ++mt)
#pragma unroll
            for (int nt = 0; nt < 8; ++nt) { const int tok = (b * 128 + 16 * nt + l15) * 16 + 2 * w + mt; const f32x4 a = acc[mt][nt];
                const unsigned wv = pk4_f8(gelu_tanh(a[0]) * F8_SY, gelu_tanh(a[1]) * F8_SY, gelu_tanh(a[2]) * F8_SY, gelu_tanh(a[3]) * F8_SY);
                if (!(pf & 256)) *(GAS unsigned*)(Y8 + ((((size_t)(tok >> 8) * 64 + (g >> 1)) * 256) + (tok & 255)) * 32 + (g & 1) * 16 + 4 * lq) = wv; else asm volatile("" :: "v"(wv)); }
        __syncthreads();
    }
}

struct Args { const float* in[36]; float* out; unsigned char* ws; int ph_lo, ph_hi; };
__global__ void __launch_bounds__(NT, 2) fwd(Args args) {
    extern __shared__ __attribute__((aligned(16))) unsigned char lds[];
    Frame F;
    F.lds = (LAS unsigned char*)lds;
    F.MISC = (volatile LAS unsigned*)(F.lds + MISC_OFF);
    F.tid = threadIdx.x; F.lane = F.tid & 63; F.wave = __builtin_amdgcn_readfirstlane(F.tid >> 6);
    F.G = gridDim.x; { const int bx = blockIdx.x; F.vcu = (F.G % 8 == 0) ? (bx % 8) * (F.G / 8) + bx / 8 : bx; }
    F.out = args.out; F.ws = args.ws; F.ctl = (gu32*)(args.ws + WS_CTL);
    if (F.tid < 64) F.MISC[F.tid] = 0u;
    if (F.tid >= 64 && F.tid < 100) { const unsigned long long pv = (unsigned long long)args.in[F.tid - 64]; F.MISC[64 + 2 * (F.tid - 64)] = (unsigned)pv; F.MISC[65 + 2 * (F.tid - 64)] = (unsigned)(pv >> 32); }
    __syncthreads();
    XcdBarrier bar; bar.bar = (unsigned*)(F.ctl + CW_BAR); bar.x = 0; bar.st = nullptr;
    if (!MK_PER_PHASE) bar = xcd_barrier_post((unsigned*)(F.ctl + CW_BAR), F.MISC + 8);
    const int lo = args.ph_lo & 255, hi = args.ph_hi, pflags = args.ph_lo >> 8;
#ifndef PHMASK
#define PHMASK 0x3ffff
#endif
#define IN(k) ((((PHMASK) >> (k)) & 1) && lo <= (k) && (k) < hi)
#ifdef DOUBLE_BAR
#define SEAM(k) do { if (!MK_PER_PHASE && IN(k) && IN((k) + 1)) { xcd_barrier(bar); xcd_barrier(bar); } } while (0)
#else
#define SEAM(k) do { if (!MK_PER_PHASE && IN(k) && IN((k) + 1)) xcd_barrier(bar); } while (0)
#endif
    unsigned char* ws = args.ws;
    bf16* XB = (bf16*)(ws + WS_XB); bf16* Pb = (bf16*)(ws + WS_P); bf16* Yb = (bf16*)(ws + WS_Y); float* RSTD = (float*)(ws + WS_RSTD);
    const int bx = (int)blockIdx.x;

    if (IN(0)) { ph_prologue(F, pflags); }
    SEAM(0);
#ifndef P1_WGM
#define P1_WGM 8
#endif
    if (IN(1)) {
        pg8::GemmP g{nullptr, 2048, 4096u, 32u, 4096u};
#ifdef P1_STAGGER
        {
            const unsigned long long t0 = __builtin_amdgcn_s_memrealtime(), dl = (unsigned long long)((bx >> 3) & 3) * (P1_STAGGER * 100ull);
            while (__builtin_amdgcn_s_memrealtime() - t0 < dl) __builtin_amdgcn_s_sleep(8);
        }
#endif
#ifdef P1_SPLIT3
#pragma unroll
        for (int j3 = 0; j3 < 3; ++j3) {
            DenseSched S; S.to.init(T / 256, 8, F.G, bx, P1_WGM); S.A = (const char*)XB; S.tstepA = (size_t)256 * 4096; S.B0 = (const char*)(ws + WS_WIN) + (size_t)j3 * 2048 * 4096; S.B1 = S.B0 + (size_t)128 * 4096; S.tstepB = (size_t)256 * 4096; S.cpt = 256;
            EpiScaleBf16 E{Pb + j3 * 2048, PN, RSTD, pflags, 1.0f};
            pg8::gemm_phase<EpiScaleBf16, DenseSched, false>(F.lds, g, S, E); }
#else
        {
            pg8::GemmP g8{nullptr, 1024, 2048u, 32u, 2048u};
            DenseSched S; S.to.init(T / 256, 8, F.G, bx, P1_WGM); S.A = (const char*)(ws + WS_X8IN); S.tstepA = (size_t)256 * 2048; S.B0 = (const char*)(ws + WS_WIN); S.B1 = S.B0 + (size_t)128 * 2048; S.tstepB = (size_t)256 * 2048; S.cpt = 256;
            EpiScaleBf16 E{Pb, PN, RSTD, pflags, 1.0f / (F8_SX * F8_SW)};
            pg8::gemm_phase<EpiScaleBf16, DenseSched, false, false, true>(F.lds, g8, S, E); }
        {
            DenseSched S; S.to.init(T / 256, 16, F.G, bx, P1_WGM); S.A = (const char*)XB; S.tstepA = (size_t)256 * 4096; S.B0 = (const char*)(ws + WS_WIN) + (size_t)2048 * 4096; S.B1 = S.B0 + (size_t)128 * 4096; S.tstepB = (size_t)256 * 4096; S.cpt = 256;
            EpiScaleBf16 E{Pb + 2048, PN, RSTD, pflags, 1.0f};
            pg8::gemm_phase<EpiScaleBf16, DenseSched, false>(F.lds, g, S, E); }
#endif
    }
    SEAM(1);
    if (IN(2)) {
#ifndef NO_MLSTM
        if (!(pflags & 1)) for (int u = F.vcu; u < 256; u += F.G) { mlstm_unit(F, u >> 4, (u >> 2) & 3, u & 3, pflags); if (!(pflags & 8)) hn_post(F, u >> 2); }
#endif
#ifndef NO_LRU
        if (!(pflags & 2)) for (int u = F.vcu; u < 256; u += F.G) lru_unit(F, u >> 4, (u >> 1) & 7, u & 1);
#endif
#ifndef NO_MLSTM
        if (!(pflags & 1) && !(pflags & 8)) for (int u = F.vcu; u < 256; u += F.G) { hn_wait(F, u >> 2); headnorm_slice(F, u >> 4, (u >> 2) & 3, u & 3); }
#endif
    }
    SEAM(3);
    if (IN(4)) {
        pg8::GemmP g{nullptr, 2048, 4096u, 32u, 4096u};
        DenseSched S; S.to.init(T / 256, D / 256, F.G, bx); S.A = (const char*)Yb; S.tstepA = (size_t)256 * 4096; S.B0 = (const char*)(ws + WS_WOUT); S.B1 = S.B0 + (size_t)128 * 4096; S.tstepB = (size_t)256 * 4096; S.cpt = 256;
        EpiOutRes E{XB, ws + WS_X8};
        pg8::gemm_phase<EpiOutRes, DenseSched, false>(F.lds, g, S, E);
    }
    SEAM(4);
#define MOE_LAYER(PH, l, WSW) \
    if (IN(PH)) { ph_router(F, l, (pflags & 4) != 0); } \
    SEAM(PH); \
    if (IN(PH + 1)) { moe_table(F, l); \
        pg8::GemmP g{(const char*)(ws + WS_X8), 1024, 2048u, 32u, 2048u}; \
        MoeSched<false> S{F.MISC, F.G, F.vcu, (const char*)(ws + WSW), (const char*)(ws + WSW + 32 * MiB), nullptr, (const int*)(ws + WS_PTOK)}; \
        EpiGateUp E{ws + WS_H, (const float*)(ws + WS_PRSTD), (const float*)(ws + WS_PGA), (const float*)(ws + WS_PGB), F.MISC, pflags}; \
        pg8::gemm_phase<EpiGateUp, MoeSched<false>, true, false, true>(F.lds, g, S, E); } \
    SEAM(PH + 1); \
    if (IN(PH + 2)) { moe_table(F, l); \
        pg8::GemmP g{nullptr, 512, 1024u, 32u, 512u}; \
        MoeSched<true> S{F.MISC, F.G, F.vcu, (const char*)(ws + WSW + 64 * MiB), nullptr, (const char*)(ws + WS_H), nullptr}; \
        EpiDownRes E{XB, (const int*)(ws + WS_PTOK), F.MISC, (pflags & 4) ? (bf16*)(ws + 712 * MiB) : XB, (l == 0) ? ws + ((pflags & 4) ? 776 * MiB : WS_X8) : nullptr}; \
        pg8::gemm_phase<EpiDownRes, MoeSched<true>, false, true, true>(F.lds, g, S, E); } \
    SEAM(PH + 2); \
    if (IN(PH + 3)) { ph_rowpass(F, l, (pflags & 4) != 0); }
    MOE_LAYER(5, 0, WS_WMOE0)
    SEAM(8);
    if (IN(9)) {
        pg8::GemmP g{nullptr, 1024, 2048u, 32u, 2048u};
        DenseSched S; S.to.init(T / 256, D / 256, F.G, bx); S.A = (const char*)(ws + WS_X8); S.tstepA = (size_t)256 * 2048; S.B0 = (const char*)(ws + WS_WS5IN); S.B1 = S.B0 + (size_t)128 * 2048; S.tstepB = (size_t)256 * 2048; S.cpt = 256;
        EpiS5U E{(bf16*)(ws + WS_A2), RSTD, 1.0f / (F8_SX * F8_SW)};
        pg8::gemm_phase<EpiS5U, DenseSched, false, false, true>(F.lds, g, S, E);
    }
    SEAM(9);
    if (IN(10)) { ph_s5core(F, pflags); }
    SEAM(12);
    if (IN(13)) {
        pg8::GemmP g{nullptr, 1024, 32u, 8192u, 2048u};
        DenseSched S; S.to.init(T / 256, D / 128, F.G, bx); S.A = (const char*)Yb; S.tstepA = (size_t)64 * 8192; S.B0 = (const char*)(ws + WS_WGLUV); S.B1 = (const char*)(ws + WS_WGLUG); S.tstepB = (size_t)128 * 2048; S.cpt = 128;
        EpiGlu E{(pflags & 4) ? (bf16*)(ws + 712 * MiB) : XB, ws + ((pflags & 4) ? 776 * MiB : WS_X8)};
        pg8::gemm_phase<EpiGlu, DenseSched, false, false, true>(F.lds, g, S, E);
    }
    SEAM(13);
    MOE_LAYER(14, 1, WS_WMOE1)
#undef IN
#undef SEAM
}

extern "C" void kernel_launch(void* const* d_in, const int* in_sizes, int n_in, void* d_out, int out_size, void* d_ws, size_t ws_size, hipStream_t stream) {
    static int grid = 0;
    if (grid == 0) {
        if (n_in != 36 || in_sizes[0] != T * D || out_size != T * D || ws_size < WS_END) { fprintf(stderr, "kernel_launch: unexpected shapes (n_in %d, in0 %d, out %d, ws %zu < %zu); nothing launched\n", n_in, n_in > 0 ? in_sizes[0] : -1, out_size, ws_size, (size_t)WS_END); grid = -1; return; }
        int dev = 0, cus = 0, per_cu = 0;
        if (hipGetDevice(&dev) != hipSuccess || hipDeviceGetAttribute(&cus, hipDeviceAttributeMultiprocessorCount, dev) != hipSuccess) { grid = -1; return; }
        if (hipFuncSetAttribute((const void*)fwd, hipFuncAttributeMaxDynamicSharedMemorySize, LDS_BYTES) != hipSuccess) { fprintf(stderr, "kernel_launch: hipFuncSetAttribute failed\n"); grid = -1; return; }
        if (hipOccupancyMaxActiveBlocksPerMultiprocessor(&per_cu, (const void*)fwd, NT, LDS_BYTES) != hipSuccess || per_cu < 1) fprintf(stderr, "kernel_launch: occupancy query says %d\n", per_cu);
        (void)hipGetLastError();
        grid = cus;
    }
    if (grid < 0) return;
    (void)hipMemsetAsync((char*)d_ws + WS_CTL, 0, CTL_ZERO_BYTES, stream);
    Args a{};
    for (int i = 0; i < 36; ++i) a.in[i] = (const float*)d_in[i];
    a.out = (float*)d_out; a.ws = (unsigned char*)d_ws;
#if MK_PER_PHASE
    for (int ph = 0; ph < NPHASE; ++ph) { a.ph_lo = ph; a.ph_hi = ph + 1; hipLaunchKernelGGL(fwd, dim3(grid), dim3(NT), LDS_BYTES, stream, a);
#ifdef REPEAT_PHASE
        if (ph == REPEAT_PHASE) {
#ifdef REPEAT_FLAGS
            a.ph_lo = ph | (REPEAT_FLAGS << 8);
#endif
            hipLaunchKernelGGL(fwd, dim3(grid), dim3(NT), LDS_BYTES, stream, a); }
#endif
    }
#else
    a.ph_lo = 0; a.ph_hi = NPHASE;
    hipLaunchKernelGGL(fwd, dim3(grid), dim3(NT), LDS_BYTES, stream, a);
#endif
    const hipError_t le = hipPeekAtLastError();
    if (le != hipSuccess) fprintf(stderr, "kernel_launch: launch failed: %s\n", hipGetErrorName(le));
}
```

```cpp
#include <hip/hip_runtime.h>
#include <cstdio>
#include <cstdint>

#define LAS __attribute__((address_space(3)))
#define GAS __attribute__((address_space(1)))
typedef unsigned short bf16;
typedef short bf16x8 __attribute__((ext_vector_type(8)));
typedef float f32x4 __attribute__((ext_vector_type(4)));
typedef float f32x2 __attribute__((ext_vector_type(2)));
typedef unsigned u32x4 __attribute__((ext_vector_type(4)));
typedef unsigned u32x2 __attribute__((ext_vector_type(2)));
typedef GAS unsigned gu32;
#define RLX_AGENT __ATOMIC_RELAXED, __HIP_MEMORY_SCOPE_AGENT
#define LDS_WAIT() asm volatile("s_waitcnt lgkmcnt(0)" ::: "memory")
#define VM_WAIT() asm volatile("s_waitcnt vmcnt(0)" ::: "memory")

#ifndef MK_PER_PHASE
#define MK_PER_PHASE 0
#endif

constexpr int T = 32768, D = 2048, SEQ = 2048, NBATCH = 16;
constexpr int NWAVES = 8, NT = 512;
constexpr int INCOLS = 6152, PN = 6144;
constexpr int NEXP = 16, FF = 512;
constexpr int NPAIR = 24;
constexpr int SLOT_ROWS = 32768 + NPAIR * 256;
constexpr float EPS = 1e-6f;
constexpr int NPHASE = 18;

typedef __bf16 bf16x2_t __attribute__((ext_vector_type(2)));
__device__ __forceinline__ unsigned pk2(float lo, float hi) { f32x2 v = {lo, hi}; bf16x2_t b = __builtin_convertvector(v, bf16x2_t); return __builtin_bit_cast(unsigned, b); }
__device__ __forceinline__ unsigned f2bf(float f) { return pk2(f, 0.f) & 0xffffu; }
__device__ __forceinline__ float bf_lo(unsigned w) { return __builtin_bit_cast(float, w << 16); }
__device__ __forceinline__ float bf_hi(unsigned w) { return __builtin_bit_cast(float, w & 0xffff0000u); }
__device__ __forceinline__ float bf2f(bf16 b) { return __builtin_bit_cast(float, ((unsigned)b) << 16); }
typedef int i32x8 __attribute__((ext_vector_type(8)));
typedef int i32x4 __attribute__((ext_vector_type(4)));
__device__ __forceinline__ unsigned pk4_f8(float a, float b, float c, float d) {
    a = __builtin_amdgcn_fmed3f(a, -448.f, 448.f); b = __builtin_amdgcn_fmed3f(b, -448.f, 448.f); c = __builtin_amdgcn_fmed3f(c, -448.f, 448.f); d = __builtin_amdgcn_fmed3f(d, -448.f, 448.f);
    int p = __builtin_amdgcn_cvt_pk_fp8_f32(a, b, 0, false); p = __builtin_amdgcn_cvt_pk_fp8_f32(c, d, p, true); return (unsigned)p; }
constexpr float F8_SX = 8.f, F8_SH = 64.f, F8_SY = 16.f, F8_SW = 512.f, F8_SWD = 256.f;
__device__ __forceinline__ float wave_sum(float v) {
#pragma unroll
    for (int o = 1; o < 64; o <<= 1) v += __shfl_xor(v, o);
    return v;
}
__device__ __forceinline__ float sigmoidf_(float x) { return __builtin_amdgcn_rcpf(1.0f + __expf(-x)); }
__device__ __forceinline__ float gelu_tanh(float x) { const float u = 0.7978845608028654f * (x + 0.044715f * x * x * x); return x * __builtin_amdgcn_rcpf(1.0f + __expf(-2.0f * u)); }
__device__ __forceinline__ float siluf_(float x) { return x * __builtin_amdgcn_rcpf(1.0f + __expf(-x)); }

namespace pg8 {
constexpr int BM = 256, BK = 64, HALF = 128, HTB = HALF * BK * 2, STAGE_BYTES = 8 * HTB, NXCD = 8, WGM = 8;
__host__ __device__ __forceinline__ int lds_byte(int r, int c) { const int st = (r >> 4) * 2 + (c >> 5), rr = r & 15, cc = c & 31, ob = rr * 64 + cc * 2; return st * 1024 + (ob ^ (((ob >> 9) & 1) << 5)); }
__host__ __device__ __forceinline__ void stage_rc(int b, int& R, int& C) { const int st = b / 1024, sb = b % 1024, swz = sb ^ (((sb >> 9) & 1) << 5); R = (st >> 1) * 16 + swz / 64; C = (st & 1) * 32 + (swz % 64) / 2; }
__host__ __device__ __forceinline__ int perm32(int rho) { const int n = rho >> 4, i = rho & 15; return 8 * (i >> 2) + 4 * n + (i & 3); }

struct Unit { const char* a; const char* b0; const char* b1; const char* b0x; const char* b1x; int r0, c0, aux, x; };
struct GemmP { const char* gA; int K; unsigned rsA, planeA, ldb; };

struct TileOrder {
    int nM, nN, nwg, G, c, wgm;
    __device__ __forceinline__ void init(int nM_, int nN_, int G_, int c_, int wgm_ = WGM) { nM = nM_; nN = nN_; nwg = nM * nN; G = G_; c = c_; wgm = wgm_; }
    __device__ __forceinline__ bool next(int i, int& pm, int& pn) const {
        const long L = (long)i * G + c; if (L >= nwg) return false;
        int wgid = (int)L; { const int q = nwg / NXCD, r = nwg % NXCD, xcd = wgid % NXCD, off = wgid / NXCD; wgid = (xcd < r ? xcd * (q + 1) : r * (q + 1) + (xcd - r) * q) + off; }
        const int nig = wgm * nN, gid = wgid / nig, fm = gid * wgm, gsz = (nM - fm) < wgm ? (nM - fm) : wgm;
        pm = fm + ((wgid % nig) % gsz); pn = (wgid % nig) / gsz; return true;
    }
};

template <class Epi, class Sched, bool GATHER, bool DUALB = false, bool FP8 = false>
__device__ __forceinline__ void gemm_phase(LAS unsigned char* lds, const GemmP g, const Sched& S, const Epi& E) {
    const int tid = threadIdx.x, wid = __builtin_amdgcn_readfirstlane(tid >> 6), lane = tid & 63, wr = wid >> 2, wc = wid & 3, fr = lane & 15, fq = lane >> 4;
    const int nt = g.K / BK;
    unsigned voffA[2], voffB[2], coff[2]; int RA[2];
#pragma unroll
    for (int i = 0; i < 2; ++i) { int R, C; stage_rc(tid * 16 + i * 8192, R, C); const int Rb = Epi::PERM ? ((R & ~31) + perm32(R & 31)) : R;
        coff[i] = (unsigned)(C >> 4) * g.planeA + (unsigned)(C & 15) * 2u; RA[i] = R;
        voffA[i] = (unsigned)R * g.rsA + coff[i]; voffB[i] = (unsigned)Rb * g.ldb + (unsigned)C * 2u; }
    const size_t ksA = (size_t)4 * g.planeA, ksB = (size_t)(BK * 2);
    const size_t hstepA = (size_t)HALF * g.rsA;
    const unsigned ldsw = (unsigned)wid * 1024u;
    const int aoff = lds_byte(wr * 64 + fr, fq * 8), boff = lds_byte(wc * 32 + fr, fq * 8);
#define PG8_SA(b, h) (((b) * 2 + (h)) * HTB)
#define PG8_SB(b, h) ((4 + (b) * 2 + (h)) * HTB)
#define PG8_STG(bufoff, ptr, o0, o1) do { \
        __builtin_amdgcn_global_load_lds((const unsigned*)((const char*)(ptr) + (o0)), (LAS unsigned*)(lds + (bufoff) + ldsw), 16, 0, 0); \
        __builtin_amdgcn_global_load_lds((const unsigned*)((const char*)(ptr) + (o1)), (LAS unsigned*)(lds + (bufoff) + ldsw + 8192), 16, 0, 0); } while (0)
#define PG8_STAGE_B(bufoff, ptr) PG8_STG(bufoff, ptr, voffB[0], voffB[1])
#define PG8_STAGE_A(bufoff, h, ptr, usenext) do { if constexpr (GATHER) { const unsigned _o0 = (usenext) ? voN[h][0] : voC[h][0], _o1 = (usenext) ? voN[h][1] : voC[h][1]; PG8_STG(bufoff, ptr, _o0, _o1); } \
        else { PG8_STG(bufoff, (ptr) + (h) * hstepA, voffA[0], voffA[1]); } } while (0)
#define PG8_LD16(off) (*(const LAS bf16x8*)(lds + (off)))
#define PG8_CAT8(x, y) __builtin_shufflevector(__builtin_bit_cast(i32x4, x), __builtin_bit_cast(i32x4, y), 0, 1, 2, 3, 4, 5, 6, 7)
#define PG8_LDA(dst, b, h) do { if constexpr (FP8) { _Pragma("unroll") for (int m = 0; m < 4; ++m) dst##8[m] = PG8_CAT8(PG8_LD16(PG8_SA(b, h) + aoff + m * 2048), PG8_LD16(PG8_SA(b, h) + aoff + m * 2048 + 1024)); } \
        else { _Pragma("unroll") for (int m = 0; m < 4; ++m) _Pragma("unroll") for (int k = 0; k < 2; ++k) dst[m][k] = PG8_LD16(PG8_SA(b, h) + aoff + m * 2048 + k * 1024); } } while (0)
#define PG8_LDB(dst, b, h) do { if constexpr (FP8) { _Pragma("unroll") for (int n = 0; n < 2; ++n) dst##8[n] = PG8_CAT8(PG8_LD16(PG8_SB(b, h) + boff + n * 2048), PG8_LD16(PG8_SB(b, h) + boff + n * 2048 + 1024)); } \
        else { _Pragma("unroll") for (int n = 0; n < 2; ++n) _Pragma("unroll") for (int k = 0; k < 2; ++k) dst[n][k] = PG8_LD16(PG8_SB(b, h) + boff + n * 2048 + k * 1024); } } while (0)
#define PG8_MMA(ai, bj, At, Bt) do { __builtin_amdgcn_s_setprio(1); \
        if constexpr (FP8) { _Pragma("unroll") for (int m = 0; m < 4; ++m) _Pragma("unroll") for (int n = 0; n < 2; ++n) \
            asm volatile("v_mfma_f32_16x16x128_f8f6f4 %0, %1, %2, %0" : "+v"(acc[ai][bj][m][n]) : "v"(Bt##8[n]), "v"(At##8[m])); } \
        else { _Pragma("unroll") for (int m = 0; m < 4; ++m) _Pragma("unroll") for (int n = 0; n < 2; ++n) _Pragma("unroll") for (int k = 0; k < 2; ++k) \
            acc[ai][bj][m][n] = __builtin_amdgcn_mfma_f32_16x16x32_bf16(Bt[n][k], At[m][k], acc[ai][bj][m][n], 0, 0, 0); } \
        __builtin_amdgcn_s_setprio(0); } while (0)
#define PG8_WAIT_V(n) asm volatile("s_waitcnt vmcnt(" #n ")" ::: "memory")
#define PG8_WAIT_L(n) asm volatile("s_waitcnt lgkmcnt(" #n ")" ::: "memory")
#define PG8_BAR __builtin_amdgcn_s_barrier()
#define PG8_SCHED __builtin_amdgcn_sched_barrier(0)
    Unit cur, nxt; int ui = 0;
    if (!S.next(0, cur)) return;
    unsigned voC[2][2], voN[2][2];
    if constexpr (GATHER) {
#pragma unroll
        for (int h = 0; h < 2; ++h)
#pragma unroll
            for (int i = 0; i < 2; ++i) { voC[h][i] = S.row_off(cur, h * HALF + RA[i]) + coff[i]; voN[h][i] = voC[h][i]; }
    } else { voC[0][0] = voC[0][1] = voC[1][0] = voC[1][1] = 0u; voN[0][0] = voN[0][1] = voN[1][0] = voN[1][1] = 0u; }
    f32x4 acc[2][2][4][2];
#pragma unroll
    for (int a = 0; a < 2; ++a)
#pragma unroll
        for (int b = 0; b < 2; ++b)
#pragma unroll
            for (int m = 0; m < 4; ++m)
#pragma unroll
                for (int n = 0; n < 2; ++n) acc[a][b][m][n] = (f32x4){0.f, 0.f, 0.f, 0.f};
    bf16x8 At[4][2], B0[2][2], B1[2][2];
    i32x8 At8[4], B08[2], B18[2];
    const char* cA = GATHER ? g.gA : cur.a; const char* cB0 = cur.b0; const char* cB1 = cur.b1; const char* cB0x = cur.b0x; const char* cB1x = cur.b1x;
    const int nth = nt >> 1;
#define PG8_BPTR(h, kt) ((DUALB && (kt) >= nth) ? ((h) ? cB1x : cB0x) + (size_t)((kt) - nth) * ksB : ((h) ? cB1 : cB0) + (size_t)(kt) * ksB)
    PG8_STAGE_B(PG8_SB(0, 0), cB0); PG8_STAGE_B(PG8_SB(0, 1), cB1); PG8_STAGE_A(PG8_SA(0, 0), 0, cA, false); PG8_STAGE_A(PG8_SA(0, 1), 1, cA, false);
    if (wr == 1) PG8_BAR;
    PG8_WAIT_V(2); PG8_BAR;
    PG8_STAGE_B(PG8_SB(1, 0), cB0 + ksB); PG8_STAGE_A(PG8_SA(1, 0), 0, cA + ksA, false); PG8_STAGE_B(PG8_SB(1, 1), cB1 + ksB);
    PG8_WAIT_V(6); PG8_BAR;
    for (;;) {
        const bool has_next = S.next(ui + 1, nxt);
        const char* nA = GATHER ? g.gA : (has_next ? nxt.a : cA); const char* nB0 = has_next ? nxt.b0 : cB0; const char* nB1 = has_next ? nxt.b1 : cB1;
        const char* nB0x = has_next ? nxt.b0x : cB0x; const char* nB1x = has_next ? nxt.b1x : cB1x;
        if constexpr (GATHER) {
            if (has_next) {
#pragma unroll
                for (int h = 0; h < 2; ++h)
#pragma unroll
                    for (int i = 0; i < 2; ++i) voN[h][i] = S.row_off(nxt, h * HALF + RA[i]) + coff[i];
            } else {
#pragma unroll
                for (int h = 0; h < 2; ++h)
#pragma unroll
                    for (int i = 0; i < 2; ++i) voN[h][i] = voC[h][i];
            }
        }
#pragma nounroll
        for (int t = 0; t < nt; t += 2) {
            const bool last = (t == nt - 2);
            const char* a1 = cA + (size_t)(t + 1) * ksA;
            const char* a2 = last ? nA : cA + (size_t)(t + 2) * ksA;
            const char* b20 = last ? nB0 : PG8_BPTR(0, t + 2); const char* b21 = last ? nB1 : PG8_BPTR(1, t + 2);
            const char* a3 = a2 + ksA; const char* b30 = last ? nB0 + ksB : PG8_BPTR(0, t + 3); const char* b31 = last ? nB1 + ksB : PG8_BPTR(1, t + 3);
            PG8_LDB(B0, 0, 0); PG8_LDB(B1, 0, 1); PG8_SCHED; PG8_LDA(At, 0, 0); PG8_STAGE_A(PG8_SA(1, 1), 1, a1, false);
            PG8_WAIT_V(8); PG8_WAIT_L(0); PG8_BAR; PG8_MMA(0, 0, At, B0); PG8_MMA(0, 1, At, B1); PG8_BAR; PG8_SCHED;
            PG8_LDA(At, 0, 1); PG8_STAGE_B(PG8_SB(0, 0), b20); PG8_STAGE_B(PG8_SB(0, 1), b21); PG8_STAGE_A(PG8_SA(0, 0), 0, a2, last);
            PG8_WAIT_V(8); PG8_WAIT_L(0); PG8_BAR; PG8_MMA(1, 0, At, B0); PG8_MMA(1, 1, At, B1); PG8_BAR; PG8_SCHED;
            PG8_LDB(B0, 1, 0); PG8_LDB(B1, 1, 1); PG8_SCHED; PG8_LDA(At, 1, 0); PG8_STAGE_A(PG8_SA(0, 1), 1, a2, last);
            PG8_WAIT_V(8); PG8_WAIT_L(0); PG8_BAR; PG8_MMA(0, 0, At, B0); PG8_MMA(0, 1, At, B1); PG8_BAR; PG8_SCHED;
            PG8_LDA(At, 1, 1); PG8_STAGE_B(PG8_SB(1, 0), b30); PG8_STAGE_B(PG8_SB(1, 1), b31); PG8_STAGE_A(PG8_SA(1, 0), 0, a3, last);
            PG8_WAIT_V(8); PG8_WAIT_L(0); PG8_BAR; PG8_MMA(1, 0, At, B0); PG8_MMA(1, 1, At, B1); PG8_BAR; PG8_SCHED;
        }
#ifndef PG8_NOALIGN
        if (wr == 0) PG8_BAR;
#endif
        if constexpr (FP8) asm volatile("s_nop 15\n\ts_nop 15" ::: "memory");
        E(acc, cur, wr, wc, fr, fq);
        if (!has_next) break;
#pragma unroll
        for (int a = 0; a < 2; ++a)
#pragma unroll
            for (int b = 0; b < 2; ++b)
#pragma unroll
                for (int m = 0; m < 4; ++m)
#pragma unroll
                    for (int n = 0; n < 2; ++n) acc[a][b][m][n] = (f32x4){0.f, 0.f, 0.f, 0.f};
        cur = nxt; cA = nA; cB0 = nB0; cB1 = nB1; cB0x = nB0x; cB1x = nB1x; ++ui;
        if constexpr (GATHER) {
#pragma unroll
            for (int h = 0; h < 2; ++h)
#pragma unroll
                for (int i = 0; i < 2; ++i) voC[h][i] = voN[h][i];
        }
#ifndef PG8_NOALIGN
        if (wr == 1) PG8_BAR;
#endif
    }
    PG8_WAIT_V(0);
#ifdef PG8_NOALIGN
    if (wr == 0) PG8_BAR;
#endif
    PG8_BAR;
#undef PG8_BPTR
#undef PG8_SA
#undef PG8_SB
#undef PG8_STG
#undef PG8_STAGE_A
#undef PG8_STAGE_B
#undef PG8_LDA
#undef PG8_LDB
#undef PG8_MMA
#undef PG8_CAT8
#undef PG8_LD16
#undef PG8_WAIT_V
#undef PG8_WAIT_L
#undef PG8_BAR
#undef PG8_SCHED
}
}

#define XB_TMO      128
#define XB_XCNT(j)  (256  + 64 * (j))
#define XB_XSUB(j)  (1280 + 64 * (j))
#define XB_XGEN(j)  (2304 + 64 * (j))
#define XB_TOP      3328
#define XB_TOPGEN   3392
#define XCD_BAR_WORDS 3456
#define XB_SPIN_CAP (1u << 18)
__device__ __forceinline__ unsigned xb_ld(unsigned* p)              { return __hip_atomic_load(p, __ATOMIC_RELAXED, __HIP_MEMORY_SCOPE_AGENT); }
__device__ __forceinline__ unsigned xb_add(unsigned* p, unsigned v) { return __hip_atomic_fetch_add(p, v, __ATOMIC_RELAXED, __HIP_MEMORY_SCOPE_AGENT); }
__device__ __forceinline__ unsigned xb_xcc_id() { return (unsigned)__builtin_amdgcn_s_getreg((3 << 11) | 20) & 0xFu; }
#define XB_SPIN(cond, bar) do { unsigned _sp = 0; while (cond) { __builtin_amdgcn_s_sleep(1); \
    if ((++_sp & 255u) == 0u) { if (xb_ld(&(bar)[XB_TMO])) break; if (_sp > XB_SPIN_CAP) { atomicAdd(&(bar)[XB_TMO], 1u); break; } } } } while (0)
struct XcdBarrier { unsigned* bar; unsigned x; volatile LAS unsigned* st; };
__device__ __forceinline__ XcdBarrier xcd_barrier_post(unsigned* bar, volatile LAS unsigned* st) {
    XcdBarrier b; b.bar = bar; b.x = xb_xcc_id(); b.st = st;
    if (threadIdx.x == 0) (void)xb_add(&bar[XB_XCNT(b.x)], 1u);
    return b;
}
__device__ __forceinline__ void xcd_barrier_complete(unsigned* bar, unsigned x, unsigned& nloc, unsigned& nx) {
    const unsigned G = gridDim.x * gridDim.y * gridDim.z;
    unsigned sum, cnt, mine, sp = 0u;
    for (;;) {
        sum = 0u; cnt = 0u; mine = 0u;
#pragma unroll
        for (unsigned j = 0; j < 16; ++j) { const unsigned c = xb_ld(&bar[XB_XCNT(j)]); sum += c; cnt += (c > 0u) ? 1u : 0u; mine = (j == x) ? c : mine; }
        if (sum == G) break;
        __builtin_amdgcn_s_sleep(1);
        if ((++sp & 255u) == 0u) { if (xb_ld(&bar[XB_TMO])) break; if (sp > XB_SPIN_CAP) { atomicAdd(&bar[XB_TMO], 1u); break; } }
    }
    nloc = mine > 0u ? mine : 1u; nx = cnt > 0u ? cnt : 1u;
}
__device__ __forceinline__ void xcd_barrier(const XcdBarrier& b) {
    asm volatile("s_waitcnt vmcnt(0)" ::: "memory");
    __syncthreads();
    if (threadIdx.x == 0) {
        unsigned* bar = b.bar;
        __builtin_amdgcn_s_waitcnt(0);
        unsigned nloc = b.st[0], nx = b.st[1];
        if (nloc == 0u) { xcd_barrier_complete(bar, b.x, nloc, nx); b.st[0] = nloc; b.st[1] = nx; }
        const unsigned old = xb_add(&bar[XB_XSUB(b.x)], 1u);
        const unsigned gen = old / nloc;
        if (old + 1u == (gen + 1u) * nloc) {
            __builtin_amdgcn_fence(__ATOMIC_RELEASE, "agent");
            asm volatile("s_waitcnt vmcnt(0)" ::: "memory");
            const unsigned og = xb_add(&bar[XB_TOP], 1u);
            const unsigned tg = og / nx;
            if (og + 1u == (tg + 1u) * nx) xb_add(&bar[XB_TOPGEN], 1u);
            else XB_SPIN(xb_ld(&bar[XB_TOPGEN]) == tg, bar);
            __builtin_amdgcn_fence(__ATOMIC_ACQUIRE, "agent");
            xb_add(&bar[XB_XGEN(b.x)], 1u);
            asm volatile("s_waitcnt vmcnt(0)" ::: "memory");
        } else {
            XB_SPIN(xb_ld(&bar[XB_XGEN(b.x)]) == gen, bar);
            __builtin_amdgcn_fence(__ATOMIC_ACQUIRE, "agent");
            asm volatile("s_waitcnt vmcnt(0)" ::: "memory");
        }
    }
    __syncthreads();
}

constexpr size_t MiB = 1u << 20;
constexpr size_t WS_CTL = 0, CTL_ZERO_BYTES = 1 * MiB;
constexpr size_t WS_RSTD = 1 * MiB;
constexpr size_t WS_GATES = 2 * MiB;
constexpr size_t WS_SUMSQ = 3 * MiB;
constexpr size_t WS_RW = 5 * MiB;
constexpr size_t WS_LAM = 6 * MiB;
constexpr size_t WS_LRUW = 7 * MiB;
constexpr size_t WS_TOKL = 8 * MiB;
constexpr size_t WS_RSTDL = 10 * MiB;
constexpr size_t WS_GATEL = 12 * MiB;
constexpr size_t WS_TOKSLOT = 14 * MiB;
constexpr size_t WS_WIN = 16 * MiB;
constexpr size_t WS_WOUT = 40 * MiB;
constexpr size_t WS_WS5IN = 48 * MiB, WS_WGLUV = 56 * MiB, WS_WGLUG = 64 * MiB;
constexpr size_t WS_WMOE0 = 72 * MiB;
constexpr size_t WS_S5WIN = 168 * MiB;
constexpr size_t WS_S5WO = 176 * MiB;
constexpr size_t WS_S5K = 192 * MiB;
constexpr size_t WS_XB = 200 * MiB;
constexpr size_t WS_Y = 328 * MiB;
constexpr size_t WS_P = 456 * MiB;
constexpr size_t WS_H = 456 * MiB;
constexpr size_t WS_PTOK = 540 * MiB;
constexpr size_t WS_PRSTD = 544 * MiB, WS_PGA = 548 * MiB, WS_PGB = 552 * MiB;
constexpr size_t WS_A2 = 456 * MiB;
constexpr size_t WS_XIN = 648 * MiB;
constexpr size_t WS_X8IN = 328 * MiB;
constexpr size_t WS_X8 = 648 * MiB;
constexpr size_t WS_WMOE1 = 840 * MiB;
constexpr size_t WS_END = 936 * MiB;
static_assert(WS_H + (size_t)SLOT_ROWS * 1024 * 2 <= WS_PTOK && WS_PGB + (size_t)NPAIR * T * 4 <= WS_XIN, "moe buffers");
static_assert(WS_A2 + (size_t)128 * 2048 * 384 * 2 <= WS_XIN && WS_XIN + (size_t)128 * 2048 * 128 * 4 <= WS_WMOE1, "s5 buffers");
static_assert(WS_P + (size_t)T * PN * 2 <= WS_WMOE1, "p buffer");
constexpr int CW_BAR = 4096;
constexpr int CW_TMO = 8;
constexpr int CW_PANEL = 32768;
constexpr int CW_CNT = 16384;

constexpr int RING_BYTES = 131072;
constexpr int LDS_BYTES = 163840;
constexpr int MISC_OFF = LDS_BYTES - 1024;
constexpr int MI_PRE = 136, MI_CNT = 164;

struct Frame {
    LAS unsigned char* lds;
    volatile LAS unsigned* MISC;
    gu32* ctl;
    int tid, lane, wave, vcu, G;
    float* out; unsigned char* ws;
    __device__ __forceinline__ const float* in(int i) const {
        const unsigned lo = __builtin_amdgcn_readfirstlane(MISC[64 + 2 * i]), hi = __builtin_amdgcn_readfirstlane(MISC[65 + 2 * i]);
        return (const float*)(((unsigned long long)hi << 32) | lo); }
};

__device__ __forceinline__ void transpose_item(const float* W, int ldw, const float* gain, bf16* WT, int ldt, int nblk, LAS float* scr, int item, int lane) {
    const int kb = item / nblk, nb = item % nblk, k0 = 64 * kb, n0 = 32 * nb;
    float v[32];
#pragma unroll
    for (int i = 0; i < 32; ++i) v[i] = W[(size_t)(k0 + 2 * i + (lane >> 5)) * ldw + n0 + (lane & 31)];
    const int c = lane & 7;
    f32x4 g0 = (f32x4){1.f, 1.f, 1.f, 1.f}, g1 = g0;
    if (gain) { g0 = *(const f32x4*)(gain + k0 + 8 * c); g1 = *(const f32x4*)(gain + k0 + 8 * c + 4); }
#pragma unroll
    for (int i = 0; i < 32; ++i) scr[(2 * i + (lane >> 5)) * 33 + (lane & 31)] = v[i];
    LDS_WAIT(); asm volatile("" ::: "memory");
#pragma unroll
    for (int j = 0; j < 4; ++j) { const int n = (lane >> 3) + 8 * j; const LAS float* s = scr + (8 * c) * 33 + n;
        u32x4 o; o.x = pk2(s[0 * 33] * g0[0], s[1 * 33] * g0[1]); o.y = pk2(s[2 * 33] * g0[2], s[3 * 33] * g0[3]); o.z = pk2(s[4 * 33] * g1[0], s[5 * 33] * g1[1]); o.w = pk2(s[6 * 33] * g1[2], s[7 * 33] * g1[3]);
        *(GAS u32x4*)(WT + (size_t)(n0 + n) * ldt + k0 + 8 * c) = o; }
    LDS_WAIT(); asm volatile("" ::: "memory");
}
__device__ __forceinline__ void transpose_item8(const float* W, int ldw, const float* gain, unsigned char* WT, int ldt, int nblk, LAS float* scr, int item, int lane, float sc) {
    const int kb = item / nblk, nb = item % nblk, k0 = 64 * kb, n0 = 32 * nb;
    float v[32];
#pragma unroll
    for (int i = 0; i < 32; ++i) v[i] = W[(size_t)(k0 + 2 * i + (lane >> 5)) * ldw + n0 + (lane & 31)];
    const int c = lane & 7;
    f32x4 g0 = (f32x4){sc, sc, sc, sc}, g1 = g0;
    if (gain) { g0 = *(const f32x4*)(gain + k0 + 8 * c) * sc; g1 = *(const f32x4*)(gain + k0 + 8 * c + 4) * sc; }
#pragma unroll
    for (int i = 0; i < 32; ++i) scr[(2 * i + (lane >> 5)) * 33 + (lane & 31)] = v[i];
    LDS_WAIT(); asm volatile("" ::: "memory");
#pragma unroll
    for (int j = 0; j < 4; ++j) { const int n = (lane >> 3) + 8 * j; const LAS float* s = scr + (8 * c) * 33 + n;
        u32x2 o; o.x = pk4_f8(s[0 * 33] * g0[0], s[1 * 33] * g0[1], s[2 * 33] * g0[2], s[3 * 33] * g0[3]); o.y = pk4_f8(s[4 * 33] * g1[0], s[5 * 33] * g1[1], s[6 * 33] * g1[2], s[7 * 33] * g1[3]);
        *(GAS u32x2*)(WT + (size_t)(n0 + n) * ldt + k0 + 8 * c) = o; }
    LDS_WAIT(); asm volatile("" ::: "memory");
}
__device__ __forceinline__ void sincos_d(double th, double& s, double& c) {
    const double TWO_PI = 6.283185307179586476925286766559;
    const double k = __builtin_rint(th / TWO_PI); const double x = th - k * TWO_PI;
    const double x2 = x * x; double ts = x, tc = 1.0; s = x; c = 1.0;
#pragma unroll
    for (int i = 1; i <= 16; ++i) { tc *= -x2 / (double)((2 * i - 1) * (2 * i)); ts *= -x2 / (double)((2 * i) * (2 * i + 1)); c += tc; s += ts; }
}
__device__ __forceinline__ void s5_build_group(Frame& F, int g, int half) {
    LAS float* pwr = (LAS float*)(F.lds);
    LAS float* pwi = pwr + 17 * 64;
    LAS float* bbr = pwi + 17 * 64;
    LAS float* bbi = bbr + 1024;
    LAS float* cre = bbi + 1024;
    LAS float* cim = cre + 1024;
    LAS float* km = cim + 1024;
    LAS float* ff = km + 4096;
    LAS float* ctr = ff + 128;
    LAS float* cti = ctr + 1024;
    const int tid = F.tid;
    const float* a_re = F.in(19) + g * 64; const float* a_im = F.in(20) + g * 64;
    if (tid < 64) {
        const double dt = (double)expf(F.in(21)[g]), ar = (double)a_re[tid], ai = (double)a_im[tid];
        const double mag = (double)expf((float)(ar * dt)); double sn, cs; sincos_d(ai * dt, sn, cs);
        const double lr = mag * cs, li = mag * sn; double pr = 1.0, pi = 0.0;
        for (int d = 0; d <= 16; ++d) { pwr[d * 64 + tid] = (float)pr; pwi[d * 64 + tid] = (float)pi; const double nr = pr * lr - pi * li, ni = pr * li + pi * lr; pr = nr; pi = ni; }
        const double den = ar * ar + ai * ai;
        ff[tid] = (float)(((lr - 1.0) * ar + li * ai) / den); ff[64 + tid] = (float)((li * ar - (lr - 1.0) * ai) / den);
        if (half == 0) {
            double q16r = 1.0, q16i = 0.0;
            for (int d = 0; d < 16; ++d) { const double nr = q16r * lr - q16i * li, ni = q16r * li + q16i * lr; q16r = nr; q16i = ni; }
            double q64r = q16r, q64i = q16i;
            for (int d = 0; d < 2; ++d) { const double nr = q64r * q64r - q64i * q64i, ni = 2.0 * q64r * q64i; q64r = nr; q64i = ni; }
            *(f32x4*)((float*)(F.ws + WS_LAM) + ((size_t)g * 64 + tid) * 4) = (f32x4){(float)q16r, (float)q16i, (float)q64r, (float)q64i};
        }
    }
    __syncthreads();
    { const float* pbr = F.in(22) + g * 1024; const float* pbi = F.in(23) + g * 1024; const float* pcr = F.in(24) + g * 1024; const float* pci = F.in(25) + g * 1024;
    for (int idx = tid; idx < 1024; idx += NT) { const int p = idx >> 4; const float br = pbr[idx], bi = pbi[idx]; const float fr = ff[p], fi = ff[64 + p];
        bbr[idx] = fr * br - fi * bi; bbi[idx] = fr * bi + fi * br; const float cr_ = pcr[idx], ci_ = pci[idx]; cre[idx] = cr_; cim[idx] = ci_;
        ctr[(idx & 63) * 16 + (idx >> 6)] = cr_; cti[(idx & 63) * 16 + (idx >> 6)] = ci_; } }
    __syncthreads();
    if (tid < 256) {
        const int d = tid >> 4, co = tid & 15; float ac[16];
#pragma unroll
        for (int ci = 0; ci < 16; ++ci) ac[ci] = 0.f;
        for (int p = 0; p < 64; ++p) { const float c_r = ctr[p * 16 + co], c_i = cti[p * 16 + co], l_r = pwr[d * 64 + p], l_i = pwi[d * 64 + p];
            const float tr = c_r * l_r - c_i * l_i, ti = c_r * l_i + c_i * l_r;
#pragma unroll
            for (int c4 = 0; c4 < 4; ++c4) { const f32x4 br = *(const LAS f32x4*)(bbr + p * 16 + 4 * c4), bi = *(const LAS f32x4*)(bbi + p * 16 + 4 * c4);
#pragma unroll
                for (int j = 0; j < 4; ++j) ac[4 * c4 + j] += tr * br[j] - ti * bi[j]; } }
#pragma unroll
        for (int c4 = 0; c4 < 4; ++c4) *(LAS f32x4*)(km + (d << 8) + (co << 4) + 4 * c4) = (f32x4){ac[4 * c4], ac[4 * c4 + 1], ac[4 * c4 + 2], ac[4 * c4 + 3]};
    }
    __syncthreads();
    const float* dsk = F.in(26) + g * 16;
    if (half == 0) { bf16* KB = (bf16*)(F.ws + WS_S5K) + (size_t)g * 4096;
        for (int idx = tid; idx < 4096; idx += NT) { const int co = (idx >> 4) & 15, ci = idx & 15; float v = km[idx]; if (idx < 256 && ci == co) v += dsk[co]; KB[idx] = (bf16)f2bf(v); } }
    bf16* Wo = (bf16*)(F.ws + WS_S5WO) + (size_t)g * 256 * 128;
    for (int idx = half * 128 * 128 + tid; idx < (half + 1) * 128 * 128; idx += NT) { const int row = idx >> 7, q = idx & 127, tl = row >> 4, co = row & 15, p = 8 * (q >> 4) + (q & 7), part = (q >> 3) & 1;
        const float c_r = cre[co * 64 + p], c_i = cim[co * 64 + p], l_r = pwr[(tl + 1) * 64 + p], l_i = pwi[(tl + 1) * 64 + p];
        Wo[idx] = (bf16)f2bf((part == 0) ? (c_r * l_r - c_i * l_i) : -(c_r * l_i + c_i * l_r)); }
    bf16* Wi = (bf16*)(F.ws + WS_S5WIN) + (size_t)g * 128 * 256;
    for (int idx = half * 64 * 256 + tid; idx < (half + 1) * 64 * 256; idx += NT) { const int row = idx >> 8, col = idx & 255, p = 8 * (row >> 4) + (row & 7), part = (row >> 3) & 1, j = col >> 4, ci = col & 15, d = 15 - j;
        const float l_r = pwr[d * 64 + p], l_i = pwi[d * 64 + p], b_r = bbr[p * 16 + ci], b_i = bbi[p * 16 + ci];
        Wi[idx] = (bf16)f2bf(part == 0 ? (l_r * b_r - l_i * b_i) : (l_r * b_i + l_i * b_r)); }
    __syncthreads();
}

__device__ __forceinline__ void ph_prologue(Frame& F, int pf) {
    LAS float* scr = (LAS float*)(F.lds + F.wave * 16384);
    const int gw = F.vcu * NWAVES + F.wave, NGW = F.G * NWAVES, lane = F.lane;
    constexpr int I_IN = 32 * 192, I_SQ = 32 * 64, I_MOE = 512;
    constexpr int NITEMS = I_IN + 4 * I_SQ + 96 * I_MOE;
    if (!(pf & 16))
    for (int it = gw; it < NITEMS; it += NGW) {
        int r = it;
        if (r < I_IN) { if ((r % 192) < 64) transpose_item8(F.in(4), INCOLS, F.in(1), F.ws + WS_WIN, 2048, 192, scr, r, lane, F8_SW);
            else transpose_item(F.in(4), INCOLS, F.in(1), (bf16*)(F.ws + WS_WIN), 2048, 192, scr, r, lane); continue; } r -= I_IN;
        if (r < I_SQ) { transpose_item(F.in(17), 2048, nullptr, (bf16*)(F.ws + WS_WOUT), 2048, 64, scr, r, lane); continue; } r -= I_SQ;
        if (r < I_SQ) { transpose_item8(F.in(18), 2048, F.in(1) + 2048, F.ws + WS_WS5IN, 2048, 64, scr, r, lane, F8_SW); continue; } r -= I_SQ;
        if (r < I_SQ) { transpose_item8(F.in(27), 2048, nullptr, F.ws + WS_WGLUV, 2048, 64, scr, r, lane, F8_SW); continue; } r -= I_SQ;
        if (r < I_SQ) { transpose_item8(F.in(28), 2048, nullptr, F.ws + WS_WGLUG, 2048, 64, scr, r, lane, F8_SW); continue; } r -= I_SQ;
        const int mat = r / I_MOE, itx = r % I_MOE, l = mat / 48, rem = mat % 48, kind = rem / 16, e = rem % 16;
        unsigned char* base = F.ws + (l ? WS_WMOE1 : WS_WMOE0);
        if (kind < 2) transpose_item8((kind == 0 ? F.in(33) : F.in(34)) + (size_t)(l * 16 + e) * 2048 * 512, 512, F.in(2) + l * 2048, base + (size_t)kind * 32 * MiB + (size_t)e * 512 * 2048, 2048, 16, scr, itx, lane, F8_SW);
        else transpose_item8(F.in(35) + (size_t)(l * 16 + e) * 512 * 2048, 2048, nullptr, base + (size_t)64 * MiB + (size_t)e * 2048 * 512, 512, 64, scr, itx, lane, F8_SWD);
    }
    __syncthreads();
    if (!(pf & 32)) for (int gh = F.vcu; gh < 256; gh += F.G) s5_build_group(F, gh >> 1, gh & 1);
    __syncthreads();
    const int gt = F.vcu * NT + F.tid, NGT = F.G * NT;
    {
        bf16* LW = (bf16*)(F.ws + WS_LRUW); const float* wa_ = F.in(7); const float* wx_ = F.in(9); const float* wc_ = F.in(29); const float* wf_ = F.in(31); const float* nf_ = F.in(2);
        for (int idx = gt; idx < 8 * 256 * 128; idx += NGT) { const int n = idx >> 15, o = (idx >> 7) & 255, i = idx & 127;
            const float v = (o < 128) ? wa_[(size_t)(n * 128 + i) * 128 + o] : wx_[(size_t)(n * 128 + i) * 128 + (o - 128)]; LW[idx] = (bf16)f2bf(v); }
        float* RW = (float*)(F.ws + WS_RW);
        bf16* RWB = (bf16*)RW;
        for (int idx = gt; idx < 2 * 32 * 2048; idx += NGT) { const int l = idx >> 16, n = (idx >> 11) & 31, k = idx & 2047;
            const float w = (n < 4) ? wc_[(size_t)(l * 2048 + k) * 4 + n] * nf_[l * 2048 + k] : (n < 20) ? wf_[(size_t)(l * 2048 + k) * 16 + (n - 4)] * nf_[l * 2048 + k] : 0.f;
            const unsigned hi = f2bf(w); const float lo = w - __builtin_bit_cast(float, hi << 16);
            RWB[((size_t)(l * 2 + 0) * 32 + n) * 2048 + k] = (bf16)hi; RWB[((size_t)(l * 2 + 1) * 32 + n) * 2048 + k] = (bf16)f2bf(lo); }
    }
    LAS float* wgT = (LAS float*)F.lds;
    { const float* win = F.in(4); const float* nm0 = F.in(1);
    for (int idx = F.tid; idx < 16384; idx += NT) { const int k = idx >> 3, c = idx & 7; wgT[c * 2048 + k] = win[(size_t)k * INCOLS + 6144 + c] * nm0[k]; } }
    __syncthreads();
    const float* x = F.in(0); bf16* xb = (bf16*)(F.ws + WS_XB); unsigned char* x8 = F.ws + WS_X8IN; float* rstd_o = (float*)(F.ws + WS_RSTD); float* gates = (float*)(F.ws + WS_GATES);
    const float bias = (lane < 4) ? F.in(14)[lane & 3] : F.in(15)[lane & 3];
    if (!(pf & 64))
    for (int m0 = 2 * gw; m0 < T; m0 += 2 * NGW) {
        f32x4 v[2][8]; float ss[2] = {0.f, 0.f};
#pragma unroll
        for (int q = 0; q < 2; ++q) { const GAS f32x4* xr = (const GAS f32x4*)(x + (size_t)(m0 + q) * D) + lane;
#pragma unroll
            for (int j = 0; j < 8; ++j) v[q][j] = xr[64 * j]; }
#pragma unroll
        for (int q = 0; q < 2; ++q) { const int m = m0 + q;
#pragma unroll
            for (int j = 0; j < 8; ++j) ss[q] += (v[q][j].x * v[q][j].x + v[q][j].y * v[q][j].y) + (v[q][j].z * v[q][j].z + v[q][j].w * v[q][j].w);
            ss[q] = wave_sum(ss[q]); const float rstd = 1.0f / sqrtf(ss[q] * (1.0f / D) + EPS);
            GAS u32x2* o8 = (GAS u32x2*)(xb + (size_t)m * D) + lane; GAS unsigned* o4 = (GAS unsigned*)(x8 + (size_t)m * D) + lane;
#pragma unroll
            for (int j = 0; j < 8; ++j) { u32x2 w; w.x = pk2(v[q][j].x, v[q][j].y); w.y = pk2(v[q][j].z, v[q][j].w); o8[64 * j] = w;
                o4[64 * j] = pk4_f8(v[q][j].x * F8_SX, v[q][j].y * F8_SX, v[q][j].z * F8_SX, v[q][j].w * F8_SX); }
            float ga[8];
#pragma unroll
            for (int c = 0; c < 8; ++c) { float a = 0.f;
#pragma unroll
                for (int j = 0; j < 8; ++j) { const f32x4 w = *(const LAS f32x4*)(wgT + c * 2048 + 4 * (lane + 64 * j)); a += (v[q][j].x * w.x + v[q][j].y * w.y) + (v[q][j].z * w.z + v[q][j].w * w.w); }
                ga[c] = wave_sum(a); asm volatile("" ::: "memory"); }
            float val = ga[0];
#pragma unroll
            for (int c = 1; c < 8; ++c) val = (lane == c) ? ga[c] : val;
            if (lane < 8) gates[(size_t)m * 8 + lane] = val * rstd + bias;
            if (lane == 0) rstd_o[m] = rstd; }
    }
    __syncthreads();
}

__device__ __forceinline__ unsigned ld_agent_u32(const unsigned* p) { return __hip_atomic_load(p, RLX_AGENT); }
__device__ __forceinline__ float ld_agent_f32(const float* p) { return __builtin_bit_cast(float, __hip_atomic_load((const unsigned*)p, RLX_AGENT)); }
using pg8::Unit;

struct DenseSched {
    pg8::TileOrder to; const char* A; size_t tstepA; const char* B0; const char* B1; size_t tstepB; int cpt;
    __device__ __forceinline__ bool next(int i, Unit& u) const { int pm, pn; if (!to.next(i, pm, pn)) return false;
        u.a = A + (size_t)pm * tstepA; u.b0 = B0 + (size_t)pn * tstepB; u.b1 = B1 + (size_t)pn * tstepB; u.b0x = u.b0; u.b1x = u.b1; u.r0 = pm * 256; u.c0 = pn * cpt; u.aux = 0; u.x = 0; return true; }
    __device__ __forceinline__ unsigned row_off(const Unit&, int) const { return 0u; }
    __device__ __forceinline__ void a_ready(const Unit&) const {}
};
struct S5Sched {
    int G, c; const char* A; const char* B; size_t gstepB; size_t hstepB;
    __device__ __forceinline__ bool next(int i, Unit& u) const { const int L = i * G + c; if (L >= 1024) return false; const int g = L >> 3, pm = L & 7;
        u.a = A + ((size_t)g * 2048 + (size_t)pm * 256) * 768; u.b0 = B + (size_t)g * gstepB; u.b1 = u.b0 + hstepB; u.b0x = u.b0; u.b1x = u.b1; u.r0 = pm * 256; u.c0 = 0; u.aux = g; u.x = 0; return true; }
    __device__ __forceinline__ unsigned row_off(const Unit&, int) const { return 0u; }
    __device__ __forceinline__ void a_ready(const Unit&) const {}
};
__device__ __forceinline__ void pair_experts(int q, int& ea, int& eb) { const int g = q / 6, p = q - 6 * g; const int ia = (p < 3) ? 0 : (p < 5) ? 1 : 2, ib = (p < 3) ? p + 1 : (p < 5) ? p - 1 : 3; ea = 4 * g + ia; eb = 4 * g + ib; }
template <bool DOWN> struct MoeSched {
    volatile LAS unsigned* misc; int G, c; const char* W0; const char* W1; const char* Hd; const int* ptok;
    __device__ __forceinline__ bool next(int i, Unit& u) const {
        const int L = i * G + c, ntiles = __builtin_amdgcn_readfirstlane((int)misc[MI_PRE + NPAIR]); if (L >= ntiles * 8) return false;
        int q = 0;
#pragma unroll
        for (int j = 1; j < NPAIR; ++j) q += ((L >> 3) >= __builtin_amdgcn_readfirstlane((int)misc[MI_PRE + j])) ? 1 : 0;
        const int pq = __builtin_amdgcn_readfirstlane((int)misc[MI_PRE + q]), tq = __builtin_amdgcn_readfirstlane((int)misc[MI_PRE + q + 1]) - pq, loc = L - 8 * pq;
        const int ct = loc / tq, gr = pq + (loc - ct * tq);
        int ea, eb; pair_experts(q, ea, eb);
        u.aux = q; u.r0 = gr * 256; u.x = (gr - pq) * 256;
        if (!DOWN) { const int e = (ct < 4) ? ea : eb; u.c0 = ct * 128; u.a = nullptr;
            u.b0 = W0 + (size_t)e * 512 * 2048 + (size_t)(ct & 3) * 128 * 2048; u.b1 = W1 + (size_t)e * 512 * 2048 + (size_t)(ct & 3) * 128 * 2048; u.b0x = u.b0; u.b1x = u.b1; }
        else { u.c0 = ct * 256; u.a = Hd + (size_t)gr * 256 * 1024;
            u.b0 = W0 + (size_t)ea * 2048 * 512 + (size_t)ct * 256 * 512; u.b1 = u.b0 + (size_t)128 * 512; u.b0x = W0 + (size_t)eb * 2048 * 512 + (size_t)ct * 256 * 512; u.b1x = u.b0x + (size_t)128 * 512; }
        return true; }
    __device__ __forceinline__ unsigned row_off(const Unit& u, int row) const { const int cnt = __builtin_amdgcn_readfirstlane((int)misc[MI_CNT + u.aux]); int idx = u.x + row; idx = idx < cnt ? idx : cnt - 1;
        return (unsigned)ptok[(size_t)u.aux * T + idx] * 2048u; }
};

struct EpiScaleBf16 {
    static constexpr bool PERM = true;
    bf16* O; int ldc; const float* scale; int pf; float k;
    __device__ __forceinline__ void operator()(const f32x4 (&acc)[2][2][4][2], const Unit& u, int wr, int wc, int fr, int fq) const {
        const int row0 = u.r0 + wr * 64 + fr, col0 = u.c0 + wc * 32 + 8 * fq;
        float sv[2][4];
#pragma unroll
        for (int ai = 0; ai < 2; ++ai)
#pragma unroll
            for (int m = 0; m < 4; ++m) sv[ai][m] = scale[row0 + ai * 128 + m * 16];
#pragma unroll
        for (int ai = 0; ai < 2; ++ai)
#pragma unroll
            for (int m = 0; m < 4; ++m) { int zz = 0; asm volatile("" : "+v"(zz)); const int row = row0 + ai * 128 + m * 16 + zz; const float s = sv[ai][m] * k; bf16* rowp = O + (size_t)row * ldc + col0;
#pragma unroll
                for (int bj = 0; bj < 2; ++bj) { const f32x4 v0 = acc[ai][bj][m][0] * s, v1 = acc[ai][bj][m][1] * s;
                    u32x4 w; w.x = pk2(v0[0], v0[1]); w.y = pk2(v0[2], v0[3]); w.z = pk2(v1[0], v1[1]); w.w = pk2(v1[2], v1[3]);
                    if (!(pf & 16)) *(u32x4*)(rowp + bj * 128) = w; else asm volatile("" :: "v"(w.x), "v"(w.y), "v"(w.z), "v"(w.w)); } }
    }
};
struct EpiS5U {
    static constexpr bool PERM = true;
    bf16* A2; const float* scale; float k;
    __device__ __forceinline__ void operator()(const f32x4 (&acc)[2][2][4][2], const Unit& u, int wr, int wc, int fr, int fq) const {
        const int row0 = u.r0 + wr * 64 + fr, col0 = u.c0 + wc * 32 + 8 * fq;
        float sv[2][4];
#pragma unroll
        for (int ai = 0; ai < 2; ++ai)
#pragma unroll
            for (int m = 0; m < 4; ++m) sv[ai][m] = scale[row0 + ai * 128 + m * 16];
#pragma unroll
        for (int ai = 0; ai < 2; ++ai)
#pragma unroll
            for (int m = 0; m < 4; ++m) { int zz = 0; asm volatile("" : "+v"(zz)); const int t = row0 + ai * 128 + m * 16 + zz; const float s = sv[ai][m] * k; const int n = t >> 4, tl = t & 15;
#pragma unroll
                for (int bj = 0; bj < 2; ++bj) { const int c = col0 + bj * 128, g = c >> 4, half = (c >> 3) & 1; const f32x4 v0 = acc[ai][bj][m][0] * s, v1 = acc[ai][bj][m][1] * s;
                    u32x4 w; w.x = pk2(v0[0], v0[1]); w.y = pk2(v0[2], v0[3]); w.z = pk2(v1[0], v1[1]); w.w = pk2(v1[2], v1[3]);
                    *(u32x4*)(A2 + ((size_t)g * 2048 + n) * 256 + tl * 16 + half * 8) = w; } }
    }
};
struct EpiOutRes {
    static constexpr bool PERM = true;
    bf16* xb; unsigned char* x8;
    __device__ __forceinline__ void operator()(const f32x4 (&acc)[2][2][4][2], const Unit& u, int wr, int wc, int fr, int fq) const {
        const int row0 = u.r0 + wr * 64 + fr, col0 = u.c0 + wc * 32 + 8 * fq;
        u32x4 xr[2][4][2];
#pragma unroll
        for (int ai = 0; ai < 2; ++ai)
#pragma unroll
            for (int m = 0; m < 4; ++m)
#pragma unroll
                for (int bj = 0; bj < 2; ++bj) xr[ai][m][bj] = *(const u32x4*)(xb + (size_t)(row0 + ai * 128 + m * 16) * D + col0 + bj * 128);
#pragma unroll
        for (int ai = 0; ai < 2; ++ai)
#pragma unroll
            for (int m = 0; m < 4; ++m) { int zz = 0; asm volatile("" : "+v"(zz)); const size_t off = (size_t)(row0 + ai * 128 + m * 16 + zz) * D + col0;
#pragma unroll
                for (int bj = 0; bj < 2; ++bj) { const f32x4 a0 = acc[ai][bj][m][0], a1 = acc[ai][bj][m][1]; const u32x4 x = xr[ai][m][bj];
                    const float v0 = bf_lo(x.x) + a0[0], v1 = bf_hi(x.x) + a0[1], v2 = bf_lo(x.y) + a0[2], v3 = bf_hi(x.y) + a0[3], v4 = bf_lo(x.z) + a1[0], v5 = bf_hi(x.z) + a1[1], v6 = bf_lo(x.w) + a1[2], v7 = bf_hi(x.w) + a1[3];
                    u32x4 w; w.x = pk2(v0, v1); w.y = pk2(v2, v3); w.z = pk2(v4, v5); w.w = pk2(v6, v7);
                    *(u32x4*)(xb + off + bj * 128) = w;
                    u32x2 o; o.x = pk4_f8(v0 * F8_SX, v1 * F8_SX, v2 * F8_SX, v3 * F8_SX); o.y = pk4_f8(v4 * F8_SX, v5 * F8_SX, v6 * F8_SX, v7 * F8_SX);
                    *(u32x2*)(x8 + off + bj * 128) = o; } }
    }
};
struct EpiGlu {
    static constexpr bool PERM = true;
    bf16* xb; unsigned char* x8;
    __device__ __forceinline__ void operator()(const f32x4 (&acc)[2][2][4][2], const Unit& u, int wr, int wc, int fr, int fq) const {
        const int row0 = u.r0 + wr * 64 + fr, col0 = u.c0 + wc * 32 + 8 * fq;
        u32x4 xr[2][4];
#pragma unroll
        for (int ai = 0; ai < 2; ++ai)
#pragma unroll
            for (int m = 0; m < 4; ++m) xr[ai][m] = *(const u32x4*)(xb + (size_t)(row0 + ai * 128 + m * 16) * D + col0);
#pragma unroll
        for (int ai = 0; ai < 2; ++ai)
#pragma unroll
            for (int m = 0; m < 4; ++m) { int zz = 0; asm volatile("" : "+v"(zz)); const size_t off = (size_t)(row0 + ai * 128 + m * 16 + zz) * D + col0;
                constexpr float kk = 1.0f / (F8_SY * F8_SW);
                const f32x4 a0 = acc[ai][0][m][0] * kk, a1 = acc[ai][0][m][1] * kk, g0 = acc[ai][1][m][0] * kk, g1 = acc[ai][1][m][1] * kk; const u32x4 x = xr[ai][m];
                const float v0 = bf_lo(x.x) + a0[0] * sigmoidf_(g0[0]), v1 = bf_hi(x.x) + a0[1] * sigmoidf_(g0[1]), v2 = bf_lo(x.y) + a0[2] * sigmoidf_(g0[2]), v3 = bf_hi(x.y) + a0[3] * sigmoidf_(g0[3]);
                const float v4 = bf_lo(x.z) + a1[0] * sigmoidf_(g1[0]), v5 = bf_hi(x.z) + a1[1] * sigmoidf_(g1[1]), v6 = bf_lo(x.w) + a1[2] * sigmoidf_(g1[2]), v7 = bf_hi(x.w) + a1[3] * sigmoidf_(g1[3]);
                u32x4 w; w.x = pk2(v0, v1); w.y = pk2(v2, v3); w.z = pk2(v4, v5); w.w = pk2(v6, v7);
                *(u32x4*)(xb + off) = w;
                u32x2 o; o.x = pk4_f8(v0 * F8_SX, v1 * F8_SX, v2 * F8_SX, v3 * F8_SX); o.y = pk4_f8(v4 * F8_SX, v5 * F8_SX, v6 * F8_SX, v7 * F8_SX);
                *(u32x2*)(x8 + off) = o; }
    }
};
struct EpiGateUp {
    static constexpr bool PERM = true;
    unsigned char* H; const float* prstd; const float* pga; const float* pgb; volatile LAS unsigned* misc; int pf;
    __device__ __forceinline__ void operator()(const f32x4 (&acc)[2][2][4][2], const Unit& u, int wr, int wc, int fr, int fq) const {
        if (pf & 16) { asm volatile("" :: "v"(acc[0][0][0][0][0]), "v"(acc[1][1][3][1][3])); return; }
        const int rl0 = wr * 64 + fr, col0 = u.c0 + wc * 32 + 8 * fq, cnt = __builtin_amdgcn_readfirstlane((int)misc[MI_CNT + u.aux]);
        const float* pg = (u.c0 < 512) ? pga : pgb;
        float sv[2][4], gv[2][4];
#pragma unroll
        for (int ai = 0; ai < 2; ++ai)
#pragma unroll
            for (int m = 0; m < 4; ++m) { int idx = u.x + rl0 + ai * 128 + m * 16; idx = idx < cnt ? idx : cnt - 1; sv[ai][m] = prstd[(size_t)u.aux * T + idx]; gv[ai][m] = pg[(size_t)u.aux * T + idx]; }
#pragma unroll
        for (int ai = 0; ai < 2; ++ai)
#pragma unroll
            for (int m = 0; m < 4; ++m) { int zz = 0; asm volatile("" : "+v"(zz)); const int rl = rl0 + ai * 128 + m * 16 + zz; const float r = sv[ai][m] * (1.0f / (F8_SX * F8_SW)), gt = gv[ai][m] * r * F8_SH;
                float hv[8];
#pragma unroll
                for (int n = 0; n < 2; ++n)
#pragma unroll
                    for (int j = 0; j < 4; ++j) hv[n * 4 + j] = siluf_(acc[ai][0][m][n][j] * r) * (acc[ai][1][m][n][j] * gt);
                u32x2 w; w.x = pk4_f8(hv[0], hv[1], hv[2], hv[3]); w.y = pk4_f8(hv[4], hv[5], hv[6], hv[7]);
                *(u32x2*)(H + (size_t)(u.r0 + rl) * 1024 + col0) = w; }
    }
};
struct EpiDownRes {
    static constexpr bool PERM = true;
    bf16* xb; const int* ptok; volatile LAS unsigned* misc; bf16* dst; unsigned char* x8;
    __device__ __forceinline__ void operator()(const f32x4 (&acc)[2][2][4][2], const Unit& u, int wr, int wc, int fr, int fq) const {
        const int rl0 = wr * 64 + fr, col0 = u.c0 + wc * 32 + 8 * fq, cnt = __builtin_amdgcn_readfirstlane((int)misc[MI_CNT + u.aux]);
        int tk[2][4];
#pragma unroll
        for (int ai = 0; ai < 2; ++ai)
#pragma unroll
            for (int m = 0; m < 4; ++m) { const int idx = u.x + rl0 + ai * 128 + m * 16; tk[ai][m] = (idx < cnt) ? ptok[(size_t)u.aux * T + idx] : -1; }
        u32x4 xr[2][4][2];
#pragma unroll
        for (int ai = 0; ai < 2; ++ai)
#pragma unroll
            for (int m = 0; m < 4; ++m)
#pragma unroll
                for (int bj = 0; bj < 2; ++bj) xr[ai][m][bj] = (tk[ai][m] >= 0) ? *(const u32x4*)(xb + (size_t)tk[ai][m] * D + col0 + bj * 128) : (u32x4){0u, 0u, 0u, 0u};
#pragma unroll
        for (int ai = 0; ai < 2; ++ai)
#pragma unroll
            for (int m = 0; m < 4; ++m) { int zz = 0; asm volatile("" : "+v"(zz)); const int tok = tk[ai][m] + zz;
                if (tok >= 0) {
#pragma unroll
                    for (int bj = 0; bj < 2; ++bj) { constexpr float kk = 1.0f / (F8_SH * F8_SWD); const f32x4 a0 = acc[ai][bj][m][0] * kk, a1 = acc[ai][bj][m][1] * kk; const u32x4 x = xr[ai][m][bj];
                        const float v0 = bf_lo(x.x) + a0[0], v1 = bf_hi(x.x) + a0[1], v2 = bf_lo(x.y) + a0[2], v3 = bf_hi(x.y) + a0[3], v4 = bf_lo(x.z) + a1[0], v5 = bf_hi(x.z) + a1[1], v6 = bf_lo(x.w) + a1[2], v7 = bf_hi(x.w) + a1[3];
                        u32x4 w; w.x = pk2(v0, v1); w.y = pk2(v2, v3); w.z = pk2(v4, v5); w.w = pk2(v6, v7);
                        *(u32x4*)(dst + (size_t)tok * D + col0 + bj * 128) = w;
                        if (x8) { u32x2 o; o.x = pk4_f8(v0 * F8_SX, v1 * F8_SX, v2 * F8_SX, v3 * F8_SX); o.y = pk4_f8(v4 * F8_SX, v5 * F8_SX, v6 * F8_SX, v7 * F8_SX);
                            *(u32x2*)(x8 + (size_t)tok * D + col0 + bj * 128) = o; } } } }
    }
};
struct EpiXin {
    static constexpr bool PERM = false;
    float* X;
    __device__ __forceinline__ void operator()(const f32x4 (&acc)[2][2][4][2], const Unit& u, int wr, int wc, int fr, int fq) const {
        const int rl0 = u.r0 + wr * 64 + fr, col0 = wc * 32 + 4 * fq;
#pragma unroll
        for (int ai = 0; ai < 2; ++ai)
#pragma unroll
            for (int m = 0; m < 4; ++m) { int zz = 0; asm volatile("" : "+v"(zz)); float* rowp = X + ((size_t)u.aux * 2048 + rl0 + ai * 128 + m * 16 + zz) * 128 + col0;
#pragma unroll
                for (int n = 0; n < 2; ++n) *(f32x4*)(rowp + n * 16) = acc[ai][0][m][n]; }
    }
};
struct EpiS5Y {
    static constexpr bool PERM = true;
    bf16* Y2;
    __device__ __forceinline__ void operator()(const f32x4 (&acc)[2][2][4][2], const Unit& u, int wr, int wc, int fr, int fq) const {
        const int rl0 = u.r0 + wr * 64 + fr, col0 = wc * 32 + 8 * fq;
#pragma unroll
        for (int ai = 0; ai < 2; ++ai)
#pragma unroll
            for (int m = 0; m < 4; ++m) { int zz = 0; asm volatile("" : "+v"(zz)); const int n = rl0 + ai * 128 + m * 16 + zz;
#pragma unroll
                for (int bj = 0; bj < 2; ++bj) { const int c = col0 + bj * 128, tl = c >> 4, half = (c >> 3) & 1; const f32x4 a0 = acc[ai][bj][m][0], a1 = acc[ai][bj][m][1];
                    u32x4 w; w.x = pk2(gelu_tanh(a0[0]), gelu_tanh(a0[1])); w.y = pk2(gelu_tanh(a0[2]), gelu_tanh(a0[3])); w.z = pk2(gelu_tanh(a1[0]), gelu_tanh(a1[1])); w.w = pk2(gelu_tanh(a1[2]), gelu_tanh(a1[3]));
                    const int tok = n * 16 + tl;
                    *(u32x4*)(Y2 + ((((size_t)(tok >> 8) * 128 + u.aux) * 256) + (tok & 255)) * 16 + half * 8) = w; } }
    }
};

constexpr int ML_QP = 528, ML_KTP = 144;
constexpr int ML_Q = 0, ML_K = 33792, ML_KT = 67584, ML_C = 104448, ML_SC = 138240;
constexpr int ML_P = ML_K, ML_VT = ML_K + 9216, ML_VWT = ML_Q;
constexpr int ML_CW = 141824;
__device__ __forceinline__ unsigned bf_elem(const u32x4& v, int i) { const unsigned w = v[i >> 1]; return (i & 1) ? (w >> 16) : (w & 0xffffu); }
__device__ __forceinline__ void mlstm_unit(Frame& F, int b, int hh, int s, int pf) {
    LAS unsigned char* L = F.lds; LAS float* sc = (LAS float*)(L + ML_SC);
    const int tid = F.tid, lane = F.lane, w = F.wave, l15 = lane & 15, lq = lane >> 4;
    const bf16* P = (const bf16*)(F.ws + WS_P); bf16* Y = (bf16*)(F.ws + ((pf & 8) ? WS_XB : WS_Y)); const float* gates = (const float*)(F.ws + WS_GATES); float* sumsq = (float*)(F.ws + ((pf & 8) ? 950 * MiB : WS_SUMSQ));
    const int isk = lane >> 5, e0 = 8 * (lane & 31), cch = (isk ? 1024 : 0) + hh * 256 + e0;
    const float osc = isk ? 0.0625f : 1.0f;
    {
        const float* cwp = F.in(12) + cch; const float* cbp = F.in(13) + cch;
        if (w == 0) {
#pragma unroll
            for (int ih = 0; ih < 2; ++ih) {
#pragma unroll
                for (int j = 0; j < 4; ++j) *(LAS f32x4*)(L + ML_CW + ((ih * 5 + j) * 64 + lane) * 16) = *(const GAS f32x4*)(cwp + j * 2048 + 4 * ih);
                *(LAS f32x4*)(L + ML_CW + ((ih * 5 + 4) * 64 + lane) * 16) = *(const GAS f32x4*)(cbp + 4 * ih); }
        }
    }
    f32x4 cacc[2][4];
#pragma unroll
    for (int q = 0; q < 2; ++q)
#pragma unroll
        for (int dc = 0; dc < 4; ++dc) cacc[q][dc] = (f32x4){0.f, 0.f, 0.f, 0.f};
    for (int idx = tid; idx < 33792 / 16; idx += NT) ((LAS u32x4*)(L + ML_C))[idx] = (u32x4){0u, 0u, 0u, 0u};
    if (tid < 256) sc[512 + tid] = 0.f;
    float m_st = 0.f;
    const int tr = w >> 1, cb2 = 2 * (w & 1);
    const int vj = tid >> 3, vdg = tid & 7;
    u32x4 raw[11];
#pragma unroll
    for (int r = 0; r < 11; ++r) { const int t = 8 * w - 3 + r;
        raw[r] = (t >= 0) ? *(const GAS u32x4*)(P + ((size_t)b * SEQ + t) * PN + 2048 + cch) : (u32x4){0u, 0u, 0u, 0u}; }
    float ipn = 0.f, fpn = 0.f;
    if (w == 0) { ipn = gates[((size_t)b * SEQ + lane) * 8 + hh]; fpn = gates[((size_t)b * SEQ + lane) * 8 + 4 + hh]; }
    __syncthreads();
    for (int ch = 0; ch < 32; ++ch) {
        const int t0 = ch * 64; const size_t row0 = (size_t)b * SEQ + t0;
        const u32x4 vraw = *(const GAS u32x4*)(P + (row0 + vj) * PN + 4096 + hh * 256 + s * 64 + 8 * vdg);
        bf16 ov[4][2];
#pragma unroll
        for (int r = 0; r < 4; ++r) { const size_t prow = (row0 + 16 * tr + 4 * lq + r) * PN + 5120 + hh * 256 + s * 64 + 16 * cb2 + l15; ov[r][0] = P[prow]; ov[r][1] = P[prow + 16]; }
        if (!(pf & 16)) {
            asm volatile("" ::: "memory");
#pragma unroll
            for (int ih = 0; ih < 2; ++ih) {
                const f32x4 cb4 = *(const LAS f32x4*)(L + ML_CW + ((ih * 5 + 4) * 64 + lane) * 16);
                f32x4 cw4[4];
#pragma unroll
                for (int j = 0; j < 4; ++j) cw4[j] = *(const LAS f32x4*)(L + ML_CW + ((ih * 5 + j) * 64 + lane) * 16);
                u32x2 outp[8];
                float xw[3][4];
#pragma unroll
                for (int r = 0; r < 3; ++r) { xw[r][0] = bf_lo(raw[r][2 * ih]); xw[r][1] = bf_hi(raw[r][2 * ih]); xw[r][2] = bf_lo(raw[r][2 * ih + 1]); xw[r][3] = bf_hi(raw[r][2 * ih + 1]); }
#pragma unroll
                for (int r = 0; r < 8; ++r) { float o[4], xc[4];
                    xc[0] = bf_lo(raw[r + 3][2 * ih]); xc[1] = bf_hi(raw[r + 3][2 * ih]); xc[2] = bf_lo(raw[r + 3][2 * ih + 1]); xc[3] = bf_hi(raw[r + 3][2 * ih + 1]);
#pragma unroll
                    for (int i4 = 0; i4 < 4; ++i4) { const float cv = cb4[i4] + cw4[0][i4] * xw[0][i4] + cw4[1][i4] * xw[1][i4] + cw4[2][i4] * xw[2][i4] + cw4[3][i4] * xc[i4]; o[i4] = siluf_(cv) * osc;
                        xw[0][i4] = xw[1][i4]; xw[1][i4] = xw[2][i4]; xw[2][i4] = xc[i4]; }
                    outp[r].x = pk2(o[0], o[1]); outp[r].y = pk2(o[2], o[3]);
                    *(LAS u32x2*)(L + (isk ? ML_K : ML_Q) + (8 * w + r) * ML_QP + (e0 + 4 * ih) * 2) = outp[r]; }
                if (isk) {
#pragma unroll
                    for (int i4 = 0; i4 < 4; ++i4) { u32x4 v;
#define ML_EL(r) ((i4 & 1) ? (outp[r][i4 >> 1] >> 16) : (outp[r][i4 >> 1] & 0xffffu))
                        v.x = ML_EL(0) | (ML_EL(1) << 16); v.y = ML_EL(2) | (ML_EL(3) << 16); v.z = ML_EL(4) | (ML_EL(5) << 16); v.w = ML_EL(6) | (ML_EL(7) << 16);
#undef ML_EL
                        *(LAS u32x4*)(L + ML_KT + (e0 + 4 * ih + i4) * ML_KTP + (8 * w) * 2) = v; }
                }
            }
        }
        asm volatile("" ::: "memory");
        if (ch + 1 < 32) {
#pragma unroll
            for (int r = 0; r < 11; ++r) raw[r] = *(const GAS u32x4*)(P + (row0 + 64 + 8 * w - 3 + r) * PN + 2048 + cch);
        }
        if (w == 0) {
            const float ip = ipn, fp = fpn;
            if (ch + 1 < 32) { ipn = gates[(row0 + 64 + lane) * 8 + hh]; fpn = gates[(row0 + 64 + lane) * 8 + 4 + hh]; }
            const float lf = fminf(fp, 0.f) - __logf(1.0f + __expf(-fabsf(fp)));
            float bc = lf;
#pragma unroll
            for (int o = 1; o < 64; o <<= 1) { const float t = __shfl_up(bc, o); if (lane >= o) bc += t; }
            const float a = ip - bc; float pm = a;
#pragma unroll
            for (int o = 1; o < 64; o <<= 1) { const float t = __shfl_up(pm, o); if (lane >= o) pm = fmaxf(pm, t); }
            const float M = fmaxf(m_st, pm);
            const float M63 = __shfl(M, 63), b63 = __shfl(bc, 63);
            sc[lane] = a; sc[64 + lane] = M; sc[128 + lane] = __expf(m_st - M); sc[192 + lane] = __expf(-(bc + M)); sc[256 + lane] = __expf(a - M63);
            if (lane == 0) sc[768] = __expf(m_st - M63);
            m_st = b63 + M63;
        }
        __syncthreads();
        float pw[2][4] = {{0.f, 0.f, 0.f, 0.f}, {0.f, 0.f, 0.f, 0.f}};
        if (!(pf & 32)) {
            f32x4 s0 = (f32x4){0.f, 0.f, 0.f, 0.f}, s1 = s0;
#pragma unroll
            for (int kk = 0; kk < 8; ++kk) {
                const bf16x8 a = *(const LAS bf16x8*)(L + ML_Q + (16 * tr + l15) * ML_QP + (32 * kk + 8 * lq) * 2);
                const bf16x8 k0 = *(const LAS bf16x8*)(L + ML_K + (16 * cb2 + l15) * ML_QP + (32 * kk + 8 * lq) * 2);
                const bf16x8 k1 = *(const LAS bf16x8*)(L + ML_K + (16 * (cb2 + 1) + l15) * ML_QP + (32 * kk + 8 * lq) * 2);
                s0 = __builtin_amdgcn_mfma_f32_16x16x32_bf16(a, k0, s0, 0, 0, 0); s1 = __builtin_amdgcn_mfma_f32_16x16x32_bf16(a, k1, s1, 0, 0, 0); }
            const int j0 = 16 * cb2 + l15, j1 = j0 + 16; const float a0 = sc[j0], a1 = sc[j1];
#pragma unroll
            for (int r = 0; r < 4; ++r) { const int t = 16 * tr + 4 * lq + r; const float Mt = sc[64 + t];
                pw[0][r] = (j0 <= t) ? s0[r] * __expf(a0 - Mt) : 0.f; pw[1][r] = (j1 <= t) ? s1[r] * __expf(a1 - Mt) : 0.f; }
        }
        __syncthreads();
#pragma unroll
        for (int r = 0; r < 4; ++r) { const int t = 16 * tr + 4 * lq + r;
            *(LAS bf16*)(L + ML_P + t * ML_KTP + (16 * cb2 + l15) * 2) = (bf16)f2bf(pw[0][r]); *(LAS bf16*)(L + ML_P + t * ML_KTP + (16 * cb2 + 16 + l15) * 2) = (bf16)f2bf(pw[1][r]); }
#pragma unroll
        for (int i = 0; i < 8; ++i) *(LAS bf16*)(L + ML_VT + (8 * vdg + i) * ML_KTP + vj * 2) = (bf16)bf_elem(vraw, i);
        __syncthreads();
        {
            const int t = tid >> 3, part = tid & 7;
            const u32x4 pv = *(const LAS u32x4*)(L + ML_P + t * ML_KTP + part * 16);
            float ds = (bf_lo(pv.x) + bf_hi(pv.x)) + (bf_lo(pv.y) + bf_hi(pv.y)) + (bf_lo(pv.z) + bf_hi(pv.z)) + (bf_lo(pv.w) + bf_hi(pv.w));
            float qn = 0.f;
#pragma unroll
            for (int q4 = 0; q4 < 4; ++q4) { const u32x4 qv = *(const LAS u32x4*)(L + ML_Q + t * ML_QP + part * 64 + q4 * 16);
                const f32x4 n0 = *(const LAS f32x4*)(sc + 512 + part * 32 + q4 * 8), n1 = *(const LAS f32x4*)(sc + 512 + part * 32 + q4 * 8 + 4);
                qn += bf_lo(qv.x) * n0[0] + bf_hi(qv.x) * n0[1] + bf_lo(qv.y) * n0[2] + bf_hi(qv.y) * n0[3] + bf_lo(qv.z) * n1[0] + bf_hi(qv.z) * n1[1] + bf_lo(qv.w) * n1[2] + bf_hi(qv.w) * n1[3]; }
#pragma unroll
            for (int o = 1; o < 8; o <<= 1) { ds += __shfl_xor(ds, o); qn += __shfl_xor(qn, o); }
            if (part == 0) sc[320 + t] = ds + sc[128 + t] * qn;
        }
        f32x4 pv0 = (f32x4){0.f, 0.f, 0.f, 0.f}, pv1 = pv0, qc0 = pv0, qc1 = pv0;
        if (!(pf & 64)) {
#pragma unroll
        for (int kk = 0; kk < 2; ++kk) {
            const bf16x8 a = *(const LAS bf16x8*)(L + ML_P + (16 * tr + l15) * ML_KTP + (32 * kk + 8 * lq) * 2);
            const bf16x8 v0 = *(const LAS bf16x8*)(L + ML_VT + (16 * cb2 + l15) * ML_KTP + (32 * kk + 8 * lq) * 2);
            const bf16x8 v1 = *(const LAS bf16x8*)(L + ML_VT + (16 * (cb2 + 1) + l15) * ML_KTP + (32 * kk + 8 * lq) * 2);
            pv0 = __builtin_amdgcn_mfma_f32_16x16x32_bf16(a, v0, pv0, 0, 0, 0); pv1 = __builtin_amdgcn_mfma_f32_16x16x32_bf16(a, v1, pv1, 0, 0, 0); }
#pragma unroll
        for (int kk = 0; kk < 8; ++kk) {
            const bf16x8 a = *(const LAS bf16x8*)(L + ML_Q + (16 * tr + l15) * ML_QP + (32 * kk + 8 * lq) * 2);
            const bf16x8 c0 = *(const LAS bf16x8*)(L + ML_C + (16 * cb2 + l15) * ML_QP + (32 * kk + 8 * lq) * 2);
            const bf16x8 c1 = *(const LAS bf16x8*)(L + ML_C + (16 * (cb2 + 1) + l15) * ML_QP + (32 * kk + 8 * lq) * 2);
            qc0 = __builtin_amdgcn_mfma_f32_16x16x32_bf16(a, c0, qc0, 0, 0, 0); qc1 = __builtin_amdgcn_mfma_f32_16x16x32_bf16(a, c1, qc1, 0, 0, 0); }
        }
        __syncthreads();
        if (!(pf & 64)) {
#pragma unroll
            for (int r = 0; r < 4; ++r) { const int t = 16 * tr + 4 * lq + r; const float wi = sc[128 + t], dn = fmaxf(fabsf(sc[320 + t]), sc[192 + t]); const float inv = __builtin_amdgcn_rcpf(dn);
                const size_t yrow = (row0 + t) * D + 1024 + hh * 256 + s * 64;
                const int d0 = 16 * cb2 + l15, d1 = d0 + 16;
                const float h0 = (pv0[r] + wi * qc0[r]) * inv * sigmoidf_(bf2f(ov[r][0])), h1 = (pv1[r] + wi * qc1[r]) * inv * sigmoidf_(bf2f(ov[r][1]));
                Y[yrow + d0] = (bf16)f2bf(h0); Y[yrow + d1] = (bf16)f2bf(h1);
                float q = h0 * h0 + h1 * h1;
#pragma unroll
                for (int o = 1; o < 16; o <<= 1) q += __shfl_xor(q, o);
                if (l15 == 0) sc[384 + (w & 1) * 64 + t] = q; }
        }
        const float decay = sc[768];
        {
            const float we = sc[256 + vj];
#pragma unroll
            for (int i = 0; i < 8; ++i) *(LAS bf16*)(L + ML_VWT + (8 * vdg + i) * ML_KTP + vj * 2) = (bf16)f2bf(__builtin_bit_cast(float, bf_elem(vraw, i) << 16) * we);
            if (tid < 256) { float a = 0.f;
#pragma unroll
                for (int j8 = 0; j8 < 8; ++j8) { const u32x4 kv = *(const LAS u32x4*)(L + ML_KT + tid * ML_KTP + j8 * 16); const f32x4 w0 = *(const LAS f32x4*)(sc + 256 + j8 * 8), w1 = *(const LAS f32x4*)(sc + 256 + j8 * 8 + 4);
                    a += bf_lo(kv.x) * w0[0] + bf_hi(kv.x) * w0[1] + bf_lo(kv.y) * w0[2] + bf_hi(kv.y) * w0[3] + bf_lo(kv.z) * w1[0] + bf_hi(kv.z) * w1[1] + bf_lo(kv.w) * w1[2] + bf_hi(kv.w) * w1[3]; }
                sc[512 + tid] = decay * sc[512 + tid] + a; }
#pragma unroll
            for (int q = 0; q < 2; ++q)
#pragma unroll
                for (int dc = 0; dc < 4; ++dc) cacc[q][dc] *= decay;
        }
        __syncthreads();
        if (tid < 64) sumsq[(row0 + tid) * 16 + hh * 4 + s] = sc[384 + tid] + sc[448 + tid];
        if (!(pf & 128)) {
#pragma unroll
        for (int kk = 0; kk < 2; ++kk) {
            bf16x8 aE[2], bD[4];
#pragma unroll
            for (int q = 0; q < 2; ++q) aE[q] = *(const LAS bf16x8*)(L + ML_KT + (16 * (2 * w + q) + l15) * ML_KTP + (32 * kk + 8 * lq) * 2);
#pragma unroll
            for (int dc = 0; dc < 4; ++dc) bD[dc] = *(const LAS bf16x8*)(L + ML_VWT + (16 * dc + l15) * ML_KTP + (32 * kk + 8 * lq) * 2);
#pragma unroll
            for (int q = 0; q < 2; ++q)
#pragma unroll
                for (int dc = 0; dc < 4; ++dc) cacc[q][dc] = __builtin_amdgcn_mfma_f32_16x16x32_bf16(aE[q], bD[dc], cacc[q][dc], 0, 0, 0); }
#pragma unroll
        for (int q = 0; q < 2; ++q)
#pragma unroll
            for (int dc = 0; dc < 4; ++dc) { u32x2 wv; wv.x = pk2(cacc[q][dc][0], cacc[q][dc][1]); wv.y = pk2(cacc[q][dc][2], cacc[q][dc][3]);
                *(LAS u32x2*)(L + ML_C + (16 * dc + l15) * ML_QP + (16 * (2 * w + q) + 4 * lq) * 2) = wv; }
        }
        __syncthreads();
    }
}

constexpr int LR_XP = 272, LR_TT = 128;
constexpr int LR_XC = 0, LR_W = 34816, LR_A = 69632, LR_G = 102912, LR_SEG = 136192, LR_CARRY = 140288, LR_CWT = 140544;
__device__ __forceinline__ void lru_unit(Frame& F, int b, int n, int jh) {
    LAS unsigned char* L = F.lds;
    LAS float* Aa = (LAS float*)(L + LR_A); LAS float* Ga = (LAS float*)(L + LR_G); LAS float* seg = (LAS float*)(L + LR_SEG); LAS float* carry = (LAS float*)(L + LR_CARRY);
    const int tid = F.tid, lane = F.lane, w = F.wave, l15 = lane & 15, lq = lane >> 4;
    const bf16* P = (const bf16*)(F.ws + WS_P); bf16* Y = (bf16*)(F.ws + WS_Y); const bf16* LW = (const bf16*)(F.ws + WS_LRUW) + (size_t)n * 256 * 128;
    for (int pc = tid; pc < 2048; pc += NT) { const int orow = pc >> 4, c16 = pc & 15; const int src = (orow < 64) ? (jh * 64 + orow) : (128 + jh * 64 + (orow - 64));
        *(LAS u32x4*)(L + LR_W + orow * LR_XP + c16 * 16) = *(const GAS u32x4*)(LW + (size_t)src * 128 + c16 * 8); }
    const int cgx = tid & 15, rgx = tid >> 4, cch = n * 128 + 8 * cgx;
    if (tid < 16) {
        const float* cwp_ = F.in(5) + cch; const float* cbp_ = F.in(6) + cch;
#pragma unroll
        for (int j = 0; j < 4; ++j) { *(LAS f32x4*)(L + LR_CWT + (cgx * 5 + j) * 32) = *(const GAS f32x4*)(cwp_ + j * 1024); *(LAS f32x4*)(L + LR_CWT + (cgx * 5 + j) * 32 + 16) = *(const GAS f32x4*)(cwp_ + j * 1024 + 4); }
        *(LAS f32x4*)(L + LR_CWT + (cgx * 5 + 4) * 32) = *(const GAS f32x4*)cbp_; *(LAS f32x4*)(L + LR_CWT + (cgx * 5 + 4) * 32 + 16) = *(const GAS f32x4*)(cbp_ + 4);
    }
    const int trb = 2 * (w >> 1), ocb = 2 * (w & 1);
    float ba[2], bx[2], sp[2];
    const float* pba_ = F.in(8); const float* pbx_ = F.in(10); const float* plam_ = F.in(11);
#pragma unroll
    for (int q = 0; q < 2; ++q) { const int chq = n * 128 + jh * 64 + 16 * (ocb + q) + l15; ba[q] = pba_[chq]; bx[q] = pbx_[chq]; const float nl = -plam_[chq]; sp[q] = fmaxf(nl, 0.f) + log1pf(expf(-fabsf(nl))); }
    const int ch_s = n * 128 + jh * 64 + lane;
    if (tid < 64) carry[tid] = 0.f;
    u32x4 raw[7];
#pragma unroll
    for (int r = 0; r < 7; ++r) { const int t = 4 * rgx - 3 + r; raw[r] = (t >= 0) ? *(const GAS u32x4*)(P + ((size_t)b * SEQ + t) * PN + cch) : (u32x4){0u, 0u, 0u, 0u}; }
    __syncthreads();
    for (int tile = 0; tile < SEQ / LR_TT; ++tile) {
        const int t0 = tile * LR_TT; const size_t row0 = (size_t)b * SEQ + t0;
        bf16 zv[16];
#pragma unroll
        for (int i = 0; i < 16; ++i) zv[i] = P[(row0 + 16 * w + i) * PN + 1024 + ch_s];
        {
            float cw[4][8], cb[8];
#pragma unroll
            for (int j = 0; j < 5; ++j) { const f32x4 c0 = *(const LAS f32x4*)(L + LR_CWT + (cgx * 5 + j) * 32), c1 = *(const LAS f32x4*)(L + LR_CWT + (cgx * 5 + j) * 32 + 16);
#pragma unroll
                for (int i = 0; i < 4; ++i) { if (j < 4) { cw[j < 4 ? j : 0][i] = c0[i]; cw[j < 4 ? j : 0][4 + i] = c1[i]; } else { cb[i] = c0[i]; cb[4 + i] = c1[i]; } } }
#pragma unroll
            for (int r = 0; r < 4; ++r) { float o[8];
#pragma unroll
                for (int i = 0; i < 8; ++i) { const int wd = i >> 1; float x0, x1, x2, x3;
                    if (i & 1) { x0 = bf_hi(raw[r][wd]); x1 = bf_hi(raw[r + 1][wd]); x2 = bf_hi(raw[r + 2][wd]); x3 = bf_hi(raw[r + 3][wd]); }
                    else { x0 = bf_lo(raw[r][wd]); x1 = bf_lo(raw[r + 1][wd]); x2 = bf_lo(raw[r + 2][wd]); x3 = bf_lo(raw[r + 3][wd]); }
                    o[i] = cb[i] + cw[0][i] * x0 + cw[1][i] * x1 + cw[2][i] * x2 + cw[3][i] * x3; }
                u32x4 ov; ov.x = pk2(o[0], o[1]); ov.y = pk2(o[2], o[3]); ov.z = pk2(o[4], o[5]); ov.w = pk2(o[6], o[7]);
                *(LAS u32x4*)(L + LR_XC + (4 * rgx + r) * LR_XP + cgx * 16) = ov; }
            asm volatile("" ::: "memory");
            if (tile + 1 < SEQ / LR_TT) {
#pragma unroll
                for (int r = 0; r < 7; ++r) raw[r] = *(const GAS u32x4*)(P + (row0 + LR_TT + 4 * rgx - 3 + r) * PN + cch);
            }
        }
        __syncthreads();
        {
            f32x4 ga[2][2], gx[2][2];
#pragma unroll
            for (int rt = 0; rt < 2; ++rt)
#pragma unroll
                for (int q = 0; q < 2; ++q) { ga[rt][q] = (f32x4){0.f, 0.f, 0.f, 0.f}; gx[rt][q] = ga[rt][q]; }
#pragma unroll
            for (int kk = 0; kk < 4; ++kk) { bf16x8 a[2], wa[2], wx[2];
#pragma unroll
                for (int rt = 0; rt < 2; ++rt) a[rt] = *(const LAS bf16x8*)(L + LR_XC + (16 * (trb + rt) + l15) * LR_XP + (32 * kk + 8 * lq) * 2);
#pragma unroll
                for (int q = 0; q < 2; ++q) { wa[q] = *(const LAS bf16x8*)(L + LR_W + (16 * (ocb + q) + l15) * LR_XP + (32 * kk + 8 * lq) * 2);
                    wx[q] = *(const LAS bf16x8*)(L + LR_W + (64 + 16 * (ocb + q) + l15) * LR_XP + (32 * kk + 8 * lq) * 2); }
#pragma unroll
                for (int rt = 0; rt < 2; ++rt)
#pragma unroll
                    for (int q = 0; q < 2; ++q) { ga[rt][q] = __builtin_amdgcn_mfma_f32_16x16x32_bf16(a[rt], wa[q], ga[rt][q], 0, 0, 0); gx[rt][q] = __builtin_amdgcn_mfma_f32_16x16x32_bf16(a[rt], wx[q], gx[rt][q], 0, 0, 0); } }
#pragma unroll
            for (int rt = 0; rt < 2; ++rt)
#pragma unroll
                for (int q = 0; q < 2; ++q)
#pragma unroll
                    for (int r = 0; r < 4; ++r) { const int t = 16 * (trb + rt) + 4 * lq + r, jo = 16 * (ocb + q) + l15;
                        const float rg = sigmoidf_(ga[rt][q][r] + ba[q]), ig = sigmoidf_(gx[rt][q][r] + bx[q]); const float la = -8.0f * rg * sp[q];
                        const float xf = bf2f(*(const LAS bf16*)(L + LR_XC + t * LR_XP + (jh * 64 + jo) * 2));
                        const float av = __expf(la); Aa[t * 65 + jo] = av; Ga[t * 65 + jo] = __builtin_amdgcn_sqrtf(fmaxf(1.0f - av * av, 0.f)) * (ig * xf); }
        }
        __syncthreads();
        {
            float Ap = 1.f, H = 0.f;
#pragma unroll
            for (int i = 0; i < 16; ++i) { const float a = Aa[(16 * w + i) * 65 + lane], g = Ga[(16 * w + i) * 65 + lane]; H = a * H + g; Ap *= a; }
            seg[(w * 64 + lane) * 2] = Ap; seg[(w * 64 + lane) * 2 + 1] = H;
        }
        __syncthreads();
        float h = carry[lane];
        for (int s2 = 0; s2 < w; ++s2) h = seg[(s2 * 64 + lane) * 2] * h + seg[(s2 * 64 + lane) * 2 + 1];
#pragma unroll
        for (int i = 0; i < 16; ++i) { const int t = 16 * w + i; h = Aa[t * 65 + lane] * h + Ga[t * 65 + lane]; Y[(row0 + t) * D + ch_s] = (bf16)f2bf(h * gelu_tanh(bf2f(zv[i]))); }
        __syncthreads();
        if (w == 7) carry[lane] = h;
    }
    __syncthreads();
}

__device__ __forceinline__ void ph_headnorm(Frame& F) {
    bf16* Y = (bf16*)(F.ws + WS_Y); const float* sumsq = (const float*)(F.ws + WS_SUMSQ); const float* hg = F.in(16);
    const int gt = F.vcu * NT + F.tid, NGT = F.G * NT;
    for (int idx = gt; idx < T * 128; idx += NGT) { const int t = idx >> 7, c8 = idx & 127, hh = c8 >> 5;
        const f32x4 ss = *(const f32x4*)(sumsq + (size_t)t * 16 + hh * 4); const float rstd = 1.0f / sqrtf(((ss[0] + ss[1]) + (ss[2] + ss[3])) * (1.0f / 256.0f) + EPS);
        bf16* p = Y + (size_t)t * D + 1024 + c8 * 8; const u32x4 v = *(const u32x4*)p; const f32x4 g0 = *(const f32x4*)(hg + c8 * 8), g1 = *(const f32x4*)(hg + c8 * 8 + 4);
        u32x4 o; o.x = pk2(bf_lo(v.x) * rstd * g0[0], bf_hi(v.x) * rstd * g0[1]); o.y = pk2(bf_lo(v.y) * rstd * g0[2], bf_hi(v.y) * rstd * g0[3]);
        o.z = pk2(bf_lo(v.z) * rstd * g1[0], bf_hi(v.z) * rstd * g1[1]); o.w = pk2(bf_lo(v.w) * rstd * g1[2], bf_hi(v.w) * rstd * g1[3]);
        *(u32x4*)p = o; }
}

constexpr int RT_ROWS = 128;
__device__ __forceinline__ void ph_router(Frame& F, int l, bool dummy) {
    LAS float* lg = (LAS float*)(F.lds);
    LAS float* info = (LAS float*)(F.lds + 20480);
    LAS unsigned* lcnt = (LAS unsigned*)(F.lds + 28672);
    const int tid = F.tid, lane = F.lane, w = F.wave, l15 = lane & 15, lq = lane >> 4;
    const bf16* x1 = (const bf16*)(F.ws + WS_XB); const bf16* WH = (const bf16*)(F.ws + WS_RW) + (size_t)(l * 2) * 32 * 2048; const bf16* WL = WH + (size_t)32 * 2048;
    const float* bcs = F.in(30) + l * 4; const float* bfn = F.in(32) + l * 16;
    const size_t doff = dummy ? (size_t)200 * MiB : 0; const int cw = dummy ? 20480 : CW_CNT + l * 32 * 64;
    int* ptok = (int*)(F.ws + WS_PTOK + doff); float* prstd = (float*)(F.ws + WS_PRSTD + doff); float* pga = (float*)(F.ws + WS_PGA + doff); float* pgb = (float*)(F.ws + WS_PGB + doff);
    for (int base = F.vcu * RT_ROWS; base < T; base += F.G * RT_ROWS) {
        if (tid < 32) lcnt[tid] = 0u;
        {
            const bf16* xr = x1 + (size_t)(base + 16 * w + l15) * D + 8 * lq;
            const bf16* wh0 = WH + (size_t)l15 * 2048 + 8 * lq; const bf16* wh1 = WH + (size_t)(16 + l15) * 2048 + 8 * lq;
            const bf16* wl0 = WL + (size_t)l15 * 2048 + 8 * lq; const bf16* wl1 = WL + (size_t)(16 + l15) * 2048 + 8 * lq;
            f32x4 acc0 = (f32x4){0.f, 0.f, 0.f, 0.f}, acc1 = acc0; float ss = 0.f;
#pragma unroll 4
            for (int ks = 0; ks < 64; ++ks) {
                const bf16x8 a = *(const GAS bf16x8*)(xr + 32 * ks);
                const bf16x8 h0 = *(const GAS bf16x8*)(wh0 + 32 * ks), h1 = *(const GAS bf16x8*)(wh1 + 32 * ks), o0 = *(const GAS bf16x8*)(wl0 + 32 * ks), o1 = *(const GAS bf16x8*)(wl1 + 32 * ks);
                acc0 = __builtin_amdgcn_mfma_f32_16x16x32_bf16(a, h0, acc0, 0, 0, 0); acc1 = __builtin_amdgcn_mfma_f32_16x16x32_bf16(a, h1, acc1, 0, 0, 0);
                acc0 = __builtin_amdgcn_mfma_f32_16x16x32_bf16(a, o0, acc0, 0, 0, 0); acc1 = __builtin_amdgcn_mfma_f32_16x16x32_bf16(a, o1, acc1, 0, 0, 0);
                const u32x4 au = __builtin_bit_cast(u32x4, a);
                ss += (bf_lo(au.x) * bf_lo(au.x) + bf_hi(au.x) * bf_hi(au.x)) + (bf_lo(au.y) * bf_lo(au.y) + bf_hi(au.y) * bf_hi(au.y)) + (bf_lo(au.z) * bf_lo(au.z) + bf_hi(au.z) * bf_hi(au.z)) + (bf_lo(au.w) * bf_lo(au.w) + bf_hi(au.w) * bf_hi(au.w)); }
            ss += __shfl_xor(ss, 16); ss += __shfl_xor(ss, 32);
#pragma unroll
            for (int r = 0; r < 4; ++r) { lg[(16 * w + 4 * lq + r) * 33 + l15] = acc0[r]; lg[(16 * w + 4 * lq + r) * 33 + 16 + l15] = acc1[r]; }
            if (lq == 0) lg[(16 * w + l15) * 33 + 32] = ss;
        }
        __syncthreads();
        if (tid < RT_ROWS) {
            const LAS float* lr = lg + tid * 33;
            const float rstd = 1.0f / sqrtf(lr[32] * (1.0f / D) + EPS);
            float lc[4], lf[16];
#pragma unroll
            for (int c = 0; c < 4; ++c) lc[c] = lr[c] * rstd + bcs[c];
#pragma unroll
            for (int c = 0; c < 16; ++c) lf[c] = lr[4 + c] * rstd + bfn[c];
            int gi = 0; float gm = lc[0];
#pragma unroll
            for (int c = 1; c < 4; ++c) if (lc[c] > gm) { gm = lc[c]; gi = c; }
            float se = 0.f;
#pragma unroll
            for (int c = 0; c < 4; ++c) se += expf(lc[c] - gm);
            const float pg = 1.0f / se;
            float fs[4];
#pragma unroll
            for (int c = 0; c < 4; ++c) fs[c] = (gi == 0) ? lf[c] : (gi == 1) ? lf[4 + c] : (gi == 2) ? lf[8 + c] : lf[12 + c];
            int i0 = 0; float v0 = fs[0];
#pragma unroll
            for (int c = 1; c < 4; ++c) if (fs[c] > v0) { v0 = fs[c]; i0 = c; }
            int i1 = -1; float v1 = 0.f;
#pragma unroll
            for (int c = 0; c < 4; ++c) if (c != i0 && (i1 < 0 || fs[c] > v1)) { v1 = fs[c]; i1 = c; }
            const float e1 = expf(v1 - v0), s0 = 1.0f / (1.0f + e1), w0g = s0 * pg, w1g = (e1 * s0) * pg;
            const int ia = i0 < i1 ? i0 : i1, ib = i0 < i1 ? i1 : i0, pidx = (ia == 0) ? ib - 1 : (ia == 1) ? ib + 1 : 5, q = gi * 6 + pidx;
            LAS float* ip = info + tid * 8; ip[0] = __builtin_bit_cast(float, q); ip[1] = (i0 < i1) ? w0g : w1g; ip[2] = (i0 < i1) ? w1g : w0g; ip[3] = rstd;
            ip[4] = __builtin_bit_cast(float, __hip_atomic_fetch_add(&lcnt[q], 1u, __ATOMIC_RELAXED, __HIP_MEMORY_SCOPE_WORKGROUP));
        }
        __syncthreads();
        if (tid < NPAIR) lcnt[32 + tid] = __hip_atomic_fetch_add((unsigned*)(F.ctl + cw + tid * 64), lcnt[tid], RLX_AGENT);
        __syncthreads();
        if (tid < RT_ROWS) { LAS float* ip = info + tid * 8; const int row = base + tid; const int q = __builtin_bit_cast(int, ip[0]);
            const size_t p = (size_t)q * T + lcnt[32 + q] + __builtin_bit_cast(unsigned, ip[4]);
            ptok[p] = row; pga[p] = ip[1]; pgb[p] = ip[2]; prstd[p] = ip[3]; }
        __syncthreads();
    }
}
__device__ __forceinline__ void moe_table(Frame& F, int l) {
    if (F.tid == 0) { unsigned pre = 0u;
        for (int q = 0; q < NPAIR; ++q) { const unsigned c = ld_agent_u32((const unsigned*)(F.ctl + CW_CNT + (l * 32 + q) * 64)); F.MISC[MI_CNT + q] = c; F.MISC[MI_PRE + q] = pre; pre += (c + 255u) >> 8; }
        F.MISC[MI_PRE + NPAIR] = pre; }
    __syncthreads();
}
__device__ __forceinline__ void ph_rowpass(Frame& F, int l, bool dummy) {
    const int gw = F.vcu * NWAVES + F.wave, NGW = F.G * NWAVES, lane = F.lane;
    const bf16* xb = (const bf16*)(F.ws + WS_XB); float* rstd_o = (float*)(F.ws + WS_RSTD);
    const float* gfin = F.in(3);
    for (int m0 = 2 * gw; m0 < T; m0 += 2 * NGW) {
        u32x4 x[2][4];
#pragma unroll
        for (int q = 0; q < 2; ++q) { const GAS u32x4* xr = (const GAS u32x4*)(xb + (size_t)(m0 + q) * D) + lane;
#pragma unroll
            for (int j = 0; j < 4; ++j) x[q][j] = xr[64 * j]; }
#pragma unroll
        for (int q = 0; q < 2; ++q) { const int m = m0 + q; float ss = 0.f;
#pragma unroll
            for (int j = 0; j < 4; ++j) { const u32x4 w = x[q][j];
                ss += ((bf_lo(w.x) * bf_lo(w.x) + bf_hi(w.x) * bf_hi(w.x)) + (bf_lo(w.y) * bf_lo(w.y) + bf_hi(w.y) * bf_hi(w.y))) + ((bf_lo(w.z) * bf_lo(w.z) + bf_hi(w.z) * bf_hi(w.z)) + (bf_lo(w.w) * bf_lo(w.w) + bf_hi(w.w) * bf_hi(w.w))); }
            ss = wave_sum(ss); const float rstd = 1.0f / sqrtf(ss * (1.0f / D) + EPS);
            if (l == 0) { if (lane == 0) (dummy ? (float*)(F.ws + 950 * MiB) : rstd_o)[m] = rstd; }
            else {
                GAS f32x4* xw = dummy ? (GAS f32x4*)((float*)(F.ws + WS_Y) + (size_t)(m & 16383) * D) + 2 * lane : (GAS f32x4*)(F.out + (size_t)m * D) + 2 * lane;
#pragma unroll
                for (int j = 0; j < 4; ++j) { const u32x4 w = x[q][j]; const f32x4 g0 = *((const f32x4*)gfin + 2 * lane + 128 * j), g1 = *((const f32x4*)gfin + 2 * lane + 128 * j + 1);
                    f32x4 o0, o1; o0.x = bf_lo(w.x) * rstd * g0.x; o0.y = bf_hi(w.x) * rstd * g0.y; o0.z = bf_lo(w.y) * rstd * g0.z; o0.w = bf_hi(w.y) * rstd * g0.w;
                    o1.x = bf_lo(w.z) * rstd * g1.x; o1.y = bf_hi(w.z) * rstd * g1.y; o1.z = bf_lo(w.w) * rstd * g1.z; o1.w = bf_hi(w.w) * rstd * g1.w;
                    xw[128 * j] = o0; xw[128 * j + 1] = o1; }
            }
        }
    }
}
constexpr int S5_UP = 528, S5_XP = 272, S5_U = 0, S5_X = 67584, S5_T = 106496;
__device__ __forceinline__ void cmul_add(float ar, float ai, float br, float bi, float cr, float ci, float& orr, float& oi) { orr = ar * br - ai * bi + cr; oi = ar * bi + ai * br + ci; }
__device__ __forceinline__ void ph_s5core(Frame& F, int pf) {
    LAS unsigned char* L = F.lds;
    const int tid = F.tid, lane = F.lane, w = F.wave, l15 = lane & 15, lq = lane >> 4;
    const bf16* A2 = (const bf16*)(F.ws + WS_A2); unsigned char* Y8 = F.ws + ((pf & 8) ? 776 * MiB : WS_Y);
    const int urow = tid >> 2, uq = tid & 3;
    u32x4 ust[8];
    const int upc = (2048 + F.G - 1) / F.G;
    const int L0 = F.vcu * upc, Lend = (L0 + upc < 2048) ? L0 + upc : 2048;
    if (L0 < 2048) { const bf16* src = A2 + ((size_t)(L0 >> 4) * 2048 + (size_t)(L0 & 15) * 128 + urow) * 256 + uq * 64;
#pragma unroll
        for (int i = 0; i < 8; ++i) ust[i] = *(const GAS u32x4*)(src + i * 8); }
    for (int Lu = L0; Lu < Lend; ++Lu) {
        const int g = Lu >> 4, b = Lu & 15;
        const bf16* Wi = (const bf16*)(F.ws + WS_S5WIN) + (size_t)g * 128 * 256; const bf16* KB = (const bf16*)(F.ws + WS_S5K) + (size_t)g * 4096; const bf16* Wo = (const bf16*)(F.ws + WS_S5WO) + (size_t)g * 256 * 128;
#define S5_WFRAG(mt_, ks_) (((ks_) < 8) ? (((2 * w + (mt_)) - (2 * (ks_) + (lq >> 1)) >= 0) ? *(const GAS bf16x8*)(KB + (((2 * w + (mt_)) - (2 * (ks_) + (lq >> 1))) * 16 + l15) * 16 + 8 * (lq & 1)) : (bf16x8){0, 0, 0, 0, 0, 0, 0, 0}) \
                                        : *(const GAS bf16x8*)(Wo + (size_t)(16 * (2 * w + (mt_)) + l15) * 128 + 32 * ((ks_) - 8) + 8 * lq))
#pragma unroll
        for (int i = 0; i < 8; ++i) *(LAS u32x4*)(L + S5_U + urow * S5_UP + (uq * 64 + i * 8) * 2) = ust[i];
        bf16x8 wb[8];
#pragma unroll
        for (int ks = 0; ks < 8; ++ks) wb[ks] = *(const GAS bf16x8*)(Wi + (size_t)(16 * w + l15) * 256 + 32 * ks + 8 * lq);
        const f32x4 lam = *(const GAS f32x4*)((const float*)(F.ws + WS_LAM) + ((size_t)g * 64 + 8 * w + (l15 & 7)) * 4);
        __syncthreads();
        f32x4 X[8];
#pragma unroll
        for (int rt = 0; rt < 8; ++rt) X[rt] = (f32x4){0.f, 0.f, 0.f, 0.f};
        if (!(pf & 64)) {
#pragma unroll
        for (int ks = 0; ks < 8; ++ks) {
#pragma unroll
            for (int rt = 0; rt < 8; ++rt) { const bf16x8 a = *(const LAS bf16x8*)(L + S5_U + (16 * rt + l15) * S5_UP + (32 * ks + 8 * lq) * 2);
                X[rt] = __builtin_amdgcn_mfma_f32_16x16x32_bf16(a, wb[ks], X[rt], 0, 0, 0); } }
        }
        bf16x8 wa[2][4];
#pragma unroll
        for (int mt = 0; mt < 2; ++mt)
#pragma unroll
            for (int k4 = 0; k4 < 4; ++k4) wa[mt][k4] = S5_WFRAG(mt, k4);
        if (!(pf & 16)) {
            const bool isim = (l15 & 8) != 0;
#define S5_XRI(rt_, r_) const float mine_ = X[rt_][r_], oth_ = __builtin_bit_cast(float, __builtin_amdgcn_update_dpp(0, __builtin_bit_cast(int, mine_), 0x128  , 0xf, 0xf, false)); \
            const float xr_ = isim ? oth_ : mine_, xi_ = isim ? mine_ : oth_
            LAS unsigned char* tb = L + S5_T + w * 4096;
#pragma unroll
            for (int rt = 0; rt < 8; ++rt) { float ar = 0.f, ai = 0.f;
#pragma unroll
                for (int r = 0; r < 4; ++r) { S5_XRI(rt, r); float nr, ni; cmul_add(lam[0], lam[1], ar, ai, xr_, xi_, nr, ni); ar = nr; ai = ni; }
                *(LAS f32x2*)(tb + ((rt * 16 + l15) * 4 + lq) * 8) = (f32x2){ar, ai}; }
            asm volatile("s_waitcnt lgkmcnt(0)" ::: "memory");
            float cr = 0.f, ci = 0.f;
#pragma unroll
            for (int rt = 0; rt < 8; ++rt) {
                const f32x4 t0 = *(const LAS f32x4*)(tb + (rt * 16 + l15) * 32), t1 = *(const LAS f32x4*)(tb + (rt * 16 + l15) * 32 + 16);
                float ar = 0.f, ai = 0.f;
#pragma unroll
                for (int o = 0; o < 4; ++o) { if (lq == o) { ar = cr; ai = ci; }
                    const float tr_ = (o == 0) ? t0[0] : (o == 1) ? t0[2] : (o == 2) ? t1[0] : t1[2], ti_ = (o == 0) ? t0[1] : (o == 1) ? t0[3] : (o == 2) ? t1[1] : t1[3];
                    float nr, ni; cmul_add(lam[2], lam[3], cr, ci, tr_, ti_, nr, ni); cr = nr; ci = ni; }
#pragma unroll
                for (int r = 0; r < 4; ++r) { *(LAS bf16*)(L + S5_X + (16 * rt + 4 * lq + r) * S5_XP + (16 * w + l15) * 2) = (bf16)f2bf(isim ? ai : ar);
                    S5_XRI(rt, r); float nr, ni; cmul_add(lam[0], lam[1], ar, ai, xr_, xi_, nr, ni); ar = nr; ai = ni; } }
#undef S5_XRI
        }
        { const int Ln = Lu + 1; if (Ln < Lend) { const bf16* src = A2 + ((size_t)(Ln >> 4) * 2048 + (size_t)(Ln & 15) * 128 + urow) * 256 + uq * 64;
#pragma unroll
            for (int i = 0; i < 8; ++i) ust[i] = *(const GAS u32x4*)(src + i * 8); } }
        __syncthreads();
        f32x4 acc[2][8];
#pragma unroll
        for (int mt = 0; mt < 2; ++mt)
#pragma unroll
            for (int nt = 0; nt < 8; ++nt) acc[mt][nt] = (f32x4){0.f, 0.f, 0.f, 0.f};
        if (!(pf & 32)) {
#pragma unroll
        for (int kb = 0; kb < 3; ++kb) {
            bf16x8 wnx[2][4];
            if (kb < 2) {
#pragma unroll
                for (int mt = 0; mt < 2; ++mt)
#pragma unroll
                    for (int k4 = 0; k4 < 4; ++k4) wnx[mt][k4] = S5_WFRAG(mt, 4 * (kb + 1) + k4);
            }
#pragma unroll
            for (int k4 = 0; k4 < 4; ++k4) { const int ks = 4 * kb + k4;
                if (ks >= 8 || ks <= w) {
#pragma unroll
                for (int nt = 0; nt < 8; ++nt) {
                    const bf16x8 bv = (ks < 8) ? *(const LAS bf16x8*)(L + S5_U + (16 * nt + l15) * S5_UP + (32 * ks + 8 * lq) * 2)
                                               : *(const LAS bf16x8*)(L + S5_X + (16 * nt + l15) * S5_XP + (32 * (ks - 8) + 8 * lq) * 2);
                    acc[0][nt] = __builtin_amdgcn_mfma_f32_16x16x32_bf16(wa[0][k4], bv, acc[0][nt], 0, 0, 0);
                    acc[1][nt] = __builtin_amdgcn_mfma_f32_16x16x32_bf16(wa[1][k4], bv, acc[1][nt], 0, 0, 0); } } }
            if (kb < 2) {
#pragma unroll
                for (int mt = 0; mt < 2; ++mt)
#pragma unroll
                    for (int k4 = 0; k4 < 4; ++k4) wa[mt][k4] = wnx[mt][k4];
            }
        }
        }
#pragma unroll
        for (int mt = 0; mt < 2; ++mt)
#pragma unroll
            for (int nt = 0; nt < 8; ++nt) { const int tok = (b * 128 + 16 * nt + l15) * 16 + 2 * w + mt; const f32x4 a = acc[mt][nt];
                const unsigned wv = pk4_f8(gelu_tanh(a[0]) * F8_SY, gelu_tanh(a[1]) * F8_SY, gelu_tanh(a[2]) * F8_SY, gelu_tanh(a[3]) * F8_SY);
                if (!(pf & 256)) *(GAS unsigned*)(Y8 + ((((size_t)(tok >> 8) * 64 + (g >> 1)) * 256) + (tok & 255)) * 32 + (g & 1) * 16 + 4 * lq) = wv; else asm volatile("" :: "v"(wv)); }
        __syncthreads();
    }
}

struct Args { const float* in[36]; float* out; unsigned char* ws; int ph_lo, ph_hi; };
__global__ void __launch_bounds__(NT, 2) fwd(Args args) {
    extern __shared__ __attribute__((aligned(16))) unsigned char lds[];
    Frame F;
    F.lds = (LAS unsigned char*)lds;
    F.MISC = (volatile LAS unsigned*)(F.lds + MISC_OFF);
    F.tid = threadIdx.x; F.lane = F.tid & 63; F.wave = __builtin_amdgcn_readfirstlane(F.tid >> 6);
    F.G = gridDim.x; { const int bx = blockIdx.x; F.vcu = (F.G % 8 == 0) ? (bx % 8) * (F.G / 8) + bx / 8 : bx; }
    F.out = args.out; F.ws = args.ws; F.ctl = (gu32*)(args.ws + WS_CTL);
    if (F.tid < 64) F.MISC[F.tid] = 0u;
    if (F.tid >= 64 && F.tid < 100) { const unsigned long long pv = (unsigned long long)args.in[F.tid - 64]; F.MISC[64 + 2 * (F.tid - 64)] = (unsigned)pv; F.MISC[65 + 2 * (F.tid - 64)] = (unsigned)(pv >> 32); }
    __syncthreads();
    XcdBarrier bar; bar.bar = (unsigned*)(F.ctl + CW_BAR); bar.x = 0; bar.st = nullptr;
    if (!MK_PER_PHASE) bar = xcd_barrier_post((unsigned*)(F.ctl + CW_BAR), F.MISC + 8);
    const int lo = args.ph_lo & 255, hi = args.ph_hi, pflags = args.ph_lo >> 8;
#ifndef PHMASK
#define PHMASK 0x3ffff
#endif
#define IN(k) ((((PHMASK) >> (k)) & 1) && lo <= (k) && (k) < hi)
#ifdef DOUBLE_BAR
#define SEAM(k) do { if (!MK_PER_PHASE && IN(k) && IN((k) + 1)) { xcd_barrier(bar); xcd_barrier(bar); } } while (0)
#else
#define SEAM(k) do { if (!MK_PER_PHASE && IN(k) && IN((k) + 1)) xcd_barrier(bar); } while (0)
#endif
    unsigned char* ws = args.ws;
    bf16* XB = (bf16*)(ws + WS_XB); bf16* Pb = (bf16*)(ws + WS_P); bf16* Yb = (bf16*)(ws + WS_Y); float* RSTD = (float*)(ws + WS_RSTD);
    const int bx = (int)blockIdx.x;

    if (IN(0)) { ph_prologue(F, pflags); }
    SEAM(0);
#ifndef P1_WGM
#define P1_WGM 8
#endif
    if (IN(1)) {
        pg8::GemmP g{nullptr, 2048, 4096u, 32u, 4096u};
#ifdef P1_STAGGER
        {
            const unsigned long long t0 = __builtin_amdgcn_s_memrealtime(), dl = (unsigned long long)((bx >> 3) & 3) * (P1_STAGGER * 100ull);
            while (__builtin_amdgcn_s_memrealtime() - t0 < dl) __builtin_amdgcn_s_sleep(8);
        }
#endif
#ifdef P1_SPLIT3
#pragma unroll
        for (int j3 = 0; j3 < 3; ++j3) {
            DenseSched S; S.to.init(T / 256, 8, F.G, bx, P1_WGM); S.A = (const char*)XB; S.tstepA = (size_t)256 * 4096; S.B0 = (const char*)(ws + WS_WIN) + (size_t)j3 * 2048 * 4096; S.B1 = S.B0 + (size_t)128 * 4096; S.tstepB = (size_t)256 * 4096; S.cpt = 256;
            EpiScaleBf16 E{Pb + j3 * 2048, PN, RSTD, pflags, 1.0f};
            pg8::gemm_phase<EpiScaleBf16, DenseSched, false>(F.lds, g, S, E); }
#else
        {
            pg8::GemmP g8{nullptr, 1024, 2048u, 32u, 2048u};
            DenseSched S; S.to.init(T / 256, 8, F.G, bx, P1_WGM); S.A = (const char*)(ws + WS_X8IN); S.tstepA = (size_t)256 * 2048; S.B0 = (const char*)(ws + WS_WIN); S.B1 = S.B0 + (size_t)128 * 2048; S.tstepB = (size_t)256 * 2048; S.cpt = 256;
            EpiScaleBf16 E{Pb, PN, RSTD, pflags, 1.0f / (F8_SX * F8_SW)};
            pg8::gemm_phase<EpiScaleBf16, DenseSched, false, false, true>(F.lds, g8, S, E); }
        {
            DenseSched S; S.to.init(T / 256, 16, F.G, bx, P1_WGM); S.A = (const char*)XB; S.tstepA = (size_t)256 * 4096; S.B0 = (const char*)(ws + WS_WIN) + (size_t)2048 * 4096; S.B1 = S.B0 + (size_t)128 * 4096; S.tstepB = (size_t)256 * 4096; S.cpt = 256;
            EpiScaleBf16 E{Pb + 2048, PN, RSTD, pflags, 1.0f};
            pg8::gemm_phase<EpiScaleBf16, DenseSched, false>(F.lds, g, S, E); }
#endif
    }
    SEAM(1);
    if (IN(2)) {
#ifndef NO_MLSTM
        if (!(pflags & 1)) for (int u = F.vcu; u < 256; u += F.G) mlstm_unit(F, u >> 4, (u >> 2) & 3, u & 3, pflags);
#endif
#ifndef NO_LRU
        if (!(pflags & 2)) for (int u = F.vcu; u < 256; u += F.G) lru_unit(F, u >> 4, (u >> 1) & 7, u & 1);
#endif
    }
    SEAM(2);
    if (IN(3)) { ph_headnorm(F); }
    SEAM(3);
    if (IN(4)) {
        pg8::GemmP g{nullptr, 2048, 4096u, 32u, 4096u};
        DenseSched S; S.to.init(T / 256, D / 256, F.G, bx); S.A = (const char*)Yb; S.tstepA = (size_t)256 * 4096; S.B0 = (const char*)(ws + WS_WOUT); S.B1 = S.B0 + (size_t)128 * 4096; S.tstepB = (size_t)256 * 4096; S.cpt = 256;
        EpiOutRes E{XB, ws + WS_X8};
        pg8::gemm_phase<EpiOutRes, DenseSched, false>(F.lds, g, S, E);
    }
    SEAM(4);
#define MOE_LAYER(PH, l, WSW) \
    if (IN(PH)) { ph_router(F, l, (pflags & 4) != 0); } \
    SEAM(PH); \
    if (IN(PH + 1)) { moe_table(F, l); \
        pg8::GemmP g{(const char*)(ws + WS_X8), 1024, 2048u, 32u, 2048u}; \
        MoeSched<false> S{F.MISC, F.G, F.vcu, (const char*)(ws + WSW), (const char*)(ws + WSW + 32 * MiB), nullptr, (const int*)(ws + WS_PTOK)}; \
        EpiGateUp E{ws + WS_H, (const float*)(ws + WS_PRSTD), (const float*)(ws + WS_PGA), (const float*)(ws + WS_PGB), F.MISC, pflags}; \
        pg8::gemm_phase<EpiGateUp, MoeSched<false>, true, false, true>(F.lds, g, S, E); } \
    SEAM(PH + 1); \
    if (IN(PH + 2)) { moe_table(F, l); \
        pg8::GemmP g{nullptr, 512, 1024u, 32u, 512u}; \
        MoeSched<true> S{F.MISC, F.G, F.vcu, (const char*)(ws + WSW + 64 * MiB), nullptr, (const char*)(ws + WS_H), nullptr}; \
        EpiDownRes E{XB, (const int*)(ws + WS_PTOK), F.MISC, (pflags & 4) ? (bf16*)(ws + 712 * MiB) : XB, (l == 0) ? ws + ((pflags & 4) ? 776 * MiB : WS_X8) : nullptr}; \
        pg8::gemm_phase<EpiDownRes, MoeSched<true>, false, true, true>(F.lds, g, S, E); } \
    SEAM(PH + 2); \
    if (IN(PH + 3)) { ph_rowpass(F, l, (pflags & 4) != 0); }
    MOE_LAYER(5, 0, WS_WMOE0)
    SEAM(8);
    if (IN(9)) {
        pg8::GemmP g{nullptr, 1024, 2048u, 32u, 2048u};
        DenseSched S; S.to.init(T / 256, D / 256, F.G, bx); S.A = (const char*)(ws + WS_X8); S.tstepA = (size_t)256 * 2048; S.B0 = (const char*)(ws + WS_WS5IN); S.B1 = S.B0 + (size_t)128 * 2048; S.tstepB = (size_t)256 * 2048; S.cpt = 256;
        EpiS5U E{(bf16*)(ws + WS_A2), RSTD, 1.0f / (F8_SX * F8_SW)};
        pg8::gemm_phase<EpiS5U, DenseSched, false, false, true>(F.lds, g, S, E);
    }
    SEAM(9);
    if (IN(10)) { ph_s5core(F, pflags); }
    SEAM(12);
    if (IN(13)) {
        pg8::GemmP g{nullptr, 1024, 32u, 8192u, 2048u};
        DenseSched S; S.to.init(T / 256, D / 128, F.G, bx); S.A = (const char*)Yb; S.tstepA = (size_t)64 * 8192; S.B0 = (const char*)(ws + WS_WGLUV); S.B1 = (const char*)(ws + WS_WGLUG); S.tstepB = (size_t)128 * 2048; S.cpt = 128;
        EpiGlu E{(pflags & 4) ? (bf16*)(ws + 712 * MiB) : XB, ws + ((pflags & 4) ? 776 * MiB : WS_X8)};
        pg8::gemm_phase<EpiGlu, DenseSched, false, false, true>(F.lds, g, S, E);
    }
    SEAM(13);
    MOE_LAYER(14, 1, WS_WMOE1)
#undef IN
#undef SEAM
}

extern "C" void kernel_launch(void* const* d_in, const int* in_sizes, int n_in, void* d_out, int out_size, void* d_ws, size_t ws_size, hipStream_t stream) {
    static int grid = 0;
    if (grid == 0) {
        if (n_in != 36 || in_sizes[0] != T * D || out_size != T * D || ws_size < WS_END) { fprintf(stderr, "kernel_launch: unexpected shapes (n_in %d, in0 %d, out %d, ws %zu < %zu); nothing launched\n", n_in, n_in > 0 ? in_sizes[0] : -1, out_size, ws_size, (size_t)WS_END); grid = -1; return; }
        int dev = 0, cus = 0, per_cu = 0;
        if (hipGetDevice(&dev) != hipSuccess || hipDeviceGetAttribute(&cus, hipDeviceAttributeMultiprocessorCount, dev) != hipSuccess) { grid = -1; return; }
        if (hipFuncSetAttribute((const void*)fwd, hipFuncAttributeMaxDynamicSharedMemorySize, LDS_BYTES) != hipSuccess) { fprintf(stderr, "kernel_launch: hipFuncSetAttribute failed\n"); grid = -1; return; }
        if (hipOccupancyMaxActiveBlocksPerMultiprocessor(&per_cu, (const void*)fwd, NT, LDS_BYTES) != hipSuccess || per_cu < 1) fprintf(stderr, "kernel_launch: occupancy query says %d\n", per_cu);
        (void)hipGetLastError();
        grid = cus;
    }
    if (grid < 0) return;
    (void)hipMemsetAsync((char*)d_ws + WS_CTL, 0, CTL_ZERO_BYTES, stream);
    Args a{};
    for (int i = 0; i < 36; ++i) a.in[i] = (const float*)d_in[i];
    a.out = (float*)d_out; a.ws = (unsigned char*)d_ws;
#if MK_PER_PHASE
    for (int ph = 0; ph < NPHASE; ++ph) { a.ph_lo = ph; a.ph_hi = ph + 1; hipLaunchKernelGGL(fwd, dim3(grid), dim3(NT), LDS_BYTES, stream, a);
#ifdef REPEAT_PHASE
        if (ph == REPEAT_PHASE) {
#ifdef REPEAT_FLAGS
            a.ph_lo = ph | (REPEAT_FLAGS << 8);
#endif
            hipLaunchKernelGGL(fwd, dim3(grid), dim3(NT), LDS_BYTES, stream, a); }
#endif
    }
#else
    a.ph_lo = 0; a.ph_hi = NPHASE;
    hipLaunchKernelGGL(fwd, dim3(grid), dim3(NT), LDS_BYTES, stream, a);
#endif
    const hipError_t le = hipPeekAtLastError();
    if (le != hipSuccess) fprintf(stderr, "kernel_launch: launch failed: %s\n", hipGetErrorName(le));
}
```

```cpp
#include <hip/hip_runtime.h>
#include <cstdio>
#include <cstdint>

#define LAS __attribute__((address_space(3)))
#define GAS __attribute__((address_space(1)))
typedef unsigned short bf16;
typedef short bf16x8 __attribute__((ext_vector_type(8)));
typedef float f32x4 __attribute__((ext_vector_type(4)));
typedef float f32x2 __attribute__((ext_vector_type(2)));
typedef unsigned u32x4 __attribute__((ext_vector_type(4)));
typedef unsigned u32x2 __attribute__((ext_vector_type(2)));
typedef GAS unsigned gu32;
#define RLX_AGENT __ATOMIC_RELAXED, __HIP_MEMORY_SCOPE_AGENT
#define LDS_WAIT() asm volatile("s_waitcnt lgkmcnt(0)" ::: "memory")
#define VM_WAIT() asm volatile("s_waitcnt vmcnt(0)" ::: "memory")

#ifndef MK_PER_PHASE
#define MK_PER_PHASE 0
#endif

constexpr int T = 32768, D = 2048, SEQ = 2048, NBATCH = 16;
constexpr int NWAVES = 8, NT = 512;
constexpr int INCOLS = 6152, PN = 6144;
constexpr int NEXP = 16, FF = 512;
constexpr int NPAIR = 24;
constexpr int SLOT_ROWS = 32768 + NPAIR * 256;
constexpr float EPS = 1e-6f;
constexpr int NPHASE = 18;

typedef __bf16 bf16x2_t __attribute__((ext_vector_type(2)));
__device__ __forceinline__ unsigned pk2(float lo, float hi) { f32x2 v = {lo, hi}; bf16x2_t b = __builtin_convertvector(v, bf16x2_t); return __builtin_bit_cast(unsigned, b); }
__device__ __forceinline__ unsigned f2bf(float f) { return pk2(f, 0.f) & 0xffffu; }
__device__ __forceinline__ float bf_lo(unsigned w) { return __builtin_bit_cast(float, w << 16); }
__device__ __forceinline__ float bf_hi(unsigned w) { return __builtin_bit_cast(float, w & 0xffff0000u); }
__device__ __forceinline__ float bf2f(bf16 b) { return __builtin_bit_cast(float, ((unsigned)b) << 16); }
typedef int i32x8 __attribute__((ext_vector_type(8)));
typedef int i32x4 __attribute__((ext_vector_type(4)));
__device__ __forceinline__ unsigned pk4_f8(float a, float b, float c, float d) {
    a = __builtin_amdgcn_fmed3f(a, -448.f, 448.f); b = __builtin_amdgcn_fmed3f(b, -448.f, 448.f); c = __builtin_amdgcn_fmed3f(c, -448.f, 448.f); d = __builtin_amdgcn_fmed3f(d, -448.f, 448.f);
    int p = __builtin_amdgcn_cvt_pk_fp8_f32(a, b, 0, false); p = __builtin_amdgcn_cvt_pk_fp8_f32(c, d, p, true); return (unsigned)p; }
__device__ __forceinline__ unsigned pk4_f8_mm(float a, float b, float c, float d) {
    a = __builtin_fminf(__builtin_fmaxf(a, -448.f), 448.f); b = __builtin_fminf(__builtin_fmaxf(b, -448.f), 448.f); c = __builtin_fminf(__builtin_fmaxf(c, -448.f), 448.f); d = __builtin_fminf(__builtin_fmaxf(d, -448.f), 448.f);
    int p = __builtin_amdgcn_cvt_pk_fp8_f32(a, b, 0, false); p = __builtin_amdgcn_cvt_pk_fp8_f32(c, d, p, true); return (unsigned)p; }
constexpr float F8_SX = 8.f, F8_SH = 64.f, F8_SY = 16.f, F8_SW = 512.f, F8_SWD = 256.f, F8_SYA = 16.f;
constexpr int Y3P = 3072;
__device__ __forceinline__ float wave_sum(float v) {
#pragma unroll
    for (int o = 1; o < 64; o <<= 1) v += __shfl_xor(v, o);
    return v;
}
__device__ __forceinline__ float sigmoidf_(float x) { return __builtin_amdgcn_rcpf(1.0f + __expf(-x)); }
__device__ __forceinline__ float gelu_tanh(float x) { const float u = 0.7978845608028654f * (x + 0.044715f * x * x * x); return x * __builtin_amdgcn_rcpf(1.0f + __expf(-2.0f * u)); }
__device__ __forceinline__ float siluf_(float x) { return x * __builtin_amdgcn_rcpf(1.0f + __expf(-x)); }

namespace pg8 {
constexpr int BM = 256, BK = 64, HALF = 128, HTB = HALF * BK * 2, STAGE_BYTES = 8 * HTB, NXCD = 8, WGM = 8;
__host__ __device__ __forceinline__ int lds_byte(int r, int c) { const int st = (r >> 4) * 2 + (c >> 5), rr = r & 15, cc = c & 31, ob = rr * 64 + cc * 2; return st * 1024 + (ob ^ (((ob >> 9) & 1) << 5)); }
__host__ __device__ __forceinline__ void stage_rc(int b, int& R, int& C) { const int st = b / 1024, sb = b % 1024, swz = sb ^ (((sb >> 9) & 1) << 5); R = (st >> 1) * 16 + swz / 64; C = (st & 1) * 32 + (swz % 64) / 2; }
__host__ __device__ __forceinline__ int perm32(int rho) { const int n = rho >> 4, i = rho & 15; return 8 * (i >> 2) + 4 * n + (i & 3); }

struct Unit { const char* a; const char* b0; const char* b1; const char* b0x; const char* b1x; int r0, c0, aux, x; };
template <bool B> struct BoolC { static constexpr bool value = B; };
struct GemmP { const char* gA; int K; unsigned rsA, planeA, ldb; int t8; };

struct TileOrder {
    int nM, nN, nwg, G, c, wgm;
    __device__ __forceinline__ void init(int nM_, int nN_, int G_, int c_, int wgm_ = WGM) { nM = nM_; nN = nN_; nwg = nM * nN; G = G_; c = c_; wgm = wgm_; }
    __device__ __forceinline__ bool next(int i, int& pm, int& pn) const {
        const long L = (long)i * G + c; if (L >= nwg) return false;
        int wgid = (int)L; { const int q = nwg / NXCD, r = nwg % NXCD, xcd = wgid % NXCD, off = wgid / NXCD; wgid = (xcd < r ? xcd * (q + 1) : r * (q + 1) + (xcd - r) * q) + off; }
        const int nig = wgm * nN, gid = wgid / nig, fm = gid * wgm, gsz = (nM - fm) < wgm ? (nM - fm) : wgm;
        pm = fm + ((wgid % nig) % gsz); pn = (wgid % nig) / gsz; return true;
    }
};

template <class Epi, class Sched, bool GATHER, bool DUALB = false, bool FP8 = false, bool MIXED = false>
__device__ __forceinline__ void gemm_phase(LAS unsigned char* lds, const GemmP g, const Sched& S, const Epi& E) {
    const int tid = threadIdx.x, wid = __builtin_amdgcn_readfirstlane(tid >> 6), lane = tid & 63, wr = wid >> 2, wc = wid & 3, fr = lane & 15, fq = lane >> 4;
    const int nt = g.K / BK;
    unsigned voffA[2], voffB[2], coff[2]; int RA[2];
#pragma unroll
    for (int i = 0; i < 2; ++i) { int R, C; stage_rc(tid * 16 + i * 8192, R, C); const int Rb = Epi::PERM ? ((R & ~31) + perm32(R & 31)) : R;
        coff[i] = (unsigned)(C >> 4) * g.planeA + (unsigned)(C & 15) * 2u; RA[i] = R;
        voffA[i] = (unsigned)R * g.rsA + coff[i]; voffB[i] = (unsigned)Rb * g.ldb + (unsigned)C * 2u; }
    const size_t ksA = (size_t)4 * g.planeA, ksB = (size_t)(BK * 2);
    const size_t hstepA = (size_t)HALF * g.rsA;
    const unsigned ldsw = (unsigned)wid * 1024u;
    const int aoff = lds_byte(wr * 64 + fr, fq * 8); int boffH = lds_byte(wc * 32 + fr, fq * 8) + 4 * HTB;
    asm volatile("" : "+v"(boffH));
#define PG8_SA(b, h) (((b) * 2 + (h)) * HTB)
#define PG8_SB(b, h) ((4 + (b) * 2 + (h)) * HTB)
#define PG8_STG(bufoff, ptr, o0, o1) do { \
        __builtin_amdgcn_global_load_lds((const unsigned*)((const char*)(ptr) + (o0)), (LAS unsigned*)(lds + (bufoff) + ldsw), 16, 0, 0); \
        __builtin_amdgcn_global_load_lds((const unsigned*)((const char*)(ptr) + (o1)), (LAS unsigned*)(lds + (bufoff) + ldsw + 8192), 16, 0, 0); } while (0)
#define PG8_STAGE_B(bufoff, ptr) PG8_STG(bufoff, ptr, voffB[0], voffB[1])
#define PG8_STAGE_A(bufoff, h, ptr, usenext) do { if constexpr (GATHER) { const unsigned _o0 = (usenext) ? voN[h][0] : voC[h][0], _o1 = (usenext) ? voN[h][1] : voC[h][1]; PG8_STG(bufoff, ptr, _o0, _o1); } \
        else { PG8_STG(bufoff, (ptr) + (h) * hstepA, voffA[0], voffA[1]); } } while (0)
#define PG8_LD16(off) (*(const LAS bf16x8*)(lds + (off)))
#define PG8_LO(x) __builtin_bit_cast(bf16x8, __builtin_shufflevector(x, x, 0, 1, 2, 3))
#define PG8_HI(x) __builtin_bit_cast(bf16x8, __builtin_shufflevector(x, x, 4, 5, 6, 7))
#define PG8_CAT8(x, y) __builtin_shufflevector(__builtin_bit_cast(i32x4, x), __builtin_bit_cast(i32x4, y), 0, 1, 2, 3, 4, 5, 6, 7)
#define PG8_LDA(dst, b, h) do { if constexpr (mode8) { _Pragma("unroll") for (int m = 0; m < 4; ++m) dst##8[m] = PG8_CAT8(PG8_LD16(PG8_SA(b, h) + aoff + m * 2048), PG8_LD16(PG8_SA(b, h) + aoff + m * 2048 + 1024)); } \
        else { _Pragma("unroll") for (int m = 0; m < 4; ++m) _Pragma("unroll") for (int k = 0; k < 2; ++k) dst[m][k] = PG8_LD16(PG8_SA(b, h) + aoff + m * 2048 + k * 1024); } } while (0)
#define PG8_LDB(dst, b, h) do { if constexpr (mode8) { _Pragma("unroll") for (int n = 0; n < 2; ++n) dst##8[n] = PG8_CAT8(PG8_LD16(boffH + ((b) * 2 + (h)) * HTB + n * 2048), PG8_LD16(boffH + ((b) * 2 + (h)) * HTB + n * 2048 + 1024)); } \
        else { _Pragma("unroll") for (int n = 0; n < 2; ++n) _Pragma("unroll") for (int k = 0; k < 2; ++k) dst[n][k] = PG8_LD16(boffH + ((b) * 2 + (h)) * HTB + n * 2048 + k * 1024); } } while (0)
#define PG8_MMA(ai, bj, At, Bt) do { __builtin_amdgcn_s_setprio(1); \
        if constexpr (FP8) { if constexpr (mode8) { _Pragma("unroll") for (int m = 0; m < 4; ++m) _Pragma("unroll") for (int n = 0; n < 2; ++n) \
            asm volatile("v_mfma_f32_16x16x128_f8f6f4 %0, %1, %2, %0" : "+v"(acc[ai][bj][m][n]) : "v"(Bt##8[n]), "v"(At##8[m])); } \
          else { _Pragma("unroll") for (int m = 0; m < 4; ++m) _Pragma("unroll") for (int n = 0; n < 2; ++n) \
                asm volatile("v_mfma_f32_16x16x32_bf16 %0, %1, %2, %0" : "+v"(acc[ai][bj][m][n]) : "v"(Bt[n][0]), "v"(At[m][0])); \
            _Pragma("unroll") for (int m = 0; m < 4; ++m) _Pragma("unroll") for (int n = 0; n < 2; ++n) \
                asm volatile("v_mfma_f32_16x16x32_bf16 %0, %1, %2, %0" : "+v"(acc[ai][bj][m][n]) : "v"(Bt[n][1]), "v"(At[m][1])); } } \
        else { _Pragma("unroll") for (int m = 0; m < 4; ++m) _Pragma("unroll") for (int n = 0; n < 2; ++n) _Pragma("unroll") for (int k = 0; k < 2; ++k) \
            acc[ai][bj][m][n] = __builtin_amdgcn_mfma_f32_16x16x32_bf16(Bt[n][k], At[m][k], acc[ai][bj][m][n], 0, 0, 0); } \
        __builtin_amdgcn_s_setprio(0); } while (0)
#define PG8_WAIT_V(n) asm volatile("s_waitcnt vmcnt(" #n ")" ::: "memory")
#define PG8_WAIT_L(n) asm volatile("s_waitcnt lgkmcnt(" #n ")" ::: "memory")
#define PG8_BAR __builtin_amdgcn_s_barrier()
#define PG8_SCHED __builtin_amdgcn_sched_barrier(0)
    Unit cur, nxt; int ui = 0;
    if (!S.next(0, cur)) return;
    unsigned voC[2][2], voN[2][2];
    if constexpr (GATHER) {
#pragma unroll
        for (int h = 0; h < 2; ++h)
#pragma unroll
            for (int i = 0; i < 2; ++i) { voC[h][i] = S.row_off(cur, h * HALF + RA[i]) + coff[i]; voN[h][i] = voC[h][i]; }
    } else { voC[0][0] = voC[0][1] = voC[1][0] = voC[1][1] = 0u; voN[0][0] = voN[0][1] = voN[1][0] = voN[1][1] = 0u; }
    f32x4 acc[2][2][4][2];
#pragma unroll
    for (int a = 0; a < 2; ++a)
#pragma unroll
        for (int b = 0; b < 2; ++b)
#pragma unroll
            for (int m = 0; m < 4; ++m)
#pragma unroll
                for (int n = 0; n < 2; ++n) acc[a][b][m][n] = (f32x4){0.f, 0.f, 0.f, 0.f};
    bf16x8 At[4][2], B0[2][2], B1[2][2];
    i32x8 At8[4], B08[2], B18[2];
    const char* cA = GATHER ? g.gA : cur.a; const char* cB0 = cur.b0; const char* cB1 = cur.b1; const char* cB0x = cur.b0x; const char* cB1x = cur.b1x;
    const int nth = nt >> 1;
#define PG8_BPTR(h, kt) ((DUALB && (kt) >= nth) ? ((h) ? cB1x : cB0x) + (size_t)((kt) - nth) * ksB : ((h) ? cB1 : cB0) + (size_t)(kt) * ksB)
    PG8_STAGE_B(PG8_SB(0, 0), cB0); PG8_STAGE_B(PG8_SB(0, 1), cB1); PG8_STAGE_A(PG8_SA(0, 0), 0, cA, false); PG8_STAGE_A(PG8_SA(0, 1), 1, cA, false);
    if (wr == 1) PG8_BAR;
    PG8_WAIT_V(2); PG8_BAR;
    PG8_STAGE_B(PG8_SB(1, 0), cB0 + ksB); PG8_STAGE_A(PG8_SA(1, 0), 0, cA + ksA, false); PG8_STAGE_B(PG8_SB(1, 1), cB1 + ksB);
    PG8_WAIT_V(6); PG8_BAR;
    for (;;) {
        const bool has_next = S.next(ui + 1, nxt);
        const char* nA = GATHER ? g.gA : (has_next ? nxt.a : cA); const char* nB0 = has_next ? nxt.b0 : cB0; const char* nB1 = has_next ? nxt.b1 : cB1;
        const char* nB0x = has_next ? nxt.b0x : cB0x; const char* nB1x = has_next ? nxt.b1x : cB1x;
        if constexpr (GATHER) {
            if (has_next) {
#pragma unroll
                for (int h = 0; h < 2; ++h)
#pragma unroll
                    for (int i = 0; i < 2; ++i) voN[h][i] = S.row_off(nxt, h * HALF + RA[i]) + coff[i];
            } else {
#pragma unroll
                for (int h = 0; h < 2; ++h)
#pragma unroll
                    for (int i = 0; i < 2; ++i) voN[h][i] = voC[h][i];
            }
        }
        auto kiter = [&](const int t, auto m8tag) __attribute__((always_inline)) {
            constexpr bool mode8 = decltype(m8tag)::value;
            const bool last = (t == nt - 2);
            const char* a1 = cA + (size_t)(t + 1) * ksA;
            const char* a2 = last ? nA : cA + (size_t)(t + 2) * ksA;
            const char* b20 = last ? nB0 : PG8_BPTR(0, t + 2); const char* b21 = last ? nB1 : PG8_BPTR(1, t + 2);
            const char* a3 = a2 + ksA; const char* b30 = last ? nB0 + ksB : PG8_BPTR(0, t + 3); const char* b31 = last ? nB1 + ksB : PG8_BPTR(1, t + 3);
            PG8_LDB(B0, 0, 0); PG8_LDB(B1, 0, 1); PG8_SCHED; PG8_LDA(At, 0, 0); PG8_STAGE_A(PG8_SA(1, 1), 1, a1, false);
            PG8_WAIT_V(8); PG8_WAIT_L(0); PG8_BAR; PG8_MMA(0, 0, At, B0); PG8_MMA(0, 1, At, B1); PG8_BAR; PG8_SCHED;
            PG8_LDA(At, 0, 1); PG8_STAGE_B(PG8_SB(0, 0), b20); PG8_STAGE_B(PG8_SB(0, 1), b21); PG8_STAGE_A(PG8_SA(0, 0), 0, a2, last);
            PG8_WAIT_V(8); PG8_WAIT_L(0); PG8_BAR; PG8_MMA(1, 0, At, B0); PG8_MMA(1, 1, At, B1); PG8_BAR; PG8_SCHED;
            PG8_LDB(B0, 1, 0); PG8_LDB(B1, 1, 1); PG8_SCHED; PG8_LDA(At, 1, 0); PG8_STAGE_A(PG8_SA(0, 1), 1, a2, last);
            PG8_WAIT_V(8); PG8_WAIT_L(0); PG8_BAR; PG8_MMA(0, 0, At, B0); PG8_MMA(0, 1, At, B1); PG8_BAR; PG8_SCHED;
            PG8_LDA(At, 1, 1); PG8_STAGE_B(PG8_SB(1, 0), b30); PG8_STAGE_B(PG8_SB(1, 1), b31); PG8_STAGE_A(PG8_SA(1, 0), 0, a3, last);
            PG8_WAIT_V(8); PG8_WAIT_L(0); PG8_BAR; PG8_MMA(1, 0, At, B0); PG8_MMA(1, 1, At, B1); PG8_BAR; PG8_SCHED;
        };
        if constexpr (MIXED) {
#pragma nounroll
            for (int t = 0; t < g.t8; t += 2) kiter(t, BoolC<true>{});
            asm volatile("s_nop 15\n\ts_nop 15" ::: "memory");
#pragma unroll
            for (int a = 0; a < 2; ++a)
#pragma unroll
                for (int b = 0; b < 2; ++b)
#pragma unroll
                    for (int m = 0; m < 4; ++m)
#pragma unroll
                        for (int n = 0; n < 2; ++n) acc[a][b][m][n] *= (1.0f / (F8_SYA * F8_SW));
#pragma nounroll
            for (int t = g.t8; t < nt; t += 2) kiter(t, BoolC<false>{});
        } else {
#pragma nounroll
            for (int t = 0; t < nt; t += 2) kiter(t, BoolC<FP8>{});
        }
#ifndef PG8_NOALIGN
        if (wr == 0) PG8_BAR;
#endif
        if constexpr (FP8) asm volatile("s_nop 15\n\ts_nop 15" ::: "memory");
        E(acc, cur, wr, wc, fr, fq);
        if (!has_next) break;
#pragma unroll
        for (int a = 0; a < 2; ++a)
#pragma unroll
            for (int b = 0; b < 2; ++b)
#pragma unroll
                for (int m = 0; m < 4; ++m)
#pragma unroll
                    for (int n = 0; n < 2; ++n) acc[a][b][m][n] = (f32x4){0.f, 0.f, 0.f, 0.f};
        cur = nxt; cA = nA; cB0 = nB0; cB1 = nB1; cB0x = nB0x; cB1x = nB1x; ++ui;
        if constexpr (GATHER) {
#pragma unroll
            for (int h = 0; h < 2; ++h)
#pragma unroll
                for (int i = 0; i < 2; ++i) voC[h][i] = voN[h][i];
        }
#ifndef PG8_NOALIGN
        if (wr == 1) PG8_BAR;
#endif
    }
    PG8_WAIT_V(0);
#ifdef PG8_NOALIGN
    if (wr == 0) PG8_BAR;
#endif
    PG8_BAR;
#undef PG8_BPTR
#undef PG8_SA
#undef PG8_SB
#undef PG8_STG
#undef PG8_STAGE_A
#undef PG8_STAGE_B
#undef PG8_LDA
#undef PG8_LDB
#undef PG8_MMA
#undef PG8_CAT8
#undef PG8_LD16
#undef PG8_LO
#undef PG8_HI
#undef PG8_WAIT_V
#undef PG8_WAIT_L
#undef PG8_BAR
#undef PG8_SCHED
}
}

#define XB_TMO      128
#define XB_XCNT(j)  (256  + 64 * (j))
#define XB_XSUB(j)  (1280 + 64 * (j))
#define XB_XGEN(j)  (2304 + 64 * (j))
#define XB_TOP      3328
#define XB_TOPGEN   3392
#define XCD_BAR_WORDS 3456
#define XB_SPIN_CAP (1u << 18)
__device__ __forceinline__ unsigned xb_ld(unsigned* p)              { return __hip_atomic_load(p, __ATOMIC_RELAXED, __HIP_MEMORY_SCOPE_AGENT); }
__device__ __forceinline__ unsigned xb_add(unsigned* p, unsigned v) { return __hip_atomic_fetch_add(p, v, __ATOMIC_RELAXED, __HIP_MEMORY_SCOPE_AGENT); }
__device__ __forceinline__ unsigned xb_xcc_id() { return (unsigned)__builtin_amdgcn_s_getreg((3 << 11) | 20) & 0xFu; }
#define XB_SPIN(cond, bar) do { unsigned _sp = 0; while (cond) { __builtin_amdgcn_s_sleep(1); \
    if ((++_sp & 255u) == 0u) { if (xb_ld(&(bar)[XB_TMO])) break; if (_sp > XB_SPIN_CAP) { atomicAdd(&(bar)[XB_TMO], 1u); break; } } } } while (0)
struct XcdBarrier { unsigned* bar; unsigned x; volatile LAS unsigned* st; };
__device__ __forceinline__ XcdBarrier xcd_barrier_post(unsigned* bar, volatile LAS unsigned* st) {
    XcdBarrier b; b.bar = bar; b.x = xb_xcc_id(); b.st = st;
    if (threadIdx.x == 0) (void)xb_add(&bar[XB_XCNT(b.x)], 1u);
    return b;
}
__device__ __forceinline__ void xcd_barrier_complete(unsigned* bar, unsigned x, unsigned& nloc, unsigned& nx) {
    const unsigned G = gridDim.x * gridDim.y * gridDim.z;
    unsigned sum, cnt, mine, sp = 0u;
    for (;;) {
        sum = 0u; cnt = 0u; mine = 0u;
#pragma unroll
        for (unsigned j = 0; j < 16; ++j) { const unsigned c = xb_ld(&bar[XB_XCNT(j)]); sum += c; cnt += (c > 0u) ? 1u : 0u; mine = (j == x) ? c : mine; }
        if (sum == G) break;
        __builtin_amdgcn_s_sleep(1);
        if ((++sp & 255u) == 0u) { if (xb_ld(&bar[XB_TMO])) break; if (sp > XB_SPIN_CAP) { atomicAdd(&bar[XB_TMO], 1u); break; } }
    }
    nloc = mine > 0u ? mine : 1u; nx = cnt > 0u ? cnt : 1u;
}
__device__ __forceinline__ void xcd_barrier(const XcdBarrier& b) {
    asm volatile("s_waitcnt vmcnt(0)" ::: "memory");
    __syncthreads();
    if (threadIdx.x == 0) {
        unsigned* bar = b.bar;
        __builtin_amdgcn_s_waitcnt(0);
        unsigned nloc = b.st[0], nx = b.st[1];
        if (nloc == 0u) { xcd_barrier_complete(bar, b.x, nloc, nx); b.st[0] = nloc; b.st[1] = nx; }
        const unsigned old = xb_add(&bar[XB_XSUB(b.x)], 1u);
        const unsigned gen = old / nloc;
        if (old + 1u == (gen + 1u) * nloc) {
            __builtin_amdgcn_fence(__ATOMIC_RELEASE, "agent");
            asm volatile("s_waitcnt vmcnt(0)" ::: "memory");
            const unsigned og = xb_add(&bar[XB_TOP], 1u);
            const unsigned tg = og / nx;
            if (og + 1u == (tg + 1u) * nx) xb_add(&bar[XB_TOPGEN], 1u);
            else XB_SPIN(xb_ld(&bar[XB_TOPGEN]) == tg, bar);
            __builtin_amdgcn_fence(__ATOMIC_ACQUIRE, "agent");
            xb_add(&bar[XB_XGEN(b.x)], 1u);
            asm volatile("s_waitcnt vmcnt(0)" ::: "memory");
        } else {
            XB_SPIN(xb_ld(&bar[XB_XGEN(b.x)]) == gen, bar);
            __builtin_amdgcn_fence(__ATOMIC_ACQUIRE, "agent");
            asm volatile("s_waitcnt vmcnt(0)" ::: "memory");
        }
    }
    __syncthreads();
}

constexpr size_t MiB = 1u << 20;
constexpr size_t WS_CTL = 0, CTL_ZERO_BYTES = 1 * MiB;
constexpr size_t WS_RSTD = 1 * MiB;
constexpr size_t WS_GATES = 2 * MiB;
constexpr size_t WS_SUMSQ = 3 * MiB;
constexpr size_t WS_RW = 5 * MiB;
constexpr size_t WS_LAM = 6 * MiB;
constexpr size_t WS_LRUW = 7 * MiB;
constexpr size_t WS_TOKL = 8 * MiB;
constexpr size_t WS_RSTDL = 10 * MiB;
constexpr size_t WS_GATEL = 12 * MiB;
constexpr size_t WS_TOKSLOT = 14 * MiB;
constexpr size_t WS_WIN = 16 * MiB;
constexpr size_t WS_WOUT = 40 * MiB;
constexpr size_t WS_WS5IN = 48 * MiB, WS_WGLUV = 56 * MiB, WS_WGLUG = 64 * MiB;
constexpr size_t WS_WMOE0 = 72 * MiB;
constexpr size_t WS_S5WIN = 168 * MiB;
constexpr size_t WS_S5WO = 176 * MiB;
constexpr size_t WS_S5K = 192 * MiB;
constexpr size_t WS_XB = 200 * MiB;
constexpr size_t WS_Y = 328 * MiB;
constexpr size_t WS_P = 456 * MiB;
constexpr size_t WS_H = 456 * MiB;
constexpr size_t WS_PTOK = 540 * MiB;
constexpr size_t WS_PRSTD = 544 * MiB, WS_PGA = 548 * MiB, WS_PGB = 552 * MiB;
constexpr size_t WS_A2 = 456 * MiB;
constexpr size_t WS_XIN = 648 * MiB;
constexpr size_t WS_X8IN = 328 * MiB;
constexpr size_t WS_X8 = 648 * MiB;
constexpr size_t WS_WMOE1 = 840 * MiB;
constexpr size_t WS_END = 936 * MiB;
static_assert(WS_H + (size_t)SLOT_ROWS * 1024 * 2 <= WS_PTOK && WS_PGB + (size_t)NPAIR * T * 4 <= WS_XIN, "moe buffers");
static_assert(WS_A2 + (size_t)128 * 2048 * 384 * 2 <= WS_XIN && WS_XIN + (size_t)128 * 2048 * 128 * 4 <= WS_WMOE1, "s5 buffers");
static_assert(WS_P + (size_t)T * PN * 2 <= WS_WMOE1, "p buffer");
constexpr int CW_BAR = 4096;
constexpr int CW_TMO = 8;
constexpr int CW_PANEL = 32768;
constexpr int CW_CNT = 16384;

constexpr int RING_BYTES = 131072;
constexpr int LDS_BYTES = 163840;
constexpr int MISC_OFF = LDS_BYTES - 1024;
constexpr int MI_PRE = 136, MI_CNT = 164;

struct Frame {
    LAS unsigned char* lds;
    volatile LAS unsigned* MISC;
    gu32* ctl;
    int tid, lane, wave, vcu, G;
    unsigned char* ws;
    __device__ __forceinline__ const float* in(int i) const {
        const unsigned lo = __builtin_amdgcn_readfirstlane(MISC[64 + 2 * i]), hi = __builtin_amdgcn_readfirstlane(MISC[65 + 2 * i]);
        return (const float*)(((unsigned long long)hi << 32) | lo); }
    __device__ __forceinline__ float* outp() const {
        const unsigned lo = __builtin_amdgcn_readfirstlane(MISC[200]), hi = __builtin_amdgcn_readfirstlane(MISC[201]);
        return (float*)(((unsigned long long)hi << 32) | lo); }
};

__device__ __forceinline__ void transpose_item(const float* W, int ldw, const float* gain, bf16* WT, int ldt, int nblk, LAS float* scr, int item, int lane) {
    const int kb = item / nblk, nb = item % nblk, k0 = 64 * kb, n0 = 32 * nb;
    float v[32];
#pragma unroll
    for (int i = 0; i < 32; ++i) v[i] = W[(size_t)(k0 + 2 * i + (lane >> 5)) * ldw + n0 + (lane & 31)];
    const int c = lane & 7;
    f32x4 g0 = (f32x4){1.f, 1.f, 1.f, 1.f}, g1 = g0;
    if (gain) { g0 = *(const f32x4*)(gain + k0 + 8 * c); g1 = *(const f32x4*)(gain + k0 + 8 * c + 4); }
#pragma unroll
    for (int i = 0; i < 32; ++i) scr[(2 * i + (lane >> 5)) * 33 + (lane & 31)] = v[i];
    LDS_WAIT(); asm volatile("" ::: "memory");
#pragma unroll
    for (int j = 0; j < 4; ++j) { const int n = (lane >> 3) + 8 * j; const LAS float* s = scr + (8 * c) * 33 + n;
        u32x4 o; o.x = pk2(s[0 * 33] * g0[0], s[1 * 33] * g0[1]); o.y = pk2(s[2 * 33] * g0[2], s[3 * 33] * g0[3]); o.z = pk2(s[4 * 33] * g1[0], s[5 * 33] * g1[1]); o.w = pk2(s[6 * 33] * g1[2], s[7 * 33] * g1[3]);
        *(GAS u32x4*)(WT + (size_t)(n0 + n) * ldt + k0 + 8 * c) = o; }
    LDS_WAIT(); asm volatile("" ::: "memory");
}
__device__ __forceinline__ void transpose_item8(const float* W, int ldw, const float* gain, unsigned char* WT, int ldt, int nblk, LAS float* scr, int item, int lane, float sc) {
    const int kb = item / nblk, nb = item % nblk, k0 = 64 * kb, n0 = 32 * nb;
    float v[32];
#pragma unroll
    for (int i = 0; i < 32; ++i) v[i] = W[(size_t)(k0 + 2 * i + (lane >> 5)) * ldw + n0 + (lane & 31)];
    const int c = lane & 7;
    f32x4 g0 = (f32x4){sc, sc, sc, sc}, g1 = g0;
    if (gain) { g0 = *(const f32x4*)(gain + k0 + 8 * c) * sc; g1 = *(const f32x4*)(gain + k0 + 8 * c + 4) * sc; }
#pragma unroll
    for (int i = 0; i < 32; ++i) scr[(2 * i + (lane >> 5)) * 33 + (lane & 31)] = v[i];
    LDS_WAIT(); asm volatile("" ::: "memory");
#pragma unroll
    for (int j = 0; j < 4; ++j) { const int n = (lane >> 3) + 8 * j; const LAS float* s = scr + (8 * c) * 33 + n;
        u32x2 o; o.x = pk4_f8(s[0 * 33] * g0[0], s[1 * 33] * g0[1], s[2 * 33] * g0[2], s[3 * 33] * g0[3]); o.y = pk4_f8(s[4 * 33] * g1[0], s[5 * 33] * g1[1], s[6 * 33] * g1[2], s[7 * 33] * g1[3]);
        *(GAS u32x2*)(WT + (size_t)(n0 + n) * ldt + k0 + 8 * c) = o; }
    LDS_WAIT(); asm volatile("" ::: "memory");
}
__device__ __forceinline__ void sincos_d(double th, double& s, double& c) {
    const double TWO_PI = 6.283185307179586476925286766559;
    const double k = __builtin_rint(th / TWO_PI); const double x = th - k * TWO_PI;
    const double x2 = x * x; double ts = x, tc = 1.0; s = x; c = 1.0;
#pragma unroll
    for (int i = 1; i <= 16; ++i) { tc *= -x2 / (double)((2 * i - 1) * (2 * i)); ts *= -x2 / (double)((2 * i) * (2 * i + 1)); c += tc; s += ts; }
}
__device__ __forceinline__ void s5_build_group(Frame& F, int g, int half) {
    LAS float* pwr = (LAS float*)(F.lds);
    LAS float* pwi = pwr + 17 * 64;
    LAS float* bbr = pwi + 17 * 64;
    LAS float* bbi = bbr + 1024;
    LAS float* cre = bbi + 1024;
    LAS float* cim = cre + 1024;
    LAS float* km = cim + 1024;
    LAS float* ff = km + 4096;
    LAS float* ctr = ff + 128;
    LAS float* cti = ctr + 1024;
    const int tid = F.tid;
    const float* a_re = F.in(19) + g * 64; const float* a_im = F.in(20) + g * 64;
    if (tid < 64) {
        const double dt = (double)expf(F.in(21)[g]), ar = (double)a_re[tid], ai = (double)a_im[tid];
        const double mag = (double)expf((float)(ar * dt)); double sn, cs; sincos_d(ai * dt, sn, cs);
        const double lr = mag * cs, li = mag * sn; double pr = 1.0, pi = 0.0;
        for (int d = 0; d <= 16; ++d) { pwr[d * 64 + tid] = (float)pr; pwi[d * 64 + tid] = (float)pi; const double nr = pr * lr - pi * li, ni = pr * li + pi * lr; pr = nr; pi = ni; }
        const double den = ar * ar + ai * ai;
        ff[tid] = (float)(((lr - 1.0) * ar + li * ai) / den); ff[64 + tid] = (float)((li * ar - (lr - 1.0) * ai) / den);
        if (half == 0) {
            double q16r = 1.0, q16i = 0.0;
            for (int d = 0; d < 16; ++d) { const double nr = q16r * lr - q16i * li, ni = q16r * li + q16i * lr; q16r = nr; q16i = ni; }
            double q64r = q16r, q64i = q16i;
            for (int d = 0; d < 2; ++d) { const double nr = q64r * q64r - q64i * q64i, ni = 2.0 * q64r * q64i; q64r = nr; q64i = ni; }
            *(f32x4*)((float*)(F.ws + WS_LAM) + ((size_t)g * 64 + tid) * 4) = (f32x4){(float)q16r, (float)q16i, (float)q64r, (float)q64i};
        }
    }
    __syncthreads();
    { const float* pbr = F.in(22) + g * 1024; const float* pbi = F.in(23) + g * 1024; const float* pcr = F.in(24) + g * 1024; const float* pci = F.in(25) + g * 1024;
    for (int idx = tid; idx < 1024; idx += NT) { const int p = idx >> 4; const float br = pbr[idx], bi = pbi[idx]; const float fr = ff[p], fi = ff[64 + p];
        bbr[idx] = fr * br - fi * bi; bbi[idx] = fr * bi + fi * br; const float cr_ = pcr[idx], ci_ = pci[idx]; cre[idx] = cr_; cim[idx] = ci_;
        ctr[(idx & 63) * 16 + (idx >> 6)] = cr_; cti[(idx & 63) * 16 + (idx >> 6)] = ci_; } }
    __syncthreads();
    if (tid < 256) {
        const int d = tid >> 4, co = tid & 15; float ac[16];
#pragma unroll
        for (int ci = 0; ci < 16; ++ci) ac[ci] = 0.f;
        for (int p = 0; p < 64; ++p) { const float c_r = ctr[p * 16 + co], c_i = cti[p * 16 + co], l_r = pwr[d * 64 + p], l_i = pwi[d * 64 + p];
            const float tr = c_r * l_r - c_i * l_i, ti = c_r * l_i + c_i * l_r;
#pragma unroll
            for (int c4 = 0; c4 < 4; ++c4) { const f32x4 br = *(const LAS f32x4*)(bbr + p * 16 + 4 * c4), bi = *(const LAS f32x4*)(bbi + p * 16 + 4 * c4);
#pragma unroll
                for (int j = 0; j < 4; ++j) ac[4 * c4 + j] += tr * br[j] - ti * bi[j]; } }
#pragma unroll
        for (int c4 = 0; c4 < 4; ++c4) *(LAS f32x4*)(km + (d << 8) + (co << 4) + 4 * c4) = (f32x4){ac[4 * c4], ac[4 * c4 + 1], ac[4 * c4 + 2], ac[4 * c4 + 3]};
    }
    __syncthreads();
    const float* dsk = F.in(26) + g * 16;
    if (half == 0) { bf16* KB = (bf16*)(F.ws + WS_S5K) + (size_t)g * 4096;
        for (int idx = tid; idx < 4096; idx += NT) { const int co = (idx >> 4) & 15, ci = idx & 15; float v = km[idx]; if (idx < 256 && ci == co) v += dsk[co]; KB[idx] = (bf16)f2bf(v); } }
    bf16* Wo = (bf16*)(F.ws + WS_S5WO) + (size_t)g * 256 * 128;
    for (int idx = half * 128 * 128 + tid; idx < (half + 1) * 128 * 128; idx += NT) { const int row = idx >> 7, q = idx & 127, tl = row >> 4, co = row & 15, p = 8 * (q >> 4) + (q & 7), part = (q >> 3) & 1;
        const float c_r = cre[co * 64 + p], c_i = cim[co * 64 + p], l_r = pwr[(tl + 1) * 64 + p], l_i = pwi[(tl + 1) * 64 + p];
        Wo[idx] = (bf16)f2bf((part == 0) ? (c_r * l_r - c_i * l_i) : -(c_r * l_i + c_i * l_r)); }
    bf16* Wi = (bf16*)(F.ws + WS_S5WIN) + (size_t)g * 128 * 256;
    for (int idx = half * 64 * 256 + tid; idx < (half + 1) * 64 * 256; idx += NT) { const int row = idx >> 8, col = idx & 255, p = 8 * (row >> 4) + (row & 7), part = (row >> 3) & 1, j = col >> 4, ci = col & 15, d = 15 - j;
        const float l_r = pwr[d * 64 + p], l_i = pwi[d * 64 + p], b_r = bbr[p * 16 + ci], b_i = bbi[p * 16 + ci];
        Wi[idx] = (bf16)f2bf(part == 0 ? (l_r * b_r - l_i * b_i) : (l_r * b_i + l_i * b_r)); }
    __syncthreads();
}

__device__ __forceinline__ void ph_prologue(Frame& F, int pf) {
    LAS float* scr = (LAS float*)(F.lds + F.wave * 16384);
    const int gw = F.vcu * NWAVES + F.wave, NGW = F.G * NWAVES, lane = F.lane;
    constexpr int I_IN = 32 * 192, I_SQ = 32 * 64, I_MOE = 512;
    constexpr int NITEMS = I_IN + 4 * I_SQ + 96 * I_MOE;
    if (!(pf & 16))
    for (int it = gw; it < NITEMS; it += NGW) {
        int r = it;
        if (r < I_IN) { if ((r % 192) < 64) transpose_item8(F.in(4), INCOLS, F.in(1), F.ws + WS_WIN, 2048, 192, scr, r, lane, F8_SW);
            else transpose_item(F.in(4), INCOLS, F.in(1), (bf16*)(F.ws + WS_WIN), 2048, 192, scr, r, lane); continue; } r -= I_IN;
        if (r < I_SQ) { if (r < 16 * 64) transpose_item8(F.in(17), 2048, nullptr, F.ws + WS_WOUT, Y3P, 64, scr, r, lane, F8_SW);
            else transpose_item(F.in(17), 2048, nullptr, (bf16*)(F.ws + WS_WOUT + 1024) - 1024, Y3P / 2, 64, scr, r, lane); continue; } r -= I_SQ;
        if (r < I_SQ) { transpose_item8(F.in(18), 2048, F.in(1) + 2048, F.ws + WS_WS5IN, 2048, 64, scr, r, lane, F8_SW); continue; } r -= I_SQ;
        if (r < I_SQ) { transpose_item8(F.in(27), 2048, nullptr, F.ws + WS_WGLUV, 2048, 64, scr, r, lane, F8_SW); continue; } r -= I_SQ;
        if (r < I_SQ) { transpose_item8(F.in(28), 2048, nullptr, F.ws + WS_WGLUG, 2048, 64, scr, r, lane, F8_SW); continue; } r -= I_SQ;
        const int mat = r / I_MOE, itx = r % I_MOE, l = mat / 48, rem = mat % 48, kind = rem / 16, e = rem % 16;
        unsigned char* base = F.ws + (l ? WS_WMOE1 : WS_WMOE0);
        if (kind < 2) transpose_item8((kind == 0 ? F.in(33) : F.in(34)) + (size_t)(l * 16 + e) * 2048 * 512, 512, F.in(2) + l * 2048, base + (size_t)kind * 32 * MiB + (size_t)e * 512 * 2048, 2048, 16, scr, itx, lane, F8_SW);
        else transpose_item8(F.in(35) + (size_t)(l * 16 + e) * 512 * 2048, 2048, nullptr, base + (size_t)64 * MiB + (size_t)e * 2048 * 512, 512, 64, scr, itx, lane, F8_SWD);
    }
    __syncthreads();
    if (!(pf & 32)) for (int gh = F.vcu; gh < 256; gh += F.G) s5_build_group(F, gh >> 1, gh & 1);
    __syncthreads();
    const int gt = F.vcu * NT + F.tid, NGT = F.G * NT;
    {
        bf16* LW = (bf16*)(F.ws + WS_LRUW); const float* wa_ = F.in(7); const float* wx_ = F.in(9); const float* wc_ = F.in(29); const float* wf_ = F.in(31); const float* nf_ = F.in(2);
        for (int idx = gt; idx < 8 * 256 * 128; idx += NGT) { const int n = idx >> 15, o = (idx >> 7) & 255, i = idx & 127;
            const float v = (o < 128) ? wa_[(size_t)(n * 128 + i) * 128 + o] : wx_[(size_t)(n * 128 + i) * 128 + (o - 128)]; LW[idx] = (bf16)f2bf(v); }
        float* RW = (float*)(F.ws + WS_RW);
        bf16* RWB = (bf16*)RW;
        for (int idx = gt; idx < 2 * 32 * 2048; idx += NGT) { const int l = idx >> 16, n = (idx >> 11) & 31, k = idx & 2047;
            const float w = (n < 4) ? wc_[(size_t)(l * 2048 + k) * 4 + n] * nf_[l * 2048 + k] : (n < 20) ? wf_[(size_t)(l * 2048 + k) * 16 + (n - 4)] * nf_[l * 2048 + k] : 0.f;
            const unsigned hi = f2bf(w); const float lo = w - __builtin_bit_cast(float, hi << 16);
            RWB[((size_t)(l * 2 + 0) * 32 + n) * 2048 + k] = (bf16)hi; RWB[((size_t)(l * 2 + 1) * 32 + n) * 2048 + k] = (bf16)f2bf(lo); }
    }
    LAS float* wgT = (LAS float*)F.lds;
    { const float* win = F.in(4); const float* nm0 = F.in(1);
    for (int idx = F.tid; idx < 16384; idx += NT) { const int k = idx >> 3, c = idx & 7; wgT[c * 2048 + k] = win[(size_t)k * INCOLS + 6144 + c] * nm0[k]; } }
    __syncthreads();
    const float* x = F.in(0); bf16* xb = (bf16*)(F.ws + WS_XB); unsigned char* x8 = F.ws + WS_X8IN; float* rstd_o = (float*)(F.ws + WS_RSTD); float* gates = (float*)(F.ws + WS_GATES);
    const float bias = (lane < 4) ? F.in(14)[lane & 3] : F.in(15)[lane & 3];
    if (!(pf & 64))
    for (int m0 = 2 * gw; m0 < T; m0 += 2 * NGW) {
        f32x4 v[2][8]; float ss[2] = {0.f, 0.f};
#pragma unroll
        for (int q = 0; q < 2; ++q) { const GAS f32x4* xr = (const GAS f32x4*)(x + (size_t)(m0 + q) * D) + lane;
#pragma unroll
            for (int j = 0; j < 8; ++j) v[q][j] = xr[64 * j]; }
#pragma unroll
        for (int q = 0; q < 2; ++q) { const int m = m0 + q;
#pragma unroll
            for (int j = 0; j < 8; ++j) ss[q] += (v[q][j].x * v[q][j].x + v[q][j].y * v[q][j].y) + (v[q][j].z * v[q][j].z + v[q][j].w * v[q][j].w);
            ss[q] = wave_sum(ss[q]); const float rstd = 1.0f / sqrtf(ss[q] * (1.0f / D) + EPS);
            GAS u32x2* o8 = (GAS u32x2*)(xb + (size_t)m * D) + lane; GAS unsigned* o4 = (GAS unsigned*)(x8 + (size_t)m * D) + lane;
#pragma unroll
            for (int j = 0; j < 8; ++j) { u32x2 w; w.x = pk2(v[q][j].x, v[q][j].y); w.y = pk2(v[q][j].z, v[q][j].w); o8[64 * j] = w;
                o4[64 * j] = pk4_f8(v[q][j].x * F8_SX, v[q][j].y * F8_SX, v[q][j].z * F8_SX, v[q][j].w * F8_SX); }
            float ga[8];
#pragma unroll
            for (int c = 0; c < 8; ++c) { float a = 0.f;
#pragma unroll
                for (int j = 0; j < 8; ++j) { const f32x4 w = *(const LAS f32x4*)(wgT + c * 2048 + 4 * (lane + 64 * j)); a += (v[q][j].x * w.x + v[q][j].y * w.y) + (v[q][j].z * w.z + v[q][j].w * w.w); }
                ga[c] = wave_sum(a); asm volatile("" ::: "memory"); }
            float val = ga[0];
#pragma unroll
            for (int c = 1; c < 8; ++c) val = (lane == c) ? ga[c] : val;
            if (lane < 8) gates[(size_t)m * 8 + lane] = val * rstd + bias;
            if (lane == 0) rstd_o[m] = rstd; }
    }
    __syncthreads();
}

__device__ __forceinline__ unsigned ld_agent_u32(const unsigned* p) { return __hip_atomic_load(p, RLX_AGENT); }
__device__ __forceinline__ float ld_agent_f32(const float* p) { return __builtin_bit_cast(float, __hip_atomic_load((const unsigned*)p, RLX_AGENT)); }
using pg8::Unit;

struct DenseSched {
    pg8::TileOrder to; const char* A; size_t tstepA; const char* B0; const char* B1; size_t tstepB; int cpt;
    __device__ __forceinline__ bool next(int i, Unit& u) const { int pm, pn; if (!to.next(i, pm, pn)) return false;
        u.a = A + (size_t)pm * tstepA; u.b0 = B0 + (size_t)pn * tstepB; u.b1 = B1 + (size_t)pn * tstepB; u.b0x = u.b0; u.b1x = u.b1; u.r0 = pm * 256; u.c0 = pn * cpt; u.aux = 0; u.x = 0; return true; }
    __device__ __forceinline__ unsigned row_off(const Unit&, int) const { return 0u; }
    __device__ __forceinline__ void a_ready(const Unit&) const {}
};
struct S5Sched {
    int G, c; const char* A; const char* B; size_t gstepB; size_t hstepB;
    __device__ __forceinline__ bool next(int i, Unit& u) const { const int L = i * G + c; if (L >= 1024) return false; const int g = L >> 3, pm = L & 7;
        u.a = A + ((size_t)g * 2048 + (size_t)pm * 256) * 768; u.b0 = B + (size_t)g * gstepB; u.b1 = u.b0 + hstepB; u.b0x = u.b0; u.b1x = u.b1; u.r0 = pm * 256; u.c0 = 0; u.aux = g; u.x = 0; return true; }
    __device__ __forceinline__ unsigned row_off(const Unit&, int) const { return 0u; }
    __device__ __forceinline__ void a_ready(const Unit&) const {}
};
__device__ __forceinline__ void pair_experts(int q, int& ea, int& eb) { const int g = q / 6, p = q - 6 * g; const int ia = (p < 3) ? 0 : (p < 5) ? 1 : 2, ib = (p < 3) ? p + 1 : (p < 5) ? p - 1 : 3; ea = 4 * g + ia; eb = 4 * g + ib; }
template <bool DOWN> struct MoeSched {
    volatile LAS unsigned* misc; int G, c; const char* W0; const char* W1; const char* Hd; const int* ptok;
    __device__ __forceinline__ bool next(int i, Unit& u) const {
        const int L = i * G + c, ntiles = __builtin_amdgcn_readfirstlane((int)misc[MI_PRE + NPAIR]); if (L >= ntiles * 8) return false;
        int q = 0;
#pragma unroll
        for (int j = 1; j < NPAIR; ++j) q += ((L >> 3) >= __builtin_amdgcn_readfirstlane((int)misc[MI_PRE + j])) ? 1 : 0;
        const int pq = __builtin_amdgcn_readfirstlane((int)misc[MI_PRE + q]), tq = __builtin_amdgcn_readfirstlane((int)misc[MI_PRE + q + 1]) - pq, loc = L - 8 * pq;
        const int ct = loc / tq, gr = pq + (loc - ct * tq);
        int ea, eb; pair_experts(q, ea, eb);
        u.aux = q; u.r0 = gr * 256; u.x = (gr - pq) * 256;
        if (!DOWN) { const int e = (ct < 4) ? ea : eb; u.c0 = ct * 128; u.a = nullptr;
            u.b0 = W0 + (size_t)e * 512 * 2048 + (size_t)(ct & 3) * 128 * 2048; u.b1 = W1 + (size_t)e * 512 * 2048 + (size_t)(ct & 3) * 128 * 2048; u.b0x = u.b0; u.b1x = u.b1; }
        else { u.c0 = ct * 256; u.a = Hd + (size_t)gr * 256 * 1024;
            u.b0 = W0 + (size_t)ea * 2048 * 512 + (size_t)ct * 256 * 512; u.b1 = u.b0 + (size_t)128 * 512; u.b0x = W0 + (size_t)eb * 2048 * 512 + (size_t)ct * 256 * 512; u.b1x = u.b0x + (size_t)128 * 512; }
        return true; }
    __device__ __forceinline__ unsigned row_off(const Unit& u, int row) const { const int cnt = __builtin_amdgcn_readfirstlane((int)misc[MI_CNT + u.aux]); int idx = u.x + row; idx = idx < cnt ? idx : cnt - 1;
        return (unsigned)ptok[(size_t)u.aux * T + idx] * 2048u; }
};

struct EpiScaleBf16 {
    static constexpr bool PERM = true;
    bf16* O; int ldc; const float* scale; int pf; float k;
    __device__ __forceinline__ void operator()(const f32x4 (&acc)[2][2][4][2], const Unit& u, int wr, int wc, int fr, int fq) const {
        const int row0 = u.r0 + wr * 64 + fr, col0 = u.c0 + wc * 32 + 8 * fq;
        float sv[2][4];
#pragma unroll
        for (int ai = 0; ai < 2; ++ai)
#pragma unroll
            for (int m = 0; m < 4; ++m) sv[ai][m] = scale[row0 + ai * 128 + m * 16];
#pragma unroll
        for (int ai = 0; ai < 2; ++ai)
#pragma unroll
            for (int m = 0; m < 4; ++m) { int zz = 0; asm volatile("" : "+v"(zz)); const int row = row0 + ai * 128 + m * 16 + zz; const float s = sv[ai][m] * k; bf16* rowp = O + (size_t)row * ldc + col0;
#pragma unroll
                for (int bj = 0; bj < 2; ++bj) { const f32x4 v0 = acc[ai][bj][m][0] * s, v1 = acc[ai][bj][m][1] * s;
                    u32x4 w; w.x = pk2(v0[0], v0[1]); w.y = pk2(v0[2], v0[3]); w.z = pk2(v1[0], v1[1]); w.w = pk2(v1[2], v1[3]);
                    if (!(pf & 16)) *(u32x4*)(rowp + bj * 128) = w; else asm volatile("" :: "v"(w.x), "v"(w.y), "v"(w.z), "v"(w.w)); } }
    }
};
struct EpiS5U {
    static constexpr bool PERM = true;
    bf16* A2; const float* scale; float k;
    __device__ __forceinline__ void operator()(const f32x4 (&acc)[2][2][4][2], const Unit& u, int wr, int wc, int fr, int fq) const {
        const int row0 = u.r0 + wr * 64 + fr, col0 = u.c0 + wc * 32 + 8 * fq;
        float sv[2][4];
#pragma unroll
        for (int ai = 0; ai < 2; ++ai)
#pragma unroll
            for (int m = 0; m < 4; ++m) sv[ai][m] = scale[row0 + ai * 128 + m * 16];
#pragma unroll
        for (int ai = 0; ai < 2; ++ai)
#pragma unroll
            for (int m = 0; m < 4; ++m) { int zz = 0; asm volatile("" : "+v"(zz)); const int t = row0 + ai * 128 + m * 16 + zz; const float s = sv[ai][m] * k; const int n = t >> 4, tl = t & 15;
#pragma unroll
                for (int bj = 0; bj < 2; ++bj) { const int c = col0 + bj * 128, g = c >> 4, half = (c >> 3) & 1; const f32x4 v0 = acc[ai][bj][m][0] * s, v1 = acc[ai][bj][m][1] * s;
                    u32x4 w; w.x = pk2(v0[0], v0[1]); w.y = pk2(v0[2], v0[3]); w.z = pk2(v1[0], v1[1]); w.w = pk2(v1[2], v1[3]);
                    *(u32x4*)(A2 + ((size_t)g * 2048 + n) * 256 + tl * 16 + half * 8) = w; } }
    }
};
struct EpiOutRes {
    static constexpr bool PERM = true;
    bf16* xb; unsigned char* x8;
    __device__ __forceinline__ void operator()(const f32x4 (&acc)[2][2][4][2], const Unit& u, int wr, int wc, int fr, int fq) const {
        const int row0 = u.r0 + wr * 64 + fr, col0 = u.c0 + wc * 32 + 8 * fq;
        u32x4 xr[2][4][2];
#pragma unroll
        for (int ai = 0; ai < 2; ++ai)
#pragma unroll
            for (int m = 0; m < 4; ++m)
#pragma unroll
                for (int bj = 0; bj < 2; ++bj) xr[ai][m][bj] = *(const u32x4*)(xb + (size_t)(row0 + ai * 128 + m * 16) * D + col0 + bj * 128);
#pragma unroll
        for (int ai = 0; ai < 2; ++ai)
#pragma unroll
            for (int m = 0; m < 4; ++m) { int zz = 0; asm volatile("" : "+v"(zz)); const size_t off = (size_t)(row0 + ai * 128 + m * 16 + zz) * D + col0;
#pragma unroll
                for (int bj = 0; bj < 2; ++bj) { const f32x4 a0 = acc[ai][bj][m][0], a1 = acc[ai][bj][m][1]; const u32x4 x = xr[ai][m][bj];
                    const float v0 = bf_lo(x.x) + a0[0], v1 = bf_hi(x.x) + a0[1], v2 = bf_lo(x.y) + a0[2], v3 = bf_hi(x.y) + a0[3], v4 = bf_lo(x.z) + a1[0], v5 = bf_hi(x.z) + a1[1], v6 = bf_lo(x.w) + a1[2], v7 = bf_hi(x.w) + a1[3];
                    u32x4 w; w.x = pk2(v0, v1); w.y = pk2(v2, v3); w.z = pk2(v4, v5); w.w = pk2(v6, v7);
                    *(u32x4*)(xb + off + bj * 128) = w;
                    u32x2 o; o.x = pk4_f8(v0 * F8_SX, v1 * F8_SX, v2 * F8_SX, v3 * F8_SX); o.y = pk4_f8(v4 * F8_SX, v5 * F8_SX, v6 * F8_SX, v7 * F8_SX);
                    *(u32x2*)(x8 + off + bj * 128) = o; } }
    }
};
struct EpiGlu {
    static constexpr bool PERM = true;
    bf16* xb; unsigned char* x8;
    __device__ __forceinline__ void operator()(const f32x4 (&acc)[2][2][4][2], const Unit& u, int wr, int wc, int fr, int fq) const {
        const int row0 = u.r0 + wr * 64 + fr, col0 = u.c0 + wc * 32 + 8 * fq;
        u32x4 xr[2][4];
#pragma unroll
        for (int ai = 0; ai < 2; ++ai)
#pragma unroll
            for (int m = 0; m < 4; ++m) xr[ai][m] = *(const u32x4*)(xb + (size_t)(row0 + ai * 128 + m * 16) * D + col0);
#pragma unroll
        for (int ai = 0; ai < 2; ++ai)
#pragma unroll
            for (int m = 0; m < 4; ++m) { int zz = 0; asm volatile("" : "+v"(zz)); const size_t off = (size_t)(row0 + ai * 128 + m * 16 + zz) * D + col0;
                constexpr float kk = 1.0f / (F8_SY * F8_SW);
                const f32x4 a0 = acc[ai][0][m][0] * kk, a1 = acc[ai][0][m][1] * kk, g0 = acc[ai][1][m][0] * kk, g1 = acc[ai][1][m][1] * kk; const u32x4 x = xr[ai][m];
                const float v0 = bf_lo(x.x) + a0[0] * sigmoidf_(g0[0]), v1 = bf_hi(x.x) + a0[1] * sigmoidf_(g0[1]), v2 = bf_lo(x.y) + a0[2] * sigmoidf_(g0[2]), v3 = bf_hi(x.y) + a0[3] * sigmoidf_(g0[3]);
                const float v4 = bf_lo(x.z) + a1[0] * sigmoidf_(g1[0]), v5 = bf_hi(x.z) + a1[1] * sigmoidf_(g1[1]), v6 = bf_lo(x.w) + a1[2] * sigmoidf_(g1[2]), v7 = bf_hi(x.w) + a1[3] * sigmoidf_(g1[3]);
                u32x4 w; w.x = pk2(v0, v1); w.y = pk2(v2, v3); w.z = pk2(v4, v5); w.w = pk2(v6, v7);
                *(u32x4*)(xb + off) = w;
                u32x2 o; o.x = pk4_f8(v0 * F8_SX, v1 * F8_SX, v2 * F8_SX, v3 * F8_SX); o.y = pk4_f8(v4 * F8_SX, v5 * F8_SX, v6 * F8_SX, v7 * F8_SX);
                *(u32x2*)(x8 + off) = o; }
    }
};
struct EpiGateUp {
    static constexpr bool PERM = true;
    unsigned char* H; const float* prstd; const float* pga; const float* pgb; volatile LAS unsigned* misc; int pf;
    __device__ __forceinline__ void operator()(const f32x4 (&acc)[2][2][4][2], const Unit& u, int wr, int wc, int fr, int fq) const {
        if (pf & 16) { asm volatile("" :: "v"(acc[0][0][0][0][0]), "v"(acc[1][1][3][1][3])); return; }
        const int rl0 = wr * 64 + fr, col0 = u.c0 + wc * 32 + 8 * fq, cnt = __builtin_amdgcn_readfirstlane((int)misc[MI_CNT + u.aux]);
        const float* pg = (u.c0 < 512) ? pga : pgb;
        float sv[2][4], gv[2][4];
#pragma unroll
        for (int ai = 0; ai < 2; ++ai)
#pragma unroll
            for (int m = 0; m < 4; ++m) { int idx = u.x + rl0 + ai * 128 + m * 16; idx = idx < cnt ? idx : cnt - 1; sv[ai][m] = prstd[(size_t)u.aux * T + idx]; gv[ai][m] = pg[(size_t)u.aux * T + idx]; }
#pragma unroll
        for (int ai = 0; ai < 2; ++ai)
#pragma unroll
            for (int m = 0; m < 4; ++m) { int zz = 0; asm volatile("" : "+v"(zz)); const int rl = rl0 + ai * 128 + m * 16 + zz; const float r = sv[ai][m] * (1.0f / (F8_SX * F8_SW)), gt = gv[ai][m] * r * F8_SH;
                float hv[8];
#pragma unroll
                for (int n = 0; n < 2; ++n)
#pragma unroll
                    for (int j = 0; j < 4; ++j) hv[n * 4 + j] = siluf_(acc[ai][0][m][n][j] * r) * (acc[ai][1][m][n][j] * gt);
                u32x2 w; w.x = pk4_f8(hv[0], hv[1], hv[2], hv[3]); w.y = pk4_f8(hv[4], hv[5], hv[6], hv[7]);
                *(u32x2*)(H + (size_t)(u.r0 + rl) * 1024 + col0) = w; }
    }
};
struct EpiDownRes {
    static constexpr bool PERM = true;
    bf16* xb; const int* ptok; volatile LAS unsigned* misc; bf16* dst; unsigned char* x8;
    __device__ __forceinline__ void operator()(const f32x4 (&acc)[2][2][4][2], const Unit& u, int wr, int wc, int fr, int fq) const {
        const int rl0 = wr * 64 + fr, col0 = u.c0 + wc * 32 + 8 * fq, cnt = __builtin_amdgcn_readfirstlane((int)misc[MI_CNT + u.aux]);
        int tk[2][4];
#pragma unroll
        for (int ai = 0; ai < 2; ++ai)
#pragma unroll
            for (int m = 0; m < 4; ++m) { const int idx = u.x + rl0 + ai * 128 + m * 16; tk[ai][m] = (idx < cnt) ? ptok[(size_t)u.aux * T + idx] : -1; }
        u32x4 xr[2][4][2];
#pragma unroll
        for (int ai = 0; ai < 2; ++ai)
#pragma unroll
            for (int m = 0; m < 4; ++m)
#pragma unroll
                for (int bj = 0; bj < 2; ++bj) xr[ai][m][bj] = (tk[ai][m] >= 0) ? *(const u32x4*)(xb + (size_t)tk[ai][m] * D + col0 + bj * 128) : (u32x4){0u, 0u, 0u, 0u};
#pragma unroll
        for (int ai = 0; ai < 2; ++ai)
#pragma unroll
            for (int m = 0; m < 4; ++m) { int zz = 0; asm volatile("" : "+v"(zz)); const int tok = tk[ai][m] + zz;
                if (tok >= 0) {
#pragma unroll
                    for (int bj = 0; bj < 2; ++bj) { constexpr float kk = 1.0f / (F8_SH * F8_SWD); const f32x4 a0 = acc[ai][bj][m][0] * kk, a1 = acc[ai][bj][m][1] * kk; const u32x4 x = xr[ai][m][bj];
                        const float v0 = bf_lo(x.x) + a0[0], v1 = bf_hi(x.x) + a0[1], v2 = bf_lo(x.y) + a0[2], v3 = bf_hi(x.y) + a0[3], v4 = bf_lo(x.z) + a1[0], v5 = bf_hi(x.z) + a1[1], v6 = bf_lo(x.w) + a1[2], v7 = bf_hi(x.w) + a1[3];
                        u32x4 w; w.x = pk2(v0, v1); w.y = pk2(v2, v3); w.z = pk2(v4, v5); w.w = pk2(v6, v7);
                        *(u32x4*)(dst + (size_t)tok * D + col0 + bj * 128) = w;
                        if (x8) { u32x2 o; o.x = pk4_f8(v0 * F8_SX, v1 * F8_SX, v2 * F8_SX, v3 * F8_SX); o.y = pk4_f8(v4 * F8_SX, v5 * F8_SX, v6 * F8_SX, v7 * F8_SX);
                            *(u32x2*)(x8 + (size_t)tok * D + col0 + bj * 128) = o; } } } }
    }
};
struct EpiXin {
    static constexpr bool PERM = false;
    float* X;
    __device__ __forceinline__ void operator()(const f32x4 (&acc)[2][2][4][2], const Unit& u, int wr, int wc, int fr, int fq) const {
        const int rl0 = u.r0 + wr * 64 + fr, col0 = wc * 32 + 4 * fq;
#pragma unroll
        for (int ai = 0; ai < 2; ++ai)
#pragma unroll
            for (int m = 0; m < 4; ++m) { int zz = 0; asm volatile("" : "+v"(zz)); float* rowp = X + ((size_t)u.aux * 2048 + rl0 + ai * 128 + m * 16 + zz) * 128 + col0;
#pragma unroll
                for (int n = 0; n < 2; ++n) *(f32x4*)(rowp + n * 16) = acc[ai][0][m][n]; }
    }
};
struct EpiS5Y {
    static constexpr bool PERM = true;
    bf16* Y2;
    __device__ __forceinline__ void operator()(const f32x4 (&acc)[2][2][4][2], const Unit& u, int wr, int wc, int fr, int fq) const {
        const int rl0 = u.r0 + wr * 64 + fr, col0 = wc * 32 + 8 * fq;
#pragma unroll
        for (int ai = 0; ai < 2; ++ai)
#pragma unroll
            for (int m = 0; m < 4; ++m) { int zz = 0; asm volatile("" : "+v"(zz)); const int n = rl0 + ai * 128 + m * 16 + zz;
#pragma unroll
                for (int bj = 0; bj < 2; ++bj) { const int c = col0 + bj * 128, tl = c >> 4, half = (c >> 3) & 1; const f32x4 a0 = acc[ai][bj][m][0], a1 = acc[ai][bj][m][1];
                    u32x4 w; w.x = pk2(gelu_tanh(a0[0]), gelu_tanh(a0[1])); w.y = pk2(gelu_tanh(a0[2]), gelu_tanh(a0[3])); w.z = pk2(gelu_tanh(a1[0]), gelu_tanh(a1[1])); w.w = pk2(gelu_tanh(a1[2]), gelu_tanh(a1[3]));
                    const int tok = n * 16 + tl;
                    *(u32x4*)(Y2 + ((((size_t)(tok >> 8) * 128 + u.aux) * 256) + (tok & 255)) * 16 + half * 8) = w; } }
    }
};

constexpr int ML_QP = 528, ML_KTP = 144;
constexpr int ML_Q = 0, ML_K = 33792, ML_KT = 67584, ML_C = 104448, ML_SC = 138240;
constexpr int ML_P = ML_K, ML_VT = ML_K + 9216, ML_VWT = ML_Q;
constexpr int ML_CW = 141824;
__device__ __forceinline__ unsigned bf_elem(const u32x4& v, int i) { const unsigned w = v[i >> 1]; return (i & 1) ? (w >> 16) : (w & 0xffffu); }
__device__ __forceinline__ void mlstm_unit(Frame& F, int b, int hh, int s, int pf) {
    LAS unsigned char* L = F.lds; LAS float* sc = (LAS float*)(L + ML_SC);
    const int tid = F.tid, lane = F.lane, w = F.wave, l15 = lane & 15, lq = lane >> 4;
    const bf16* P = (const bf16*)(F.ws + WS_P); bf16* Y = (bf16*)(F.ws + ((pf & 8) ? WS_XB : WS_Y)); const float* gates = (const float*)(F.ws + WS_GATES); float* sumsq = (float*)(F.ws + ((pf & 8) ? 950 * MiB : WS_SUMSQ));
    const int isk = lane >> 5, e0 = 8 * (lane & 31), cch = (isk ? 1024 : 0) + hh * 256 + e0;
    const float osc = isk ? 0.0625f : 1.0f;
    {
        const float* cwp = F.in(12) + cch; const float* cbp = F.in(13) + cch;
        if (w == 0) {
#pragma unroll
            for (int ih = 0; ih < 2; ++ih) {
#pragma unroll
                for (int j = 0; j < 4; ++j) *(LAS f32x4*)(L + ML_CW + ((ih * 5 + j) * 64 + lane) * 16) = *(const GAS f32x4*)(cwp + j * 2048 + 4 * ih);
                *(LAS f32x4*)(L + ML_CW + ((ih * 5 + 4) * 64 + lane) * 16) = *(const GAS f32x4*)(cbp + 4 * ih); }
        }
    }
    f32x4 cacc[2][4];
#pragma unroll
    for (int q = 0; q < 2; ++q)
#pragma unroll
        for (int dc = 0; dc < 4; ++dc) cacc[q][dc] = (f32x4){0.f, 0.f, 0.f, 0.f};
    for (int idx = tid; idx < 33792 / 16; idx += NT) ((LAS u32x4*)(L + ML_C))[idx] = (u32x4){0u, 0u, 0u, 0u};
    if (tid < 256) sc[512 + tid] = 0.f;
    float m_st = 0.f;
    const int tr = w >> 1, cb2 = 2 * (w & 1);
    const int vj = tid >> 3, vdg = tid & 7;
    u32x4 raw[11];
#pragma unroll
    for (int r = 0; r < 11; ++r) { const int t = 8 * w - 3 + r;
        raw[r] = (t >= 0) ? *(const GAS u32x4*)(P + ((size_t)b * SEQ + t) * PN + 2048 + cch) : (u32x4){0u, 0u, 0u, 0u}; }
    float ipn = 0.f, fpn = 0.f;
    if (w == 0) { ipn = gates[((size_t)b * SEQ + lane) * 8 + hh]; fpn = gates[((size_t)b * SEQ + lane) * 8 + 4 + hh]; }
    __syncthreads();
    for (int ch = 0; ch < 32; ++ch) {
        const int t0 = ch * 64; const size_t row0 = (size_t)b * SEQ + t0;
        const u32x4 vraw = *(const GAS u32x4*)(P + (row0 + vj) * PN + 4096 + hh * 256 + s * 64 + 8 * vdg);
        bf16 ov[4][2];
#pragma unroll
        for (int r = 0; r < 4; ++r) { const size_t prow = (row0 + 16 * tr + 4 * lq + r) * PN + 5120 + hh * 256 + s * 64 + 16 * cb2 + l15; ov[r][0] = P[prow]; ov[r][1] = P[prow + 16]; }
        if (!(pf & 16)) {
            asm volatile("" ::: "memory");
#pragma unroll
            for (int ih = 0; ih < 2; ++ih) {
                const f32x4 cb4 = *(const LAS f32x4*)(L + ML_CW + ((ih * 5 + 4) * 64 + lane) * 16);
                f32x4 cw4[4];
#pragma unroll
                for (int j = 0; j < 4; ++j) cw4[j] = *(const LAS f32x4*)(L + ML_CW + ((ih * 5 + j) * 64 + lane) * 16);
                u32x2 outp[8];
                float xw[3][4];
#pragma unroll
                for (int r = 0; r < 3; ++r) { xw[r][0] = bf_lo(raw[r][2 * ih]); xw[r][1] = bf_hi(raw[r][2 * ih]); xw[r][2] = bf_lo(raw[r][2 * ih + 1]); xw[r][3] = bf_hi(raw[r][2 * ih + 1]); }
#pragma unroll
                for (int r = 0; r < 8; ++r) { float o[4], xc[4];
                    xc[0] = bf_lo(raw[r + 3][2 * ih]); xc[1] = bf_hi(raw[r + 3][2 * ih]); xc[2] = bf_lo(raw[r + 3][2 * ih + 1]); xc[3] = bf_hi(raw[r + 3][2 * ih + 1]);
#pragma unroll
                    for (int i4 = 0; i4 < 4; ++i4) { const float cv = cb4[i4] + cw4[0][i4] * xw[0][i4] + cw4[1][i4] * xw[1][i4] + cw4[2][i4] * xw[2][i4] + cw4[3][i4] * xc[i4]; o[i4] = siluf_(cv) * osc;
                        xw[0][i4] = xw[1][i4]; xw[1][i4] = xw[2][i4]; xw[2][i4] = xc[i4]; }
                    outp[r].x = pk2(o[0], o[1]); outp[r].y = pk2(o[2], o[3]);
                    *(LAS u32x2*)(L + (isk ? ML_K : ML_Q) + (8 * w + r) * ML_QP + (e0 + 4 * ih) * 2) = outp[r]; }
                if (isk) {
#pragma unroll
                    for (int i4 = 0; i4 < 4; ++i4) { u32x4 v;
#define ML_EL(r) ((i4 & 1) ? (outp[r][i4 >> 1] >> 16) : (outp[r][i4 >> 1] & 0xffffu))
                        v.x = ML_EL(0) | (ML_EL(1) << 16); v.y = ML_EL(2) | (ML_EL(3) << 16); v.z = ML_EL(4) | (ML_EL(5) << 16); v.w = ML_EL(6) | (ML_EL(7) << 16);
#undef ML_EL
                        *(LAS u32x4*)(L + ML_KT + (e0 + 4 * ih + i4) * ML_KTP + (8 * w) * 2) = v; }
                }
            }
        }
        asm volatile("" ::: "memory");
        if (ch + 1 < 32) {
#pragma unroll
            for (int r = 0; r < 11; ++r) raw[r] = *(const GAS u32x4*)(P + (row0 + 64 + 8 * w - 3 + r) * PN + 2048 + cch);
        }
        if (w == 0) {
            const float ip = ipn, fp = fpn;
            if (ch + 1 < 32) { ipn = gates[(row0 + 64 + lane) * 8 + hh]; fpn = gates[(row0 + 64 + lane) * 8 + 4 + hh]; }
            const float lf = fminf(fp, 0.f) - __logf(1.0f + __expf(-fabsf(fp)));
            float bc = lf;
#pragma unroll
            for (int o = 1; o < 64; o <<= 1) { const float t = __shfl_up(bc, o); if (lane >= o) bc += t; }
            const float a = ip - bc; float pm = a;
#pragma unroll
            for (int o = 1; o < 64; o <<= 1) { const float t = __shfl_up(pm, o); if (lane >= o) pm = fmaxf(pm, t); }
            const float M = fmaxf(m_st, pm);
            const float M63 = __shfl(M, 63), b63 = __shfl(bc, 63);
            sc[lane] = a; sc[64 + lane] = M; sc[128 + lane] = __expf(m_st - M); sc[192 + lane] = __expf(-(bc + M)); sc[256 + lane] = __expf(a - M63);
            if (lane == 0) sc[768] = __expf(m_st - M63);
            m_st = b63 + M63;
        }
        __syncthreads();
        float pw[2][4] = {{0.f, 0.f, 0.f, 0.f}, {0.f, 0.f, 0.f, 0.f}};
        if (!(pf & 32)) {
            f32x4 s0 = (f32x4){0.f, 0.f, 0.f, 0.f}, s1 = s0;
#pragma unroll
            for (int kk = 0; kk < 8; ++kk) {
                const bf16x8 a = *(const LAS bf16x8*)(L + ML_Q + (16 * tr + l15) * ML_QP + (32 * kk + 8 * lq) * 2);
                const bf16x8 k0 = *(const LAS bf16x8*)(L + ML_K + (16 * cb2 + l15) * ML_QP + (32 * kk + 8 * lq) * 2);
                const bf16x8 k1 = *(const LAS bf16x8*)(L + ML_K + (16 * (cb2 + 1) + l15) * ML_QP + (32 * kk + 8 * lq) * 2);
                s0 = __builtin_amdgcn_mfma_f32_16x16x32_bf16(a, k0, s0, 0, 0, 0); s1 = __builtin_amdgcn_mfma_f32_16x16x32_bf16(a, k1, s1, 0, 0, 0); }
            const int j0 = 16 * cb2 + l15, j1 = j0 + 16; const float a0 = sc[j0], a1 = sc[j1];
#pragma unroll
            for (int r = 0; r < 4; ++r) { const int t = 16 * tr + 4 * lq + r; const float Mt = sc[64 + t];
                pw[0][r] = (j0 <= t) ? s0[r] * __expf(a0 - Mt) : 0.f; pw[1][r] = (j1 <= t) ? s1[r] * __expf(a1 - Mt) : 0.f; }
        }
        __syncthreads();
#pragma unroll
        for (int r = 0; r < 4; ++r) { const int t = 16 * tr + 4 * lq + r;
            *(LAS bf16*)(L + ML_P + t * ML_KTP + (16 * cb2 + l15) * 2) = (bf16)f2bf(pw[0][r]); *(LAS bf16*)(L + ML_P + t * ML_KTP + (16 * cb2 + 16 + l15) * 2) = (bf16)f2bf(pw[1][r]); }
#pragma unroll
        for (int i = 0; i < 8; ++i) *(LAS bf16*)(L + ML_VT + (8 * vdg + i) * ML_KTP + vj * 2) = (bf16)bf_elem(vraw, i);
        __syncthreads();
        {
            const int t = tid >> 3, part = tid & 7;
            const u32x4 pv = *(const LAS u32x4*)(L + ML_P + t * ML_KTP + part * 16);
            float ds = (bf_lo(pv.x) + bf_hi(pv.x)) + (bf_lo(pv.y) + bf_hi(pv.y)) + (bf_lo(pv.z) + bf_hi(pv.z)) + (bf_lo(pv.w) + bf_hi(pv.w));
            float qn = 0.f;
#pragma unroll
            for (int q4 = 0; q4 < 4; ++q4) { const u32x4 qv = *(const LAS u32x4*)(L + ML_Q + t * ML_QP + part * 64 + q4 * 16);
                const f32x4 n0 = *(const LAS f32x4*)(sc + 512 + part * 32 + q4 * 8), n1 = *(const LAS f32x4*)(sc + 512 + part * 32 + q4 * 8 + 4);
                qn += bf_lo(qv.x) * n0[0] + bf_hi(qv.x) * n0[1] + bf_lo(qv.y) * n0[2] + bf_hi(qv.y) * n0[3] + bf_lo(qv.z) * n1[0] + bf_hi(qv.z) * n1[1] + bf_lo(qv.w) * n1[2] + bf_hi(qv.w) * n1[3]; }
#pragma unroll
            for (int o = 1; o < 8; o <<= 1) { ds += __shfl_xor(ds, o); qn += __shfl_xor(qn, o); }
            if (part == 0) sc[320 + t] = ds + sc[128 + t] * qn;
        }
        f32x4 pv0 = (f32x4){0.f, 0.f, 0.f, 0.f}, pv1 = pv0, qc0 = pv0, qc1 = pv0;
        if (!(pf & 64)) {
#pragma unroll
        for (int kk = 0; kk < 2; ++kk) {
            const bf16x8 a = *(const LAS bf16x8*)(L + ML_P + (16 * tr + l15) * ML_KTP + (32 * kk + 8 * lq) * 2);
            const bf16x8 v0 = *(const LAS bf16x8*)(L + ML_VT + (16 * cb2 + l15) * ML_KTP + (32 * kk + 8 * lq) * 2);
            const bf16x8 v1 = *(const LAS bf16x8*)(L + ML_VT + (16 * (cb2 + 1) + l15) * ML_KTP + (32 * kk + 8 * lq) * 2);
            pv0 = __builtin_amdgcn_mfma_f32_16x16x32_bf16(a, v0, pv0, 0, 0, 0); pv1 = __builtin_amdgcn_mfma_f32_16x16x32_bf16(a, v1, pv1, 0, 0, 0); }
#pragma unroll
        for (int kk = 0; kk < 8; ++kk) {
            const bf16x8 a = *(const LAS bf16x8*)(L + ML_Q + (16 * tr + l15) * ML_QP + (32 * kk + 8 * lq) * 2);
            const bf16x8 c0 = *(const LAS bf16x8*)(L + ML_C + (16 * cb2 + l15) * ML_QP + (32 * kk + 8 * lq) * 2);
            const bf16x8 c1 = *(const LAS bf16x8*)(L + ML_C + (16 * (cb2 + 1) + l15) * ML_QP + (32 * kk + 8 * lq) * 2);
            qc0 = __builtin_amdgcn_mfma_f32_16x16x32_bf16(a, c0, qc0, 0, 0, 0); qc1 = __builtin_amdgcn_mfma_f32_16x16x32_bf16(a, c1, qc1, 0, 0, 0); }
        }
        __syncthreads();
        if (!(pf & 64)) {
#pragma unroll
            for (int r = 0; r < 4; ++r) { const int t = 16 * tr + 4 * lq + r; const float wi = sc[128 + t], dn = fmaxf(fabsf(sc[320 + t]), sc[192 + t]); const float inv = __builtin_amdgcn_rcpf(dn);
                const size_t yrow = (row0 + t) * (Y3P / 2) + 512 + hh * 256 + s * 64;
                const int d0 = 16 * cb2 + l15, d1 = d0 + 16;
                const float h0 = (pv0[r] + wi * qc0[r]) * inv * sigmoidf_(bf2f(ov[r][0])), h1 = (pv1[r] + wi * qc1[r]) * inv * sigmoidf_(bf2f(ov[r][1]));
                Y[yrow + d0] = (bf16)f2bf(h0); Y[yrow + d1] = (bf16)f2bf(h1);
                float q = h0 * h0 + h1 * h1;
#pragma unroll
                for (int o = 1; o < 16; o <<= 1) q += __shfl_xor(q, o);
                if (l15 == 0) sc[384 + (w & 1) * 64 + t] = q; }
        }
        const float decay = sc[768];
        {
            const float we = sc[256 + vj];
#pragma unroll
            for (int i = 0; i < 8; ++i) *(LAS bf16*)(L + ML_VWT + (8 * vdg + i) * ML_KTP + vj * 2) = (bf16)f2bf(__builtin_bit_cast(float, bf_elem(vraw, i) << 16) * we);
            if (tid < 256) { float a = 0.f;
#pragma unroll
                for (int j8 = 0; j8 < 8; ++j8) { const u32x4 kv = *(const LAS u32x4*)(L + ML_KT + tid * ML_KTP + j8 * 16); const f32x4 w0 = *(const LAS f32x4*)(sc + 256 + j8 * 8), w1 = *(const LAS f32x4*)(sc + 256 + j8 * 8 + 4);
                    a += bf_lo(kv.x) * w0[0] + bf_hi(kv.x) * w0[1] + bf_lo(kv.y) * w0[2] + bf_hi(kv.y) * w0[3] + bf_lo(kv.z) * w1[0] + bf_hi(kv.z) * w1[1] + bf_lo(kv.w) * w1[2] + bf_hi(kv.w) * w1[3]; }
                sc[512 + tid] = decay * sc[512 + tid] + a; }
#pragma unroll
            for (int q = 0; q < 2; ++q)
#pragma unroll
                for (int dc = 0; dc < 4; ++dc) cacc[q][dc] *= decay;
        }
        __syncthreads();
        if (tid < 64) sumsq[(row0 + tid) * 16 + hh * 4 + s] = sc[384 + tid] + sc[448 + tid];
        if (!(pf & 128)) {
#pragma unroll
        for (int kk = 0; kk < 2; ++kk) {
            bf16x8 aE[2], bD[4];
#pragma unroll
            for (int q = 0; q < 2; ++q) aE[q] = *(const LAS bf16x8*)(L + ML_KT + (16 * (2 * w + q) + l15) * ML_KTP + (32 * kk + 8 * lq) * 2);
#pragma unroll
            for (int dc = 0; dc < 4; ++dc) bD[dc] = *(const LAS bf16x8*)(L + ML_VWT + (16 * dc + l15) * ML_KTP + (32 * kk + 8 * lq) * 2);
#pragma unroll
            for (int q = 0; q < 2; ++q)
#pragma unroll
                for (int dc = 0; dc < 4; ++dc) cacc[q][dc] = __builtin_amdgcn_mfma_f32_16x16x32_bf16(aE[q], bD[dc], cacc[q][dc], 0, 0, 0); }
#pragma unroll
        for (int q = 0; q < 2; ++q)
#pragma unroll
            for (int dc = 0; dc < 4; ++dc) { u32x2 wv; wv.x = pk2(cacc[q][dc][0], cacc[q][dc][1]); wv.y = pk2(cacc[q][dc][2], cacc[q][dc][3]);
                *(LAS u32x2*)(L + ML_C + (16 * dc + l15) * ML_QP + (16 * (2 * w + q) + 4 * lq) * 2) = wv; }
        }
        __syncthreads();
    }
}

constexpr int LR_XP = 272, LR_TT = 128;
constexpr int LR_XC = 0, LR_W = 34816, LR_A = 69632, LR_G = 102912, LR_SEG = 136192, LR_CARRY = 140288, LR_CWT = 140544;
__device__ __forceinline__ void lru_unit(Frame& F, int b, int n, int jh) {
    LAS unsigned char* L = F.lds;
    LAS float* Aa = (LAS float*)(L + LR_A); LAS float* Ga = (LAS float*)(L + LR_G); LAS float* seg = (LAS float*)(L + LR_SEG); LAS float* carry = (LAS float*)(L + LR_CARRY);
    const int tid = F.tid, lane = F.lane, w = F.wave, l15 = lane & 15, lq = lane >> 4;
    const bf16* P = (const bf16*)(F.ws + WS_P); unsigned char* Y8a = F.ws + WS_Y; const bf16* LW = (const bf16*)(F.ws + WS_LRUW) + (size_t)n * 256 * 128;
    for (int pc = tid; pc < 2048; pc += NT) { const int orow = pc >> 4, c16 = pc & 15; const int src = (orow < 64) ? (jh * 64 + orow) : (128 + jh * 64 + (orow - 64));
        *(LAS u32x4*)(L + LR_W + orow * LR_XP + c16 * 16) = *(const GAS u32x4*)(LW + (size_t)src * 128 + c16 * 8); }
    const int cgx = tid & 15, rgx = tid >> 4, cch = n * 128 + 8 * cgx;
    if (tid < 16) {
        const float* cwp_ = F.in(5) + cch; const float* cbp_ = F.in(6) + cch;
#pragma unroll
        for (int j = 0; j < 4; ++j) { *(LAS f32x4*)(L + LR_CWT + (cgx * 5 + j) * 32) = *(const GAS f32x4*)(cwp_ + j * 1024); *(LAS f32x4*)(L + LR_CWT + (cgx * 5 + j) * 32 + 16) = *(const GAS f32x4*)(cwp_ + j * 1024 + 4); }
        *(LAS f32x4*)(L + LR_CWT + (cgx * 5 + 4) * 32) = *(const GAS f32x4*)cbp_; *(LAS f32x4*)(L + LR_CWT + (cgx * 5 + 4) * 32 + 16) = *(const GAS f32x4*)(cbp_ + 4);
    }
    const int trb = 2 * (w >> 1), ocb = 2 * (w & 1);
    float ba[2], bx[2], sp[2];
    const float* pba_ = F.in(8); const float* pbx_ = F.in(10); const float* plam_ = F.in(11);
#pragma unroll
    for (int q = 0; q < 2; ++q) { const int chq = n * 128 + jh * 64 + 16 * (ocb + q) + l15; ba[q] = pba_[chq]; bx[q] = pbx_[chq]; const float nl = -plam_[chq]; sp[q] = fmaxf(nl, 0.f) + log1pf(expf(-fabsf(nl))); }
    const int ch_s = n * 128 + jh * 64 + lane;
    if (tid < 64) carry[tid] = 0.f;
    u32x4 raw[7];
#pragma unroll
    for (int r = 0; r < 7; ++r) { const int t = 4 * rgx - 3 + r; raw[r] = (t >= 0) ? *(const GAS u32x4*)(P + ((size_t)b * SEQ + t) * PN + cch) : (u32x4){0u, 0u, 0u, 0u}; }
    __syncthreads();
    for (int tile = 0; tile < SEQ / LR_TT; ++tile) {
        const int t0 = tile * LR_TT; const size_t row0 = (size_t)b * SEQ + t0;
        bf16 zv[16];
#pragma unroll
        for (int i = 0; i < 16; ++i) zv[i] = P[(row0 + 16 * w + i) * PN + 1024 + ch_s];
        {
            float cw[4][8], cb[8];
#pragma unroll
            for (int j = 0; j < 5; ++j) { const f32x4 c0 = *(const LAS f32x4*)(L + LR_CWT + (cgx * 5 + j) * 32), c1 = *(const LAS f32x4*)(L + LR_CWT + (cgx * 5 + j) * 32 + 16);
#pragma unroll
                for (int i = 0; i < 4; ++i) { if (j < 4) { cw[j < 4 ? j : 0][i] = c0[i]; cw[j < 4 ? j : 0][4 + i] = c1[i]; } else { cb[i] = c0[i]; cb[4 + i] = c1[i]; } } }
#pragma unroll
            for (int r = 0; r < 4; ++r) { float o[8];
#pragma unroll
                for (int i = 0; i < 8; ++i) { const int wd = i >> 1; float x0, x1, x2, x3;
                    if (i & 1) { x0 = bf_hi(raw[r][wd]); x1 = bf_hi(raw[r + 1][wd]); x2 = bf_hi(raw[r + 2][wd]); x3 = bf_hi(raw[r + 3][wd]); }
                    else { x0 = bf_lo(raw[r][wd]); x1 = bf_lo(raw[r + 1][wd]); x2 = bf_lo(raw[r + 2][wd]); x3 = bf_lo(raw[r + 3][wd]); }
                    o[i] = cb[i] + cw[0][i] * x0 + cw[1][i] * x1 + cw[2][i] * x2 + cw[3][i] * x3; }
                u32x4 ov; ov.x = pk2(o[0], o[1]); ov.y = pk2(o[2], o[3]); ov.z = pk2(o[4], o[5]); ov.w = pk2(o[6], o[7]);
                *(LAS u32x4*)(L + LR_XC + (4 * rgx + r) * LR_XP + cgx * 16) = ov; }
            asm volatile("" ::: "memory");
            if (tile + 1 < SEQ / LR_TT) {
#pragma unroll
                for (int r = 0; r < 7; ++r) raw[r] = *(const GAS u32x4*)(P + (row0 + LR_TT + 4 * rgx - 3 + r) * PN + cch);
            }
        }
        __syncthreads();
        {
            f32x4 ga[2][2], gx[2][2];
#pragma unroll
            for (int rt = 0; rt < 2; ++rt)
#pragma unroll
                for (int q = 0; q < 2; ++q) { ga[rt][q] = (f32x4){0.f, 0.f, 0.f, 0.f}; gx[rt][q] = ga[rt][q]; }
#pragma unroll
            for (int kk = 0; kk < 4; ++kk) { bf16x8 a[2], wa[2], wx[2];
#pragma unroll
                for (int rt = 0; rt < 2; ++rt) a[rt] = *(const LAS bf16x8*)(L + LR_XC + (16 * (trb + rt) + l15) * LR_XP + (32 * kk + 8 * lq) * 2);
#pragma unroll
                for (int q = 0; q < 2; ++q) { wa[q] = *(const LAS bf16x8*)(L + LR_W + (16 * (ocb + q) + l15) * LR_XP + (32 * kk + 8 * lq) * 2);
                    wx[q] = *(const LAS bf16x8*)(L + LR_W + (64 + 16 * (ocb + q) + l15) * LR_XP + (32 * kk + 8 * lq) * 2); }
#pragma unroll
                for (int rt = 0; rt < 2; ++rt)
#pragma unroll
                    for (int q = 0; q < 2; ++q) { ga[rt][q] = __builtin_amdgcn_mfma_f32_16x16x32_bf16(a[rt], wa[q], ga[rt][q], 0, 0, 0); gx[rt][q] = __builtin_amdgcn_mfma_f32_16x16x32_bf16(a[rt], wx[q], gx[rt][q], 0, 0, 0); } }
#pragma unroll
            for (int rt = 0; rt < 2; ++rt)
#pragma unroll
                for (int q = 0; q < 2; ++q)
#pragma unroll
                    for (int r = 0; r < 4; ++r) { const int t = 16 * (trb + rt) + 4 * lq + r, jo = 16 * (ocb + q) + l15;
                        const float rg = sigmoidf_(ga[rt][q][r] + ba[q]), ig = sigmoidf_(gx[rt][q][r] + bx[q]); const float la = -8.0f * rg * sp[q];
                        const float xf = bf2f(*(const LAS bf16*)(L + LR_XC + t * LR_XP + (jh * 64 + jo) * 2));
                        const float av = __expf(la); Aa[t * 65 + jo] = av; Ga[t * 65 + jo] = __builtin_amdgcn_sqrtf(fmaxf(1.0f - av * av, 0.f)) * (ig * xf); }
        }
        __syncthreads();
        {
            float Ap = 1.f, H = 0.f;
#pragma unroll
            for (int i = 0; i < 16; ++i) { const float a = Aa[(16 * w + i) * 65 + lane], g = Ga[(16 * w + i) * 65 + lane]; H = a * H + g; Ap *= a; }
            seg[(w * 64 + lane) * 2] = Ap; seg[(w * 64 + lane) * 2 + 1] = H;
        }
        __syncthreads();
        float h = carry[lane];
        for (int s2 = 0; s2 < w; ++s2) h = seg[(s2 * 64 + lane) * 2] * h + seg[(s2 * 64 + lane) * 2 + 1];
#pragma unroll
        for (int i = 0; i < 16; ++i) { const int t = 16 * w + i; h = Aa[t * 65 + lane] * h + Ga[t * 65 + lane]; Y8a[(row0 + t) * Y3P + ch_s] = (unsigned char)pk4_f8(h * gelu_tanh(bf2f(zv[i])) * F8_SYA, 0.f, 0.f, 0.f); }
        __syncthreads();
        if (w == 7) carry[lane] = h;
    }
    __syncthreads();
}

__device__ __forceinline__ void ph_headnorm(Frame& F) {
    bf16* Y = (bf16*)(F.ws + WS_Y); const float* sumsq = (const float*)(F.ws + WS_SUMSQ); const float* hg = F.in(16);
    const int gt = F.vcu * NT + F.tid, NGT = F.G * NT;
    for (int idx = gt; idx < T * 128; idx += NGT) { const int t = idx >> 7, c8 = idx & 127, hh = c8 >> 5;
        const f32x4 ss = *(const f32x4*)(sumsq + (size_t)t * 16 + hh * 4); const float rstd = 1.0f / sqrtf(((ss[0] + ss[1]) + (ss[2] + ss[3])) * (1.0f / 256.0f) + EPS);
        bf16* p = Y + (size_t)t * (Y3P / 2) + 512 + c8 * 8; const u32x4 v = *(const u32x4*)p; const f32x4 g0 = *(const f32x4*)(hg + c8 * 8), g1 = *(const f32x4*)(hg + c8 * 8 + 4);
        u32x4 o; o.x = pk2(bf_lo(v.x) * rstd * g0[0], bf_hi(v.x) * rstd * g0[1]); o.y = pk2(bf_lo(v.y) * rstd * g0[2], bf_hi(v.y) * rstd * g0[3]);
        o.z = pk2(bf_lo(v.z) * rstd * g1[0], bf_hi(v.z) * rstd * g1[1]); o.w = pk2(bf_lo(v.w) * rstd * g1[2], bf_hi(v.w) * rstd * g1[3]);
        *(u32x4*)p = o; }
}

constexpr int RT_ROWS = 128;
__device__ __forceinline__ void ph_router(Frame& F, int l, bool dummy) {
    LAS float* lg = (LAS float*)(F.lds);
    LAS float* info = (LAS float*)(F.lds + 20480);
    LAS unsigned* lcnt = (LAS unsigned*)(F.lds + 28672);
    const int tid = F.tid, lane = F.lane, w = F.wave, l15 = lane & 15, lq = lane >> 4;
    const bf16* x1 = (const bf16*)(F.ws + WS_XB); const bf16* WH = (const bf16*)(F.ws + WS_RW) + (size_t)(l * 2) * 32 * 2048; const bf16* WL = WH + (size_t)32 * 2048;
    const float* bcs = F.in(30) + l * 4; const float* bfn = F.in(32) + l * 16;
    const size_t doff = dummy ? (size_t)200 * MiB : 0; const int cw = dummy ? 20480 : CW_CNT + l * 32 * 64;
    int* ptok = (int*)(F.ws + WS_PTOK + doff); float* prstd = (float*)(F.ws + WS_PRSTD + doff); float* pga = (float*)(F.ws + WS_PGA + doff); float* pgb = (float*)(F.ws + WS_PGB + doff);
    for (int base = F.vcu * RT_ROWS; base < T; base += F.G * RT_ROWS) {
        if (tid < 32) lcnt[tid] = 0u;
        {
            const bf16* xr = x1 + (size_t)(base + 16 * w + l15) * D + 8 * lq;
            const bf16* wh0 = WH + (size_t)l15 * 2048 + 8 * lq; const bf16* wh1 = WH + (size_t)(16 + l15) * 2048 + 8 * lq;
            const bf16* wl0 = WL + (size_t)l15 * 2048 + 8 * lq; const bf16* wl1 = WL + (size_t)(16 + l15) * 2048 + 8 * lq;
            f32x4 acc0 = (f32x4){0.f, 0.f, 0.f, 0.f}, acc1 = acc0; float ss = 0.f;
#pragma unroll 4
            for (int ks = 0; ks < 64; ++ks) {
                const bf16x8 a = *(const GAS bf16x8*)(xr + 32 * ks);
                const bf16x8 h0 = *(const GAS bf16x8*)(wh0 + 32 * ks), h1 = *(const GAS bf16x8*)(wh1 + 32 * ks), o0 = *(const GAS bf16x8*)(wl0 + 32 * ks), o1 = *(const GAS bf16x8*)(wl1 + 32 * ks);
                acc0 = __builtin_amdgcn_mfma_f32_16x16x32_bf16(a, h0, acc0, 0, 0, 0); acc1 = __builtin_amdgcn_mfma_f32_16x16x32_bf16(a, h1, acc1, 0, 0, 0);
                acc0 = __builtin_amdgcn_mfma_f32_16x16x32_bf16(a, o0, acc0, 0, 0, 0); acc1 = __builtin_amdgcn_mfma_f32_16x16x32_bf16(a, o1, acc1, 0, 0, 0);
                const u32x4 au = __builtin_bit_cast(u32x4, a);
                ss += (bf_lo(au.x) * bf_lo(au.x) + bf_hi(au.x) * bf_hi(au.x)) + (bf_lo(au.y) * bf_lo(au.y) + bf_hi(au.y) * bf_hi(au.y)) + (bf_lo(au.z) * bf_lo(au.z) + bf_hi(au.z) * bf_hi(au.z)) + (bf_lo(au.w) * bf_lo(au.w) + bf_hi(au.w) * bf_hi(au.w)); }
            ss += __shfl_xor(ss, 16); ss += __shfl_xor(ss, 32);
#pragma unroll
            for (int r = 0; r < 4; ++r) { lg[(16 * w + 4 * lq + r) * 33 + l15] = acc0[r]; lg[(16 * w + 4 * lq + r) * 33 + 16 + l15] = acc1[r]; }
            if (lq == 0) lg[(16 * w + l15) * 33 + 32] = ss;
        }
        __syncthreads();
        if (tid < RT_ROWS) {
            const LAS float* lr = lg + tid * 33;
            const float rstd = 1.0f / sqrtf(lr[32] * (1.0f / D) + EPS);
            float lc[4], lf[16];
#pragma unroll
            for (int c = 0; c < 4; ++c) lc[c] = lr[c] * rstd + bcs[c];
#pragma unroll
            for (int c = 0; c < 16; ++c) lf[c] = lr[4 + c] * rstd + bfn[c];
            int gi = 0; float gm = lc[0];
#pragma unroll
            for (int c = 1; c < 4; ++c) if (lc[c] > gm) { gm = lc[c]; gi = c; }
            float se = 0.f;
#pragma unroll
            for (int c = 0; c < 4; ++c) se += expf(lc[c] - gm);
            const float pg = 1.0f / se;
            float fs[4];
#pragma unroll
            for (int c = 0; c < 4; ++c) fs[c] = (gi == 0) ? lf[c] : (gi == 1) ? lf[4 + c] : (gi == 2) ? lf[8 + c] : lf[12 + c];
            int i0 = 0; float v0 = fs[0];
#pragma unroll
            for (int c = 1; c < 4; ++c) if (fs[c] > v0) { v0 = fs[c]; i0 = c; }
            int i1 = -1; float v1 = 0.f;
#pragma unroll
            for (int c = 0; c < 4; ++c) if (c != i0 && (i1 < 0 || fs[c] > v1)) { v1 = fs[c]; i1 = c; }
            const float e1 = expf(v1 - v0), s0 = 1.0f / (1.0f + e1), w0g = s0 * pg, w1g = (e1 * s0) * pg;
            const int ia = i0 < i1 ? i0 : i1, ib = i0 < i1 ? i1 : i0, pidx = (ia == 0) ? ib - 1 : (ia == 1) ? ib + 1 : 5, q = gi * 6 + pidx;
            LAS float* ip = info + tid * 8; ip[0] = __builtin_bit_cast(float, q); ip[1] = (i0 < i1) ? w0g : w1g; ip[2] = (i0 < i1) ? w1g : w0g; ip[3] = rstd;
            ip[4] = __builtin_bit_cast(float, __hip_atomic_fetch_add(&lcnt[q], 1u, __ATOMIC_RELAXED, __HIP_MEMORY_SCOPE_WORKGROUP));
        }
        __syncthreads();
        if (tid < NPAIR) lcnt[32 + tid] = __hip_atomic_fetch_add((unsigned*)(F.ctl + cw + tid * 64), lcnt[tid], RLX_AGENT);
        __syncthreads();
        if (tid < RT_ROWS) { LAS float* ip = info + tid * 8; const int row = base + tid; const int q = __builtin_bit_cast(int, ip[0]);
            const size_t p = (size_t)q * T + lcnt[32 + q] + __builtin_bit_cast(unsigned, ip[4]);
            ptok[p] = row; pga[p] = ip[1]; pgb[p] = ip[2]; prstd[p] = ip[3]; }
        __syncthreads();
    }
}
__device__ __forceinline__ void moe_table(Frame& F, int l) {
    if (F.tid == 0) { unsigned pre = 0u;
        for (int q = 0; q < NPAIR; ++q) { const unsigned c = ld_agent_u32((const unsigned*)(F.ctl + CW_CNT + (l * 32 + q) * 64)); F.MISC[MI_CNT + q] = c; F.MISC[MI_PRE + q] = pre; pre += (c + 255u) >> 8; }
        F.MISC[MI_PRE + NPAIR] = pre; }
    __syncthreads();
}
__device__ __forceinline__ void ph_rowpass(Frame& F, int l, bool dummy) {
    const int gw = F.vcu * NWAVES + F.wave, NGW = F.G * NWAVES, lane = F.lane;
    const bf16* xb = (const bf16*)(F.ws + WS_XB); float* rstd_o = (float*)(F.ws + WS_RSTD);
    const float* gfin = F.in(3);
    for (int m0 = 2 * gw; m0 < T; m0 += 2 * NGW) {
        u32x4 x[2][4];
#pragma unroll
        for (int q = 0; q < 2; ++q) { const GAS u32x4* xr = (const GAS u32x4*)(xb + (size_t)(m0 + q) * D) + lane;
#pragma unroll
            for (int j = 0; j < 4; ++j) x[q][j] = xr[64 * j]; }
#pragma unroll
        for (int q = 0; q < 2; ++q) { const int m = m0 + q; float ss = 0.f;
#pragma unroll
            for (int j = 0; j < 4; ++j) { const u32x4 w = x[q][j];
                ss += ((bf_lo(w.x) * bf_lo(w.x) + bf_hi(w.x) * bf_hi(w.x)) + (bf_lo(w.y) * bf_lo(w.y) + bf_hi(w.y) * bf_hi(w.y))) + ((bf_lo(w.z) * bf_lo(w.z) + bf_hi(w.z) * bf_hi(w.z)) + (bf_lo(w.w) * bf_lo(w.w) + bf_hi(w.w) * bf_hi(w.w))); }
            ss = wave_sum(ss); const float rstd = 1.0f / sqrtf(ss * (1.0f / D) + EPS);
            if (l == 0) { if (lane == 0) (dummy ? (float*)(F.ws + 950 * MiB) : rstd_o)[m] = rstd; }
            else {
                GAS f32x4* xw = dummy ? (GAS f32x4*)((float*)(F.ws + WS_Y) + (size_t)(m & 16383) * D) + 2 * lane : (GAS f32x4*)(F.outp() + (size_t)m * D) + 2 * lane;
#pragma unroll
                for (int j = 0; j < 4; ++j) { const u32x4 w = x[q][j]; const f32x4 g0 = *((const f32x4*)gfin + 2 * lane + 128 * j), g1 = *((const f32x4*)gfin + 2 * lane + 128 * j + 1);
                    f32x4 o0, o1; o0.x = bf_lo(w.x) * rstd * g0.x; o0.y = bf_hi(w.x) * rstd * g0.y; o0.z = bf_lo(w.y) * rstd * g0.z; o0.w = bf_hi(w.y) * rstd * g0.w;
                    o1.x = bf_lo(w.z) * rstd * g1.x; o1.y = bf_hi(w.z) * rstd * g1.y; o1.z = bf_lo(w.w) * rstd * g1.z; o1.w = bf_hi(w.w) * rstd * g1.w;
                    xw[128 * j] = o0; xw[128 * j + 1] = o1; }
            }
        }
    }
}
constexpr int S5_UP = 528, S5_XP = 272, S5_U = 0, S5_X = 67584, S5_T = 106496;
__device__ __forceinline__ void cmul_add(float ar, float ai, float br, float bi, float cr, float ci, float& orr, float& oi) { orr = ar * br - ai * bi + cr; oi = ar * bi + ai * br + ci; }
__device__ __forceinline__ void ph_s5core(Frame& F, int pf) {
    LAS unsigned char* L = F.lds;
    const int tid = F.tid, lane = F.lane, w = F.wave, l15 = lane & 15, lq = lane >> 4;
    const bf16* A2 = (const bf16*)(F.ws + WS_A2); unsigned char* Y8 = F.ws + ((pf & 8) ? 776 * MiB : WS_Y);
    const int urow = tid >> 2, uq = tid & 3;
    u32x4 ust[8];
    const int upc = (2048 + F.G - 1) / F.G;
    const int L0 = F.vcu * upc, Lend = (L0 + upc < 2048) ? L0 + upc : 2048;
    const int uoff = urow * 256 + uq * 64;
    if (L0 < 2048) { const bf16* src = A2 + (size_t)__builtin_amdgcn_readfirstlane(((L0 >> 4) * 2048 + (L0 & 15) * 128) * 256) + uoff;
#pragma unroll
        for (int i = 0; i < 8; ++i) ust[i] = *(const GAS u32x4*)(src + i * 8); }
    for (int Lu = L0; Lu < Lend; ++Lu) {
        const int g = __builtin_amdgcn_readfirstlane(Lu >> 4), b = __builtin_amdgcn_readfirstlane(Lu & 15);
        const bf16* Wi = (const bf16*)(F.ws + WS_S5WIN) + (size_t)g * 128 * 256; const bf16* KB = (const bf16*)(F.ws + WS_S5K) + (size_t)g * 4096; const bf16* Wo = (const bf16*)(F.ws + WS_S5WO) + (size_t)g * 256 * 128;
        int zq = 0; asm volatile("" : "+v"(zq)); const int l15z = l15 + zq, lqz = lq + zq;
#define S5_WFRAG(mt_, ks_) (((ks_) < 8) ? (((2 * w + (mt_)) - (2 * (ks_) + (lqz >> 1)) >= 0) ? *(const GAS bf16x8*)(KB + (((2 * w + (mt_)) - (2 * (ks_) + (lqz >> 1))) * 16 + l15z) * 16 + 8 * (lqz & 1)) : (bf16x8){0, 0, 0, 0, 0, 0, 0, 0}) \
                                        : *(const GAS bf16x8*)(Wo + (size_t)(16 * (2 * w + (mt_)) + l15z) * 128 + 32 * ((ks_) - 8) + 8 * lqz))
#pragma unroll
        for (int i = 0; i < 8; ++i) *(LAS u32x4*)(L + S5_U + urow * S5_UP + (uq * 64 + i * 8) * 2) = ust[i];
        bf16x8 wb[8];
#pragma unroll
        for (int ks = 0; ks < 8; ++ks) wb[ks] = *(const GAS bf16x8*)(Wi + (16 * w + l15z) * 256 + 32 * ks + 8 * lqz);
        const f32x4 lam = *(const GAS f32x4*)((const float*)(F.ws + WS_LAM) + ((size_t)g * 64 + 8 * w + (l15 & 7)) * 4);
        __syncthreads();
        f32x4 X[8];
#pragma unroll
        for (int rt = 0; rt < 8; ++rt) X[rt] = (f32x4){0.f, 0.f, 0.f, 0.f};
        if (!(pf & 64)) {
#pragma unroll
        for (int ks = 0; ks < 8; ++ks) {
#pragma unroll
            for (int rt = 0; rt < 8; ++rt) { const bf16x8 a = *(const LAS bf16x8*)(L + S5_U + (16 * rt + l15) * S5_UP + (32 * ks + 8 * lq) * 2);
                X[rt] = __builtin_amdgcn_mfma_f32_16x16x32_bf16(a, wb[ks], X[rt], 0, 0, 0); } }
        }
        bf16x8 wa[2][4];
#pragma unroll
        for (int mt = 0; mt < 2; ++mt)
#pragma unroll
            for (int k4 = 0; k4 < 4; ++k4) wa[mt][k4] = S5_WFRAG(mt, k4);
        if (!(pf & 16)) {
            const bool isim = (l15 & 8) != 0;
#define S5_XRI(rt_, r_) const float mine_ = X[rt_][r_], oth_ = __builtin_bit_cast(float, __builtin_amdgcn_update_dpp(0, __builtin_bit_cast(int, mine_), 0x128  , 0xf, 0xf, false)); \
            const float xr_ = isim ? oth_ : mine_, xi_ = isim ? mine_ : oth_
            LAS unsigned char* tb = L + S5_T + w * 4096;
#pragma unroll
            for (int rt = 0; rt < 8; ++rt) { float ar = 0.f, ai = 0.f;
#pragma unroll
                for (int r = 0; r < 4; ++r) { S5_XRI(rt, r); float nr, ni; cmul_add(lam[0], lam[1], ar, ai, xr_, xi_, nr, ni); ar = nr; ai = ni; }
                *(LAS f32x2*)(tb + ((rt * 16 + l15) * 4 + lq) * 8) = (f32x2){ar, ai}; }
            asm volatile("s_waitcnt lgkmcnt(0)" ::: "memory");
            float cr = 0.f, ci = 0.f;
#pragma unroll
            for (int rt = 0; rt < 8; ++rt) {
                const f32x4 t0 = *(const LAS f32x4*)(tb + (rt * 16 + l15) * 32), t1 = *(const LAS f32x4*)(tb + (rt * 16 + l15) * 32 + 16);
                float ar = 0.f, ai = 0.f;
#pragma unroll
                for (int o = 0; o < 4; ++o) { if (lq == o) { ar = cr; ai = ci; }
                    const float tr_ = (o == 0) ? t0[0] : (o == 1) ? t0[2] : (o == 2) ? t1[0] : t1[2], ti_ = (o == 0) ? t0[1] : (o == 1) ? t0[3] : (o == 2) ? t1[1] : t1[3];
                    float nr, ni; cmul_add(lam[2], lam[3], cr, ci, tr_, ti_, nr, ni); cr = nr; ci = ni; }
#pragma unroll
                for (int r = 0; r < 4; ++r) { *(LAS bf16*)(L + S5_X + (16 * rt + 4 * lq + r) * S5_XP + (16 * w + l15) * 2) = (bf16)f2bf(isim ? ai : ar);
                    S5_XRI(rt, r); float nr, ni; cmul_add(lam[0], lam[1], ar, ai, xr_, xi_, nr, ni); ar = nr; ai = ni; } }
#undef S5_XRI
        }
        { const int Ln = Lu + 1; if (Ln < Lend) { const bf16* src = A2 + (size_t)__builtin_amdgcn_readfirstlane(((Ln >> 4) * 2048 + (Ln & 15) * 128) * 256) + uoff;
#pragma unroll
            for (int i = 0; i < 8; ++i) ust[i] = *(const GAS u32x4*)(src + i * 8); } }
        __syncthreads();
        f32x4 acc[2][8];
#pragma unroll
        for (int mt = 0; mt < 2; ++mt)
#pragma unroll
            for (int nt = 0; nt < 8; ++nt) acc[mt][nt] = (f32x4){0.f, 0.f, 0.f, 0.f};
        if (!(pf & 32)) {
#pragma unroll
        for (int kb = 0; kb < 3; ++kb) {
            bf16x8 wnx[2][4];
            if (kb < 2) {
#pragma unroll
                for (int mt = 0; mt < 2; ++mt)
#pragma unroll
                    for (int k4 = 0; k4 < 4; ++k4) wnx[mt][k4] = S5_WFRAG(mt, 4 * (kb + 1) + k4);
            }
#pragma unroll
            for (int k4 = 0; k4 < 4; ++k4) { const int ks = 4 * kb + k4;
                if (ks >= 8 || ks <= w) {
#pragma unroll
                for (int nt = 0; nt < 8; ++nt) {
                    const bf16x8 bv = (ks < 8) ? *(const LAS bf16x8*)(L + S5_U + (16 * nt + l15) * S5_UP + (32 * ks + 8 * lq) * 2)
                                               : *(const LAS bf16x8*)(L + S5_X + (16 * nt + l15) * S5_XP + (32 * (ks - 8) + 8 * lq) * 2);
                    acc[0][nt] = __builtin_amdgcn_mfma_f32_16x16x32_bf16(wa[0][k4], bv, acc[0][nt], 0, 0, 0);
                    acc[1][nt] = __builtin_amdgcn_mfma_f32_16x16x32_bf16(wa[1][k4], bv, acc[1][nt], 0, 0, 0); } } }
            if (kb < 2) {
#pragma unroll
                for (int mt = 0; mt < 2; ++mt)
#pragma unroll
                    for (int k4 = 0; k4 < 4; ++k4) wa[mt][k4] = wnx[mt][k4];
            }
        }
        }
#pragma unroll
        for (int mt = 0; mt < 2; ++mt)
#pragma unroll
            for (int nt = 0; nt < 8; ++nt) { const int tok = (b * 128 + 16 * nt + l15) * 16 + 2 * w + mt; const f32x4 a = acc[mt][nt];
                const unsigned wv = pk4_f8_mm(gelu_tanh(a[0]) * F8_SY, gelu_tanh(a[1]) * F8_SY, gelu_tanh(a[2]) * F8_SY, gelu_tanh(a[3]) * F8_SY);
                if (!(pf & 256)) *(GAS unsigned*)(Y8 + ((((size_t)(tok >> 8) * 64 + (g >> 1)) * 256) + (tok & 255)) * 32 + (g & 1) * 16 + 4 * lq) = wv; else asm volatile("" :: "v"(wv)); }
        __syncthreads();
    }
}

struct Args { const float* in[36]; float* out; unsigned char* ws; int ph_lo, ph_hi; };
__global__ void __launch_bounds__(NT, 2) fwd(Args args) {
    extern __shared__ __attribute__((aligned(16))) unsigned char lds[];
    Frame F;
    F.lds = (LAS unsigned char*)lds;
    F.MISC = (volatile LAS unsigned*)(F.lds + MISC_OFF);
    F.tid = threadIdx.x; F.lane = F.tid & 63; F.wave = __builtin_amdgcn_readfirstlane(F.tid >> 6);
    F.G = gridDim.x; { const int bx = blockIdx.x; F.vcu = (F.G % 8 == 0) ? (bx % 8) * (F.G / 8) + bx / 8 : bx; }
    F.ws = args.ws; F.ctl = (gu32*)(args.ws + WS_CTL);
    if (F.tid < 64) F.MISC[F.tid] = 0u;
    if (F.tid == 100) { const unsigned long long pv = (unsigned long long)args.out; F.MISC[200] = (unsigned)pv; F.MISC[201] = (unsigned)(pv >> 32); }
    if (F.tid >= 64 && F.tid < 100) { const unsigned long long pv = (unsigned long long)args.in[F.tid - 64]; F.MISC[64 + 2 * (F.tid - 64)] = (unsigned)pv; F.MISC[65 + 2 * (F.tid - 64)] = (unsigned)(pv >> 32); }
    __syncthreads();
    XcdBarrier bar; bar.bar = (unsigned*)(F.ctl + CW_BAR); bar.x = 0; bar.st = nullptr;
    if (!MK_PER_PHASE) bar = xcd_barrier_post((unsigned*)(F.ctl + CW_BAR), F.MISC + 8);
    const int lo = args.ph_lo & 255, hi = args.ph_hi, pflags = MK_PER_PHASE ? (args.ph_lo >> 8) : 0;
#ifndef PHMASK
#define PHMASK 0x3ffff
#endif
#define IN(k) ((((PHMASK) >> (k)) & 1) && lo <= (k) && (k) < hi)
#ifdef DOUBLE_BAR
#define SEAM(k) do { if (!MK_PER_PHASE && IN(k) && IN((k) + 1)) { xcd_barrier(bar); xcd_barrier(bar); } } while (0)
#else
#define SEAM(k) do { if (!MK_PER_PHASE && IN(k) && IN((k) + 1)) xcd_barrier(bar); } while (0)
#endif
    unsigned char* ws = args.ws;
    bf16* XB = (bf16*)(ws + WS_XB); bf16* Pb = (bf16*)(ws + WS_P); bf16* Yb = (bf16*)(ws + WS_Y); float* RSTD = (float*)(ws + WS_RSTD);
    const int bx = (int)blockIdx.x;

    if (IN(0)) { ph_prologue(F, pflags); }
    SEAM(0);
#ifndef P1_WGM
#define P1_WGM 8
#endif
    if (IN(1)) {
        pg8::GemmP g{nullptr, 2048, 4096u, 32u, 4096u};
#ifdef P1_STAGGER
        {
            const unsigned long long t0 = __builtin_amdgcn_s_memrealtime(), dl = (unsigned long long)((bx >> 3) & 3) * (P1_STAGGER * 100ull);
            while (__builtin_amdgcn_s_memrealtime() - t0 < dl) __builtin_amdgcn_s_sleep(8);
        }
#endif
#ifdef P1_SPLIT3
#pragma unroll
        for (int j3 = 0; j3 < 3; ++j3) {
            DenseSched S; S.to.init(T / 256, 8, F.G, bx, P1_WGM); S.A = (const char*)XB; S.tstepA = (size_t)256 * 4096; S.B0 = (const char*)(ws + WS_WIN) + (size_t)j3 * 2048 * 4096; S.B1 = S.B0 + (size_t)128 * 4096; S.tstepB = (size_t)256 * 4096; S.cpt = 256;
            EpiScaleBf16 E{Pb + j3 * 2048, PN, RSTD, pflags, 1.0f};
            pg8::gemm_phase<EpiScaleBf16, DenseSched, false>(F.lds, g, S, E); }
#else
        {
            pg8::GemmP g8{nullptr, 1024, 2048u, 32u, 2048u};
            DenseSched S; S.to.init(T / 256, 8, F.G, bx, P1_WGM); S.A = (const char*)(ws + WS_X8IN); S.tstepA = (size_t)256 * 2048; S.B0 = (const char*)(ws + WS_WIN); S.B1 = S.B0 + (size_t)128 * 2048; S.tstepB = (size_t)256 * 2048; S.cpt = 256;
            EpiScaleBf16 E{Pb, PN, RSTD, pflags, 1.0f / (F8_SX * F8_SW)};
            pg8::gemm_phase<EpiScaleBf16, DenseSched, false, false, true>(F.lds, g8, S, E); }
        {
            DenseSched S; S.to.init(T / 256, 16, F.G, bx, P1_WGM); S.A = (const char*)XB; S.tstepA = (size_t)256 * 4096; S.B0 = (const char*)(ws + WS_WIN) + (size_t)2048 * 4096; S.B1 = S.B0 + (size_t)128 * 4096; S.tstepB = (size_t)256 * 4096; S.cpt = 256;
            EpiScaleBf16 E{Pb + 2048, PN, RSTD, pflags, 1.0f};
            pg8::gemm_phase<EpiScaleBf16, DenseSched, false>(F.lds, g, S, E); }
#endif
    }
    SEAM(1);
    if (IN(2)) {
#ifndef NO_MLSTM
        if (!(pflags & 1)) for (int u = F.vcu; u < 256; u += F.G) mlstm_unit(F, u >> 4, (u >> 2) & 3, u & 3, pflags);
#endif
#ifndef NO_LRU
        if (!(pflags & 2)) for (int u = F.vcu; u < 256; u += F.G) lru_unit(F, u >> 4, (u >> 1) & 7, u & 1);
#endif
    }
    SEAM(2);
    if (IN(3)) { ph_headnorm(F); }
    SEAM(3);
    if (IN(4)) {
        pg8::GemmP g{nullptr, 24 * 64, (unsigned)Y3P, 32u, (unsigned)Y3P, 8};
        DenseSched S; S.to.init(T / 256, D / 256, F.G, bx); S.A = (const char*)Yb; S.tstepA = (size_t)256 * Y3P; S.B0 = (const char*)(ws + WS_WOUT); S.B1 = S.B0 + (size_t)128 * Y3P; S.tstepB = (size_t)256 * Y3P; S.cpt = 256;
        EpiOutRes E{XB, ws + WS_X8};
        pg8::gemm_phase<EpiOutRes, DenseSched, false, false, true, true>(F.lds, g, S, E);
    }
    SEAM(4);
#define MOE_LAYER(PH, l, WSW) \
    if (IN(PH)) { ph_router(F, l, (pflags & 4) != 0); } \
    SEAM(PH); \
    if (IN(PH + 1)) { moe_table(F, l); \
        pg8::GemmP g{(const char*)(ws + WS_X8), 1024, 2048u, 32u, 2048u}; \
        MoeSched<false> S{F.MISC, F.G, F.vcu, (const char*)(ws + WSW), (const char*)(ws + WSW + 32 * MiB), nullptr, (const int*)(ws + WS_PTOK)}; \
        EpiGateUp E{ws + WS_H, (const float*)(ws + WS_PRSTD), (const float*)(ws + WS_PGA), (const float*)(ws + WS_PGB), F.MISC, pflags}; \
        pg8::gemm_phase<EpiGateUp, MoeSched<false>, true, false, true>(F.lds, g, S, E); } \
    SEAM(PH + 1); \
    if (IN(PH + 2)) { moe_table(F, l); \
        pg8::GemmP g{nullptr, 512, 1024u, 32u, 512u}; \
        MoeSched<true> S{F.MISC, F.G, F.vcu, (const char*)(ws + WSW + 64 * MiB), nullptr, (const char*)(ws + WS_H), nullptr}; \
        EpiDownRes E{XB, (const int*)(ws + WS_PTOK), F.MISC, (pflags & 4) ? (bf16*)(ws + 712 * MiB) : XB, (l == 0) ? ws + ((pflags & 4) ? 776 * MiB : WS_X8) : nullptr}; \
        pg8::gemm_phase<EpiDownRes, MoeSched<true>, false, true, true>(F.lds, g, S, E); } \
    SEAM(PH + 2); \
    if (IN(PH + 3)) { ph_rowpass(F, l, (pflags & 4) != 0); }
    MOE_LAYER(5, 0, WS_WMOE0)
    SEAM(8);
    if (IN(9)) {
        pg8::GemmP g{nullptr, 1024, 2048u, 32u, 2048u};
        DenseSched S; S.to.init(T / 256, D / 256, F.G, bx); S.A = (const char*)(ws + WS_X8); S.tstepA = (size_t)256 * 2048; S.B0 = (const char*)(ws + WS_WS5IN); S.B1 = S.B0 + (size_t)128 * 2048; S.tstepB = (size_t)256 * 2048; S.cpt = 256;
        EpiS5U E{(bf16*)(ws + WS_A2), RSTD, 1.0f / (F8_SX * F8_SW)};
        pg8::gemm_phase<EpiS5U, DenseSched, false, false, true>(F.lds, g, S, E);
    }
    SEAM(9);
    if (IN(10)) { ph_s5core(F, pflags); }
    SEAM(12);
    if (IN(13)) {
        pg8::GemmP g{nullptr, 1024, 32u, 8192u, 2048u};
        DenseSched S; S.to.init(T / 256, D / 128, F.G, bx); S.A = (const char*)Yb; S.tstepA = (size_t)64 * 8192; S.B0 = (const char*)(ws + WS_WGLUV); S.B1 = (const char*)(ws + WS_WGLUG); S.tstepB = (size_t)128 * 2048; S.cpt = 128;
        EpiGlu E{(pflags & 4) ? (bf16*)(ws + 712 * MiB) : XB, ws + ((pflags & 4) ? 776 * MiB : WS_X8)};
        pg8::gemm_phase<EpiGlu, DenseSched, false, false, true>(F.lds, g, S, E);
    }
    SEAM(13);
    MOE_LAYER(14, 1, WS_WMOE1)
#undef IN
#undef SEAM
}

extern "C" void kernel_launch(void* const* d_in, const int* in_sizes, int n_in, void* d_out, int out_size, void* d_ws, size_t ws_size, hipStream_t stream) {
    static int grid = 0;
    if (grid == 0) {
        if (n_in != 36 || in_sizes[0] != T * D || out_size != T * D || ws_size < WS_END) { fprintf(stderr, "kernel_launch: unexpected shapes (n_in %d, in0 %d, out %d, ws %zu < %zu); nothing launched\n", n_in, n_in > 0 ? in_sizes[0] : -1, out_size, ws_size, (size_t)WS_END); grid = -1; return; }
        int dev = 0, cus = 0, per_cu = 0;
        if (hipGetDevice(&dev) != hipSuccess || hipDeviceGetAttribute(&cus, hipDeviceAttributeMultiprocessorCount, dev) != hipSuccess) { grid = -1; return; }
        if (hipFuncSetAttribute((const void*)fwd, hipFuncAttributeMaxDynamicSharedMemorySize, LDS_BYTES) != hipSuccess) { fprintf(stderr, "kernel_launch: hipFuncSetAttribute failed\n"); grid = -1; return; }
        if (hipOccupancyMaxActiveBlocksPerMultiprocessor(&per_cu, (const void*)fwd, NT, LDS_BYTES) != hipSuccess || per_cu < 1) fprintf(stderr, "kernel_launch: occupancy query says %d\n", per_cu);
        (void)hipGetLastError();
        grid = cus;
    }
    if (grid < 0) return;
    (void)hipMemsetAsync((char*)d_ws + WS_CTL, 0, CTL_ZERO_BYTES, stream);
    Args a{};
    for (int i = 0; i < 36; ++i) a.in[i] = (const float*)d_in[i];
    a.out = (float*)d_out; a.ws = (unsigned char*)d_ws;
#if MK_PER_PHASE
    for (int ph = 0; ph < NPHASE; ++ph) { a.ph_lo = ph; a.ph_hi = ph + 1; hipLaunchKernelGGL(fwd, dim3(grid), dim3(NT), LDS_BYTES, stream, a);
#ifdef REPEAT_PHASE
        if (ph == REPEAT_PHASE) {
#ifdef REPEAT_FLAGS
            a.ph_lo = ph | (REPEAT_FLAGS << 8);
#endif
            hipLaunchKernelGGL(fwd, dim3(grid), dim3(NT), LDS_BYTES, stream, a); }
#endif
    }
#else
    a.ph_lo = 0; a.ph_hi = NPHASE;
    hipLaunchKernelGGL(fwd, dim3(grid), dim3(NT), LDS_BYTES, stream, a);
#endif
    const hipError_t le = hipPeekAtLastError();
    if (le != hipSuccess) fprintf(stderr, "kernel_launch: launch failed: %s\n", hipGetErrorName(le));
}
```

```cpp
#include <hip/hip_runtime.h>
#include <cstdio>
#include <cstdint>

#define LAS __attribute__((address_space(3)))
#define GAS __attribute__((address_space(1)))
typedef unsigned short bf16;
typedef short bf16x8 __attribute__((ext_vector_type(8)));
typedef float f32x4 __attribute__((ext_vector_type(4)));
typedef float f32x2 __attribute__((ext_vector_type(2)));
typedef unsigned u32x4 __attribute__((ext_vector_type(4)));
typedef unsigned u32x2 __attribute__((ext_vector_type(2)));
typedef GAS unsigned gu32;
#define RLX_AGENT __ATOMIC_RELAXED, __HIP_MEMORY_SCOPE_AGENT
#define LDS_WAIT() asm volatile("s_waitcnt lgkmcnt(0)" ::: "memory")
#define VM_WAIT() asm volatile("s_waitcnt vmcnt(0)" ::: "memory")

#ifndef MK_PER_PHASE
#define MK_PER_PHASE 0
#endif

constexpr int T = 32768, D = 2048, SEQ = 2048, NBATCH = 16;
constexpr int NWAVES = 8, NT = 512;
constexpr int INCOLS = 6152, PN = 6144;
constexpr int NEXP = 16, FF = 512;
constexpr int NPAIR = 24;
constexpr int SLOT_ROWS = 32768 + NPAIR * 256;
constexpr float EPS = 1e-6f;
constexpr int NPHASE = 18;

typedef __bf16 bf16x2_t __attribute__((ext_vector_type(2)));
__device__ __forceinline__ unsigned pk2(float lo, float hi) { f32x2 v = {lo, hi}; bf16x2_t b = __builtin_convertvector(v, bf16x2_t); return __builtin_bit_cast(unsigned, b); }
__device__ __forceinline__ unsigned f2bf(float f) { return pk2(f, 0.f) & 0xffffu; }
__device__ __forceinline__ float bf_lo(unsigned w) { return __builtin_bit_cast(float, w << 16); }
__device__ __forceinline__ float bf_hi(unsigned w) { return __builtin_bit_cast(float, w & 0xffff0000u); }
__device__ __forceinline__ float bf2f(bf16 b) { return __builtin_bit_cast(float, ((unsigned)b) << 16); }
typedef int i32x8 __attribute__((ext_vector_type(8)));
typedef int i32x4 __attribute__((ext_vector_type(4)));
__device__ __forceinline__ unsigned pk4_f8(float a, float b, float c, float d) {
    a = __builtin_amdgcn_fmed3f(a, -448.f, 448.f); b = __builtin_amdgcn_fmed3f(b, -448.f, 448.f); c = __builtin_amdgcn_fmed3f(c, -448.f, 448.f); d = __builtin_amdgcn_fmed3f(d, -448.f, 448.f);
    int p = __builtin_amdgcn_cvt_pk_fp8_f32(a, b, 0, false); p = __builtin_amdgcn_cvt_pk_fp8_f32(c, d, p, true); return (unsigned)p; }
__device__ __forceinline__ unsigned pk4_f8_mm(float a, float b, float c, float d) {
    a = __builtin_fminf(__builtin_fmaxf(a, -448.f), 448.f); b = __builtin_fminf(__builtin_fmaxf(b, -448.f), 448.f); c = __builtin_fminf(__builtin_fmaxf(c, -448.f), 448.f); d = __builtin_fminf(__builtin_fmaxf(d, -448.f), 448.f);
    int p = __builtin_amdgcn_cvt_pk_fp8_f32(a, b, 0, false); p = __builtin_amdgcn_cvt_pk_fp8_f32(c, d, p, true); return (unsigned)p; }
constexpr float F8_SX = 8.f, F8_SH = 64.f, F8_SY = 16.f, F8_SW = 512.f, F8_SWD = 256.f, F8_SYA = 16.f;
constexpr int Y3P = 3072;
__device__ __forceinline__ float wave_sum(float v) {
#pragma unroll
    for (int o = 1; o < 64; o <<= 1) v += __shfl_xor(v, o);
    return v;
}
__device__ __forceinline__ float sigmoidf_(float x) { return __builtin_amdgcn_rcpf(1.0f + __expf(-x)); }
__device__ __forceinline__ float gelu_tanh(float x) { const float u = 0.7978845608028654f * (x + 0.044715f * x * x * x); return x * __builtin_amdgcn_rcpf(1.0f + __expf(-2.0f * u)); }
__device__ __forceinline__ float siluf_(float x) { return x * __builtin_amdgcn_rcpf(1.0f + __expf(-x)); }

namespace pg8 {
constexpr int BM = 256, BK = 64, HALF = 128, HTB = HALF * BK * 2, STAGE_BYTES = 8 * HTB, NXCD = 8, WGM = 8;
__host__ __device__ __forceinline__ int lds_byte(int r, int c) { const int st = (r >> 4) * 2 + (c >> 5), rr = r & 15, cc = c & 31, ob = rr * 64 + cc * 2; return st * 1024 + (ob ^ (((ob >> 9) & 1) << 5)); }
__host__ __device__ __forceinline__ void stage_rc(int b, int& R, int& C) { const int st = b / 1024, sb = b % 1024, swz = sb ^ (((sb >> 9) & 1) << 5); R = (st >> 1) * 16 + swz / 64; C = (st & 1) * 32 + (swz % 64) / 2; }
__host__ __device__ __forceinline__ int perm32(int rho) { const int n = rho >> 4, i = rho & 15; return 8 * (i >> 2) + 4 * n + (i & 3); }

struct Unit { const char* a; const char* b0; const char* b1; const char* b0x; const char* b1x; int r0, c0, aux, x; };
template <bool B> struct BoolC { static constexpr bool value = B; };
struct GemmP { const char* gA; int K; unsigned rsA, planeA, ldb; int t8; };

struct TileOrder {
    int nM, nN, nwg, G, c, wgm;
    __device__ __forceinline__ void init(int nM_, int nN_, int G_, int c_, int wgm_ = WGM) { nM = nM_; nN = nN_; nwg = nM * nN; G = G_; c = c_; wgm = wgm_; }
    __device__ __forceinline__ bool next(int i, int& pm, int& pn) const {
        const long L = (long)i * G + c; if (L >= nwg) return false;
        int wgid = (int)L; { const int q = nwg / NXCD, r = nwg % NXCD, xcd = wgid % NXCD, off = wgid / NXCD; wgid = (xcd < r ? xcd * (q + 1) : r * (q + 1) + (xcd - r) * q) + off; }
        const int nig = wgm * nN, gid = wgid / nig, fm = gid * wgm, gsz = (nM - fm) < wgm ? (nM - fm) : wgm;
        pm = fm + ((wgid % nig) % gsz); pn = (wgid % nig) / gsz; return true;
    }
};

template <class Epi, class Sched, bool GATHER, bool DUALB = false, bool FP8 = false, bool MIXED = false>
__device__ __forceinline__ void gemm_phase(LAS unsigned char* lds, const GemmP g, const Sched& S, const Epi& E) {
    const int tid = threadIdx.x, wid = __builtin_amdgcn_readfirstlane(tid >> 6), lane = tid & 63, wr = wid >> 2, wc = wid & 3, fr = lane & 15, fq = lane >> 4;
    const int nt = g.K / BK;
    unsigned voffA[2], voffB[2], coff[2]; int RA[2];
#pragma unroll
    for (int i = 0; i < 2; ++i) { int R, C; stage_rc(tid * 16 + i * 8192, R, C); const int Rb = Epi::PERM ? ((R & ~31) + perm32(R & 31)) : R;
        coff[i] = (unsigned)(C >> 4) * g.planeA + (unsigned)(C & 15) * 2u; RA[i] = R;
        voffA[i] = (unsigned)R * g.rsA + coff[i]; voffB[i] = (unsigned)Rb * g.ldb + (unsigned)C * 2u; }
    const size_t ksA = (size_t)4 * g.planeA, ksB = (size_t)(BK * 2);
    const size_t hstepA = (size_t)HALF * g.rsA;
    const unsigned ldsw = (unsigned)wid * 1024u;
    const int aoff = lds_byte(wr * 64 + fr, fq * 8); int boffH = lds_byte(wc * 32 + fr, fq * 8) + 4 * HTB;
    asm volatile("" : "+v"(boffH));
#define PG8_SA(b, h) (((b) * 2 + (h)) * HTB)
#define PG8_SB(b, h) ((4 + (b) * 2 + (h)) * HTB)
#define PG8_STG(bufoff, ptr, o0, o1) do { \
        __builtin_amdgcn_global_load_lds((const unsigned*)((const char*)(ptr) + (o0)), (LAS unsigned*)(lds + (bufoff) + ldsw), 16, 0, 0); \
        __builtin_amdgcn_global_load_lds((const unsigned*)((const char*)(ptr) + (o1)), (LAS unsigned*)(lds + (bufoff) + ldsw + 8192), 16, 0, 0); } while (0)
#define PG8_STAGE_B(bufoff, ptr) PG8_STG(bufoff, ptr, voffB[0], voffB[1])
#define PG8_STAGE_A(bufoff, h, ptr, usenext) do { if constexpr (GATHER) { const unsigned _o0 = (usenext) ? voN[h][0] : voC[h][0], _o1 = (usenext) ? voN[h][1] : voC[h][1]; PG8_STG(bufoff, ptr, _o0, _o1); } \
        else { PG8_STG(bufoff, (ptr) + (h) * hstepA, voffA[0], voffA[1]); } } while (0)
#define PG8_LD16(off) (*(const LAS bf16x8*)(lds + (off)))
#define PG8_LO(x) __builtin_bit_cast(bf16x8, __builtin_shufflevector(x, x, 0, 1, 2, 3))
#define PG8_HI(x) __builtin_bit_cast(bf16x8, __builtin_shufflevector(x, x, 4, 5, 6, 7))
#define PG8_CAT8(x, y) __builtin_shufflevector(__builtin_bit_cast(i32x4, x), __builtin_bit_cast(i32x4, y), 0, 1, 2, 3, 4, 5, 6, 7)
#define PG8_LDA(dst, b, h) do { if constexpr (mode8) { _Pragma("unroll") for (int m = 0; m < 4; ++m) dst##8[m] = PG8_CAT8(PG8_LD16(PG8_SA(b, h) + aoff + m * 2048), PG8_LD16(PG8_SA(b, h) + aoff + m * 2048 + 1024)); } \
        else { _Pragma("unroll") for (int m = 0; m < 4; ++m) _Pragma("unroll") for (int k = 0; k < 2; ++k) dst[m][k] = PG8_LD16(PG8_SA(b, h) + aoff + m * 2048 + k * 1024); } } while (0)
#define PG8_LDB(dst, b, h) do { if constexpr (mode8) { _Pragma("unroll") for (int n = 0; n < 2; ++n) dst##8[n] = PG8_CAT8(PG8_LD16(boffH + ((b) * 2 + (h)) * HTB + n * 2048), PG8_LD16(boffH + ((b) * 2 + (h)) * HTB + n * 2048 + 1024)); } \
        else { _Pragma("unroll") for (int n = 0; n < 2; ++n) _Pragma("unroll") for (int k = 0; k < 2; ++k) dst[n][k] = PG8_LD16(boffH + ((b) * 2 + (h)) * HTB + n * 2048 + k * 1024); } } while (0)
#define PG8_MMA(ai, bj, At, Bt) do { __builtin_amdgcn_s_setprio(1); \
        if constexpr (FP8) { if constexpr (mode8) { _Pragma("unroll") for (int m = 0; m < 4; ++m) _Pragma("unroll") for (int n = 0; n < 2; ++n) \
            asm volatile("v_mfma_f32_16x16x128_f8f6f4 %0, %1, %2, %0" : "+v"(acc[ai][bj][m][n]) : "v"(Bt##8[n]), "v"(At##8[m])); } \
          else { _Pragma("unroll") for (int m = 0; m < 4; ++m) _Pragma("unroll") for (int n = 0; n < 2; ++n) \
                asm volatile("v_mfma_f32_16x16x32_bf16 %0, %1, %2, %0" : "+v"(acc[ai][bj][m][n]) : "v"(Bt[n][0]), "v"(At[m][0])); \
            _Pragma("unroll") for (int m = 0; m < 4; ++m) _Pragma("unroll") for (int n = 0; n < 2; ++n) \
                asm volatile("v_mfma_f32_16x16x32_bf16 %0, %1, %2, %0" : "+v"(acc[ai][bj][m][n]) : "v"(Bt[n][1]), "v"(At[m][1])); } } \
        else { _Pragma("unroll") for (int m = 0; m < 4; ++m) _Pragma("unroll") for (int n = 0; n < 2; ++n) _Pragma("unroll") for (int k = 0; k < 2; ++k) \
            acc[ai][bj][m][n] = __builtin_amdgcn_mfma_f32_16x16x32_bf16(Bt[n][k], At[m][k], acc[ai][bj][m][n], 0, 0, 0); } \
        __builtin_amdgcn_s_setprio(0); } while (0)
#define PG8_WAIT_V(n) asm volatile("s_waitcnt vmcnt(" #n ")" ::: "memory")
#define PG8_WAIT_L(n) asm volatile("s_waitcnt lgkmcnt(" #n ")" ::: "memory")
#define PG8_BAR __builtin_amdgcn_s_barrier()
#define PG8_SCHED __builtin_amdgcn_sched_barrier(0)
    Unit cur, nxt; int ui = 0;
    if (!S.next(0, cur)) return;
    unsigned voC[2][2], voN[2][2];
    if constexpr (GATHER) {
#pragma unroll
        for (int h = 0; h < 2; ++h)
#pragma unroll
            for (int i = 0; i < 2; ++i) { voC[h][i] = S.row_off(cur, h * HALF + RA[i]) + coff[i]; voN[h][i] = voC[h][i]; }
    } else { voC[0][0] = voC[0][1] = voC[1][0] = voC[1][1] = 0u; voN[0][0] = voN[0][1] = voN[1][0] = voN[1][1] = 0u; }
    f32x4 acc[2][2][4][2];
#pragma unroll
    for (int a = 0; a < 2; ++a)
#pragma unroll
        for (int b = 0; b < 2; ++b)
#pragma unroll
            for (int m = 0; m < 4; ++m)
#pragma unroll
                for (int n = 0; n < 2; ++n) acc[a][b][m][n] = (f32x4){0.f, 0.f, 0.f, 0.f};
    bf16x8 At[4][2], B0[2][2], B1[2][2];
    i32x8 At8[4], B08[2], B18[2];
    const char* cA = GATHER ? g.gA : cur.a; const char* cB0 = cur.b0; const char* cB1 = cur.b1; const char* cB0x = cur.b0x; const char* cB1x = cur.b1x;
    const int nth = nt >> 1;
#define PG8_BPTR(h, kt) ((DUALB && (kt) >= nth) ? ((h) ? cB1x : cB0x) + (size_t)((kt) - nth) * ksB : ((h) ? cB1 : cB0) + (size_t)(kt) * ksB)
    PG8_STAGE_B(PG8_SB(0, 0), cB0); PG8_STAGE_B(PG8_SB(0, 1), cB1); PG8_STAGE_A(PG8_SA(0, 0), 0, cA, false); PG8_STAGE_A(PG8_SA(0, 1), 1, cA, false);
    if (wr == 1) PG8_BAR;
    PG8_WAIT_V(2); PG8_BAR;
    PG8_STAGE_B(PG8_SB(1, 0), cB0 + ksB); PG8_STAGE_A(PG8_SA(1, 0), 0, cA + ksA, false); PG8_STAGE_B(PG8_SB(1, 1), cB1 + ksB);
    PG8_WAIT_V(6); PG8_BAR;
    for (;;) {
        const bool has_next = S.next(ui + 1, nxt);
        const char* nA = GATHER ? g.gA : (has_next ? nxt.a : cA); const char* nB0 = has_next ? nxt.b0 : cB0; const char* nB1 = has_next ? nxt.b1 : cB1;
        const char* nB0x = has_next ? nxt.b0x : cB0x; const char* nB1x = has_next ? nxt.b1x : cB1x;
        if constexpr (GATHER) {
            if (has_next) {
#pragma unroll
                for (int h = 0; h < 2; ++h)
#pragma unroll
                    for (int i = 0; i < 2; ++i) voN[h][i] = S.row_off(nxt, h * HALF + RA[i]) + coff[i];
            } else {
#pragma unroll
                for (int h = 0; h < 2; ++h)
#pragma unroll
                    for (int i = 0; i < 2; ++i) voN[h][i] = voC[h][i];
            }
        }
        auto kiter = [&](const int t, auto m8tag) __attribute__((always_inline)) {
            constexpr bool mode8 = decltype(m8tag)::value;
            const bool last = (t == nt - 2);
            const char* a1 = cA + (size_t)(t + 1) * ksA;
            const char* a2 = last ? nA : cA + (size_t)(t + 2) * ksA;
            const char* b20 = last ? nB0 : PG8_BPTR(0, t + 2); const char* b21 = last ? nB1 : PG8_BPTR(1, t + 2);
            const char* a3 = a2 + ksA; const char* b30 = last ? nB0 + ksB : PG8_BPTR(0, t + 3); const char* b31 = last ? nB1 + ksB : PG8_BPTR(1, t + 3);
            PG8_LDB(B0, 0, 0); PG8_LDB(B1, 0, 1); PG8_SCHED; PG8_LDA(At, 0, 0); PG8_STAGE_A(PG8_SA(1, 1), 1, a1, false);
            PG8_WAIT_V(8); PG8_WAIT_L(0); PG8_BAR; PG8_MMA(0, 0, At, B0); PG8_MMA(0, 1, At, B1); PG8_BAR; PG8_SCHED;
            PG8_LDA(At, 0, 1); PG8_STAGE_B(PG8_SB(0, 0), b20); PG8_STAGE_B(PG8_SB(0, 1), b21); PG8_STAGE_A(PG8_SA(0, 0), 0, a2, last);
            PG8_WAIT_V(8); PG8_WAIT_L(0); PG8_BAR; PG8_MMA(1, 0, At, B0); PG8_MMA(1, 1, At, B1); PG8_BAR; PG8_SCHED;
            PG8_LDB(B0, 1, 0); PG8_LDB(B1, 1, 1); PG8_SCHED; PG8_LDA(At, 1, 0); PG8_STAGE_A(PG8_SA(0, 1), 1, a2, last);
            PG8_WAIT_V(8); PG8_WAIT_L(0); PG8_BAR; PG8_MMA(0, 0, At, B0); PG8_MMA(0, 1, At, B1); PG8_BAR; PG8_SCHED;
            PG8_LDA(At, 1, 1); PG8_STAGE_B(PG8_SB(1, 0), b30); PG8_STAGE_B(PG8_SB(1, 1), b31); PG8_STAGE_A(PG8_SA(1, 0), 0, a3, last);
            PG8_WAIT_V(8); PG8_WAIT_L(0); PG8_BAR; PG8_MMA(1, 0, At, B0); PG8_MMA(1, 1, At, B1); PG8_BAR; PG8_SCHED;
        };
        if constexpr (MIXED) {
#pragma nounroll
            for (int t = 0; t < g.t8; t += 2) kiter(t, BoolC<true>{});
            asm volatile("s_nop 15\n\ts_nop 15" ::: "memory");
#pragma unroll
            for (int a = 0; a < 2; ++a)
#pragma unroll
                for (int b = 0; b < 2; ++b)
#pragma unroll
                    for (int m = 0; m < 4; ++m)
#pragma unroll
                        for (int n = 0; n < 2; ++n) acc[a][b][m][n] *= (1.0f / (F8_SYA * F8_SW));
#pragma nounroll
            for (int t = g.t8; t < nt; t += 2) kiter(t, BoolC<false>{});
        } else {
#pragma nounroll
            for (int t = 0; t < nt; t += 2) kiter(t, BoolC<FP8>{});
        }
#ifndef PG8_NOALIGN
        if (wr == 0) PG8_BAR;
#endif
        if constexpr (FP8) asm volatile("s_nop 15\n\ts_nop 15" ::: "memory");
        E(acc, cur, wr, wc, fr, fq);
        if (!has_next) break;
#pragma unroll
        for (int a = 0; a < 2; ++a)
#pragma unroll
            for (int b = 0; b < 2; ++b)
#pragma unroll
                for (int m = 0; m < 4; ++m)
#pragma unroll
                    for (int n = 0; n < 2; ++n) acc[a][b][m][n] = (f32x4){0.f, 0.f, 0.f, 0.f};
        cur = nxt; cA = nA; cB0 = nB0; cB1 = nB1; cB0x = nB0x; cB1x = nB1x; ++ui;
        if constexpr (GATHER) {
#pragma unroll
            for (int h = 0; h < 2; ++h)
#pragma unroll
                for (int i = 0; i < 2; ++i) voC[h][i] = voN[h][i];
        }
#ifndef PG8_NOALIGN
        if (wr == 1) PG8_BAR;
#endif
    }
    PG8_WAIT_V(0);
#ifdef PG8_NOALIGN
    if (wr == 0) PG8_BAR;
#endif
    PG8_BAR;
#undef PG8_BPTR
#undef PG8_SA
#undef PG8_SB
#undef PG8_STG
#undef PG8_STAGE_A
#undef PG8_STAGE_B
#undef PG8_LDA
#undef PG8_LDB
#undef PG8_MMA
#undef PG8_CAT8
#undef PG8_LD16
#undef PG8_LO
#undef PG8_HI
#undef PG8_WAIT_V
#undef PG8_WAIT_L
#undef PG8_BAR
#undef PG8_SCHED
}
}

#define XB_TMO      128
#define XB_XCNT(j)  (256  + 64 * (j))
#define XB_XSUB(j)  (1280 + 64 * (j))
#define XB_XGEN(j)  (2304 + 64 * (j))
#define XB_TOP      3328
#define XB_TOPGEN   3392
#define XCD_BAR_WORDS 3456
#define XB_SPIN_CAP (1u << 18)
__device__ __forceinline__ unsigned xb_ld(unsigned* p)              { return __hip_atomic_load(p, __ATOMIC_RELAXED, __HIP_MEMORY_SCOPE_AGENT); }
__device__ __forceinline__ unsigned xb_add(unsigned* p, unsigned v) { return __hip_atomic_fetch_add(p, v, __ATOMIC_RELAXED, __HIP_MEMORY_SCOPE_AGENT); }
__device__ __forceinline__ unsigned xb_xcc_id() { return (unsigned)__builtin_amdgcn_s_getreg((3 << 11) | 20) & 0xFu; }
#define XB_SPIN(cond, bar) do { unsigned _sp = 0; while (cond) { __builtin_amdgcn_s_sleep(1); \
    if ((++_sp & 255u) == 0u) { if (xb_ld(&(bar)[XB_TMO])) break; if (_sp > XB_SPIN_CAP) { atomicAdd(&(bar)[XB_TMO], 1u); break; } } } } while (0)
struct XcdBarrier { unsigned* bar; unsigned x; volatile LAS unsigned* st; };
__device__ __forceinline__ XcdBarrier xcd_barrier_post(unsigned* bar, volatile LAS unsigned* st) {
    XcdBarrier b; b.bar = bar; b.x = xb_xcc_id(); b.st = st;
    if (threadIdx.x == 0) (void)xb_add(&bar[XB_XCNT(b.x)], 1u);
    return b;
}
__device__ __forceinline__ void xcd_barrier_complete(unsigned* bar, unsigned x, unsigned& nloc, unsigned& nx) {
    const unsigned G = gridDim.x * gridDim.y * gridDim.z;
    unsigned sum, cnt, mine, sp = 0u;
    for (;;) {
        sum = 0u; cnt = 0u; mine = 0u;
#pragma unroll
        for (unsigned j = 0; j < 16; ++j) { const unsigned c = xb_ld(&bar[XB_XCNT(j)]); sum += c; cnt += (c > 0u) ? 1u : 0u; mine = (j == x) ? c : mine; }
        if (sum == G) break;
        __builtin_amdgcn_s_sleep(1);
        if ((++sp & 255u) == 0u) { if (xb_ld(&bar[XB_TMO])) break; if (sp > XB_SPIN_CAP) { atomicAdd(&bar[XB_TMO], 1u); break; } }
    }
    nloc = mine > 0u ? mine : 1u; nx = cnt > 0u ? cnt : 1u;
}
__device__ __forceinline__ void xcd_barrier(const XcdBarrier& b) {
    asm volatile("s_waitcnt vmcnt(0)" ::: "memory");
    __syncthreads();
    if (threadIdx.x == 0) {
        unsigned* bar = b.bar;
        __builtin_amdgcn_s_waitcnt(0);
        unsigned nloc = b.st[0], nx = b.st[1];
        if (nloc == 0u) { xcd_barrier_complete(bar, b.x, nloc, nx); b.st[0] = nloc; b.st[1] = nx; }
        const unsigned old = xb_add(&bar[XB_XSUB(b.x)], 1u);
        const unsigned gen = old / nloc;
        if (old + 1u == (gen + 1u) * nloc) {
            __builtin_amdgcn_fence(__ATOMIC_RELEASE, "agent");
            asm volatile("s_waitcnt vmcnt(0)" ::: "memory");
            const unsigned og = xb_add(&bar[XB_TOP], 1u);
            const unsigned tg = og / nx;
            if (og + 1u == (tg + 1u) * nx) xb_add(&bar[XB_TOPGEN], 1u);
            else XB_SPIN(xb_ld(&bar[XB_TOPGEN]) == tg, bar);
            __builtin_amdgcn_fence(__ATOMIC_ACQUIRE, "agent");
            xb_add(&bar[XB_XGEN(b.x)], 1u);
            asm volatile("s_waitcnt vmcnt(0)" ::: "memory");
        } else {
            XB_SPIN(xb_ld(&bar[XB_XGEN(b.x)]) == gen, bar);
            __builtin_amdgcn_fence(__ATOMIC_ACQUIRE, "agent");
            asm volatile("s_waitcnt vmcnt(0)" ::: "memory");
        }
    }
    __syncthreads();
}

constexpr size_t MiB = 1u << 20;
constexpr size_t WS_CTL = 0, CTL_ZERO_BYTES = 1 * MiB;
constexpr size_t WS_RSTD = 1 * MiB;
constexpr size_t WS_GATES = 2 * MiB;
constexpr size_t WS_SUMSQ = 3 * MiB;
constexpr size_t WS_RW = 5 * MiB;
constexpr size_t WS_LAM = 6 * MiB;
constexpr size_t WS_LRUW = 7 * MiB;
constexpr size_t WS_TOKL = 8 * MiB;
constexpr size_t WS_RSTDL = 10 * MiB;
constexpr size_t WS_GATEL = 12 * MiB;
constexpr size_t WS_TOKSLOT = 14 * MiB;
constexpr size_t WS_WIN = 16 * MiB;
constexpr size_t WS_WOUT = 40 * MiB;
constexpr size_t WS_WS5IN = 48 * MiB, WS_WGLUV = 56 * MiB, WS_WGLUG = 64 * MiB;
constexpr size_t WS_WMOE0 = 72 * MiB;
constexpr size_t WS_S5WIN = 168 * MiB;
constexpr size_t WS_S5WO = 176 * MiB;
constexpr size_t WS_S5K = 192 * MiB;
constexpr size_t WS_XB = 200 * MiB;
constexpr size_t WS_Y = 328 * MiB;
constexpr size_t WS_P = 456 * MiB;
constexpr size_t WS_H = 456 * MiB;
constexpr size_t WS_PTOK = 540 * MiB;
constexpr size_t WS_PRSTD = 544 * MiB, WS_PGA = 548 * MiB, WS_PGB = 552 * MiB;
constexpr size_t WS_A2 = 456 * MiB;
constexpr size_t WS_XIN = 648 * MiB;
constexpr size_t WS_X8IN = 328 * MiB;
constexpr size_t WS_X8 = 648 * MiB;
constexpr size_t WS_WMOE1 = 840 * MiB;
constexpr size_t WS_MQ = 888 * MiB, WS_MKT = 952 * MiB;
constexpr size_t WS_MP = 16 * MiB, WS_MPS = 32 * MiB;
constexpr size_t WS_MSC = 33 * MiB;
constexpr size_t WS_END = 1016 * MiB;
static_assert(WS_H + (size_t)SLOT_ROWS * 1024 * 2 <= WS_PTOK && WS_PGB + (size_t)NPAIR * T * 4 <= WS_XIN, "moe buffers");
static_assert(WS_A2 + (size_t)128 * 2048 * 384 * 2 <= WS_XIN && WS_XIN + (size_t)128 * 2048 * 128 * 4 <= WS_WMOE1, "s5 buffers");
static_assert(WS_P + (size_t)T * PN * 2 <= WS_WMOE1, "p buffer");
constexpr int CW_BAR = 4096;
constexpr int CW_TMO = 8;
constexpr int CW_PANEL = 32768;
constexpr int CW_CNT = 16384;

constexpr int RING_BYTES = 131072;
constexpr int LDS_BYTES = 163840;
constexpr int MISC_OFF = LDS_BYTES - 1024;
constexpr int MI_PRE = 136, MI_CNT = 164;

struct Frame {
    LAS unsigned char* lds;
    volatile LAS unsigned* MISC;
    gu32* ctl;
    int tid, lane, wave, vcu, G;
    unsigned char* ws;
    __device__ __forceinline__ const float* in(int i) const {
        const unsigned lo = __builtin_amdgcn_readfirstlane(MISC[64 + 2 * i]), hi = __builtin_amdgcn_readfirstlane(MISC[65 + 2 * i]);
        return (const float*)(((unsigned long long)hi << 32) | lo); }
    __device__ __forceinline__ float* outp() const {
        const unsigned lo = __builtin_amdgcn_readfirstlane(MISC[200]), hi = __builtin_amdgcn_readfirstlane(MISC[201]);
        return (float*)(((unsigned long long)hi << 32) | lo); }
};

__device__ __forceinline__ void transpose_item(const float* W, int ldw, const float* gain, bf16* WT, int ldt, int nblk, LAS float* scr, int item, int lane, bool late = false) {
    const int kb = item / nblk, nb = item % nblk, k0 = 64 * kb, n0 = 32 * nb;
    float v[32];
#pragma unroll
    for (int i = 0; i < 32; ++i) v[i] = __builtin_nontemporal_load(&W[(size_t)(k0 + 2 * i + (lane >> 5)) * ldw + n0 + (lane & 31)]);
    const int c = lane & 7;
    f32x4 g0 = (f32x4){1.f, 1.f, 1.f, 1.f}, g1 = g0;
    if (gain) { g0 = *(const f32x4*)(gain + k0 + 8 * c); g1 = *(const f32x4*)(gain + k0 + 8 * c + 4); }
#pragma unroll
    for (int i = 0; i < 32; ++i) scr[(2 * i + (lane >> 5)) * 33 + (lane & 31)] = v[i];
    LDS_WAIT(); asm volatile("" ::: "memory");
#pragma unroll
    for (int j = 0; j < 4; ++j) { const int n = (lane >> 3) + 8 * j; const LAS float* s = scr + (8 * c) * 33 + n;
        u32x4 o; o.x = pk2(s[0 * 33] * g0[0], s[1 * 33] * g0[1]); o.y = pk2(s[2 * 33] * g0[2], s[3 * 33] * g0[3]); o.z = pk2(s[4 * 33] * g1[0], s[5 * 33] * g1[1]); o.w = pk2(s[6 * 33] * g1[2], s[7 * 33] * g1[3]);
        if (late) __builtin_nontemporal_store(o, (GAS u32x4*)(WT + (size_t)(n0 + n) * ldt + k0 + 8 * c)); else *(GAS u32x4*)(WT + (size_t)(n0 + n) * ldt + k0 + 8 * c) = o; }
    LDS_WAIT(); asm volatile("" ::: "memory");
}
__device__ __forceinline__ void transpose_item8(const float* W, int ldw, const float* gain, unsigned char* WT, int ldt, int nblk, LAS float* scr, int item, int lane, float sc, bool late = true) {
    const int kb = item / nblk, nb = item % nblk, k0 = 64 * kb, n0 = 32 * nb;
    float v[32];
#pragma unroll
    for (int i = 0; i < 32; ++i) v[i] = __builtin_nontemporal_load(&W[(size_t)(k0 + 2 * i + (lane >> 5)) * ldw + n0 + (lane & 31)]);
    const int c = lane & 7;
    f32x4 g0 = (f32x4){sc, sc, sc, sc}, g1 = g0;
    if (gain) { g0 = *(const f32x4*)(gain + k0 + 8 * c) * sc; g1 = *(const f32x4*)(gain + k0 + 8 * c + 4) * sc; }
#pragma unroll
    for (int i = 0; i < 32; ++i) scr[(2 * i + (lane >> 5)) * 33 + (lane & 31)] = v[i];
    LDS_WAIT(); asm volatile("" ::: "memory");
#pragma unroll
    for (int j = 0; j < 4; ++j) { const int n = (lane >> 3) + 8 * j; const LAS float* s = scr + (8 * c) * 33 + n;
        u32x2 o; o.x = pk4_f8(s[0 * 33] * g0[0], s[1 * 33] * g0[1], s[2 * 33] * g0[2], s[3 * 33] * g0[3]); o.y = pk4_f8(s[4 * 33] * g1[0], s[5 * 33] * g1[1], s[6 * 33] * g1[2], s[7 * 33] * g1[3]);
        if (late) __builtin_nontemporal_store(o, (GAS u32x2*)(WT + (size_t)(n0 + n) * ldt + k0 + 8 * c)); else *(GAS u32x2*)(WT + (size_t)(n0 + n) * ldt + k0 + 8 * c) = o; }
    LDS_WAIT(); asm volatile("" ::: "memory");
}
__device__ __forceinline__ void sincos_d(double th, double& s, double& c) {
    const double TWO_PI = 6.283185307179586476925286766559;
    const double k = __builtin_rint(th / TWO_PI); const double x = th - k * TWO_PI;
    const double x2 = x * x; double ts = x, tc = 1.0; s = x; c = 1.0;
#pragma unroll
    for (int i = 1; i <= 16; ++i) { tc *= -x2 / (double)((2 * i - 1) * (2 * i)); ts *= -x2 / (double)((2 * i) * (2 * i + 1)); c += tc; s += ts; }
}
__device__ __forceinline__ void s5_build_group(Frame& F, int g, int half) {
    LAS float* pwr = (LAS float*)(F.lds);
    LAS float* pwi = pwr + 17 * 64;
    LAS float* bbr = pwi + 17 * 64;
    LAS float* bbi = bbr + 1024;
    LAS float* cre = bbi + 1024;
    LAS float* cim = cre + 1024;
    LAS float* km = cim + 1024;
    LAS float* ff = km + 4096;
    LAS float* ctr = ff + 128;
    LAS float* cti = ctr + 1024;
    const int tid = F.tid;
    const float* a_re = F.in(19) + g * 64; const float* a_im = F.in(20) + g * 64;
    if (tid < 64) {
        const double dt = (double)expf(F.in(21)[g]), ar = (double)a_re[tid], ai = (double)a_im[tid];
        const double mag = (double)expf((float)(ar * dt)); double sn, cs; sincos_d(ai * dt, sn, cs);
        const double lr = mag * cs, li = mag * sn; double pr = 1.0, pi = 0.0;
        for (int d = 0; d <= 16; ++d) { pwr[d * 64 + tid] = (float)pr; pwi[d * 64 + tid] = (float)pi; const double nr = pr * lr - pi * li, ni = pr * li + pi * lr; pr = nr; pi = ni; }
        const double den = ar * ar + ai * ai;
        ff[tid] = (float)(((lr - 1.0) * ar + li * ai) / den); ff[64 + tid] = (float)((li * ar - (lr - 1.0) * ai) / den);
        if (half == 0) {
            double q16r = 1.0, q16i = 0.0;
            for (int d = 0; d < 16; ++d) { const double nr = q16r * lr - q16i * li, ni = q16r * li + q16i * lr; q16r = nr; q16i = ni; }
            double q64r = q16r, q64i = q16i;
            for (int d = 0; d < 2; ++d) { const double nr = q64r * q64r - q64i * q64i, ni = 2.0 * q64r * q64i; q64r = nr; q64i = ni; }
            *(f32x4*)((float*)(F.ws + WS_LAM) + ((size_t)g * 64 + tid) * 4) = (f32x4){(float)q16r, (float)q16i, (float)q64r, (float)q64i};
        }
    }
    __syncthreads();
    { const float* pbr = F.in(22) + g * 1024; const float* pbi = F.in(23) + g * 1024; const float* pcr = F.in(24) + g * 1024; const float* pci = F.in(25) + g * 1024;
    for (int idx = tid; idx < 1024; idx += NT) { const int p = idx >> 4; const float br = pbr[idx], bi = pbi[idx]; const float fr = ff[p], fi = ff[64 + p];
        bbr[idx] = fr * br - fi * bi; bbi[idx] = fr * bi + fi * br; const float cr_ = pcr[idx], ci_ = pci[idx]; cre[idx] = cr_; cim[idx] = ci_;
        ctr[(idx & 63) * 16 + (idx >> 6)] = cr_; cti[(idx & 63) * 16 + (idx >> 6)] = ci_; } }
    __syncthreads();
    if (tid < 256) {
        const int d = tid >> 4, co = tid & 15; float ac[16];
#pragma unroll
        for (int ci = 0; ci < 16; ++ci) ac[ci] = 0.f;
        for (int p = 0; p < 64; ++p) { const float c_r = ctr[p * 16 + co], c_i = cti[p * 16 + co], l_r = pwr[d * 64 + p], l_i = pwi[d * 64 + p];
            const float tr = c_r * l_r - c_i * l_i, ti = c_r * l_i + c_i * l_r;
#pragma unroll
            for (int c4 = 0; c4 < 4; ++c4) { const f32x4 br = *(const LAS f32x4*)(bbr + p * 16 + 4 * c4), bi = *(const LAS f32x4*)(bbi + p * 16 + 4 * c4);
#pragma unroll
                for (int j = 0; j < 4; ++j) ac[4 * c4 + j] += tr * br[j] - ti * bi[j]; } }
#pragma unroll
        for (int c4 = 0; c4 < 4; ++c4) *(LAS f32x4*)(km + (d << 8) + (co << 4) + 4 * c4) = (f32x4){ac[4 * c4], ac[4 * c4 + 1], ac[4 * c4 + 2], ac[4 * c4 + 3]};
    }
    __syncthreads();
    const float* dsk = F.in(26) + g * 16;
    if (half == 0) { bf16* KB = (bf16*)(F.ws + WS_S5K) + (size_t)g * 4096;
        for (int idx = tid; idx < 4096; idx += NT) { const int co = (idx >> 4) & 15, ci = idx & 15; float v = km[idx]; if (idx < 256 && ci == co) v += dsk[co]; KB[idx] = (bf16)f2bf(v); } }
    bf16* Wo = (bf16*)(F.ws + WS_S5WO) + (size_t)g * 256 * 128;
    for (int idx = half * 128 * 128 + tid; idx < (half + 1) * 128 * 128; idx += NT) { const int row = idx >> 7, q = idx & 127, tl = row >> 4, co = row & 15, p = 8 * (q >> 4) + (q & 7), part = (q >> 3) & 1;
        const float c_r = cre[co * 64 + p], c_i = cim[co * 64 + p], l_r = pwr[(tl + 1) * 64 + p], l_i = pwi[(tl + 1) * 64 + p];
        Wo[idx] = (bf16)f2bf((part == 0) ? (c_r * l_r - c_i * l_i) : -(c_r * l_i + c_i * l_r)); }
    bf16* Wi = (bf16*)(F.ws + WS_S5WIN) + (size_t)g * 128 * 256;
    for (int idx = half * 64 * 256 + tid; idx < (half + 1) * 64 * 256; idx += NT) { const int row = idx >> 8, col = idx & 255, p = 8 * (row >> 4) + (row & 7), part = (row >> 3) & 1, j = col >> 4, ci = col & 15, d = 15 - j;
        const float l_r = pwr[d * 64 + p], l_i = pwi[d * 64 + p], b_r = bbr[p * 16 + ci], b_i = bbi[p * 16 + ci];
        Wi[idx] = (bf16)f2bf(part == 0 ? (l_r * b_r - l_i * b_i) : (l_r * b_i + l_i * b_r)); }
    __syncthreads();
}

__device__ __forceinline__ void moe1_tail_convert(Frame& F, int half) {
    const int ntiles = __builtin_amdgcn_readfirstlane((int)F.MISC[MI_PRE + NPAIR]);
    const int rem = (8 * ntiles) % F.G, first = rem, nidle = F.G - first;
    if (F.vcu < first) return;
    LAS float* scr = (LAS float*)(F.lds + F.wave * 16384);
    const int gw = (F.vcu - first) * NWAVES + F.wave, NGWi = nidle * NWAVES, lane = F.lane;
    constexpr int I_MOE = 512, W0 = 19 * I_MOE, W1 = 32 * I_MOE, W2 = 48 * I_MOE;
    const int i0 = (half == 0) ? 0 : (half == 1) ? W0 : W1, i1 = (half == 0) ? W0 : (half == 1) ? W1 : W2;
    for (int it = i0 + gw; it < i1; it += NGWi) {
        const int r = it, mat = r / I_MOE, itx = r % I_MOE, kind = mat / 16, e = mat % 16;
        unsigned char* base = F.ws + WS_WMOE1;
        if (kind < 2) transpose_item8((kind == 0 ? F.in(33) : F.in(34)) + (size_t)(16 + e) * 2048 * 512, 512, F.in(2) + 2048, base + (size_t)kind * 16 * MiB + (size_t)e * 512 * 2048, 2048, 16, scr, itx, lane, F8_SW);
        else transpose_item8(F.in(35) + (size_t)(16 + e) * 512 * 2048, 2048, nullptr, base + (size_t)32 * MiB + (size_t)e * 2048 * 512, 512, 64, scr, itx, lane, F8_SWD);
    }
}
__device__ __forceinline__ void ph_prologue(Frame& F, int pf) {
    LAS float* scr = (LAS float*)(F.lds + F.wave * 16384);
    const int gw = F.vcu * NWAVES + F.wave, NGW = F.G * NWAVES, lane = F.lane;
    constexpr int I_IN = 32 * 192, I_SQ = 32 * 64, I_MOE = 512;
    constexpr int NITEMS = I_IN + 4 * I_SQ + 48 * I_MOE;
    if (!(pf & 16))
    for (int it = gw; it < NITEMS; it += NGW) {
        int r = it;
        if (r < I_IN) { if ((r % 192) < 64) transpose_item8(F.in(4), INCOLS, F.in(1), F.ws + WS_WIN, 2048, 192, scr, r, lane, F8_SW, false);
            else transpose_item(F.in(4), INCOLS, F.in(1), (bf16*)(F.ws + WS_WIN), 2048, 192, scr, r, lane); continue; } r -= I_IN;
        if (r < I_SQ) { if (r < 16 * 64) transpose_item8(F.in(17), 2048, nullptr, F.ws + WS_WOUT, Y3P, 64, scr, r, lane, F8_SW);
            else transpose_item(F.in(17), 2048, nullptr, (bf16*)(F.ws + WS_WOUT + 1024) - 1024, Y3P / 2, 64, scr, r, lane, true); continue; } r -= I_SQ;
        if (r < I_SQ) { transpose_item8(F.in(18), 2048, F.in(1) + 2048, F.ws + WS_WS5IN, 2048, 64, scr, r, lane, F8_SW); continue; } r -= I_SQ;
        if (r < I_SQ) { transpose_item8(F.in(27), 2048, nullptr, F.ws + WS_WGLUV, 2048, 64, scr, r, lane, F8_SW); continue; } r -= I_SQ;
        if (r < I_SQ) { transpose_item8(F.in(28), 2048, nullptr, F.ws + WS_WGLUG, 2048, 64, scr, r, lane, F8_SW); continue; } r -= I_SQ;
        const int mat = r / I_MOE, itx = r % I_MOE, l = mat / 48, rem = mat % 48, kind = rem / 16, e = rem % 16;
        unsigned char* base = F.ws + (l ? WS_WMOE1 : WS_WMOE0);
        if (kind < 2) transpose_item8((kind == 0 ? F.in(33) : F.in(34)) + (size_t)(l * 16 + e) * 2048 * 512, 512, F.in(2) + l * 2048, base + (size_t)kind * 16 * MiB + (size_t)e * 512 * 2048, 2048, 16, scr, itx, lane, F8_SW);
        else transpose_item8(F.in(35) + (size_t)(l * 16 + e) * 512 * 2048, 2048, nullptr, base + (size_t)32 * MiB + (size_t)e * 2048 * 512, 512, 64, scr, itx, lane, F8_SWD);
    }
    __syncthreads();
    if (!(pf & 32)) for (int gh = F.vcu; gh < 256; gh += F.G) s5_build_group(F, gh >> 1, gh & 1);
    __syncthreads();
    const int gt = F.vcu * NT + F.tid, NGT = F.G * NT;
    {
        bf16* LW = (bf16*)(F.ws + WS_LRUW); const float* wa_ = F.in(7); const float* wx_ = F.in(9); const float* wc_ = F.in(29); const float* wf_ = F.in(31); const float* nf_ = F.in(2);
        for (int idx = gt; idx < 8 * 256 * 128; idx += NGT) { const int n = idx >> 15, o = (idx >> 7) & 255, i = idx & 127;
            const float v = (o < 128) ? wa_[(size_t)(n * 128 + i) * 128 + o] : wx_[(size_t)(n * 128 + i) * 128 + (o - 128)]; LW[idx] = (bf16)f2bf(v); }
        float* RW = (float*)(F.ws + WS_RW);
        bf16* RWB = (bf16*)RW;
        for (int idx = gt; idx < 2 * 32 * 2048; idx += NGT) { const int l = idx >> 16, n = (idx >> 11) & 31, k = idx & 2047;
            const float w = (n < 4) ? wc_[(size_t)(l * 2048 + k) * 4 + n] * nf_[l * 2048 + k] : (n < 20) ? wf_[(size_t)(l * 2048 + k) * 16 + (n - 4)] * nf_[l * 2048 + k] : 0.f;
            const unsigned hi = f2bf(w); const float lo = w - __builtin_bit_cast(float, hi << 16);
            RWB[((size_t)(l * 2 + 0) * 32 + n) * 2048 + k] = (bf16)hi; RWB[((size_t)(l * 2 + 1) * 32 + n) * 2048 + k] = (bf16)f2bf(lo); }
    }
    LAS float* wgT = (LAS float*)F.lds;
    { const float* win = F.in(4); const float* nm0 = F.in(1);
#pragma unroll
    for (int j = 0; j < 4; ++j) { const int k = F.tid + NT * j;
        const f32x4 a = *(const GAS f32x4*)(win + (size_t)k * INCOLS + 6144), b = *(const GAS f32x4*)(win + (size_t)k * INCOLS + 6148); const float g = nm0[k];
        wgT[0 * 2048 + k] = a[0] * g; wgT[1 * 2048 + k] = a[1] * g; wgT[2 * 2048 + k] = a[2] * g; wgT[3 * 2048 + k] = a[3] * g;
        wgT[4 * 2048 + k] = b[0] * g; wgT[5 * 2048 + k] = b[1] * g; wgT[6 * 2048 + k] = b[2] * g; wgT[7 * 2048 + k] = b[3] * g; } }
    __syncthreads();
    const float* x = F.in(0); bf16* xb = (bf16*)(F.ws + WS_XB); unsigned char* x8 = F.ws + WS_X8IN; float* rstd_o = (float*)(F.ws + WS_RSTD); float* gates = (float*)(F.ws + WS_GATES);
    const float bias = (lane < 4) ? F.in(14)[lane & 3] : F.in(15)[lane & 3];
    if (!(pf & 64))
    for (int m0 = 2 * gw; m0 < T; m0 += 2 * NGW) {
        f32x4 v[2][8]; float ss[2] = {0.f, 0.f};
#pragma unroll
        for (int q = 0; q < 2; ++q) { const GAS f32x4* xr = (const GAS f32x4*)(x + (size_t)(m0 + q) * D) + lane;
#pragma unroll
            for (int j = 0; j < 8; ++j) v[q][j] = __builtin_nontemporal_load(&xr[64 * j]); }
#pragma unroll
        for (int q = 0; q < 2; ++q) { const int m = m0 + q;
#pragma unroll
            for (int j = 0; j < 8; ++j) ss[q] += (v[q][j].x * v[q][j].x + v[q][j].y * v[q][j].y) + (v[q][j].z * v[q][j].z + v[q][j].w * v[q][j].w);
            ss[q] = wave_sum(ss[q]); const float rstd = 1.0f / sqrtf(ss[q] * (1.0f / D) + EPS);
            GAS u32x2* o8 = (GAS u32x2*)(xb + (size_t)m * D) + lane; GAS unsigned* o4 = (GAS unsigned*)(x8 + (size_t)m * D) + lane;
#pragma unroll
            for (int j = 0; j < 8; ++j) { u32x2 w; w.x = pk2(v[q][j].x, v[q][j].y); w.y = pk2(v[q][j].z, v[q][j].w); o8[64 * j] = w;
                o4[64 * j] = pk4_f8(v[q][j].x * F8_SX, v[q][j].y * F8_SX, v[q][j].z * F8_SX, v[q][j].w * F8_SX); }
            float ga[8];
#pragma unroll
            for (int c = 0; c < 8; ++c) { float a = 0.f;
#pragma unroll
                for (int j = 0; j < 8; ++j) { const f32x4 w = *(const LAS f32x4*)(wgT + c * 2048 + 4 * (lane + 64 * j)); a += (v[q][j].x * w.x + v[q][j].y * w.y) + (v[q][j].z * w.z + v[q][j].w * w.w); }
                ga[c] = wave_sum(a); asm volatile("" ::: "memory"); }
            float val = ga[0];
#pragma unroll
            for (int c = 1; c < 8; ++c) val = (lane == c) ? ga[c] : val;
            if (lane < 8) gates[(size_t)m * 8 + lane] = val * rstd + bias;
            if (lane == 0) rstd_o[m] = rstd; }
    }
    __syncthreads();
}

__device__ __forceinline__ unsigned ld_agent_u32(const unsigned* p) { return __hip_atomic_load(p, RLX_AGENT); }
__device__ __forceinline__ float ld_agent_f32(const float* p) { return __builtin_bit_cast(float, __hip_atomic_load((const unsigned*)p, RLX_AGENT)); }
using pg8::Unit;

struct DenseSched {
    pg8::TileOrder to; const char* A; size_t tstepA; const char* B0; const char* B1; size_t tstepB; int cpt;
    __device__ __forceinline__ bool next(int i, Unit& u) const { int pm, pn; if (!to.next(i, pm, pn)) return false;
        u.a = A + (size_t)pm * tstepA; u.b0 = B0 + (size_t)pn * tstepB; u.b1 = B1 + (size_t)pn * tstepB; u.b0x = u.b0; u.b1x = u.b1; u.r0 = pm * 256; u.c0 = pn * cpt; u.aux = 0; u.x = 0; return true; }
    __device__ __forceinline__ unsigned row_off(const Unit&, int) const { return 0u; }
    __device__ __forceinline__ void a_ready(const Unit&) const {}
};
struct S5Sched {
    int G, c; const char* A; const char* B; size_t gstepB; size_t hstepB;
    __device__ __forceinline__ bool next(int i, Unit& u) const { const int L = i * G + c; if (L >= 1024) return false; const int g = L >> 3, pm = L & 7;
        u.a = A + ((size_t)g * 2048 + (size_t)pm * 256) * 768; u.b0 = B + (size_t)g * gstepB; u.b1 = u.b0 + hstepB; u.b0x = u.b0; u.b1x = u.b1; u.r0 = pm * 256; u.c0 = 0; u.aux = g; u.x = 0; return true; }
    __device__ __forceinline__ unsigned row_off(const Unit&, int) const { return 0u; }
    __device__ __forceinline__ void a_ready(const Unit&) const {}
};
__device__ __forceinline__ void pair_experts(int q, int& ea, int& eb) { const int g = q / 6, p = q - 6 * g; const int ia = (p < 3) ? 0 : (p < 5) ? 1 : 2, ib = (p < 3) ? p + 1 : (p < 5) ? p - 1 : 3; ea = 4 * g + ia; eb = 4 * g + ib; }
template <bool DOWN> struct MoeSched {
    volatile LAS unsigned* misc; int G, c; const char* W0; const char* W1; const char* Hd; const int* ptok;
    __device__ __forceinline__ bool next(int i, Unit& u) const {
        const int L = i * G + c, ntiles = __builtin_amdgcn_readfirstlane((int)misc[MI_PRE + NPAIR]); if (L >= ntiles * 8) return false;
        int q = 0;
#pragma unroll
        for (int j = 1; j < NPAIR; ++j) q += ((L >> 3) >= __builtin_amdgcn_readfirstlane((int)misc[MI_PRE + j])) ? 1 : 0;
        const int pq = __builtin_amdgcn_readfirstlane((int)misc[MI_PRE + q]), tq = __builtin_amdgcn_readfirstlane((int)misc[MI_PRE + q + 1]) - pq, loc = L - 8 * pq;
        const int ct = loc / tq, gr = pq + (loc - ct * tq);
        int ea, eb; pair_experts(q, ea, eb);
        u.aux = q; u.r0 = gr * 256; u.x = (gr - pq) * 256;
        if (!DOWN) { const int e = (ct < 4) ? ea : eb; u.c0 = ct * 128; u.a = nullptr;
            u.b0 = W0 + (size_t)e * 512 * 2048 + (size_t)(ct & 3) * 128 * 2048; u.b1 = W1 + (size_t)e * 512 * 2048 + (size_t)(ct & 3) * 128 * 2048; u.b0x = u.b0; u.b1x = u.b1; }
        else { u.c0 = ct * 256; u.a = Hd + (size_t)gr * 256 * 1024;
            u.b0 = W0 + (size_t)ea * 2048 * 512 + (size_t)ct * 256 * 512; u.b1 = u.b0 + (size_t)128 * 512; u.b0x = W0 + (size_t)eb * 2048 * 512 + (size_t)ct * 256 * 512; u.b1x = u.b0x + (size_t)128 * 512; }
        return true; }
    __device__ __forceinline__ unsigned row_off(const Unit& u, int row) const { const int cnt = __builtin_amdgcn_readfirstlane((int)misc[MI_CNT + u.aux]); int idx = u.x + row; idx = idx < cnt ? idx : cnt - 1;
        return (unsigned)ptok[(size_t)u.aux * T + idx] * 2048u; }
};

struct EpiScaleBf16 {
    static constexpr bool PERM = true;
    bf16* O; int ldc; const float* scale; int pf; float k;
    __device__ __forceinline__ void operator()(const f32x4 (&acc)[2][2][4][2], const Unit& u, int wr, int wc, int fr, int fq) const {
        const int row0 = u.r0 + wr * 64 + fr, col0 = u.c0 + wc * 32 + 8 * fq;
        float sv[2][4];
#pragma unroll
        for (int ai = 0; ai < 2; ++ai)
#pragma unroll
            for (int m = 0; m < 4; ++m) sv[ai][m] = scale[row0 + ai * 128 + m * 16];
#pragma unroll
        for (int ai = 0; ai < 2; ++ai)
#pragma unroll
            for (int m = 0; m < 4; ++m) { int zz = 0; asm volatile("" : "+v"(zz)); const int row = row0 + ai * 128 + m * 16 + zz; const float s = sv[ai][m] * k; bf16* rowp = O + (size_t)row * ldc + col0;
#pragma unroll
                for (int bj = 0; bj < 2; ++bj) { const f32x4 v0 = acc[ai][bj][m][0] * s, v1 = acc[ai][bj][m][1] * s;
                    u32x4 w; w.x = pk2(v0[0], v0[1]); w.y = pk2(v0[2], v0[3]); w.z = pk2(v1[0], v1[1]); w.w = pk2(v1[2], v1[3]);
                    if (!(pf & 16)) *(u32x4*)(rowp + bj * 128) = w; else asm volatile("" :: "v"(w.x), "v"(w.y), "v"(w.z), "v"(w.w)); } }
    }
};
struct EpiS5U {
    static constexpr bool PERM = true;
    bf16* A2; const float* scale; float k;
    __device__ __forceinline__ void operator()(const f32x4 (&acc)[2][2][4][2], const Unit& u, int wr, int wc, int fr, int fq) const {
        const int row0 = u.r0 + wr * 64 + fr, col0 = u.c0 + wc * 32 + 8 * fq;
        float sv[2][4];
#pragma unroll
        for (int ai = 0; ai < 2; ++ai)
#pragma unroll
            for (int m = 0; m < 4; ++m) sv[ai][m] = scale[row0 + ai * 128 + m * 16];
#pragma unroll
        for (int ai = 0; ai < 2; ++ai)
#pragma unroll
            for (int m = 0; m < 4; ++m) { int zz = 0; asm volatile("" : "+v"(zz)); const int t = row0 + ai * 128 + m * 16 + zz; const float s = sv[ai][m] * k; const int n = t >> 4, tl = t & 15;
#pragma unroll
                for (int bj = 0; bj < 2; ++bj) { const int c = col0 + bj * 128, g = c >> 4, half = (c >> 3) & 1; const f32x4 v0 = acc[ai][bj][m][0] * s, v1 = acc[ai][bj][m][1] * s;
                    u32x4 w; w.x = pk2(v0[0], v0[1]); w.y = pk2(v0[2], v0[3]); w.z = pk2(v1[0], v1[1]); w.w = pk2(v1[2], v1[3]);
                    *(u32x4*)(A2 + ((size_t)g * 2048 + n) * 256 + tl * 16 + half * 8) = w; } }
    }
};
struct EpiOutRes {
    static constexpr bool PERM = true;
    bf16* xb; unsigned char* x8;
    __device__ __forceinline__ void operator()(const f32x4 (&acc)[2][2][4][2], const Unit& u, int wr, int wc, int fr, int fq) const {
        const int row0 = u.r0 + wr * 64 + fr, col0 = u.c0 + wc * 32 + 8 * fq;
        u32x4 xr[2][4][2];
#pragma unroll
        for (int ai = 0; ai < 2; ++ai)
#pragma unroll
            for (int m = 0; m < 4; ++m)
#pragma unroll
                for (int bj = 0; bj < 2; ++bj) xr[ai][m][bj] = *(const u32x4*)(xb + (size_t)(row0 + ai * 128 + m * 16) * D + col0 + bj * 128);
#pragma unroll
        for (int ai = 0; ai < 2; ++ai)
#pragma unroll
            for (int mp = 0; mp < 2; ++mp) { int zz = 0; asm volatile("" : "+v"(zz));
                u32x2 oq[2][2];
#pragma unroll
                for (int h = 0; h < 2; ++h) { const int m = 2 * mp + h; const size_t off = (size_t)(row0 + ai * 128 + m * 16 + zz) * D + col0;
#pragma unroll
                    for (int bj = 0; bj < 2; ++bj) { const f32x4 a0 = acc[ai][bj][m][0], a1 = acc[ai][bj][m][1]; const u32x4 x = xr[ai][m][bj];
                        const float v0 = bf_lo(x.x) + a0[0], v1 = bf_hi(x.x) + a0[1], v2 = bf_lo(x.y) + a0[2], v3 = bf_hi(x.y) + a0[3], v4 = bf_lo(x.z) + a1[0], v5 = bf_hi(x.z) + a1[1], v6 = bf_lo(x.w) + a1[2], v7 = bf_hi(x.w) + a1[3];
                        u32x4 w; w.x = pk2(v0, v1); w.y = pk2(v2, v3); w.z = pk2(v4, v5); w.w = pk2(v6, v7);
                        *(u32x4*)(xb + off + bj * 128) = w;
                        oq[h][bj].x = pk4_f8(v0 * F8_SX, v1 * F8_SX, v2 * F8_SX, v3 * F8_SX); oq[h][bj].y = pk4_f8(v4 * F8_SX, v5 * F8_SX, v6 * F8_SX, v7 * F8_SX); } }
                const size_t off8 = (size_t)(row0 + ai * 128 + (2 * mp + (fq & 1)) * 16 + zz) * D + u.c0 + wc * 32 + 8 * (fq & 2);
#pragma unroll
                for (int bj = 0; bj < 2; ++bj) { const auto sx = __builtin_amdgcn_permlane16_swap(oq[0][bj].x, oq[1][bj].x, false, false), sy = __builtin_amdgcn_permlane16_swap(oq[0][bj].y, oq[1][bj].y, false, false);
                    u32x4 o; o.x = sx[0]; o.y = sy[0]; o.z = sx[1]; o.w = sy[1]; *(u32x4*)(x8 + off8 + bj * 128) = o; } }
    }
};
struct EpiGlu {
    static constexpr bool PERM = true;
    bf16* xb; unsigned char* x8;
    __device__ __forceinline__ void operator()(const f32x4 (&acc)[2][2][4][2], const Unit& u, int wr, int wc, int fr, int fq) const {
        const int row0 = u.r0 + wr * 64 + fr, col0 = u.c0 + wc * 32 + 8 * fq;
        u32x4 xr[2][4];
#pragma unroll
        for (int ai = 0; ai < 2; ++ai)
#pragma unroll
            for (int m = 0; m < 4; ++m) xr[ai][m] = *(const u32x4*)(xb + (size_t)(row0 + ai * 128 + m * 16) * D + col0);
#pragma unroll
        for (int ai = 0; ai < 2; ++ai)
#pragma unroll
            for (int mp = 0; mp < 2; ++mp) { int zz = 0; asm volatile("" : "+v"(zz));
                u32x2 oq[2];
#pragma unroll
                for (int h = 0; h < 2; ++h) { const int m = 2 * mp + h; const size_t off = (size_t)(row0 + ai * 128 + m * 16 + zz) * D + col0;
                    constexpr float kk = 1.0f / (F8_SY * F8_SW);
                    const f32x4 a0 = acc[ai][0][m][0] * kk, a1 = acc[ai][0][m][1] * kk, g0 = acc[ai][1][m][0] * kk, g1 = acc[ai][1][m][1] * kk; const u32x4 x = xr[ai][m];
                    const float v0 = bf_lo(x.x) + a0[0] * sigmoidf_(g0[0]), v1 = bf_hi(x.x) + a0[1] * sigmoidf_(g0[1]), v2 = bf_lo(x.y) + a0[2] * sigmoidf_(g0[2]), v3 = bf_hi(x.y) + a0[3] * sigmoidf_(g0[3]);
                    const float v4 = bf_lo(x.z) + a1[0] * sigmoidf_(g1[0]), v5 = bf_hi(x.z) + a1[1] * sigmoidf_(g1[1]), v6 = bf_lo(x.w) + a1[2] * sigmoidf_(g1[2]), v7 = bf_hi(x.w) + a1[3] * sigmoidf_(g1[3]);
                    u32x4 w; w.x = pk2(v0, v1); w.y = pk2(v2, v3); w.z = pk2(v4, v5); w.w = pk2(v6, v7);
                    *(u32x4*)(xb + off) = w;
                    oq[h].x = pk4_f8(v0 * F8_SX, v1 * F8_SX, v2 * F8_SX, v3 * F8_SX); oq[h].y = pk4_f8(v4 * F8_SX, v5 * F8_SX, v6 * F8_SX, v7 * F8_SX); }
                const auto sx = __builtin_amdgcn_permlane16_swap(oq[0].x, oq[1].x, false, false), sy = __builtin_amdgcn_permlane16_swap(oq[0].y, oq[1].y, false, false);
                u32x4 o; o.x = sx[0]; o.y = sy[0]; o.z = sx[1]; o.w = sy[1];
                *(u32x4*)(x8 + (size_t)(row0 + ai * 128 + (2 * mp + (fq & 1)) * 16 + zz) * D + u.c0 + wc * 32 + 8 * (fq & 2)) = o; }
    }
};
struct EpiGateUp {
    static constexpr bool PERM = true;
    unsigned char* H; const float* prstd; const float* pga; const float* pgb; volatile LAS unsigned* misc; int pf;
    __device__ __forceinline__ void operator()(const f32x4 (&acc)[2][2][4][2], const Unit& u, int wr, int wc, int fr, int fq) const {
        if (pf & 16) { asm volatile("" :: "v"(acc[0][0][0][0][0]), "v"(acc[1][1][3][1][3])); return; }
        const int rl0 = wr * 64 + fr, col0 = u.c0 + wc * 32 + 8 * fq, cnt = __builtin_amdgcn_readfirstlane((int)misc[MI_CNT + u.aux]);
        const float* pg = (u.c0 < 512) ? pga : pgb;
        float sv[2][4], gv[2][4];
#pragma unroll
        for (int ai = 0; ai < 2; ++ai)
#pragma unroll
            for (int m = 0; m < 4; ++m) { int idx = u.x + rl0 + ai * 128 + m * 16; idx = idx < cnt ? idx : cnt - 1; sv[ai][m] = prstd[(size_t)u.aux * T + idx]; gv[ai][m] = pg[(size_t)u.aux * T + idx]; }
#pragma unroll
        for (int ai = 0; ai < 2; ++ai)
#pragma unroll
            for (int mp = 0; mp < 2; ++mp) { int zz = 0; asm volatile("" : "+v"(zz));
                u32x2 wq[2];
#pragma unroll
                for (int h = 0; h < 2; ++h) { const int m = 2 * mp + h; const float r = sv[ai][m] * (1.0f / (F8_SX * F8_SW)), gt = gv[ai][m] * r * F8_SH;
                    float hv[8];
#pragma unroll
                    for (int n = 0; n < 2; ++n)
#pragma unroll
                        for (int j = 0; j < 4; ++j) hv[n * 4 + j] = siluf_(acc[ai][0][m][n][j] * r) * (acc[ai][1][m][n][j] * gt);
                    wq[h].x = pk4_f8(hv[0], hv[1], hv[2], hv[3]); wq[h].y = pk4_f8(hv[4], hv[5], hv[6], hv[7]); }
                const auto sx = __builtin_amdgcn_permlane16_swap(wq[0].x, wq[1].x, false, false), sy = __builtin_amdgcn_permlane16_swap(wq[0].y, wq[1].y, false, false);
                u32x4 w; w.x = sx[0]; w.y = sy[0]; w.z = sx[1]; w.w = sy[1];
                const int rl = rl0 + ai * 128 + (2 * mp + (fq & 1)) * 16 + zz;
                *(u32x4*)(H + (size_t)(u.r0 + rl) * 1024 + u.c0 + wc * 32 + 8 * (fq & 2)) = w; }
    }
};
struct EpiDownRes {
    static constexpr bool PERM = true;
    bf16* xb; const int* ptok; volatile LAS unsigned* misc; bf16* dst; unsigned char* x8; int pf;
    __device__ __forceinline__ void operator()(const f32x4 (&acc)[2][2][4][2], const Unit& u, int wr, int wc, int fr, int fq) const {
        if (pf & 16) { asm volatile("" :: "v"(acc[0][0][0][0][0]), "v"(acc[1][1][3][1][3])); return; }
        const int rl0 = wr * 64 + fr, col0 = u.c0 + wc * 32 + 8 * fq, cnt = __builtin_amdgcn_readfirstlane((int)misc[MI_CNT + u.aux]);
        int tk[2][4];
#pragma unroll
        for (int ai = 0; ai < 2; ++ai)
#pragma unroll
            for (int m = 0; m < 4; ++m) { const int idx = u.x + rl0 + ai * 128 + m * 16; tk[ai][m] = (idx < cnt) ? ptok[(size_t)u.aux * T + idx] : -1; }
        u32x4 xr[2][4][2];
#pragma unroll
        for (int ai = 0; ai < 2; ++ai)
#pragma unroll
            for (int m = 0; m < 4; ++m)
#pragma unroll
                for (int bj = 0; bj < 2; ++bj) xr[ai][m][bj] = (tk[ai][m] >= 0) ? *(const u32x4*)(xb + (size_t)tk[ai][m] * D + col0 + bj * 128) : (u32x4){0u, 0u, 0u, 0u};
#pragma unroll
        for (int ai = 0; ai < 2; ++ai)
#pragma unroll
            for (int m = 0; m < 4; ++m) { int zz = 0; asm volatile("" : "+v"(zz)); const int tok = tk[ai][m] + zz;
                if (tok >= 0) {
#pragma unroll
                    for (int bj = 0; bj < 2; ++bj) { constexpr float kk = 1.0f / (F8_SH * F8_SWD); const f32x4 a0 = acc[ai][bj][m][0] * kk, a1 = acc[ai][bj][m][1] * kk; const u32x4 x = xr[ai][m][bj];
                        const float v0 = bf_lo(x.x) + a0[0], v1 = bf_hi(x.x) + a0[1], v2 = bf_lo(x.y) + a0[2], v3 = bf_hi(x.y) + a0[3], v4 = bf_lo(x.z) + a1[0], v5 = bf_hi(x.z) + a1[1], v6 = bf_lo(x.w) + a1[2], v7 = bf_hi(x.w) + a1[3];
                        u32x4 w; w.x = pk2(v0, v1); w.y = pk2(v2, v3); w.z = pk2(v4, v5); w.w = pk2(v6, v7);
                        *(u32x4*)(dst + (size_t)tok * D + col0 + bj * 128) = w;
                        if (x8) { u32x2 o; o.x = pk4_f8(v0 * F8_SX, v1 * F8_SX, v2 * F8_SX, v3 * F8_SX); o.y = pk4_f8(v4 * F8_SX, v5 * F8_SX, v6 * F8_SX, v7 * F8_SX);
                            *(u32x2*)(x8 + (size_t)tok * D + col0 + bj * 128) = o; } } } }
    }
};
struct EpiXin {
    static constexpr bool PERM = false;
    float* X;
    __device__ __forceinline__ void operator()(const f32x4 (&acc)[2][2][4][2], const Unit& u, int wr, int wc, int fr, int fq) const {
        const int rl0 = u.r0 + wr * 64 + fr, col0 = wc * 32 + 4 * fq;
#pragma unroll
        for (int ai = 0; ai < 2; ++ai)
#pragma unroll
            for (int m = 0; m < 4; ++m) { int zz = 0; asm volatile("" : "+v"(zz)); float* rowp = X + ((size_t)u.aux * 2048 + rl0 + ai * 128 + m * 16 + zz) * 128 + col0;
#pragma unroll
                for (int n = 0; n < 2; ++n) *(f32x4*)(rowp + n * 16) = acc[ai][0][m][n]; }
    }
};
struct EpiS5Y {
    static constexpr bool PERM = true;
    bf16* Y2;
    __device__ __forceinline__ void operator()(const f32x4 (&acc)[2][2][4][2], const Unit& u, int wr, int wc, int fr, int fq) const {
        const int rl0 = u.r0 + wr * 64 + fr, col0 = wc * 32 + 8 * fq;
#pragma unroll
        for (int ai = 0; ai < 2; ++ai)
#pragma unroll
            for (int m = 0; m < 4; ++m) { int zz = 0; asm volatile("" : "+v"(zz)); const int n = rl0 + ai * 128 + m * 16 + zz;
#pragma unroll
                for (int bj = 0; bj < 2; ++bj) { const int c = col0 + bj * 128, tl = c >> 4, half = (c >> 3) & 1; const f32x4 a0 = acc[ai][bj][m][0], a1 = acc[ai][bj][m][1];
                    u32x4 w; w.x = pk2(gelu_tanh(a0[0]), gelu_tanh(a0[1])); w.y = pk2(gelu_tanh(a0[2]), gelu_tanh(a0[3])); w.z = pk2(gelu_tanh(a1[0]), gelu_tanh(a1[1])); w.w = pk2(gelu_tanh(a1[2]), gelu_tanh(a1[3]));
                    const int tok = n * 16 + tl;
                    *(u32x4*)(Y2 + ((((size_t)(tok >> 8) * 128 + u.aux) * 256) + (tok & 255)) * 16 + half * 8) = w; } }
    }
};

constexpr int ML_QP = 528, ML_KTP = 144;
constexpr int ML_Q = 0, ML_K = 33792, ML_KT = 67584, ML_C = 104448, ML_SC = 138240;
constexpr int ML_P = ML_K, ML_VT = ML_K + 9216, ML_VWT = ML_Q;
constexpr int ML_CW = 141824;
__device__ __forceinline__ unsigned bf_elem(const u32x4& v, int i) { const unsigned w = v[i >> 1]; return (i & 1) ? (w >> 16) : (w & 0xffffu); }
__device__ __forceinline__ void mlstm_unit_fused(Frame& F, int b, int hh, int s, int pf) {
    LAS unsigned char* L = F.lds; LAS float* sc = (LAS float*)(L + ML_SC);
    const int tid = F.tid, lane = F.lane, w = F.wave, l15 = lane & 15, lq = lane >> 4;
    const bf16* P = (const bf16*)(F.ws + WS_P); bf16* Y = (bf16*)(F.ws + ((pf & 8) ? 712 * MiB : WS_Y)); const float* gates = (const float*)(F.ws + WS_GATES); float* sumsq = (float*)(F.ws + ((pf & 8) ? 950 * MiB : WS_SUMSQ));
    const int isk = lane >> 5, e0 = 8 * (lane & 31), cch = (isk ? 1024 : 0) + hh * 256 + e0;
    const float osc = isk ? 0.0625f : 1.0f;
    {
        const float* cwp = F.in(12) + cch; const float* cbp = F.in(13) + cch;
        if (w == 0) {
#pragma unroll
            for (int ih = 0; ih < 2; ++ih) {
#pragma unroll
                for (int j = 0; j < 4; ++j) *(LAS f32x4*)(L + ML_CW + ((ih * 5 + j) * 64 + lane) * 16) = *(const GAS f32x4*)(cwp + j * 2048 + 4 * ih);
                *(LAS f32x4*)(L + ML_CW + ((ih * 5 + 4) * 64 + lane) * 16) = *(const GAS f32x4*)(cbp + 4 * ih); }
        }
    }
    f32x4 cacc[2][4];
#pragma unroll
    for (int q = 0; q < 2; ++q)
#pragma unroll
        for (int dc = 0; dc < 4; ++dc) cacc[q][dc] = (f32x4){0.f, 0.f, 0.f, 0.f};
    for (int idx = tid; idx < 33792 / 16; idx += NT) ((LAS u32x4*)(L + ML_C))[idx] = (u32x4){0u, 0u, 0u, 0u};
    if (tid < 256) sc[512 + tid] = 0.f;
    float m_st = 0.f;
    const int tr = w >> 1, cb2 = 2 * (w & 1);
    const int vj = tid >> 3, vdg = tid & 7;
    u32x4 raw[11];
#pragma unroll
    for (int r = 0; r < 11; ++r) { const int t = 8 * w - 3 + r;
        raw[r] = (t >= 0) ? *(const GAS u32x4*)(P + ((size_t)b * SEQ + t) * PN + 2048 + cch) : (u32x4){0u, 0u, 0u, 0u}; }
    float ipn = 0.f, fpn = 0.f;
    if (w == 0) { ipn = gates[((size_t)b * SEQ + lane) * 8 + hh]; fpn = gates[((size_t)b * SEQ + lane) * 8 + 4 + hh]; }
    __syncthreads();
    for (int ch = 0; ch < 32; ++ch) {
        const int t0 = ch * 64; const size_t row0 = (size_t)b * SEQ + t0;
        const u32x4 vraw = *(const GAS u32x4*)(P + (row0 + vj) * PN + 4096 + hh * 256 + s * 64 + 8 * vdg);
        bf16 ov[4][2];
#pragma unroll
        for (int r = 0; r < 4; ++r) { const size_t prow = (row0 + 16 * tr + 4 * lq + r) * PN + 5120 + hh * 256 + s * 64 + 16 * cb2 + l15; ov[r][0] = P[prow]; ov[r][1] = P[prow + 16]; }
        if (!(pf & 16)) {
            asm volatile("" ::: "memory");
#pragma unroll
            for (int ih = 0; ih < 2; ++ih) {
                const f32x4 cb4 = *(const LAS f32x4*)(L + ML_CW + ((ih * 5 + 4) * 64 + lane) * 16);
                f32x4 cw4[4];
#pragma unroll
                for (int j = 0; j < 4; ++j) cw4[j] = *(const LAS f32x4*)(L + ML_CW + ((ih * 5 + j) * 64 + lane) * 16);
                u32x2 outp[8];
                float xw[3][4];
#pragma unroll
                for (int r = 0; r < 3; ++r) { xw[r][0] = bf_lo(raw[r][2 * ih]); xw[r][1] = bf_hi(raw[r][2 * ih]); xw[r][2] = bf_lo(raw[r][2 * ih + 1]); xw[r][3] = bf_hi(raw[r][2 * ih + 1]); }
#pragma unroll
                for (int r = 0; r < 8; ++r) { float o[4], xc[4];
                    xc[0] = bf_lo(raw[r + 3][2 * ih]); xc[1] = bf_hi(raw[r + 3][2 * ih]); xc[2] = bf_lo(raw[r + 3][2 * ih + 1]); xc[3] = bf_hi(raw[r + 3][2 * ih + 1]);
#pragma unroll
                    for (int i4 = 0; i4 < 4; ++i4) { const float cv = cb4[i4] + cw4[0][i4] * xw[0][i4] + cw4[1][i4] * xw[1][i4] + cw4[2][i4] * xw[2][i4] + cw4[3][i4] * xc[i4]; o[i4] = siluf_(cv) * osc;
                        xw[0][i4] = xw[1][i4]; xw[1][i4] = xw[2][i4]; xw[2][i4] = xc[i4]; }
                    outp[r].x = pk2(o[0], o[1]); outp[r].y = pk2(o[2], o[3]);
                    *(LAS u32x2*)(L + (isk ? ML_K : ML_Q) + (8 * w + r) * ML_QP + (e0 + 4 * ih) * 2) = outp[r]; }
                if (isk) {
#pragma unroll
                    for (int i4 = 0; i4 < 4; ++i4) { u32x4 v;
#define ML_EL(r) ((i4 & 1) ? (outp[r][i4 >> 1] >> 16) : (outp[r][i4 >> 1] & 0xffffu))
                        v.x = ML_EL(0) | (ML_EL(1) << 16); v.y = ML_EL(2) | (ML_EL(3) << 16); v.z = ML_EL(4) | (ML_EL(5) << 16); v.w = ML_EL(6) | (ML_EL(7) << 16);
#undef ML_EL
                        *(LAS u32x4*)(L + ML_KT + (e0 + 4 * ih + i4) * ML_KTP + (8 * w) * 2) = v; }
                }
            }
        }
        asm volatile("" ::: "memory");
        if (ch + 1 < 32) {
#pragma unroll
            for (int r = 0; r < 11; ++r) raw[r] = *(const GAS u32x4*)(P + (row0 + 64 + 8 * w - 3 + r) * PN + 2048 + cch);
        }
        if (w == 0) {
            const float ip = ipn, fp = fpn;
            if (ch + 1 < 32) { ipn = gates[(row0 + 64 + lane) * 8 + hh]; fpn = gates[(row0 + 64 + lane) * 8 + 4 + hh]; }
            const float lf = fminf(fp, 0.f) - __logf(1.0f + __expf(-fabsf(fp)));
            float bc = lf;
#pragma unroll
            for (int o = 1; o < 64; o <<= 1) { const float t = __shfl_up(bc, o); if (lane >= o) bc += t; }
            const float a = ip - bc; float pm = a;
#pragma unroll
            for (int o = 1; o < 64; o <<= 1) { const float t = __shfl_up(pm, o); if (lane >= o) pm = fmaxf(pm, t); }
            const float M = fmaxf(m_st, pm);
            const float M63 = __shfl(M, 63), b63 = __shfl(bc, 63);
            sc[lane] = a; sc[64 + lane] = M; sc[128 + lane] = __expf(m_st - M); sc[192 + lane] = __expf(-(bc + M)); sc[256 + lane] = __expf(a - M63);
            if (lane == 0) sc[768] = __expf(m_st - M63);
            m_st = b63 + M63;
        }
        __syncthreads();
        float pw[2][4] = {{0.f, 0.f, 0.f, 0.f}, {0.f, 0.f, 0.f, 0.f}};
        if (!(pf & 32)) {
            f32x4 s0 = (f32x4){0.f, 0.f, 0.f, 0.f}, s1 = s0;
#pragma unroll
            for (int kk = 0; kk < 8; ++kk) {
                const bf16x8 a = *(const LAS bf16x8*)(L + ML_Q + (16 * tr + l15) * ML_QP + (32 * kk + 8 * lq) * 2);
                const bf16x8 k0 = *(const LAS bf16x8*)(L + ML_K + (16 * cb2 + l15) * ML_QP + (32 * kk + 8 * lq) * 2);
                const bf16x8 k1 = *(const LAS bf16x8*)(L + ML_K + (16 * (cb2 + 1) + l15) * ML_QP + (32 * kk + 8 * lq) * 2);
                s0 = __builtin_amdgcn_mfma_f32_16x16x32_bf16(a, k0, s0, 0, 0, 0); s1 = __builtin_amdgcn_mfma_f32_16x16x32_bf16(a, k1, s1, 0, 0, 0); }
            const int j0 = 16 * cb2 + l15, j1 = j0 + 16; const float a0 = sc[j0], a1 = sc[j1];
#pragma unroll
            for (int r = 0; r < 4; ++r) { const int t = 16 * tr + 4 * lq + r; const float Mt = sc[64 + t];
                pw[0][r] = (j0 <= t) ? s0[r] * __expf(a0 - Mt) : 0.f; pw[1][r] = (j1 <= t) ? s1[r] * __expf(a1 - Mt) : 0.f; }
        }
        __syncthreads();
#pragma unroll
        for (int r = 0; r < 4; ++r) { const int t = 16 * tr + 4 * lq + r;
            *(LAS bf16*)(L + ML_P + t * ML_KTP + (16 * cb2 + l15) * 2) = (bf16)f2bf(pw[0][r]); *(LAS bf16*)(L + ML_P + t * ML_KTP + (16 * cb2 + 16 + l15) * 2) = (bf16)f2bf(pw[1][r]); }
#pragma unroll
        for (int i = 0; i < 8; ++i) *(LAS bf16*)(L + ML_VT + (8 * vdg + i) * ML_KTP + vj * 2) = (bf16)bf_elem(vraw, i);
        __syncthreads();
        {
            const int t = tid >> 3, part = tid & 7;
            const u32x4 pv = *(const LAS u32x4*)(L + ML_P + t * ML_KTP + part * 16);
            float ds = (bf_lo(pv.x) + bf_hi(pv.x)) + (bf_lo(pv.y) + bf_hi(pv.y)) + (bf_lo(pv.z) + bf_hi(pv.z)) + (bf_lo(pv.w) + bf_hi(pv.w));
            float qn = 0.f;
#pragma unroll
            for (int q4 = 0; q4 < 4; ++q4) { const u32x4 qv = *(const LAS u32x4*)(L + ML_Q + t * ML_QP + part * 64 + q4 * 16);
                const f32x4 n0 = *(const LAS f32x4*)(sc + 512 + part * 32 + q4 * 8), n1 = *(const LAS f32x4*)(sc + 512 + part * 32 + q4 * 8 + 4);
                qn += bf_lo(qv.x) * n0[0] + bf_hi(qv.x) * n0[1] + bf_lo(qv.y) * n0[2] + bf_hi(qv.y) * n0[3] + bf_lo(qv.z) * n1[0] + bf_hi(qv.z) * n1[1] + bf_lo(qv.w) * n1[2] + bf_hi(qv.w) * n1[3]; }
#pragma unroll
            for (int o = 1; o < 8; o <<= 1) { ds += __shfl_xor(ds, o); qn += __shfl_xor(qn, o); }
            if (part == 0) sc[320 + t] = ds + sc[128 + t] * qn;
        }
        f32x4 pv0 = (f32x4){0.f, 0.f, 0.f, 0.f}, pv1 = pv0, qc0 = pv0, qc1 = pv0;
        if (!(pf & 64)) {
#pragma unroll
        for (int kk = 0; kk < 2; ++kk) {
            const bf16x8 a = *(const LAS bf16x8*)(L + ML_P + (16 * tr + l15) * ML_KTP + (32 * kk + 8 * lq) * 2);
            const bf16x8 v0 = *(const LAS bf16x8*)(L + ML_VT + (16 * cb2 + l15) * ML_KTP + (32 * kk + 8 * lq) * 2);
            const bf16x8 v1 = *(const LAS bf16x8*)(L + ML_VT + (16 * (cb2 + 1) + l15) * ML_KTP + (32 * kk + 8 * lq) * 2);
            pv0 = __builtin_amdgcn_mfma_f32_16x16x32_bf16(a, v0, pv0, 0, 0, 0); pv1 = __builtin_amdgcn_mfma_f32_16x16x32_bf16(a, v1, pv1, 0, 0, 0); }
#pragma unroll
        for (int kk = 0; kk < 8; ++kk) {
            const bf16x8 a = *(const LAS bf16x8*)(L + ML_Q + (16 * tr + l15) * ML_QP + (32 * kk + 8 * lq) * 2);
            const bf16x8 c0 = *(const LAS bf16x8*)(L + ML_C + (16 * cb2 + l15) * ML_QP + (32 * kk + 8 * lq) * 2);
            const bf16x8 c1 = *(const LAS bf16x8*)(L + ML_C + (16 * (cb2 + 1) + l15) * ML_QP + (32 * kk + 8 * lq) * 2);
            qc0 = __builtin_amdgcn_mfma_f32_16x16x32_bf16(a, c0, qc0, 0, 0, 0); qc1 = __builtin_amdgcn_mfma_f32_16x16x32_bf16(a, c1, qc1, 0, 0, 0); }
        }
        __syncthreads();
        if (!(pf & 64)) {
#pragma unroll
            for (int r = 0; r < 4; ++r) { const int t = 16 * tr + 4 * lq + r; const float wi = sc[128 + t], dn = fmaxf(fabsf(sc[320 + t]), sc[192 + t]); const float inv = __builtin_amdgcn_rcpf(dn);
                const size_t yrow = (row0 + t) * (Y3P / 2) + 512 + hh * 256 + s * 64;
                const int d0 = 16 * cb2 + l15, d1 = d0 + 16;
                const float h0 = (pv0[r] + wi * qc0[r]) * inv * sigmoidf_(bf2f(ov[r][0])), h1 = (pv1[r] + wi * qc1[r]) * inv * sigmoidf_(bf2f(ov[r][1]));
                Y[yrow + d0] = (bf16)f2bf(h0); Y[yrow + d1] = (bf16)f2bf(h1);
                float q = h0 * h0 + h1 * h1;
#pragma unroll
                for (int o = 1; o < 16; o <<= 1) q += __shfl_xor(q, o);
                if (l15 == 0) sc[384 + (w & 1) * 64 + t] = q; }
        }
        const float decay = sc[768];
        {
            const float we = sc[256 + vj];
#pragma unroll
            for (int i = 0; i < 8; ++i) *(LAS bf16*)(L + ML_VWT + (8 * vdg + i) * ML_KTP + vj * 2) = (bf16)f2bf(__builtin_bit_cast(float, bf_elem(vraw, i) << 16) * we);
            if (tid < 256) { float a = 0.f;
#pragma unroll
                for (int j8 = 0; j8 < 8; ++j8) { const u32x4 kv = *(const LAS u32x4*)(L + ML_KT + tid * ML_KTP + j8 * 16); const f32x4 w0 = *(const LAS f32x4*)(sc + 256 + j8 * 8), w1 = *(const LAS f32x4*)(sc + 256 + j8 * 8 + 4);
                    a += bf_lo(kv.x) * w0[0] + bf_hi(kv.x) * w0[1] + bf_lo(kv.y) * w0[2] + bf_hi(kv.y) * w0[3] + bf_lo(kv.z) * w1[0] + bf_hi(kv.z) * w1[1] + bf_lo(kv.w) * w1[2] + bf_hi(kv.w) * w1[3]; }
                sc[512 + tid] = decay * sc[512 + tid] + a; }
#pragma unroll
            for (int q = 0; q < 2; ++q)
#pragma unroll
                for (int dc = 0; dc < 4; ++dc) cacc[q][dc] *= decay;
        }
        __syncthreads();
        if (tid < 64) sumsq[(row0 + tid) * 16 + hh * 4 + s] = sc[384 + tid] + sc[448 + tid];
        if (!(pf & 128)) {
#pragma unroll
        for (int kk = 0; kk < 2; ++kk) {
            bf16x8 aE[2], bD[4];
#pragma unroll
            for (int q = 0; q < 2; ++q) aE[q] = *(const LAS bf16x8*)(L + ML_KT + (16 * (2 * w + q) + l15) * ML_KTP + (32 * kk + 8 * lq) * 2);
#pragma unroll
            for (int dc = 0; dc < 4; ++dc) bD[dc] = *(const LAS bf16x8*)(L + ML_VWT + (16 * dc + l15) * ML_KTP + (32 * kk + 8 * lq) * 2);
#pragma unroll
            for (int q = 0; q < 2; ++q)
#pragma unroll
                for (int dc = 0; dc < 4; ++dc) cacc[q][dc] = __builtin_amdgcn_mfma_f32_16x16x32_bf16(aE[q], bD[dc], cacc[q][dc], 0, 0, 0); }
#pragma unroll
        for (int q = 0; q < 2; ++q)
#pragma unroll
            for (int dc = 0; dc < 4; ++dc) { u32x2 wv; wv.x = pk2(cacc[q][dc][0], cacc[q][dc][1]); wv.y = pk2(cacc[q][dc][2], cacc[q][dc][3]);
                *(LAS u32x2*)(L + ML_C + (16 * dc + l15) * ML_QP + (16 * (2 * w + q) + 4 * lq) * 2) = wv; }
        }
        __syncthreads();
    }
}

constexpr int MA_Q = 0, MA_K = 33792, MA_KT = 67584, MA_P = 104448, MA_SC = 113664;
__device__ __forceinline__ void mlstm_pre(Frame& F, int b, int hh, int oct) {
    LAS unsigned char* L = F.lds; LAS float* sc = (LAS float*)(L + MA_SC);
    int tid_ = F.tid; asm volatile("" : "+v"(tid_));
    const int tid = tid_, lane = tid & 63, w = F.wave, l15 = lane & 15, lq = lane >> 4;
    const bf16* P = (const bf16*)(F.ws + WS_P); const float* gates = (const float*)(F.ws + WS_GATES);
    u32x4* QA = (u32x4*)(F.ws + WS_MQ); u32x4* KTA = (u32x4*)(F.ws + WS_MKT); u32x4* PA = (u32x4*)(F.ws + WS_MP); float* PS = (float*)(F.ws + WS_MPS); float* SCA = (float*)(F.ws + WS_MSC);
    const int isk = lane >> 5, e0 = 8 * (lane & 31), cch = (isk ? 1024 : 0) + hh * 256 + e0;
    const float osc = isk ? 0.0625f : 1.0f;
    {
        const float* cwp = F.in(12) + cch; const float* cbp = F.in(13) + cch;
        if (w == 0) {
#pragma unroll
            for (int ih = 0; ih < 2; ++ih) {
#pragma unroll
                for (int j = 0; j < 4; ++j) *(LAS f32x4*)(L + ML_CW + ((ih * 5 + j) * 64 + lane) * 16) = *(const GAS f32x4*)(cwp + j * 2048 + 4 * ih);
                *(LAS f32x4*)(L + ML_CW + ((ih * 5 + 4) * 64 + lane) * 16) = *(const GAS f32x4*)(cbp + 4 * ih); }
        }
    }
    const int tr = w >> 1, cb2 = 2 * (w & 1);
    const int tbase = oct * 512;
    u32x4 raw[11];
#pragma unroll
    for (int r = 0; r < 11; ++r) { const int t = tbase + 8 * w - 3 + r;
        raw[r] = (t >= 0) ? *(const GAS u32x4*)(P + ((size_t)b * SEQ + t) * PN + 2048 + cch) : (u32x4){0u, 0u, 0u, 0u}; }
    float ipn = 0.f, fpn = 0.f;
    if (w == 0) { ipn = gates[((size_t)b * SEQ + tbase + lane) * 8 + hh]; fpn = gates[((size_t)b * SEQ + tbase + lane) * 8 + 4 + hh]; }
    LAS float* sm = sc + 256;
    {
        float ipe[3], fpe[3];
#pragma unroll
        for (int k = 0; k < 3; ++k) { ipe[k] = 0.f; fpe[k] = 0.f; if (k < oct) { const size_t row = (size_t)b * SEQ + (8 * k + w) * 64 + lane; ipe[k] = gates[row * 8 + hh]; fpe[k] = gates[row * 8 + 4 + hh]; } }
#pragma unroll
        for (int k = 0; k < 3; ++k) if (k < oct) {
            const float lf = fminf(fpe[k], 0.f) - __logf(1.0f + __expf(-fabsf(fpe[k])));
            float bc = lf;
#pragma unroll
            for (int o = 1; o < 64; o <<= 1) { const float t = __shfl_up(bc, o); if (lane >= o) bc += t; }
            float pm = ipe[k] - bc;
#pragma unroll
            for (int o = 1; o < 64; o <<= 1) { const float t = __shfl_up(pm, o); if (lane >= o) pm = fmaxf(pm, t); }
            if (lane == 63) { sm[(8 * k + w) * 2] = bc; sm[(8 * k + w) * 2 + 1] = pm; } }
    }
    __syncthreads();
    float m_st = 0.f;
    if (w == 0) for (int cc = 0; cc < 8 * oct; ++cc) m_st = sm[cc * 2] + fmaxf(m_st, sm[cc * 2 + 1]);
    for (int c8 = 0; c8 < 8; ++c8) {
        const int ch = oct * 8 + c8, t0 = ch * 64; const size_t row0 = (size_t)b * SEQ + t0; const size_t u = (size_t)(b * 4 + hh) * 32 + ch;
        {
            asm volatile("" ::: "memory");
#pragma unroll
            for (int ih = 0; ih < 2; ++ih) {
                const f32x4 cb4 = *(const LAS f32x4*)(L + ML_CW + ((ih * 5 + 4) * 64 + lane) * 16);
                f32x4 cw4[4];
#pragma unroll
                for (int j = 0; j < 4; ++j) cw4[j] = *(const LAS f32x4*)(L + ML_CW + ((ih * 5 + j) * 64 + lane) * 16);
                u32x2 outp[8];
                float xw[3][4];
#pragma unroll
                for (int r = 0; r < 3; ++r) { xw[r][0] = bf_lo(raw[r][2 * ih]); xw[r][1] = bf_hi(raw[r][2 * ih]); xw[r][2] = bf_lo(raw[r][2 * ih + 1]); xw[r][3] = bf_hi(raw[r][2 * ih + 1]); }
#pragma unroll
                for (int r = 0; r < 8; ++r) { float o[4], xc[4];
                    xc[0] = bf_lo(raw[r + 3][2 * ih]); xc[1] = bf_hi(raw[r + 3][2 * ih]); xc[2] = bf_lo(raw[r + 3][2 * ih + 1]); xc[3] = bf_hi(raw[r + 3][2 * ih + 1]);
#pragma unroll
                    for (int i4 = 0; i4 < 4; ++i4) { const float cv = cb4[i4] + cw4[0][i4] * xw[0][i4] + cw4[1][i4] * xw[1][i4] + cw4[2][i4] * xw[2][i4] + cw4[3][i4] * xc[i4]; o[i4] = siluf_(cv) * osc;
                        xw[0][i4] = xw[1][i4]; xw[1][i4] = xw[2][i4]; xw[2][i4] = xc[i4]; }
                    outp[r].x = pk2(o[0], o[1]); outp[r].y = pk2(o[2], o[3]);
                    *(LAS u32x2*)(L + (isk ? MA_K : MA_Q) + (8 * w + r) * ML_QP + (e0 + 4 * ih) * 2) = outp[r]; }
                if (isk) {
#pragma unroll
                    for (int i4 = 0; i4 < 4; ++i4) { u32x4 v;
#define ML_EL(r) ((i4 & 1) ? (outp[r][i4 >> 1] >> 16) : (outp[r][i4 >> 1] & 0xffffu))
                        v.x = ML_EL(0) | (ML_EL(1) << 16); v.y = ML_EL(2) | (ML_EL(3) << 16); v.z = ML_EL(4) | (ML_EL(5) << 16); v.w = ML_EL(6) | (ML_EL(7) << 16);
#undef ML_EL
                        *(LAS u32x4*)(L + MA_KT + (e0 + 4 * ih + i4) * ML_KTP + (8 * w) * 2) = v; }
                }
            }
        }
        asm volatile("" ::: "memory");
        if (c8 + 1 < 8) {
#pragma unroll
            for (int r = 0; r < 11; ++r) raw[r] = *(const GAS u32x4*)(P + (row0 + 64 + 8 * w - 3 + r) * PN + 2048 + cch);
        }
        if (w == 0) {
            const float ip = ipn, fp = fpn;
            if (c8 + 1 < 8) { ipn = gates[(row0 + 64 + lane) * 8 + hh]; fpn = gates[(row0 + 64 + lane) * 8 + 4 + hh]; }
            const float lf = fminf(fp, 0.f) - __logf(1.0f + __expf(-fabsf(fp)));
            float bc = lf;
#pragma unroll
            for (int o = 1; o < 64; o <<= 1) { const float t = __shfl_up(bc, o); if (lane >= o) bc += t; }
            const float a = ip - bc; float pm = a;
#pragma unroll
            for (int o = 1; o < 64; o <<= 1) { const float t = __shfl_up(pm, o); if (lane >= o) pm = fmaxf(pm, t); }
            const float M = fmaxf(m_st, pm);
            const float M63 = __shfl(M, 63), b63 = __shfl(bc, 63);
            sc[lane] = a; sc[64 + lane] = M;
            float* so = SCA + u * 256;
            so[lane] = __expf(m_st - M); so[64 + lane] = __expf(-(bc + M)); so[128 + lane] = __expf(a - M63);
            if (lane == 0) so[192] = __expf(m_st - M63);
            m_st = b63 + M63;
        }
        __syncthreads();
        float pw[2][4];
        {
            f32x4 s0 = (f32x4){0.f, 0.f, 0.f, 0.f}, s1 = s0;
#pragma unroll
            for (int kk = 0; kk < 8; ++kk) {
                const bf16x8 a = *(const LAS bf16x8*)(L + MA_Q + (16 * tr + l15) * ML_QP + (32 * kk + 8 * lq) * 2);
                const bf16x8 k0 = *(const LAS bf16x8*)(L + MA_K + (16 * cb2 + l15) * ML_QP + (32 * kk + 8 * lq) * 2);
                const bf16x8 k1 = *(const LAS bf16x8*)(L + MA_K + (16 * (cb2 + 1) + l15) * ML_QP + (32 * kk + 8 * lq) * 2);
                s0 = __builtin_amdgcn_mfma_f32_16x16x32_bf16(a, k0, s0, 0, 0, 0); s1 = __builtin_amdgcn_mfma_f32_16x16x32_bf16(a, k1, s1, 0, 0, 0); }
            const int j0 = 16 * cb2 + l15, j1 = j0 + 16; const float a0 = sc[j0], a1 = sc[j1];
#pragma unroll
            for (int r = 0; r < 4; ++r) { const int t = 16 * tr + 4 * lq + r; const float Mt = sc[64 + t];
                pw[0][r] = (j0 <= t) ? s0[r] * __expf(a0 - Mt) : 0.f; pw[1][r] = (j1 <= t) ? s1[r] * __expf(a1 - Mt) : 0.f; }
        }
#pragma unroll
        for (int r = 0; r < 4; ++r) { const int t = 16 * tr + 4 * lq + r;
            *(LAS bf16*)(L + MA_P + t * ML_KTP + (16 * cb2 + l15) * 2) = (bf16)f2bf(pw[0][r]); *(LAS bf16*)(L + MA_P + t * ML_KTP + (16 * cb2 + 16 + l15) * 2) = (bf16)f2bf(pw[1][r]); }
#pragma unroll
        for (int i = 0; i < 4; ++i) { const int p = tid + NT * i;
            QA[u * 2048 + p] = *(const LAS u32x4*)(L + MA_Q + (p >> 5) * ML_QP + (p & 31) * 16);
            KTA[u * 2048 + p] = *(const LAS u32x4*)(L + MA_KT + (p >> 3) * ML_KTP + (p & 7) * 16); }
        __syncthreads();
        { const u32x4 pv = *(const LAS u32x4*)(L + MA_P + (tid >> 3) * ML_KTP + (tid & 7) * 16);
            PA[u * 512 + tid] = pv;
            float ds = (bf_lo(pv.x) + bf_hi(pv.x)) + (bf_lo(pv.y) + bf_hi(pv.y)) + (bf_lo(pv.z) + bf_hi(pv.z)) + (bf_lo(pv.w) + bf_hi(pv.w));
#pragma unroll
            for (int o = 1; o < 8; o <<= 1) ds += __shfl_xor(ds, o);
            if ((tid & 7) == 0) PS[u * 64 + (tid >> 3)] = ds; }
    }
    __syncthreads();
}
__device__ __forceinline__ void mlstm_unit(Frame& F, int b, int hh, int s, int pf) {
    LAS unsigned char* L = F.lds; LAS float* sc = (LAS float*)(L + ML_SC);
    int tid_ = F.tid; asm volatile("" : "+v"(tid_));
    const int tid = tid_, lane = tid & 63, w = F.wave, l15 = lane & 15, lq = lane >> 4;
    const bf16* P = (const bf16*)(F.ws + WS_P); bf16* Y = (bf16*)(F.ws + WS_Y); float* sumsq = (float*)(F.ws + WS_SUMSQ); const float* SCA = (const float*)(F.ws + WS_MSC);
    const u32x4* QA = (const u32x4*)(F.ws + WS_MQ); const u32x4* KTA = (const u32x4*)(F.ws + WS_MKT); const u32x4* PA = (const u32x4*)(F.ws + WS_MP); const float* PS = (const float*)(F.ws + WS_MPS);
    f32x4 cacc[2][4];
#pragma unroll
    for (int q = 0; q < 2; ++q)
#pragma unroll
        for (int dc = 0; dc < 4; ++dc) cacc[q][dc] = (f32x4){0.f, 0.f, 0.f, 0.f};
    for (int idx = tid; idx < 33792 / 16; idx += NT) ((LAS u32x4*)(L + ML_C))[idx] = (u32x4){0u, 0u, 0u, 0u};
    if (tid < 256) sc[512 + tid] = 0.f;
    const int tr = w >> 1, cb2 = 2 * (w & 1);
    const int vj = tid >> 3, vdg = tid & 7;
    const size_t u0 = (size_t)(b * 4 + hh) * 32;
    u32x4 qreg[4], kreg[4], preg; float psv, scv = 0.f;
#pragma unroll
    for (int i = 0; i < 4; ++i) { qreg[i] = QA[u0 * 2048 + tid + NT * i]; kreg[i] = KTA[u0 * 2048 + tid + NT * i]; }
    preg = PA[u0 * 512 + tid]; psv = PS[u0 * 64 + (tid >> 3)]; if (tid < 193) scv = SCA[u0 * 256 + tid];
    __syncthreads();
    for (int ch = 0; ch < 32; ++ch) {
        const int t0 = ch * 64; const size_t row0 = (size_t)b * SEQ + t0;
        const u32x4 vraw = *(const GAS u32x4*)(P + (row0 + vj) * PN + 4096 + hh * 256 + s * 64 + 8 * vdg);
        bf16 ov[4][2];
#pragma unroll
        for (int r = 0; r < 4; ++r) { const size_t prow = (row0 + 16 * tr + 4 * lq + r) * PN + 5120 + hh * 256 + s * 64 + 16 * cb2 + l15; ov[r][0] = P[prow]; ov[r][1] = P[prow + 16]; }
#pragma unroll
        for (int i = 0; i < 4; ++i) { const int p = tid + NT * i;
            *(LAS u32x4*)(L + ML_Q + (p >> 5) * ML_QP + (p & 31) * 16) = qreg[i];
            *(LAS u32x4*)(L + ML_KT + (p >> 3) * ML_KTP + (p & 7) * 16) = kreg[i]; }
        *(LAS u32x4*)(L + ML_P + (tid >> 3) * ML_KTP + (tid & 7) * 16) = preg;
        const float psum = psv;
        if (tid < 192) sc[128 + tid] = scv; else if (tid == 192) sc[768] = scv;
        asm volatile("" ::: "memory");
        if (ch + 1 < 32) { const size_t un = u0 + ch + 1;
#pragma unroll
            for (int i = 0; i < 4; ++i) { qreg[i] = QA[un * 2048 + tid + NT * i]; kreg[i] = KTA[un * 2048 + tid + NT * i]; }
            preg = PA[un * 512 + tid]; psv = PS[un * 64 + (tid >> 3)]; if (tid < 193) scv = SCA[un * 256 + tid]; }
#pragma unroll
        for (int i = 0; i < 8; ++i) *(LAS bf16*)(L + ML_VT + (8 * vdg + i) * ML_KTP + vj * 2) = (bf16)bf_elem(vraw, i);
        __syncthreads();
        {
            const int t = tid >> 3, part = tid & 7;
            float qn = 0.f;
#pragma unroll
            for (int q4 = 0; q4 < 4; ++q4) { const u32x4 qv = *(const LAS u32x4*)(L + ML_Q + t * ML_QP + part * 64 + q4 * 16);
                const f32x4 n0 = *(const LAS f32x4*)(sc + 512 + part * 32 + q4 * 8), n1 = *(const LAS f32x4*)(sc + 512 + part * 32 + q4 * 8 + 4);
                qn += bf_lo(qv.x) * n0[0] + bf_hi(qv.x) * n0[1] + bf_lo(qv.y) * n0[2] + bf_hi(qv.y) * n0[3] + bf_lo(qv.z) * n1[0] + bf_hi(qv.z) * n1[1] + bf_lo(qv.w) * n1[2] + bf_hi(qv.w) * n1[3]; }
#pragma unroll
            for (int o = 1; o < 8; o <<= 1) qn += __shfl_xor(qn, o);
            if (part == 0) sc[320 + t] = psum + sc[128 + t] * qn;
        }
        f32x4 pv0 = (f32x4){0.f, 0.f, 0.f, 0.f}, pv1 = pv0, qc0 = pv0, qc1 = pv0;
#pragma unroll
        for (int kk = 0; kk < 2; ++kk) {
            const bf16x8 a = *(const LAS bf16x8*)(L + ML_P + (16 * tr + l15) * ML_KTP + (32 * kk + 8 * lq) * 2);
            const bf16x8 v0 = *(const LAS bf16x8*)(L + ML_VT + (16 * cb2 + l15) * ML_KTP + (32 * kk + 8 * lq) * 2);
            const bf16x8 v1 = *(const LAS bf16x8*)(L + ML_VT + (16 * (cb2 + 1) + l15) * ML_KTP + (32 * kk + 8 * lq) * 2);
            pv0 = __builtin_amdgcn_mfma_f32_16x16x32_bf16(a, v0, pv0, 0, 0, 0); pv1 = __builtin_amdgcn_mfma_f32_16x16x32_bf16(a, v1, pv1, 0, 0, 0); }
#pragma unroll
        for (int kk = 0; kk < 8; ++kk) {
            const bf16x8 a = *(const LAS bf16x8*)(L + ML_Q + (16 * tr + l15) * ML_QP + (32 * kk + 8 * lq) * 2);
            const bf16x8 c0 = *(const LAS bf16x8*)(L + ML_C + (16 * cb2 + l15) * ML_QP + (32 * kk + 8 * lq) * 2);
            const bf16x8 c1 = *(const LAS bf16x8*)(L + ML_C + (16 * (cb2 + 1) + l15) * ML_QP + (32 * kk + 8 * lq) * 2);
            qc0 = __builtin_amdgcn_mfma_f32_16x16x32_bf16(a, c0, qc0, 0, 0, 0); qc1 = __builtin_amdgcn_mfma_f32_16x16x32_bf16(a, c1, qc1, 0, 0, 0); }
        __syncthreads();
#pragma unroll
        for (int r = 0; r < 4; ++r) { const int t = 16 * tr + 4 * lq + r; const float wi = sc[128 + t], dn = fmaxf(fabsf(sc[320 + t]), sc[192 + t]); const float inv = __builtin_amdgcn_rcpf(dn);
            const size_t yrow = (row0 + t) * (Y3P / 2) + 512 + hh * 256 + s * 64;
            const int d0 = 16 * cb2 + l15, d1 = d0 + 16;
            const float h0 = (pv0[r] + wi * qc0[r]) * inv * sigmoidf_(bf2f(ov[r][0])), h1 = (pv1[r] + wi * qc1[r]) * inv * sigmoidf_(bf2f(ov[r][1]));
            Y[yrow + d0] = (bf16)f2bf(h0); Y[yrow + d1] = (bf16)f2bf(h1);
            float q = h0 * h0 + h1 * h1;
#pragma unroll
            for (int o = 1; o < 16; o <<= 1) q += __shfl_xor(q, o);
            if (l15 == 0) sc[384 + (w & 1) * 64 + t] = q; }
        const float decay = sc[768];
        {
            const float we = sc[256 + vj];
#pragma unroll
            for (int i = 0; i < 8; ++i) *(LAS bf16*)(L + ML_VWT + (8 * vdg + i) * ML_KTP + vj * 2) = (bf16)f2bf(__builtin_bit_cast(float, bf_elem(vraw, i) << 16) * we);
            if (tid < 256) { float a = 0.f;
#pragma unroll
                for (int j8 = 0; j8 < 8; ++j8) { const u32x4 kv = *(const LAS u32x4*)(L + ML_KT + tid * ML_KTP + j8 * 16); const f32x4 w0 = *(const LAS f32x4*)(sc + 256 + j8 * 8), w1 = *(const LAS f32x4*)(sc + 256 + j8 * 8 + 4);
                    a += bf_lo(kv.x) * w0[0] + bf_hi(kv.x) * w0[1] + bf_lo(kv.y) * w0[2] + bf_hi(kv.y) * w0[3] + bf_lo(kv.z) * w1[0] + bf_hi(kv.z) * w1[1] + bf_lo(kv.w) * w1[2] + bf_hi(kv.w) * w1[3]; }
                sc[512 + tid] = decay * sc[512 + tid] + a; }
#pragma unroll
            for (int q = 0; q < 2; ++q)
#pragma unroll
                for (int dc = 0; dc < 4; ++dc) cacc[q][dc] *= decay;
        }
        __syncthreads();
        if (tid < 64) sumsq[(row0 + tid) * 16 + hh * 4 + s] = sc[384 + tid] + sc[448 + tid];
#pragma unroll
        for (int kk = 0; kk < 2; ++kk) {
            bf16x8 aE[2], bD[4];
#pragma unroll
            for (int q = 0; q < 2; ++q) aE[q] = *(const LAS bf16x8*)(L + ML_KT + (16 * (2 * w + q) + l15) * ML_KTP + (32 * kk + 8 * lq) * 2);
#pragma unroll
            for (int dc = 0; dc < 4; ++dc) bD[dc] = *(const LAS bf16x8*)(L + ML_VWT + (16 * dc + l15) * ML_KTP + (32 * kk + 8 * lq) * 2);
#pragma unroll
            for (int q = 0; q < 2; ++q)
#pragma unroll
                for (int dc = 0; dc < 4; ++dc) cacc[q][dc] = __builtin_amdgcn_mfma_f32_16x16x32_bf16(aE[q], bD[dc], cacc[q][dc], 0, 0, 0); }
#pragma unroll
        for (int q = 0; q < 2; ++q)
#pragma unroll
            for (int dc = 0; dc < 4; ++dc) { u32x2 wv; wv.x = pk2(cacc[q][dc][0], cacc[q][dc][1]); wv.y = pk2(cacc[q][dc][2], cacc[q][dc][3]);
                *(LAS u32x2*)(L + ML_C + (16 * dc + l15) * ML_QP + (16 * (2 * w + q) + 4 * lq) * 2) = wv; }
        __syncthreads();
    }
}

constexpr int LR_XP = 272, LR_TT = 128;
constexpr int LR_XC = 0, LR_W = 34816, LR_A = 69632, LR_G = 102912, LR_SEG = 136192, LR_CARRY = 140288, LR_CWT = 140544;
__device__ __forceinline__ void lru_unit(Frame& F, int b, int n, int jh) {
    LAS unsigned char* L = F.lds;
    LAS float* Aa = (LAS float*)(L + LR_A); LAS float* Ga = (LAS float*)(L + LR_G); LAS float* seg = (LAS float*)(L + LR_SEG); LAS float* carry = (LAS float*)(L + LR_CARRY);
    const int tid = F.tid, lane = F.lane, w = F.wave, l15 = lane & 15, lq = lane >> 4;
    const bf16* P = (const bf16*)(F.ws + WS_P); unsigned char* Y8a = F.ws + WS_Y; const bf16* LW = (const bf16*)(F.ws + WS_LRUW) + (size_t)n * 256 * 128;
    for (int pc = tid; pc < 2048; pc += NT) { const int orow = pc >> 4, c16 = pc & 15; const int src = (orow < 64) ? (jh * 64 + orow) : (128 + jh * 64 + (orow - 64));
        *(LAS u32x4*)(L + LR_W + orow * LR_XP + c16 * 16) = *(const GAS u32x4*)(LW + (size_t)src * 128 + c16 * 8); }
    const int cgx = tid & 15, rgx = tid >> 4, cch = n * 128 + 8 * cgx;
    if (tid < 16) {
        const float* cwp_ = F.in(5) + cch; const float* cbp_ = F.in(6) + cch;
#pragma unroll
        for (int j = 0; j < 4; ++j) { *(LAS f32x4*)(L + LR_CWT + (cgx * 5 + j) * 32) = *(const GAS f32x4*)(cwp_ + j * 1024); *(LAS f32x4*)(L + LR_CWT + (cgx * 5 + j) * 32 + 16) = *(const GAS f32x4*)(cwp_ + j * 1024 + 4); }
        *(LAS f32x4*)(L + LR_CWT + (cgx * 5 + 4) * 32) = *(const GAS f32x4*)cbp_; *(LAS f32x4*)(L + LR_CWT + (cgx * 5 + 4) * 32 + 16) = *(const GAS f32x4*)(cbp_ + 4);
    }
    const int trb = 2 * (w >> 1), ocb = 2 * (w & 1);
    float ba[2], bx[2], sp[2];
    const float* pba_ = F.in(8); const float* pbx_ = F.in(10); const float* plam_ = F.in(11);
#pragma unroll
    for (int q = 0; q < 2; ++q) { const int chq = n * 128 + jh * 64 + 16 * (ocb + q) + l15; ba[q] = pba_[chq]; bx[q] = pbx_[chq]; const float nl = -plam_[chq]; sp[q] = fmaxf(nl, 0.f) + log1pf(expf(-fabsf(nl))); }
    const int ch_s = n * 128 + jh * 64 + lane;
    if (tid < 64) carry[tid] = 0.f;
    u32x4 raw[7];
#pragma unroll
    for (int r = 0; r < 7; ++r) { const int t = 4 * rgx - 3 + r; raw[r] = (t >= 0) ? *(const GAS u32x4*)(P + ((size_t)b * SEQ + t) * PN + cch) : (u32x4){0u, 0u, 0u, 0u}; }
    __syncthreads();
    for (int tile = 0; tile < SEQ / LR_TT; ++tile) {
        const int t0 = tile * LR_TT; const size_t row0 = (size_t)b * SEQ + t0;
        bf16 zv[16];
#pragma unroll
        for (int i = 0; i < 16; ++i) zv[i] = P[(row0 + 16 * w + i) * PN + 1024 + ch_s];
        {
            float cw[4][8], cb[8];
#pragma unroll
            for (int j = 0; j < 5; ++j) { const f32x4 c0 = *(const LAS f32x4*)(L + LR_CWT + (cgx * 5 + j) * 32), c1 = *(const LAS f32x4*)(L + LR_CWT + (cgx * 5 + j) * 32 + 16);
#pragma unroll
                for (int i = 0; i < 4; ++i) { if (j < 4) { cw[j < 4 ? j : 0][i] = c0[i]; cw[j < 4 ? j : 0][4 + i] = c1[i]; } else { cb[i] = c0[i]; cb[4 + i] = c1[i]; } } }
#pragma unroll
            for (int r = 0; r < 4; ++r) { float o[8];
#pragma unroll
                for (int i = 0; i < 8; ++i) { const int wd = i >> 1; float x0, x1, x2, x3;
                    if (i & 1) { x0 = bf_hi(raw[r][wd]); x1 = bf_hi(raw[r + 1][wd]); x2 = bf_hi(raw[r + 2][wd]); x3 = bf_hi(raw[r + 3][wd]); }
                    else { x0 = bf_lo(raw[r][wd]); x1 = bf_lo(raw[r + 1][wd]); x2 = bf_lo(raw[r + 2][wd]); x3 = bf_lo(raw[r + 3][wd]); }
                    o[i] = cb[i] + cw[0][i] * x0 + cw[1][i] * x1 + cw[2][i] * x2 + cw[3][i] * x3; }
                u32x4 ov; ov.x = pk2(o[0], o[1]); ov.y = pk2(o[2], o[3]); ov.z = pk2(o[4], o[5]); ov.w = pk2(o[6], o[7]);
                *(LAS u32x4*)(L + LR_XC + (4 * rgx + r) * LR_XP + cgx * 16) = ov; }
            asm volatile("" ::: "memory");
            if (tile + 1 < SEQ / LR_TT) {
#pragma unroll
                for (int r = 0; r < 7; ++r) raw[r] = *(const GAS u32x4*)(P + (row0 + LR_TT + 4 * rgx - 3 + r) * PN + cch);
            }
        }
        __syncthreads();
        {
            f32x4 ga[2][2], gx[2][2];
#pragma unroll
            for (int rt = 0; rt < 2; ++rt)
#pragma unroll
                for (int q = 0; q < 2; ++q) { ga[rt][q] = (f32x4){0.f, 0.f, 0.f, 0.f}; gx[rt][q] = ga[rt][q]; }
#pragma unroll
            for (int kk = 0; kk < 4; ++kk) { bf16x8 a[2], wa[2], wx[2];
#pragma unroll
                for (int rt = 0; rt < 2; ++rt) a[rt] = *(const LAS bf16x8*)(L + LR_XC + (16 * (trb + rt) + l15) * LR_XP + (32 * kk + 8 * lq) * 2);
#pragma unroll
                for (int q = 0; q < 2; ++q) { wa[q] = *(const LAS bf16x8*)(L + LR_W + (16 * (ocb + q) + l15) * LR_XP + (32 * kk + 8 * lq) * 2);
                    wx[q] = *(const LAS bf16x8*)(L + LR_W + (64 + 16 * (ocb + q) + l15) * LR_XP + (32 * kk + 8 * lq) * 2); }
#pragma unroll
                for (int rt = 0; rt < 2; ++rt)
#pragma unroll
                    for (int q = 0; q < 2; ++q) { ga[rt][q] = __builtin_amdgcn_mfma_f32_16x16x32_bf16(a[rt], wa[q], ga[rt][q], 0, 0, 0); gx[rt][q] = __builtin_amdgcn_mfma_f32_16x16x32_bf16(a[rt], wx[q], gx[rt][q], 0, 0, 0); } }
#pragma unroll
            for (int rt = 0; rt < 2; ++rt)
#pragma unroll
                for (int q = 0; q < 2; ++q)
#pragma unroll
                    for (int r = 0; r < 4; ++r) { const int t = 16 * (trb + rt) + 4 * lq + r, jo = 16 * (ocb + q) + l15;
                        const float rg = sigmoidf_(ga[rt][q][r] + ba[q]), ig = sigmoidf_(gx[rt][q][r] + bx[q]); const float la = -8.0f * rg * sp[q];
                        const float xf = bf2f(*(const LAS bf16*)(L + LR_XC + t * LR_XP + (jh * 64 + jo) * 2));
                        const float av = __expf(la); Aa[t * 65 + jo] = av; Ga[t * 65 + jo] = __builtin_amdgcn_sqrtf(fmaxf(1.0f - av * av, 0.f)) * (ig * xf); }
        }
        __syncthreads();
        {
            float Ap = 1.f, H = 0.f;
#pragma unroll
            for (int i = 0; i < 16; ++i) { const float a = Aa[(16 * w + i) * 65 + lane], g = Ga[(16 * w + i) * 65 + lane]; H = a * H + g; Ap *= a; }
            seg[(w * 64 + lane) * 2] = Ap; seg[(w * 64 + lane) * 2 + 1] = H;
        }
        __syncthreads();
        float h = carry[lane];
        for (int s2 = 0; s2 < w; ++s2) h = seg[(s2 * 64 + lane) * 2] * h + seg[(s2 * 64 + lane) * 2 + 1];
        float yv[16];
#pragma unroll
        for (int i = 0; i < 16; ++i) { const int t = 16 * w + i; h = Aa[t * 65 + lane] * h + Ga[t * 65 + lane]; yv[i] = h * gelu_tanh(bf2f(zv[i])) * F8_SYA; }
#pragma unroll
        for (int g4 = 0; g4 < 4; ++g4) {
            const unsigned x0 = pk4_f8(yv[4 * g4], yv[4 * g4 + 1], yv[4 * g4 + 2], yv[4 * g4 + 3]);
            const unsigned y0 = (unsigned)__builtin_amdgcn_update_dpp(0, (int)x0, 0x4E, 0xf, 0xf, false);
            const unsigned x1 = (lane & 2) ? ((y0 >> 16) | (x0 & 0xffff0000u)) : ((x0 & 0xffffu) | (y0 << 16));
            const unsigned y1 = (unsigned)__builtin_amdgcn_update_dpp(0, (int)x1, 0xB1, 0xf, 0xf, false);
            const unsigned ow = (lane & 1) ? (((y1 >> 8) & 0xffu) | (x1 & 0xff00u) | ((y1 >> 8) & 0xff0000u) | (x1 & 0xff000000u))
                                           : ((x1 & 0xffu) | ((y1 & 0xffu) << 8) | (x1 & 0xff0000u) | ((y1 & 0xff0000u) << 8));
            const int t = 16 * w + 4 * g4 + (lane & 3);
            *(GAS unsigned*)(Y8a + (row0 + t) * Y3P + n * 128 + jh * 64 + (lane & 60)) = ow; }
        __syncthreads();
        if (w == 7) carry[lane] = h;
    }
    __syncthreads();
}

__device__ __forceinline__ void ph_headnorm(Frame& F) {
    bf16* Y = (bf16*)(F.ws + WS_Y); const float* sumsq = (const float*)(F.ws + WS_SUMSQ); const float* hg = F.in(16);
    const int gt = F.vcu * NT + F.tid, NGT = F.G * NT;
    for (int idx = gt; idx < T * 128; idx += NGT) { const int t = idx >> 7, c8 = idx & 127, hh = c8 >> 5;
        const f32x4 ss = *(const f32x4*)(sumsq + (size_t)t * 16 + hh * 4); const float rstd = 1.0f / sqrtf(((ss[0] + ss[1]) + (ss[2] + ss[3])) * (1.0f / 256.0f) + EPS);
        bf16* p = Y + (size_t)t * (Y3P / 2) + 512 + c8 * 8; const u32x4 v = *(const u32x4*)p; const f32x4 g0 = *(const f32x4*)(hg + c8 * 8), g1 = *(const f32x4*)(hg + c8 * 8 + 4);
        u32x4 o; o.x = pk2(bf_lo(v.x) * rstd * g0[0], bf_hi(v.x) * rstd * g0[1]); o.y = pk2(bf_lo(v.y) * rstd * g0[2], bf_hi(v.y) * rstd * g0[3]);
        o.z = pk2(bf_lo(v.z) * rstd * g1[0], bf_hi(v.z) * rstd * g1[1]); o.w = pk2(bf_lo(v.w) * rstd * g1[2], bf_hi(v.w) * rstd * g1[3]);
        *(u32x4*)p = o; }
}

constexpr int RT_ROWS = 128;
__device__ __forceinline__ void ph_router(Frame& F, int l, bool dummy) {
    LAS float* lg = (LAS float*)(F.lds);
    LAS float* info = (LAS float*)(F.lds + 20480);
    LAS unsigned* lcnt = (LAS unsigned*)(F.lds + 28672);
    const int tid = F.tid, lane = F.lane, w = F.wave, l15 = lane & 15, lq = lane >> 4;
    const bf16* x1 = (const bf16*)(F.ws + WS_XB); const bf16* WH = (const bf16*)(F.ws + WS_RW) + (size_t)(l * 2) * 32 * 2048; const bf16* WL = WH + (size_t)32 * 2048;
    const float* bcs = F.in(30) + l * 4; const float* bfn = F.in(32) + l * 16;
    const size_t doff = dummy ? (size_t)200 * MiB : 0; const int cw = dummy ? 20480 : CW_CNT + l * 32 * 64;
    int* ptok = (int*)(F.ws + WS_PTOK + doff); float* prstd = (float*)(F.ws + WS_PRSTD + doff); float* pga = (float*)(F.ws + WS_PGA + doff); float* pgb = (float*)(F.ws + WS_PGB + doff);
    for (int base = F.vcu * RT_ROWS; base < T; base += F.G * RT_ROWS) {
        if (tid < 32) lcnt[tid] = 0u;
        {
            const bf16* xr = x1 + (size_t)(base + 16 * w + l15) * D + 8 * lq;
            const bf16* wh0 = WH + (size_t)l15 * 2048 + 8 * lq; const bf16* wh1 = WH + (size_t)(16 + l15) * 2048 + 8 * lq;
            const bf16* wl0 = WL + (size_t)l15 * 2048 + 8 * lq; const bf16* wl1 = WL + (size_t)(16 + l15) * 2048 + 8 * lq;
            f32x4 acc0 = (f32x4){0.f, 0.f, 0.f, 0.f}, acc1 = acc0; float ss = 0.f;
#pragma unroll 4
            for (int ks = 0; ks < 64; ++ks) {
                const bf16x8 a = *(const GAS bf16x8*)(xr + 32 * ks);
                const bf16x8 h0 = *(const GAS bf16x8*)(wh0 + 32 * ks), h1 = *(const GAS bf16x8*)(wh1 + 32 * ks), o0 = *(const GAS bf16x8*)(wl0 + 32 * ks), o1 = *(const GAS bf16x8*)(wl1 + 32 * ks);
                acc0 = __builtin_amdgcn_mfma_f32_16x16x32_bf16(a, h0, acc0, 0, 0, 0); acc1 = __builtin_amdgcn_mfma_f32_16x16x32_bf16(a, h1, acc1, 0, 0, 0);
                acc0 = __builtin_amdgcn_mfma_f32_16x16x32_bf16(a, o0, acc0, 0, 0, 0); acc1 = __builtin_amdgcn_mfma_f32_16x16x32_bf16(a, o1, acc1, 0, 0, 0);
                const u32x4 au = __builtin_bit_cast(u32x4, a);
                ss += (bf_lo(au.x) * bf_lo(au.x) + bf_hi(au.x) * bf_hi(au.x)) + (bf_lo(au.y) * bf_lo(au.y) + bf_hi(au.y) * bf_hi(au.y)) + (bf_lo(au.z) * bf_lo(au.z) + bf_hi(au.z) * bf_hi(au.z)) + (bf_lo(au.w) * bf_lo(au.w) + bf_hi(au.w) * bf_hi(au.w)); }
            ss += __shfl_xor(ss, 16); ss += __shfl_xor(ss, 32);
#pragma unroll
            for (int r = 0; r < 4; ++r) { lg[(16 * w + 4 * lq + r) * 33 + l15] = acc0[r]; lg[(16 * w + 4 * lq + r) * 33 + 16 + l15] = acc1[r]; }
            if (lq == 0) lg[(16 * w + l15) * 33 + 32] = ss;
        }
        __syncthreads();
        if (tid < RT_ROWS) {
            const LAS float* lr = lg + tid * 33;
            const float rstd = 1.0f / sqrtf(lr[32] * (1.0f / D) + EPS);
            float lc[4], lf[16];
#pragma unroll
            for (int c = 0; c < 4; ++c) lc[c] = lr[c] * rstd + bcs[c];
#pragma unroll
            for (int c = 0; c < 16; ++c) lf[c] = lr[4 + c] * rstd + bfn[c];
            int gi = 0; float gm = lc[0];
#pragma unroll
            for (int c = 1; c < 4; ++c) if (lc[c] > gm) { gm = lc[c]; gi = c; }
            float se = 0.f;
#pragma unroll
            for (int c = 0; c < 4; ++c) se += expf(lc[c] - gm);
            const float pg = 1.0f / se;
            float fs[4];
#pragma unroll
            for (int c = 0; c < 4; ++c) fs[c] = (gi == 0) ? lf[c] : (gi == 1) ? lf[4 + c] : (gi == 2) ? lf[8 + c] : lf[12 + c];
            int i0 = 0; float v0 = fs[0];
#pragma unroll
            for (int c = 1; c < 4; ++c) if (fs[c] > v0) { v0 = fs[c]; i0 = c; }
            int i1 = -1; float v1 = 0.f;
#pragma unroll
            for (int c = 0; c < 4; ++c) if (c != i0 && (i1 < 0 || fs[c] > v1)) { v1 = fs[c]; i1 = c; }
            const float e1 = expf(v1 - v0), s0 = 1.0f / (1.0f + e1), w0g = s0 * pg, w1g = (e1 * s0) * pg;
            const int ia = i0 < i1 ? i0 : i1, ib = i0 < i1 ? i1 : i0, pidx = (ia == 0) ? ib - 1 : (ia == 1) ? ib + 1 : 5, q = gi * 6 + pidx;
            LAS float* ip = info + tid * 8; ip[0] = __builtin_bit_cast(float, q); ip[1] = (i0 < i1) ? w0g : w1g; ip[2] = (i0 < i1) ? w1g : w0g; ip[3] = rstd;
            ip[4] = __builtin_bit_cast(float, __hip_atomic_fetch_add(&lcnt[q], 1u, __ATOMIC_RELAXED, __HIP_MEMORY_SCOPE_WORKGROUP));
        }
        __syncthreads();
        if (tid < NPAIR) lcnt[32 + tid] = __hip_atomic_fetch_add((unsigned*)(F.ctl + cw + tid * 64), lcnt[tid], RLX_AGENT);
        __syncthreads();
        if (tid < RT_ROWS) { LAS float* ip = info + tid * 8; const int row = base + tid; const int q = __builtin_bit_cast(int, ip[0]);
            const size_t p = (size_t)q * T + lcnt[32 + q] + __builtin_bit_cast(unsigned, ip[4]);
            ptok[p] = row; pga[p] = ip[1]; pgb[p] = ip[2]; prstd[p] = ip[3]; }
        __syncthreads();
    }
}
__device__ __forceinline__ void moe_table(Frame& F, int l) {
    if (F.tid == 0) { unsigned pre = 0u;
        for (int q = 0; q < NPAIR; ++q) { const unsigned c = ld_agent_u32((const unsigned*)(F.ctl + CW_CNT + (l * 32 + q) * 64)); F.MISC[MI_CNT + q] = c; F.MISC[MI_PRE + q] = pre; pre += (c + 255u) >> 8; }
        F.MISC[MI_PRE + NPAIR] = pre; }
    __syncthreads();
}
__device__ __forceinline__ void ph_rowpass(Frame& F, int l, bool dummy) {
    const int lane = (int)__builtin_amdgcn_mbcnt_hi(~0u, __builtin_amdgcn_mbcnt_lo(~0u, 0u));
    const int gw = F.vcu * NWAVES + F.wave, NGW = F.G * NWAVES;
    const bf16* xb = (const bf16*)(F.ws + WS_XB); float* rstd_o = (float*)(F.ws + WS_RSTD);
    const float* gfin = F.in(3);
    for (int m0 = 2 * gw; m0 < T; m0 += 2 * NGW) {
        u32x4 x[2][4];
#pragma unroll
        for (int q = 0; q < 2; ++q) { const GAS u32x4* xr = (const GAS u32x4*)(xb + (size_t)(m0 + q) * D) + lane;
#pragma unroll
            for (int j = 0; j < 4; ++j) x[q][j] = (l == 1) ? __builtin_nontemporal_load(&xr[64 * j]) : xr[64 * j]; }
#pragma unroll
        for (int q = 0; q < 2; ++q) { const int m = m0 + q; float ss = 0.f;
#pragma unroll
            for (int j = 0; j < 4; ++j) { const u32x4 w = x[q][j];
                ss += ((bf_lo(w.x) * bf_lo(w.x) + bf_hi(w.x) * bf_hi(w.x)) + (bf_lo(w.y) * bf_lo(w.y) + bf_hi(w.y) * bf_hi(w.y))) + ((bf_lo(w.z) * bf_lo(w.z) + bf_hi(w.z) * bf_hi(w.z)) + (bf_lo(w.w) * bf_lo(w.w) + bf_hi(w.w) * bf_hi(w.w))); }
            ss = wave_sum(ss); const float rstd = 1.0f / sqrtf(ss * (1.0f / D) + EPS);
            if (l == 0) { if (lane == 0) (dummy ? (float*)(F.ws + 950 * MiB) : rstd_o)[m] = rstd;
                GAS u32x2* o8 = (GAS u32x2*)(F.ws + (dummy ? 776 * MiB : WS_X8) + (size_t)m * D) + lane;
#pragma unroll
                for (int j = 0; j < 4; ++j) { const u32x4 w = x[q][j]; u32x2 o; o.x = pk4_f8(bf_lo(w.x) * F8_SX, bf_hi(w.x) * F8_SX, bf_lo(w.y) * F8_SX, bf_hi(w.y) * F8_SX); o.y = pk4_f8(bf_lo(w.z) * F8_SX, bf_hi(w.z) * F8_SX, bf_lo(w.w) * F8_SX, bf_hi(w.w) * F8_SX); o8[64 * j] = o; } }
            else {
                GAS f32x4* xw = dummy ? (GAS f32x4*)((float*)(F.ws + WS_Y) + (size_t)(m & 16383) * D) + 2 * lane : (GAS f32x4*)(F.outp() + (size_t)m * D) + 2 * lane;
#pragma unroll
                for (int j = 0; j < 4; ++j) { const u32x4 w = x[q][j]; const f32x4 g0 = *((const f32x4*)gfin + 2 * lane + 128 * j), g1 = *((const f32x4*)gfin + 2 * lane + 128 * j + 1);
                    f32x4 o0, o1; o0.x = bf_lo(w.x) * rstd * g0.x; o0.y = bf_hi(w.x) * rstd * g0.y; o0.z = bf_lo(w.y) * rstd * g0.z; o0.w = bf_hi(w.y) * rstd * g0.w;
                    o1.x = bf_lo(w.z) * rstd * g1.x; o1.y = bf_hi(w.z) * rstd * g1.y; o1.z = bf_lo(w.w) * rstd * g1.z; o1.w = bf_hi(w.w) * rstd * g1.w;
                    __builtin_nontemporal_store(o0, &xw[128 * j]); __builtin_nontemporal_store(o1, &xw[128 * j + 1]); }
            }
        }
    }
}
constexpr int S5_UP = 528, S5_XP = 272, S5_U = 0, S5_X = 67584, S5_T = 106496;
__device__ __forceinline__ void cmul_add(float ar, float ai, float br, float bi, float cr, float ci, float& orr, float& oi) { orr = ar * br - ai * bi + cr; oi = ar * bi + ai * br + ci; }
__device__ __forceinline__ void ph_s5core(Frame& F, int pf) {
    LAS unsigned char* L = F.lds;
    const int tid = F.tid, lane = F.lane, w = F.wave, l15 = lane & 15, lq = lane >> 4;
    const bf16* A2 = (const bf16*)(F.ws + WS_A2); unsigned char* Y8 = F.ws + ((pf & 8) ? 776 * MiB : WS_Y);
    const int urow = tid >> 2, uq = tid & 3;
    u32x4 ust[8];
    const int upc = (2048 + F.G - 1) / F.G;
    const int L0 = F.vcu * upc, Lend = (L0 + upc < 2048) ? L0 + upc : 2048;
    const int uoff = urow * 256 + uq * 64;
    if (L0 < 2048) { const bf16* src = A2 + (size_t)__builtin_amdgcn_readfirstlane(((L0 >> 4) * 2048 + (L0 & 15) * 128) * 256) + uoff;
#pragma unroll
        for (int i = 0; i < 8; ++i) ust[i] = *(const GAS u32x4*)(src + i * 8); }
    for (int Lu = L0; Lu < Lend; ++Lu) {
        const int g = __builtin_amdgcn_readfirstlane(Lu >> 4), b = __builtin_amdgcn_readfirstlane(Lu & 15);
        const bf16* Wi = (const bf16*)(F.ws + WS_S5WIN) + (size_t)g * 128 * 256; const bf16* KB = (const bf16*)(F.ws + WS_S5K) + (size_t)g * 4096; const bf16* Wo = (const bf16*)(F.ws + WS_S5WO) + (size_t)g * 256 * 128;
        int zq = 0; asm volatile("" : "+v"(zq)); const int l15z = l15 + zq, lqz = lq + zq;
#define S5_WFRAG(mt_, ks_) (((ks_) < 8) ? (((2 * w + (mt_)) - (2 * (ks_) + (lqz >> 1)) >= 0) ? *(const GAS bf16x8*)(KB + (((2 * w + (mt_)) - (2 * (ks_) + (lqz >> 1))) * 16 + l15z) * 16 + 8 * (lqz & 1)) : (bf16x8){0, 0, 0, 0, 0, 0, 0, 0}) \
                                        : *(const GAS bf16x8*)(Wo + (size_t)(16 * (2 * w + (mt_)) + l15z) * 128 + 32 * ((ks_) - 8) + 8 * lqz))
#pragma unroll
        for (int i = 0; i < 8; ++i) *(LAS u32x4*)(L + S5_U + urow * S5_UP + (uq * 64 + i * 8) * 2) = ust[i];
        bf16x8 wb[8];
#pragma unroll
        for (int ks = 0; ks < 8; ++ks) wb[ks] = *(const GAS bf16x8*)(Wi + (16 * w + l15z) * 256 + 32 * ks + 8 * lqz);
        const f32x4 lam = *(const GAS f32x4*)((const float*)(F.ws + WS_LAM) + ((size_t)g * 64 + 8 * w + (l15 & 7)) * 4);
        __syncthreads();
        f32x4 X[8];
#pragma unroll
        for (int rt = 0; rt < 8; ++rt) X[rt] = (f32x4){0.f, 0.f, 0.f, 0.f};
        if (!(pf & 64)) {
#pragma unroll
        for (int ks = 0; ks < 8; ++ks) {
#pragma unroll
            for (int rt = 0; rt < 8; ++rt) { const bf16x8 a = *(const LAS bf16x8*)(L + S5_U + (16 * rt + l15) * S5_UP + (32 * ks + 8 * lq) * 2);
                X[rt] = __builtin_amdgcn_mfma_f32_16x16x32_bf16(a, wb[ks], X[rt], 0, 0, 0); } }
        }
        bf16x8 wa[2][4];
#pragma unroll
        for (int mt = 0; mt < 2; ++mt)
#pragma unroll
            for (int k4 = 0; k4 < 4; ++k4) wa[mt][k4] = S5_WFRAG(mt, k4);
        if (!(pf & 16)) {
            const bool isim = (l15 & 8) != 0;
#define S5_XRI(rt_, r_) const float mine_ = X[rt_][r_], oth_ = __builtin_bit_cast(float, __builtin_amdgcn_update_dpp(0, __builtin_bit_cast(int, mine_), 0x128  , 0xf, 0xf, false)); \
            const float xr_ = isim ? oth_ : mine_, xi_ = isim ? mine_ : oth_
            LAS unsigned char* tb = L + S5_T + w * 4096;
#pragma unroll
            for (int rt = 0; rt < 8; ++rt) { float ar = 0.f, ai = 0.f;
#pragma unroll
                for (int r = 0; r < 4; ++r) { S5_XRI(rt, r); float nr, ni; cmul_add(lam[0], lam[1], ar, ai, xr_, xi_, nr, ni); ar = nr; ai = ni; }
                *(LAS f32x2*)(tb + ((rt * 16 + l15) * 4 + lq) * 8) = (f32x2){ar, ai}; }
            asm volatile("s_waitcnt lgkmcnt(0)" ::: "memory");
            float cr = 0.f, ci = 0.f;
#pragma unroll
            for (int rt = 0; rt < 8; ++rt) {
                const f32x4 t0 = *(const LAS f32x4*)(tb + (rt * 16 + l15) * 32), t1 = *(const LAS f32x4*)(tb + (rt * 16 + l15) * 32 + 16);
                float ar = 0.f, ai = 0.f;
#pragma unroll
                for (int o = 0; o < 4; ++o) { if (lq == o) { ar = cr; ai = ci; }
                    const float tr_ = (o == 0) ? t0[0] : (o == 1) ? t0[2] : (o == 2) ? t1[0] : t1[2], ti_ = (o == 0) ? t0[1] : (o == 1) ? t0[3] : (o == 2) ? t1[1] : t1[3];
                    float nr, ni; cmul_add(lam[2], lam[3], cr, ci, tr_, ti_, nr, ni); cr = nr; ci = ni; }
#pragma unroll
                for (int r = 0; r < 4; ++r) { *(LAS bf16*)(L + S5_X + (16 * rt + 4 * lq + r) * S5_XP + (16 * w + l15) * 2) = (bf16)f2bf(isim ? ai : ar);
                    S5_XRI(rt, r); float nr, ni; cmul_add(lam[0], lam[1], ar, ai, xr_, xi_, nr, ni); ar = nr; ai = ni; } }
#undef S5_XRI
        }
        { const int Ln = Lu + 1; if (Ln < Lend) { const bf16* src = A2 + (size_t)__builtin_amdgcn_readfirstlane(((Ln >> 4) * 2048 + (Ln & 15) * 128) * 256) + uoff;
#pragma unroll
            for (int i = 0; i < 8; ++i) ust[i] = *(const GAS u32x4*)(src + i * 8); } }
        __syncthreads();
        f32x4 acc[2][8];
#pragma unroll
        for (int mt = 0; mt < 2; ++mt)
#pragma unroll
            for (int nt = 0; nt < 8; ++nt) acc[mt][nt] = (f32x4){0.f, 0.f, 0.f, 0.f};
        if (!(pf & 32)) {
#pragma unroll
        for (int kb = 0; kb < 3; ++kb) {
            bf16x8 wnx[2][4];
            if (kb < 2) {
#pragma unroll
                for (int mt = 0; mt < 2; ++mt)
#pragma unroll
                    for (int k4 = 0; k4 < 4; ++k4) wnx[mt][k4] = S5_WFRAG(mt, 4 * (kb + 1) + k4);
            }
#pragma unroll
            for (int k4 = 0; k4 < 4; ++k4) { const int ks = 4 * kb + k4;
                if (ks >= 8 || ks <= w) {
#pragma unroll
                for (int nt = 0; nt < 8; ++nt) {
                    const bf16x8 bv = (ks < 8) ? *(const LAS bf16x8*)(L + S5_U + (16 * nt + l15) * S5_UP + (32 * ks + 8 * lq) * 2)
                                               : *(const LAS bf16x8*)(L + S5_X + (16 * nt + l15) * S5_XP + (32 * (ks - 8) + 8 * lq) * 2);
                    acc[0][nt] = __builtin_amdgcn_mfma_f32_16x16x32_bf16(wa[0][k4], bv, acc[0][nt], 0, 0, 0);
                    acc[1][nt] = __builtin_amdgcn_mfma_f32_16x16x32_bf16(wa[1][k4], bv, acc[1][nt], 0, 0, 0); } } }
            if (kb < 2) {
#pragma unroll
                for (int mt = 0; mt < 2; ++mt)
#pragma unroll
                    for (int k4 = 0; k4 < 4; ++k4) wa[mt][k4] = wnx[mt][k4];
            }
        }
        }
#pragma unroll
        for (int mt = 0; mt < 2; ++mt)
#pragma unroll
            for (int k = 0; k < 2; ++k) { unsigned r[4];
#pragma unroll
                for (int i = 0; i < 4; ++i) { const f32x4 a = acc[mt][4 * k + i]; r[i] = pk4_f8_mm(gelu_tanh(a[0]) * F8_SY, gelu_tanh(a[1]) * F8_SY, gelu_tanh(a[2]) * F8_SY, gelu_tanh(a[3]) * F8_SY); }
                { const auto s02 = __builtin_amdgcn_permlane32_swap(r[0], r[2], false, false); r[0] = s02[0]; r[2] = s02[1]; const auto s13 = __builtin_amdgcn_permlane32_swap(r[1], r[3], false, false); r[1] = s13[0]; r[3] = s13[1]; }
                { const auto s01 = __builtin_amdgcn_permlane16_swap(r[0], r[1], false, false); r[0] = s01[0]; r[1] = s01[1]; const auto s23 = __builtin_amdgcn_permlane16_swap(r[2], r[3], false, false); r[2] = s23[0]; r[3] = s23[1]; }
                const int nt = 4 * k + lq, tok = (b * 128 + 16 * nt + l15) * 16 + 2 * w + mt;
                u32x4 o; o.x = r[0]; o.y = r[1]; o.z = r[2]; o.w = r[3];
                if (!(pf & 256)) *(GAS u32x4*)(Y8 + ((((size_t)(tok >> 8) * 64 + (g >> 1)) * 256) + (tok & 255)) * 32 + (g & 1) * 16) = o; else asm volatile("" :: "v"(o.x), "v"(o.y), "v"(o.z), "v"(o.w)); }
        __syncthreads();
    }
}

struct Args { const float* in[36]; float* out; unsigned char* ws; int ph_lo, ph_hi; };
__global__ void __launch_bounds__(NT, 2) fwd(Args args) {
    extern __shared__ __attribute__((aligned(16))) unsigned char lds[];
    Frame F;
    F.lds = (LAS unsigned char*)lds;
    F.MISC = (volatile LAS unsigned*)(F.lds + MISC_OFF);
    F.tid = threadIdx.x; F.lane = F.tid & 63; F.wave = __builtin_amdgcn_readfirstlane(F.tid >> 6);
    F.G = gridDim.x; { const int bx = blockIdx.x; F.vcu = (F.G % 8 == 0) ? (bx % 8) * (F.G / 8) + bx / 8 : bx; }
    F.ws = args.ws; F.ctl = (gu32*)(args.ws + WS_CTL);
    if (F.tid < 64) F.MISC[F.tid] = 0u;
    if (F.tid == 100) { const unsigned long long pv = (unsigned long long)args.out; F.MISC[200] = (unsigned)pv; F.MISC[201] = (unsigned)(pv >> 32); }
    if (F.tid >= 64 && F.tid < 100) { const unsigned long long pv = (unsigned long long)args.in[F.tid - 64]; F.MISC[64 + 2 * (F.tid - 64)] = (unsigned)pv; F.MISC[65 + 2 * (F.tid - 64)] = (unsigned)(pv >> 32); }
    __syncthreads();
    XcdBarrier bar; bar.bar = (unsigned*)(F.ctl + CW_BAR); bar.x = 0; bar.st = nullptr;
    if (!MK_PER_PHASE) bar = xcd_barrier_post((unsigned*)(F.ctl + CW_BAR), F.MISC + 8);
    const int lo = args.ph_lo & 255, hi = args.ph_hi, pflags = MK_PER_PHASE ? (args.ph_lo >> 8) : 0;
#ifndef PHMASK
#define PHMASK 0x3ffff
#endif
#define IN(k) ((((PHMASK) >> (k)) & 1) && lo <= (k) && (k) < hi)
#ifdef DOUBLE_BAR
#define SEAM(k) do { if (!MK_PER_PHASE && IN(k) && IN((k) + 1)) { xcd_barrier(bar); xcd_barrier(bar); } } while (0)
#else
#define SEAM(k) do { if (!MK_PER_PHASE && IN(k) && IN((k) + 1)) xcd_barrier(bar); } while (0)
#endif
    unsigned char* ws = args.ws;
    bf16* XB = (bf16*)(ws + WS_XB); bf16* Pb = (bf16*)(ws + WS_P); bf16* Yb = (bf16*)(ws + WS_Y); float* RSTD = (float*)(ws + WS_RSTD);
    const int bx = (int)blockIdx.x;

    if (IN(0)) { ph_prologue(F, pflags); }
    SEAM(0);
#ifndef P1_WGM
#define P1_WGM 8
#endif
    if (IN(1)) {
        pg8::GemmP g{nullptr, 2048, 4096u, 32u, 4096u};
#ifdef P1_STAGGER
        {
            const unsigned long long t0 = __builtin_amdgcn_s_memrealtime(), dl = (unsigned long long)((bx >> 3) & 3) * (P1_STAGGER * 100ull);
            while (__builtin_amdgcn_s_memrealtime() - t0 < dl) __builtin_amdgcn_s_sleep(8);
        }
#endif
#ifdef P1_SPLIT3
#pragma unroll
        for (int j3 = 0; j3 < 3; ++j3) {
            DenseSched S; S.to.init(T / 256, 8, F.G, bx, P1_WGM); S.A = (const char*)XB; S.tstepA = (size_t)256 * 4096; S.B0 = (const char*)(ws + WS_WIN) + (size_t)j3 * 2048 * 4096; S.B1 = S.B0 + (size_t)128 * 4096; S.tstepB = (size_t)256 * 4096; S.cpt = 256;
            EpiScaleBf16 E{Pb + j3 * 2048, PN, RSTD, pflags, 1.0f};
            pg8::gemm_phase<EpiScaleBf16, DenseSched, false>(F.lds, g, S, E); }
#else
        {
            pg8::GemmP g8{nullptr, 1024, 2048u, 32u, 2048u};
            DenseSched S; S.to.init(T / 256, 8, F.G, bx, P1_WGM); S.A = (const char*)(ws + WS_X8IN); S.tstepA = (size_t)256 * 2048; S.B0 = (const char*)(ws + WS_WIN); S.B1 = S.B0 + (size_t)128 * 2048; S.tstepB = (size_t)256 * 2048; S.cpt = 256;
            EpiScaleBf16 E{Pb, PN, RSTD, pflags, 1.0f / (F8_SX * F8_SW)};
            pg8::gemm_phase<EpiScaleBf16, DenseSched, false, false, true>(F.lds, g8, S, E); }
        {
            DenseSched S; S.to.init(T / 256, 16, F.G, bx, P1_WGM); S.A = (const char*)XB; S.tstepA = (size_t)256 * 4096; S.B0 = (const char*)(ws + WS_WIN) + (size_t)2048 * 4096; S.B1 = S.B0 + (size_t)128 * 4096; S.tstepB = (size_t)256 * 4096; S.cpt = 256;
            EpiScaleBf16 E{Pb + 2048, PN, RSTD, pflags, 1.0f};
            pg8::gemm_phase<EpiScaleBf16, DenseSched, false>(F.lds, g, S, E); }
#endif
    }
    SEAM(1);
    if (IN(2)) {
#ifndef NO_MLSTM
        if (!(pflags & 1)) for (int u = F.vcu; u < 256; u += F.G) mlstm_pre(F, u >> 4, (u >> 2) & 3, u & 3);
#endif
#ifndef NO_LRU
        if (!(pflags & 2)) for (int u = F.vcu; u < 256; u += F.G) lru_unit(F, u >> 4, (u >> 1) & 7, u & 1);
#endif
    }
    SEAM(2);
    if (IN(3)) {
#ifndef NO_MLSTM
        for (int u = F.vcu; u < 256; u += F.G) mlstm_unit(F, u >> 4, (u >> 2) & 3, u & 3, pflags);
#endif
    }
    SEAM(3);
    if (IN(4)) { ph_headnorm(F); }
    SEAM(4);
    if (IN(5)) {
        pg8::GemmP g{nullptr, 24 * 64, (unsigned)Y3P, 32u, (unsigned)Y3P, 8};
        DenseSched S; S.to.init(T / 256, D / 256, F.G, bx); S.A = (const char*)Yb; S.tstepA = (size_t)256 * Y3P; S.B0 = (const char*)(ws + WS_WOUT); S.B1 = S.B0 + (size_t)128 * Y3P; S.tstepB = (size_t)256 * Y3P; S.cpt = 256;
        EpiOutRes E{XB, ws + WS_X8};
        pg8::gemm_phase<EpiOutRes, DenseSched, false, false, true, true>(F.lds, g, S, E);
    }
    SEAM(5);
#define MOE_LAYER(PH, l, WSW) \
    if (IN(PH)) { ph_router(F, l, (pflags & 4) != 0); } \
    SEAM(PH); \
    if (IN(PH + 1)) { moe_table(F, l); \
        pg8::GemmP g{(const char*)(ws + WS_X8), 1024, 2048u, 32u, 2048u}; \
        MoeSched<false> S{F.MISC, F.G, F.vcu, (const char*)(ws + WSW), (const char*)(ws + WSW + 16 * MiB), nullptr, (const int*)(ws + WS_PTOK)}; \
        EpiGateUp E{ws + WS_H, (const float*)(ws + WS_PRSTD), (const float*)(ws + WS_PGA), (const float*)(ws + WS_PGB), F.MISC, pflags}; \
        pg8::gemm_phase<EpiGateUp, MoeSched<false>, true, false, true>(F.lds, g, S, E); \
        moe1_tail_convert(F, (l == 0) ? 0 : 2); } \
    SEAM(PH + 1); \
    if (IN(PH + 2)) { moe_table(F, l); \
        pg8::GemmP g{nullptr, 512, 1024u, 32u, 512u}; \
        MoeSched<true> S{F.MISC, F.G, F.vcu, (const char*)(ws + WSW + 32 * MiB), nullptr, (const char*)(ws + WS_H), nullptr}; \
        EpiDownRes E{XB, (const int*)(ws + WS_PTOK), F.MISC, (pflags & 4) ? (bf16*)(ws + 712 * MiB) : XB, nullptr, pflags}; \
        pg8::gemm_phase<EpiDownRes, MoeSched<true>, false, true, true>(F.lds, g, S, E); \
        if (l == 0) moe1_tail_convert(F, 1); } \
    SEAM(PH + 2); \
    if (IN(PH + 3)) { ph_rowpass(F, l, (pflags & 4) != 0); }
    MOE_LAYER(6, 0, WS_WMOE0)
    SEAM(10);
    if (IN(10)) {
        pg8::GemmP g{nullptr, 1024, 2048u, 32u, 2048u};
        DenseSched S; S.to.init(T / 256, D / 256, F.G, bx); S.A = (const char*)(ws + WS_X8); S.tstepA = (size_t)256 * 2048; S.B0 = (const char*)(ws + WS_WS5IN); S.B1 = S.B0 + (size_t)128 * 2048; S.tstepB = (size_t)256 * 2048; S.cpt = 256;
        EpiS5U E{(bf16*)(ws + WS_A2), RSTD, 1.0f / (F8_SX * F8_SW)};
        pg8::gemm_phase<EpiS5U, DenseSched, false, false, true>(F.lds, g, S, E);
    }
    SEAM(9);
    if (IN(11)) { ph_s5core(F, pflags); }
    SEAM(12);
    if (IN(13)) {
        pg8::GemmP g{nullptr, 1024, 32u, 8192u, 2048u};
        DenseSched S; S.to.init(T / 256, D / 128, F.G, bx); S.A = (const char*)Yb; S.tstepA = (size_t)64 * 8192; S.B0 = (const char*)(ws + WS_WGLUV); S.B1 = (const char*)(ws + WS_WGLUG); S.tstepB = (size_t)128 * 2048; S.cpt = 128;
        EpiGlu E{(pflags & 4) ? (bf16*)(ws + 712 * MiB) : XB, ws + ((pflags & 4) ? 776 * MiB : WS_X8)};
        pg8::gemm_phase<EpiGlu, DenseSched, false, false, true>(F.lds, g, S, E);
    }
    SEAM(13);
    MOE_LAYER(14, 1, WS_WMOE1)
#undef IN
#undef SEAM
}

extern "C" void kernel_launch(void* const* d_in, const int* in_sizes, int n_in, void* d_out, int out_size, void* d_ws, size_t ws_size, hipStream_t stream) {
    static int grid = 0;
    if (grid == 0) {
        if (n_in != 36 || in_sizes[0] != T * D || out_size != T * D || ws_size < WS_END) { fprintf(stderr, "kernel_launch: unexpected shapes (n_in %d, in0 %d, out %d, ws %zu < %zu); nothing launched\n", n_in, n_in > 0 ? in_sizes[0] : -1, out_size, ws_size, (size_t)WS_END); grid = -1; return; }
        int dev = 0, cus = 0, per_cu = 0;
        if (hipGetDevice(&dev) != hipSuccess || hipDeviceGetAttribute(&cus, hipDeviceAttributeMultiprocessorCount, dev) != hipSuccess) { grid = -1; return; }
        if (hipFuncSetAttribute((const void*)fwd, hipFuncAttributeMaxDynamicSharedMemorySize, LDS_BYTES) != hipSuccess) { fprintf(stderr, "kernel_launch: hipFuncSetAttribute failed\n"); grid = -1; return; }
        if (hipOccupancyMaxActiveBlocksPerMultiprocessor(&per_cu, (const void*)fwd, NT, LDS_BYTES) != hipSuccess || per_cu < 1) fprintf(stderr, "kernel_launch: occupancy query says %d\n", per_cu);
        (void)hipGetLastError();
        grid = cus;
    }
    if (grid < 0) return;
    (void)hipMemsetAsync((char*)d_ws + WS_CTL, 0, CTL_ZERO_BYTES, stream);
    Args a{};
    for (int i = 0; i < 36; ++i) a.in[i] = (const float*)d_in[i];
    a.out = (float*)d_out; a.ws = (unsigned char*)d_ws;
#if MK_PER_PHASE
    for (int ph = 0; ph < NPHASE; ++ph) { a.ph_lo = ph; a.ph_hi = ph + 1; hipLaunchKernelGGL(fwd, dim3(grid), dim3(NT), LDS_BYTES, stream, a);
#ifdef REPEAT_PHASE
        if (ph == REPEAT_PHASE) {
#ifdef REPEAT_FLAGS
            a.ph_lo = ph | (REPEAT_FLAGS << 8);
#endif
            hipLaunchKernelGGL(fwd, dim3(grid), dim3(NT), LDS_BYTES, stream, a); }
#endif
    }
#else
    a.ph_lo = 0; a.ph_hi = NPHASE;
    hipLaunchKernelGGL(fwd, dim3(grid), dim3(NT), LDS_BYTES, stream, a);
#endif
    const hipError_t le = hipPeekAtLastError();
    if (le != hipSuccess) fprintf(stderr, "kernel_launch: launch failed: %s\n", hipGetErrorName(le));
}
```
